# Optimizing an MI355X kernel written in HIP

```python
import math
import jax, jax.numpy as jnp
from jax import lax
import numpy as np


D_MODEL = 1024
BATCH = 8
SEQ = 8192
DEPTH = 4

GRID_W = 64
CTX_LEN = 256
N_MIXERS = 3
N_A = (DEPTH + 2) // 3
N_B = (DEPTH + 1) // 3
N_C = DEPTH // 3
Q_BLOCK = 128
RMS_EPS = 1e-6
ROPE_BASE = 10000.0

DA_HEADS = 8
DA_HEAD_DIM = 64
DA_V_DIM = 2 * DA_HEAD_DIM
DA_KW = DA_HEADS * 2 * DA_HEAD_DIM
DA_VW = DA_HEADS * DA_V_DIM
DA_QW = DA_KW
DA_IN = DA_KW + DA_VW + DA_QW

RET_HEADS = 4
RET_KDIM = D_MODEL // RET_HEADS
RET_VDIM = 2 * RET_KDIM
RET_CHUNK = 128
RET_KW = RET_HEADS * RET_KDIM
RET_VW = RET_HEADS * RET_VDIM
RET_IN = 2 * RET_KW + 2 * RET_VW

MLA_HEADS = 8
MLA_NOPE = 128
MLA_ROPE = 64
MLA_V = 128
MLA_Q_RANK = 256
MLA_KV_RANK = 128
MLA_IN = MLA_KV_RANK + MLA_ROPE + MLA_Q_RANK

N_EXPERTS = 32
TOP_K = 4
D_EXPERT = 1024
SWIGLU_LIMIT = 7.0
SWIGLU_ALPHA = 1.702
MOE_BLOCK = 512

kernel_name = 'hybrid_diffattn_retention_mla_moe_dit'


def rms_norm(x, gain=None):
    xf = x.astype(jnp.float32)
    y = xf * lax.rsqrt(jnp.mean(xf * xf, axis=-1, keepdims=True) + RMS_EPS)
    if gain is not None:
        y = y * gain.astype(jnp.float32)
    return y.astype(x.dtype)


def modulate(h, shift, scale):
    return h * (1.0 + scale) + shift


def adaln(cond, w, b, n_chunks):
    width = n_chunks * D_MODEL
    m = jax.nn.silu(cond) @ w[:, :width] + b[:width]
    return jnp.split(m, n_chunks, axis=-1)


def rope_angles(pos, dim):
    inv_freq = ROPE_BASE ** (-jnp.arange(0, dim, 2, dtype=jnp.float32) / dim)
    return pos.astype(jnp.float32)[:, None] * inv_freq[None, :]


def apply_rotary(x, ang):
    xf = x.astype(jnp.float32)
    x1, x2 = jnp.split(xf, 2, axis=-1)
    cos = jnp.cos(ang)[None, :, None, :]
    sin = jnp.sin(ang)[None, :, None, :]
    return jnp.concatenate([x1 * cos - x2 * sin, x1 * sin + x2 * cos], axis=-1).astype(x.dtype)


def axial_rope(x, rows, cols):
    half = x.shape[-1] // 2
    return jnp.concatenate([apply_rotary(x[..., :half], rope_angles(rows, half)),
                            apply_rotary(x[..., half:], rope_angles(cols, half))], axis=-1)


def to_query_blocks(a):
    b, t = a.shape[:2]
    return jnp.swapaxes(a.reshape(b, t // Q_BLOCK, Q_BLOCK, *a.shape[2:]), 0, 1)


def from_query_blocks(a):
    a = jnp.swapaxes(a, 0, 1)
    return a.reshape(a.shape[0], -1, *a.shape[3:])


def softmax_attend(q, k, v, scale):
    s = jnp.einsum('bqhd,bkhd->bhqk', q, k).astype(jnp.float32) * scale
    p = jax.nn.softmax(s, axis=-1).astype(v.dtype)
    return jnp.einsum('bhqk,bkhv->bqhv', p, v)


def diff_attention(h_lat, h_ctx, w_in, w_out, lam_vecs, subln_g, lam_init, rows, cols, need_ctx):
    def split_kv(p):
        b, t, _ = p.shape
        k = p[..., :DA_KW].reshape(b, t, DA_HEADS, 2, DA_HEAD_DIM)
        v = p[..., DA_KW:DA_KW + DA_VW].reshape(b, t, DA_HEADS, DA_V_DIM)
        return k, v

    def as_q(p):
        b, t, _ = p.shape
        return p.reshape(b, t, DA_HEADS, 2, DA_HEAD_DIM)

    def rope(a):
        b, t = a.shape[:2]
        return axial_rope(a.reshape(b, t, 2 * DA_HEADS, DA_HEAD_DIM), rows, cols).reshape(a.shape)

    lf = lam_vecs.astype(jnp.float32)
    lam = jnp.exp(jnp.sum(lf[0] * lf[1])) - jnp.exp(jnp.sum(lf[2] * lf[3])) + lam_init
    scale = DA_HEAD_DIM ** -0.5

    def attend(q, k, v):
        s = jnp.einsum('bqhmd,bkhmd->bhmqk', q, k).astype(jnp.float32) * scale
        p = jax.nn.softmax(s, axis=-1)
        a = (p[:, :, 0] - lam * p[:, :, 1]).astype(v.dtype)
        return jnp.einsum('bhqk,bkhv->bqhv', a, v)

    def finish(o):
        b, t = o.shape[:2]
        o = rms_norm(o, subln_g) * (1.0 - lam_init)
        return o.reshape(b, t, DA_VW) @ w_out

    p_lat = h_lat @ w_in
    k_lat, v_lat = split_kv(p_lat)
    k_lat = rope(k_lat)
    q_lat = rope(as_q(p_lat[..., DA_KW + DA_VW:]))
    k_ctx, v_ctx = split_kv(h_ctx @ w_in[:, :DA_KW + DA_VW])
    k_all = jnp.concatenate([k_ctx, k_lat], axis=1)
    v_all = jnp.concatenate([v_ctx, v_lat], axis=1)
    o_lat = from_query_blocks(lax.map(lambda qb: attend(qb, k_all, v_all), to_query_blocks(q_lat)))
    y_lat = finish(o_lat)
    y_ctx = None
    if need_ctx:
        q_ctx = as_q(h_ctx @ w_in[:, DA_KW + DA_VW:])
        y_ctx = finish(attend(q_ctx, k_ctx, v_ctx))
    return y_lat, y_ctx


def retention_chunkwise(q, k, v, log_gamma, state0):
    b, h, t, _ = q.shape
    n = t // RET_CHUNK
    pos = jnp.arange(RET_CHUNK, dtype=jnp.float32)
    diff = pos[:, None] - pos[None, :]
    lower = diff >= 0
    intra = jnp.where(lower[None], jnp.exp(jnp.where(lower, diff, 0.0)[None] * log_gamma[:, None, None]), 0.0)
    q_dec = jnp.exp((pos[None, :] + 1.0) * log_gamma[:, None])
    k_dec = jnp.exp((RET_CHUNK - 1.0 - pos[None, :]) * log_gamma[:, None])
    chunk_dec = jnp.exp(RET_CHUNK * log_gamma)[None, :, None, None]

    def chunks(a):
        return jnp.moveaxis(a.reshape(b, h, n, RET_CHUNK, a.shape[-1]), 2, 0)

    def step(state, blk):
        qb, kb, vb = blk
        s = jnp.einsum('bhid,bhjd->bhij', qb, kb) * intra
        o = jnp.einsum('bhij,bhjv->bhiv', s, vb) + jnp.einsum('bhid,bhdv->bhiv', qb * q_dec[..., None], state)
        state = chunk_dec * state + jnp.einsum('bhjd,bhjv->bhdv', kb * k_dec[..., None], vb)
        return state, o

    _, o = lax.scan(step, state0, (chunks(q), chunks(k), chunks(v)))
    return jnp.moveaxis(o, 0, 2).reshape(b, h, t, -1)


def retention(h_lat, h_ctx, w_in, w_out, decay_logit, need_ctx):
    log_gamma = jax.nn.log_sigmoid(decay_logit.astype(jnp.float32))
    k_scale = RET_KDIM ** -0.5

    def split_heads(a, dim):
        b, t, _ = a.shape
        return a.reshape(b, t, RET_HEADS, dim)

    def to_bhtd(a):
        return jnp.swapaxes(a, 1, 2).astype(jnp.float32)

    def rev(a):
        return jnp.flip(a, axis=2)

    def bidirectional(q, k, v, s_fwd, s_bwd):
        o_f = retention_chunkwise(q, k, v, log_gamma[0], s_fwd)
        o_b = rev(retention_chunkwise(rev(q), rev(k), rev(v), log_gamma[1], s_bwd))
        return o_f + o_b

    def finish(o, g):
        o = rms_norm(jnp.swapaxes(o, 1, 2))
        b, t = o.shape[:2]
        return (jax.nn.silu(g) * o.reshape(b, t, RET_VW).astype(g.dtype)) @ w_out

    p_ctx = h_ctx @ (w_in if need_ctx else w_in[:, :RET_KW + RET_VW])
    k_c = to_bhtd(split_heads(p_ctx[..., :RET_KW], RET_KDIM)) * k_scale
    v_c = to_bhtd(split_heads(p_ctx[..., RET_KW:RET_KW + RET_VW], RET_VDIM))
    pos_c = jnp.arange(k_c.shape[2], dtype=jnp.float32)
    w_fwd = jnp.exp((pos_c[-1] - pos_c)[None, :] * log_gamma[0][:, None])
    w_bwd = jnp.exp(pos_c[None, :] * log_gamma[1][:, None])
    s_fwd = jnp.einsum('bhtd,bhtv->bhdv', k_c * w_fwd[None, :, :, None], v_c)
    s_bwd = jnp.einsum('bhtd,bhtv->bhdv', k_c * w_bwd[None, :, :, None], v_c)

    p_lat = h_lat @ w_in
    ang = rope_angles(jnp.arange(p_lat.shape[1]), RET_KDIM)
    k_l = to_bhtd(apply_rotary(split_heads(p_lat[..., :RET_KW], RET_KDIM), ang)) * k_scale
    v_l = to_bhtd(split_heads(p_lat[..., RET_KW:RET_KW + RET_VW], RET_VDIM))
    q_l = to_bhtd(apply_rotary(split_heads(p_lat[..., RET_KW + RET_VW:2 * RET_KW + RET_VW], RET_KDIM), ang))
    y_lat = finish(bidirectional(q_l, k_l, v_l, s_fwd, s_bwd), p_lat[..., 2 * RET_KW + RET_VW:])
    y_ctx = None
    if need_ctx:
        q_c = to_bhtd(split_heads(p_ctx[..., RET_KW + RET_VW:2 * RET_KW + RET_VW], RET_KDIM))
        zero = jnp.zeros_like(s_fwd)
        y_ctx = finish(bidirectional(q_c, k_c, v_c, zero, zero), p_ctx[..., 2 * RET_KW + RET_VW:])
    return y_lat, y_ctx


def mla(h_lat, h_ctx, w_in, q_norm_g, w_q_up, kv_norm_g, w_kv_up, w_out, rows, cols, need_ctx):
    kvw = MLA_KV_RANK + MLA_ROPE
    scale = (MLA_NOPE + MLA_ROPE) ** -0.5

    def keys_values(p, positioned):
        b, t, _ = p.shape
        c_kv = rms_norm(p[..., :MLA_KV_RANK], kv_norm_g)
        kv = (c_kv @ w_kv_up).reshape(b, t, MLA_HEADS, MLA_NOPE + MLA_V)
        k_rope = p[..., MLA_KV_RANK:kvw].reshape(b, t, 1, MLA_ROPE)
        if positioned:
            k_rope = axial_rope(k_rope, rows, cols)
        k = jnp.concatenate([kv[..., :MLA_NOPE], jnp.broadcast_to(k_rope, (b, t, MLA_HEADS, MLA_ROPE))], axis=-1)
        return k, kv[..., MLA_NOPE:]

    def queries(p, positioned):
        b, t, _ = p.shape
        q = (rms_norm(p, q_norm_g) @ w_q_up).reshape(b, t, MLA_HEADS, MLA_NOPE + MLA_ROPE)
        if positioned:
            q = jnp.concatenate([q[..., :MLA_NOPE], axial_rope(q[..., MLA_NOPE:], rows, cols)], axis=-1)
        return q

    def finish(o):
        b, t = o.shape[:2]
        return o.reshape(b, t, MLA_HEADS * MLA_V) @ w_out

    p_lat = h_lat @ w_in
    k_lat, v_lat = keys_values(p_lat, True)
    q_lat = queries(p_lat[..., kvw:], True)
    p_ctx = h_ctx @ (w_in if need_ctx else w_in[:, :kvw])
    k_ctx, v_ctx = keys_values(p_ctx, False)
    k_all = jnp.concatenate([k_ctx, k_lat], axis=1)
    v_all = jnp.concatenate([v_ctx, v_lat], axis=1)
    o_lat = from_query_blocks(lax.map(lambda qb: softmax_attend(qb, k_all, v_all, scale), to_query_blocks(q_lat)))
    y_lat = finish(o_lat)
    y_ctx = None
    if need_ctx:
        y_ctx = finish(softmax_attend(queries(p_ctx[..., kvw:], False), k_ctx, v_ctx, scale))
    return y_lat, y_ctx


def moe_ffn(h, w_router, b_router, w_gate_up, b_gate_up, w_down, b_down):
    n_tok = h.shape[0]
    logits = (h @ w_router).astype(jnp.float32) + b_router.astype(jnp.float32)
    top_logit, top_idx = lax.top_k(logits, TOP_K)
    gates = jax.nn.softmax(top_logit, axis=-1)
    n_assign = n_tok * TOP_K
    e_flat = top_idx.reshape(-1)
    tok_flat = jnp.arange(n_assign, dtype=jnp.int32) // TOP_K
    order = jnp.argsort(e_flat)
    e_sorted = e_flat[order]
    counts = jnp.bincount(e_flat, length=N_EXPERTS)
    starts = jnp.cumsum(counts) - counts
    padded = (counts + MOE_BLOCK - 1) // MOE_BLOCK * MOE_BLOCK
    pad_end = jnp.cumsum(padded)
    pad_start = pad_end - padded
    slot = pad_start[e_sorted] + jnp.arange(n_assign) - starts[e_sorted]
    n_blocks = n_assign // MOE_BLOCK + N_EXPERTS
    n_slots = n_blocks * MOE_BLOCK
    slot_tok = jnp.zeros((n_slots,), jnp.int32).at[slot].set(tok_flat[order])
    slot_gate = jnp.zeros((n_slots,), jnp.float32).at[slot].set(gates.reshape(-1)[order])
    block_expert = jnp.minimum(jnp.searchsorted(pad_end, jnp.arange(n_blocks) * MOE_BLOCK, side='right'), N_EXPERTS - 1)

    def expert_block(args):
        toks, e = args
        gu = h[toks] @ w_gate_up[e] + b_gate_up[e]
        glu = jnp.minimum(gu[:, :D_EXPERT], SWIGLU_LIMIT)
        lin = jnp.clip(gu[:, D_EXPERT:], -SWIGLU_LIMIT, SWIGLU_LIMIT)
        act = glu * jax.nn.sigmoid(SWIGLU_ALPHA * glu) * (lin + 1.0)
        return act @ w_down[e] + b_down[e]

    y = lax.map(expert_block, (slot_tok.reshape(n_blocks, MOE_BLOCK), block_expert))
    y = y.reshape(n_slots, -1) * slot_gate[:, None].astype(y.dtype)
    return jax.ops.segment_sum(y, slot_tok, num_segments=n_tok)


def setup_inputs(seed: int = 0) -> dict:
    key = jax.random.key(seed)
    ks = jax.random.split(key, 27)
    f32 = jnp.float32
    D = D_MODEL

    def nrm(k, shape, scale):
        return jax.random.normal(k, shape, f32) * scale

    ret_logit0 = jnp.log(2.0 ** (5.0 + jnp.arange(RET_HEADS, dtype=f32)) - 1.0)
    return {
        'x': nrm(ks[0], (BATCH, SEQ, D), 1.0),
        'c': nrm(ks[1], (BATCH, D), 1.0),
        'ctx': nrm(ks[2], (BATCH, CTX_LEN, D), 1.0),
        'c_ctx': nrm(ks[3], (D,), 1.0),
        'ada_w': nrm(ks[4], (DEPTH, D, 6 * D), 0.5 * D ** -0.5),
        'ada_b': nrm(ks[5], (DEPTH, 6 * D), 0.01),
        'norm_g': 1.0 + nrm(ks[6], (DEPTH, 2, D), 0.1),
        'final_g': 1.0 + nrm(ks[7], (D,), 0.1),
        'da_w_in': nrm(ks[8], (N_A, D, DA_IN), D ** -0.5),
        'da_w_out': nrm(ks[9], (N_A, DA_VW, D), DA_VW ** -0.5),
        'da_lambda': nrm(ks[10], (N_A, 4, DA_HEAD_DIM), 0.1),
        'da_subln_g': 1.0 + nrm(ks[11], (N_A, DA_V_DIM), 0.1),
        'ret_w_in': nrm(ks[12], (N_B, D, RET_IN), D ** -0.5),
        'ret_decay_logit': ret_logit0[None, None, :] + nrm(ks[13], (N_B, 2, RET_HEADS), 0.1),
        'ret_w_out': nrm(ks[14], (N_B, RET_VW, D), RET_VW ** -0.5),
        'mla_w_in': nrm(ks[15], (N_C, D, MLA_IN), D ** -0.5),
        'mla_q_norm_g': 1.0 + nrm(ks[16], (N_C, MLA_Q_RANK), 0.1),
        'mla_w_q_up': nrm(ks[17], (N_C, MLA_Q_RANK, MLA_HEADS * (MLA_NOPE + MLA_ROPE)), MLA_Q_RANK ** -0.5),
        'mla_kv_norm_g': 1.0 + nrm(ks[18], (N_C, MLA_KV_RANK), 0.1),
        'mla_w_kv_up': nrm(ks[19], (N_C, MLA_KV_RANK, MLA_HEADS * (MLA_NOPE + MLA_V)), MLA_KV_RANK ** -0.5),
        'mla_w_out': nrm(ks[20], (N_C, MLA_HEADS * MLA_V, D), (MLA_HEADS * MLA_V) ** -0.5),
        'moe_w_router': nrm(ks[21], (DEPTH, D, N_EXPERTS), D ** -0.5),
        'moe_b_router': nrm(ks[22], (DEPTH, N_EXPERTS), 0.01),
        'moe_w_gate_up': nrm(ks[23], (DEPTH, N_EXPERTS, D, 2 * D_EXPERT), D ** -0.5),
        'moe_b_gate_up': nrm(ks[24], (DEPTH, N_EXPERTS, 2 * D_EXPERT), 0.01),
        'moe_w_down': nrm(ks[25], (DEPTH, N_EXPERTS, D_EXPERT, D), D_EXPERT ** -0.5),
        'moe_b_down': nrm(ks[26], (DEPTH, N_EXPERTS, D), 0.01),
    }


def reference(x, c, ctx, c_ctx, ada_w, ada_b, norm_g, final_g, da_w_in, da_w_out, da_lambda, da_subln_g,
              ret_w_in, ret_decay_logit, ret_w_out, mla_w_in, mla_q_norm_g, mla_w_q_up, mla_kv_norm_g,
              mla_w_kv_up, mla_w_out, moe_w_router, moe_b_router, moe_w_gate_up, moe_b_gate_up,
              moe_w_down, moe_b_down):
    b, seq, _ = x.shape
    n_rows = seq // GRID_W
    rows = jnp.repeat(jnp.arange(n_rows), GRID_W)
    cols = jnp.tile(jnp.arange(GRID_W), n_rows)
    x_ctx = ctx
    for i in range(DEPTH):
        last = i == DEPTH - 1
        kind = i % N_MIXERS
        j = i // N_MIXERS
        mod_lat = [m[:, None, :] for m in adaln(c, ada_w[i], ada_b[i], 6)]
        mod_ctx = adaln(c_ctx, ada_w[i], ada_b[i], 2 if last else 6)
        h_lat = modulate(rms_norm(x, norm_g[i, 0]), mod_lat[0], mod_lat[1])
        h_ctx = modulate(rms_norm(x_ctx, norm_g[i, 0]), mod_ctx[0], mod_ctx[1])
        if kind == 0:
            lam_init = 0.8 - 0.6 * math.exp(-0.3 * i)
            y_lat, y_ctx = diff_attention(h_lat, h_ctx, da_w_in[j], da_w_out[j], da_lambda[j], da_subln_g[j],
                                          lam_init, rows, cols, not last)
        elif kind == 1:
            y_lat, y_ctx = retention(h_lat, h_ctx, ret_w_in[j], ret_w_out[j], ret_decay_logit[j], not last)
        else:
            y_lat, y_ctx = mla(h_lat, h_ctx, mla_w_in[j], mla_q_norm_g[j], mla_w_q_up[j], mla_kv_norm_g[j],
                               mla_w_kv_up[j], mla_w_out[j], rows, cols, not last)
        x = x + mod_lat[2] * y_lat
        h_lat = modulate(rms_norm(x, norm_g[i, 1]), mod_lat[3], mod_lat[4]).reshape(b * seq, D_MODEL)
        if last:
            f_lat = moe_ffn(h_lat, moe_w_router[i], moe_b_router[i], moe_w_gate_up[i], moe_b_gate_up[i],
                            moe_w_down[i], moe_b_down[i])
        else:
            x_ctx = x_ctx + mod_ctx[2] * y_ctx
            h_ctx = modulate(rms_norm(x_ctx, norm_g[i, 1]), mod_ctx[3], mod_ctx[4])
            n_ctx = b * h_ctx.shape[1]
            f = moe_ffn(jnp.concatenate([h_ctx.reshape(n_ctx, D_MODEL), h_lat], axis=0), moe_w_router[i],
                        moe_b_router[i], moe_w_gate_up[i], moe_b_gate_up[i], moe_w_down[i], moe_b_down[i])
            x_ctx = x_ctx + mod_ctx[5] * f[:n_ctx].reshape(x_ctx.shape)
            f_lat = f[n_ctx:]
        x = x + mod_lat[5] * f_lat.reshape(b, seq, D_MODEL)
    return rms_norm(x, final_g)
```

```cpp
#include <hip/hip_runtime.h>
#include <cstdio>
#include <cstdint>

#ifndef MK_MULTI
#define MK_MULTI 1
#endif

#define LAS __attribute__((address_space(3)))
typedef unsigned short bf16_t;
typedef short bf16x8 __attribute__((ext_vector_type(8)));
typedef short s16x4 __attribute__((ext_vector_type(4)));
typedef float f32x4 __attribute__((ext_vector_type(4)));
typedef float f32x2 __attribute__((ext_vector_type(2)));
typedef float f32x16 __attribute__((ext_vector_type(16)));
typedef unsigned u32x4 __attribute__((ext_vector_type(4)));
typedef unsigned u32x2 __attribute__((ext_vector_type(2)));

constexpr int DM = 1024, NB = 8, SEQ = 8192, CTX = 256, TB = SEQ + CTX, T = NB * TB;
constexpr int NTILES = T / 256, TPB = TB / 256;
constexpr int NEXP = 32, TOPK = 4;
constexpr int GRID = 256, NTHR = 512, TOK_PER_BLK = T / GRID;
constexpr int MOE_MAXTILES = (T * TOPK) / 256 + NEXP;
constexpr float RMS_EPS = 1e-6f;
constexpr int LDS_BYTES = 144 * 1024, MISC_BYTES = 1024, REG_OFF = MISC_BYTES;

constexpr size_t AL(size_t x) { return (x + 255) / 256 * 256; }
constexpr size_t WS_CTL = 0, CTL_BYTES = 1u << 20;
constexpr size_t WS_MOD = WS_CTL + CTL_BYTES;
constexpr size_t WS_TABA = WS_MOD + AL((size_t)4 * 9 * 6144 * 4);
constexpr size_t WS_TABR = WS_TABA + AL(128 * 16 * 8);
constexpr size_t WS_BLKCNT = WS_TABR + AL((size_t)8192 * 128 * 8);
constexpr size_t WS_IDX = WS_BLKCNT + AL(256 * 32 * 4);
constexpr size_t WS_GATE = WS_IDX + AL((size_t)T * 16);
constexpr size_t WS_RANK = WS_GATE + AL((size_t)T * 16);
constexpr size_t WS_SLOT = WS_RANK + AL((size_t)T * 16);
constexpr size_t WS_W_DA_IN = WS_SLOT + AL((size_t)T * 16);
constexpr size_t WS_W_DA_OUT = WS_W_DA_IN + (size_t)2 * 3072 * 1024 * 2;
constexpr size_t WS_W_RET_IN = WS_W_DA_OUT + (size_t)2 * 1024 * 1024 * 2;
constexpr size_t WS_W_RET_OUT = WS_W_RET_IN + (size_t)6144 * 1024 * 2;
constexpr size_t WS_W_MLA_IN = WS_W_RET_OUT + (size_t)1024 * 2048 * 2;
constexpr size_t WS_W_MLA_QUP = WS_W_MLA_IN + (size_t)512 * 1024 * 2;
constexpr size_t WS_W_MLA_KVUP = WS_W_MLA_QUP + (size_t)1536 * 256 * 2;
constexpr size_t WS_W_MLA_OUT = WS_W_MLA_KVUP + (size_t)2048 * 256 * 2;
constexpr size_t WS_W_GU = WS_W_MLA_OUT + (size_t)1024 * 1024 * 2;
constexpr size_t WS_W_DN = WS_W_GU + (size_t)128 * 2048 * 1024 * 2;
constexpr size_t WS_XRES = WS_W_DN + (size_t)128 * 1024 * 1024 * 2;
constexpr size_t WS_HBUF = WS_XRES + (size_t)T * 1024 * 4;
constexpr size_t WS_BIG = WS_HBUF + (size_t)T * 1024 * 2;
constexpr size_t ROW1K = (size_t)T * 1024 * 2;
constexpr size_t DA_K = WS_BIG, DA_V = DA_K + ROW1K, DA_Q = DA_V + ROW1K, DA_O = DA_Q + ROW1K  , DA_O2 = DA_O + 2 * ROW1K, DA_END = DA_O2 + ROW1K;
constexpr size_t RT_K = WS_BIG, RT_V = RT_K + ROW1K  , RT_Q = RT_V + 2 * ROW1K, RT_G = RT_Q + ROW1K  , RT_OF = RT_G + 2 * ROW1K, RT_OB = RT_OF + 2 * ROW1K,
                 RT_A = RT_OB + 2 * ROW1K, RT_END = RT_A + 2 * ROW1K;
constexpr size_t ML_P = WS_BIG  , ML_AKV = ML_P + ROW1K  , ML_AQ = ML_AKV + ROW1K / 4, ML_Q = ML_AQ + ROW1K / 4  , ML_K = ML_Q + ROW1K * 3 / 2,
                 ML_V = ML_K + ROW1K * 3 / 2, ML_O = ML_V + ROW1K, ML_END = ML_O + ROW1K;
constexpr size_t MOE_ROWS = (size_t)MOE_MAXTILES * 256;
constexpr size_t MO_HS = WS_BIG, MO_ACT = MO_HS + MOE_ROWS * 2048, MO_OUT = MO_ACT + MOE_ROWS * 2048, MO_END = MO_OUT + MOE_ROWS * 2048;
constexpr size_t cmax(size_t a, size_t b) { return a > b ? a : b; }
constexpr size_t WS_END = cmax(cmax(DA_END, RT_END), cmax(ML_END, MO_END));

__device__ __forceinline__ float wave_sum(float v) {
#pragma unroll
    for (int o = 1; o < 64; o <<= 1) v += __shfl_xor(v, o);
    return v;
}
__device__ __forceinline__ unsigned pk2(float lo, float hi) { unsigned r; asm volatile("v_cvt_pk_bf16_f32 %0, %1, %2" : "=v"(r) : "v"(lo), "v"(hi)); return r; }
__device__ __forceinline__ float bflo(unsigned w) { return __uint_as_float(w << 16); }
__device__ __forceinline__ float bfhi(unsigned w) { return __uint_as_float(w & 0xffff0000u); }
__device__ __forceinline__ float bf2f(bf16_t h) { return __uint_as_float((unsigned)h << 16); }
__device__ __forceinline__ bf16_t f2bf(float f) { return (bf16_t)(pk2(f, 0.f) & 0xffffu); }
__device__ __forceinline__ bf16_t f2bf_c(float f) { unsigned u = __float_as_uint(f); u += 0x7fffu + ((u >> 16) & 1u); return (bf16_t)(u >> 16); }

#define XB_TMO      128
#define XB_XCNT(j)  (256  + 64 * (j))
#define XB_XSUB(j)  (1280 + 64 * (j))
#define XB_XGEN(j)  (2304 + 64 * (j))
#define XB_TOP      3328
#define XB_TOPGEN   3392
#define XCD_BAR_WORDS 3456
#define XB_SPIN_CAP (1u << 22)
__device__ __forceinline__ unsigned xb_ld(unsigned* p)              { return __hip_atomic_load(p, __ATOMIC_RELAXED, __HIP_MEMORY_SCOPE_AGENT); }
__device__ __forceinline__ unsigned xb_add(unsigned* p, unsigned v) { return __hip_atomic_fetch_add(p, v, __ATOMIC_RELAXED, __HIP_MEMORY_SCOPE_AGENT); }
__device__ __forceinline__ unsigned xb_xcc_id() { return (unsigned)__builtin_amdgcn_s_getreg((3 << 11) | 20) & 0xFu; }
#define XB_SPIN(cond, bar) do { unsigned _sp = 0; while (cond) { __builtin_amdgcn_s_sleep(1); \
    if ((++_sp & 255u) == 0u) { if (xb_ld(&(bar)[XB_TMO])) break; if (_sp > XB_SPIN_CAP) { atomicAdd(&(bar)[XB_TMO], 1u); break; } } } } while (0)
struct XcdBarrier { unsigned* bar; unsigned x; volatile LAS unsigned* st; };
__device__ __forceinline__ XcdBarrier xcd_barrier_post(unsigned* bar, volatile LAS unsigned* st) {
    XcdBarrier b; b.bar = bar; b.x = xb_xcc_id(); b.st = st;
    if (threadIdx.x == 0) (void)xb_add(&bar[XB_XCNT(b.x)], 1u);
    return b;
}
__device__ __forceinline__ void xcd_barrier_complete(unsigned* bar, unsigned x, unsigned& nloc, unsigned& nx) {
    const unsigned G = gridDim.x * gridDim.y * gridDim.z;
    unsigned sum, cnt, mine, sp = 0u;
    for (;;) {
        sum = 0u; cnt = 0u; mine = 0u;
#pragma unroll
        for (unsigned j = 0; j < 16; ++j) { const unsigned c = xb_ld(&bar[XB_XCNT(j)]); sum += c; cnt += (c > 0u) ? 1u : 0u; mine = (j == x) ? c : mine; }
        if (sum == G) break;
        __builtin_amdgcn_s_sleep(1);
        if ((++sp & 255u) == 0u) { if (xb_ld(&bar[XB_TMO])) break; if (sp > XB_SPIN_CAP) { atomicAdd(&bar[XB_TMO], 1u); break; } }
    }
    nloc = mine > 0u ? mine : 1u; nx = cnt > 0u ? cnt : 1u;
}
__device__ __forceinline__ void xcd_barrier(const XcdBarrier& b) {
    asm volatile("s_waitcnt vmcnt(0)" ::: "memory");
    __syncthreads();
    if (threadIdx.x == 0) {
        unsigned* bar = b.bar;
        __builtin_amdgcn_s_waitcnt(0);
        unsigned nloc = b.st[0], nx = b.st[1];
        if (nloc == 0u) { xcd_barrier_complete(bar, b.x, nloc, nx); b.st[0] = nloc; b.st[1] = nx; }
        const unsigned old = xb_add(&bar[XB_XSUB(b.x)], 1u);
        const unsigned gen = old / nloc;
        if (old + 1u == (gen + 1u) * nloc) {
            __builtin_amdgcn_fence(__ATOMIC_RELEASE, "agent");
            asm volatile("s_waitcnt vmcnt(0)" ::: "memory");
            const unsigned og = xb_add(&bar[XB_TOP], 1u);
            const unsigned tg = og / nx;
            if (og + 1u == (tg + 1u) * nx) xb_add(&bar[XB_TOPGEN], 1u);
            else XB_SPIN(xb_ld(&bar[XB_TOPGEN]) == tg, bar);
            __builtin_amdgcn_fence(__ATOMIC_ACQUIRE, "agent");
            xb_add(&bar[XB_XGEN(b.x)], 1u);
            asm volatile("s_waitcnt vmcnt(0)" ::: "memory");
        } else {
            XB_SPIN(xb_ld(&bar[XB_XGEN(b.x)]) == gen, bar);
            __builtin_amdgcn_fence(__ATOMIC_ACQUIRE, "agent");
            asm volatile("s_waitcnt vmcnt(0)" ::: "memory");
        }
    }
    __syncthreads();
}

namespace pg8 {
constexpr int BM = 256, BK = 64, HALF = 128, HTB = HALF * BK * 2, STAGE_BYTES = 8 * HTB, NXCD = 8, WGM = 8;
__host__ __device__ __forceinline__ int lds_byte(int r, int c) { const int st = (r >> 4) * 2 + (c >> 5), rr = r & 15, cc = c & 31, ob = rr * 64 + cc * 2; return st * 1024 + (ob ^ (((ob >> 9) & 1) << 5)); }
__host__ __device__ __forceinline__ void stage_rc(int b, int& R, int& C) { const int st = b / 1024, sb = b % 1024, swz = sb ^ (((sb >> 9) & 1) << 5); R = (st >> 1) * 16 + swz / 64; C = (st & 1) * 32 + (swz % 64) / 2; }
__host__ __device__ __forceinline__ int perm32(int rho) { const int n = rho >> 4, i = rho & 15; return 8 * (i >> 2) + 4 * n + (i & 3); }
struct Unit { int pm, pn, grp; };
struct StaticOrder {
    int nM, nN, nwg, c;
    __device__ __forceinline__ void init(int nM_, int nN_, int c_) { nM = nM_; nN = nN_; nwg = nM * nN; c = c_; }
    __device__ __forceinline__ bool next(int i, Unit& u) const {
        const long L = (long)i * GRID + c; if (L >= nwg) return false;
        int wgid = (int)L; { const int q = nwg / NXCD, r = nwg % NXCD, xcd = wgid % NXCD, off = wgid / NXCD; wgid = (xcd < r ? xcd * (q + 1) : r * (q + 1) + (xcd - r) * q) + off; }
        const int nig = WGM * nN, gid = wgid / nig, fm = gid * WGM, gsz = (nM - fm) < WGM ? (nM - fm) : WGM;
        u.pm = fm + ((wgid % nig) % gsz); u.pn = (wgid % nig) / gsz; u.grp = 0; return true;
    }
};
struct MoeOrder : StaticOrder {
    const volatile LAS int* pad_start;
    __device__ __forceinline__ bool next(int i, Unit& u) const {
        if (!StaticOrder::next(i, u)) return false;
        const int r0 = u.pm * 256; int e = 0;
#pragma unroll 1
        for (int k = 1; k < NEXP; ++k) e += (pad_start[k] <= r0) ? 1 : 0;
        u.grp = e; return true;
    }
};

template <class Epi, class Sched>
__device__ __forceinline__ void gemm_phase(LAS unsigned char* lds, const bf16_t* Aptr, const bf16_t* Btptr, const int K, const size_t grp_stride_bytes, const Sched& S, const Epi& E, const int tid) {
    const int wid = __builtin_amdgcn_readfirstlane(tid >> 6), lane = tid & 63, wr = wid >> 2, wc = wid & 3, fr = lane & 15, fq = lane >> 4;
    const int nt = K / BK;
    unsigned voffA[2], voffB[2];
#pragma unroll
    for (int i = 0; i < 2; ++i) { int R, C; stage_rc(tid * 16 + i * 8192, R, C); const int Rb = Epi::PERM ? ((R & ~31) + perm32(R & 31)) : R;
        voffA[i] = (unsigned)(R * K + C) * 2u; voffB[i] = (unsigned)(Rb * K + C) * 2u; }
    const size_t kstep = (size_t)(BK * 2);
    const size_t hstep = (size_t)HALF * K * 2;
    const size_t tstep = 2 * hstep;
    const unsigned ldsw = (unsigned)wid * 1024u;
    const int aoff = lds_byte(wr * 64 + fr, fq * 8), boff = lds_byte(wc * 32 + fr, fq * 8);
#define PG8_SA(b, h) (((b) * 2 + (h)) * HTB)
#define PG8_SB(b, h) ((4 + (b) * 2 + (h)) * HTB)
#define PG8_STAGE(bufoff, gbase, voff) do { _Pragma("unroll") for (int _i = 0; _i < 2; ++_i) \
        __builtin_amdgcn_global_load_lds((const unsigned*)((const char*)(gbase) + (voff)[_i]), (LAS unsigned*)(lds + (bufoff) + ldsw + _i * 8192), 16, 0, 0); } while (0)
#define PG8_LDA(dst, b, h) do { _Pragma("unroll") for (int m = 0; m < 4; ++m) _Pragma("unroll") for (int k = 0; k < 2; ++k) dst[m][k] = *(const LAS bf16x8*)(lds + PG8_SA(b, h) + aoff + m * 2048 + k * 1024); } while (0)
#define PG8_LDB(dst, b, h) do { _Pragma("unroll") for (int n = 0; n < 2; ++n) _Pragma("unroll") for (int k = 0; k < 2; ++k) dst[n][k] = *(const LAS bf16x8*)(lds + PG8_SB(b, h) + boff + n * 2048 + k * 1024); } while (0)
#define PG8_MMA(ai, bj, At, Bt) do { __builtin_amdgcn_s_setprio(1); _Pragma("unroll") for (int m = 0; m < 4; ++m) _Pragma("unroll") for (int n = 0; n < 2; ++n) _Pragma("unroll") for (int k = 0; k < 2; ++k) \
        acc[ai][bj][m][n] = __builtin_amdgcn_mfma_f32_16x16x32_bf16(Bt[n][k], At[m][k], acc[ai][bj][m][n], 0, 0, 0); __builtin_amdgcn_s_setprio(0); } while (0)
#define PG8_WAIT_V(n) asm volatile("s_waitcnt vmcnt(" #n ")" ::: "memory")
#define PG8_WAIT_L(n) asm volatile("s_waitcnt lgkmcnt(" #n ")" ::: "memory")
#define PG8_BAR __builtin_amdgcn_s_barrier()
#define PG8_SCHED __builtin_amdgcn_sched_barrier(0)
    Unit cur, nxt; int ui = 0;
    if (!S.next(0, cur)) return;
    f32x4 acc[2][2][4][2];
#pragma unroll
    for (int a = 0; a < 2; ++a)
#pragma unroll
        for (int b = 0; b < 2; ++b)
#pragma unroll
            for (int m = 0; m < 4; ++m)
#pragma unroll
                for (int n = 0; n < 2; ++n) acc[a][b][m][n] = (f32x4){0.f, 0.f, 0.f, 0.f};
    bf16x8 At[4][2], B0[2][2], B1[2][2];
    const char* cA = (const char*)Aptr + (size_t)cur.pm * tstep; const char* cB = (const char*)Btptr + (size_t)cur.grp * grp_stride_bytes + (size_t)cur.pn * tstep;
    PG8_STAGE(PG8_SB(0, 0), cB, voffB); PG8_STAGE(PG8_SA(0, 0), cA, voffA); PG8_STAGE(PG8_SB(0, 1), cB + hstep, voffB); PG8_STAGE(PG8_SA(0, 1), cA + hstep, voffA);
    if (wr == 1) PG8_BAR;
    PG8_WAIT_V(4); PG8_BAR;
    PG8_STAGE(PG8_SB(1, 0), cB + kstep, voffB); PG8_STAGE(PG8_SA(1, 0), cA + kstep, voffA); PG8_STAGE(PG8_SB(1, 1), cB + hstep + kstep, voffB);
    PG8_WAIT_V(6); PG8_BAR;
    for (;;) {
        const bool has_next = S.next(ui + 1, nxt);
        const char* nA = has_next ? (const char*)Aptr + (size_t)nxt.pm * tstep : cA;
        const char* nB = has_next ? (const char*)Btptr + (size_t)nxt.grp * grp_stride_bytes + (size_t)nxt.pn * tstep : cB;
#pragma unroll 1
        for (int t = 0; t < nt; t += 2) {
            const bool last = (t == nt - 2);
            const char* a1 = cA + (size_t)(t + 1) * kstep;
            const char* a2 = last ? nA : cA + (size_t)(t + 2) * kstep; const char* b2 = last ? nB : cB + (size_t)(t + 2) * kstep;
            const char* a3 = a2 + kstep; const char* b3 = b2 + kstep;
            PG8_LDB(B0, 0, 0); PG8_SCHED; PG8_LDA(At, 0, 0); PG8_STAGE(PG8_SA(1, 1), a1 + hstep, voffA);
            PG8_WAIT_L(8); PG8_BAR; PG8_WAIT_L(0); PG8_MMA(0, 0, At, B0); PG8_BAR; PG8_SCHED;
            PG8_LDB(B1, 0, 1); PG8_STAGE(PG8_SB(0, 0), b2, voffB);
            PG8_BAR; PG8_WAIT_L(0); PG8_MMA(0, 1, At, B1); PG8_BAR;
            PG8_LDA(At, 0, 1); PG8_STAGE(PG8_SA(0, 0), a2, voffA);
            PG8_BAR; PG8_WAIT_L(0); PG8_MMA(1, 0, At, B0); PG8_BAR; PG8_SCHED;
            PG8_STAGE(PG8_SB(0, 1), b2 + hstep, voffB);
            PG8_WAIT_V(6); PG8_BAR; PG8_MMA(1, 1, At, B1); PG8_BAR;
            PG8_LDB(B0, 1, 0); PG8_SCHED; PG8_LDA(At, 1, 0); PG8_STAGE(PG8_SA(0, 1), a2 + hstep, voffA);
            PG8_WAIT_L(8); PG8_BAR; PG8_WAIT_L(0); PG8_MMA(0, 0, At, B0); PG8_BAR; PG8_SCHED;
            PG8_LDB(B1, 1, 1); PG8_STAGE(PG8_SB(1, 0), b3, voffB);
            PG8_BAR; PG8_WAIT_L(0); PG8_MMA(0, 1, At, B1); PG8_BAR;
            PG8_LDA(At, 1, 1); PG8_STAGE(PG8_SA(1, 0), a3, voffA);
            PG8_BAR; PG8_WAIT_L(0); PG8_MMA(1, 0, At, B0); PG8_BAR; PG8_SCHED;
            PG8_STAGE(PG8_SB(1, 1), b3 + hstep, voffB);
            PG8_WAIT_V(6); PG8_BAR; PG8_MMA(1, 1, At, B1); PG8_BAR;
        }
        E(acc, cur, wr, wc, fr, fq);
        if (!has_next) break;
#pragma unroll
        for (int a = 0; a < 2; ++a)
#pragma unroll
            for (int b = 0; b < 2; ++b)
#pragma unroll
                for (int m = 0; m < 4; ++m)
#pragma unroll
                    for (int n = 0; n < 2; ++n) acc[a][b][m][n] = (f32x4){0.f, 0.f, 0.f, 0.f};
        cur = nxt; cA = nA; cB = nB; ++ui;
    }
    PG8_WAIT_V(0);
    if (wr == 0) PG8_BAR;
    PG8_BAR;
#undef PG8_SA
#undef PG8_SB
#undef PG8_STAGE
#undef PG8_LDA
#undef PG8_LDB
#undef PG8_MMA
#undef PG8_WAIT_V
#undef PG8_WAIT_L
#undef PG8_BAR
#undef PG8_SCHED
}

typedef const f32x4 (&AccRef)[2][2][4][2];

__device__ __forceinline__ void rope8(f32x4& v0, f32x4& v1, const f32x2* cs) {
    const f32x4 c01 = *(const f32x4*)cs, c23 = *(const f32x4*)(cs + 2);
    f32x4 a = v0, b = v1;
    v0[0] = a[0] * c01[0] - a[1] * c01[1]; v0[1] = a[0] * c01[1] + a[1] * c01[0];
    v0[2] = a[2] * c01[2] - a[3] * c01[3]; v0[3] = a[2] * c01[3] + a[3] * c01[2];
    v1[0] = b[0] * c23[0] - b[1] * c23[1]; v1[1] = b[0] * c23[1] + b[1] * c23[0];
    v1[2] = b[2] * c23[2] - b[3] * c23[3]; v1[3] = b[2] * c23[3] + b[3] * c23[2];
}
__device__ __forceinline__ void store8(bf16_t* p, f32x4 v0, f32x4 v1) {
    u32x4 w; w.x = pk2(v0[0], v0[1]); w.y = pk2(v0[2], v0[3]); w.z = pk2(v1[0], v1[1]); w.w = pk2(v1[2], v1[3]); *(u32x4*)p = w;
}

struct EpiDaIn {
    static constexpr bool PERM = true;
    bf16_t* KVQ; const f32x2* tabA;
    __device__ __forceinline__ void operator()(AccRef acc, const Unit& u, int wr, int wc, int fr, int fq) const {
        const int part = u.pn >> 2; bf16_t* base = KVQ + (size_t)part * ((size_t)T * 1024);
        const int tb = u.pm % TPB; const bool lat = tb != 0; const bool rope = lat && part != 1;
        const int cin0 = (u.pn & 3) * 256 + wc * 32 + 8 * fq;
#pragma unroll
        for (int ai = 0; ai < 2; ++ai)
#pragma unroll
            for (int m = 0; m < 4; ++m) {
                asm volatile("" ::: "memory");
                const int rin = ai * HALF + wr * 64 + m * 16 + fr; const size_t row = (size_t)u.pm * BM + rin; const int p = (tb - 1) * 256 + rin;
#pragma unroll
                for (int bj = 0; bj < 2; ++bj) { f32x4 v0 = acc[ai][bj][m][0], v1 = acc[ai][bj][m][1]; const int cin = cin0 + bj * HALF;
                    if (rope) { const int o = cin & 63, axis = o >> 5, f0 = (o & 31) >> 1, pos = axis ? (p & 63) : (p >> 6); rope8(v0, v1, tabA + pos * 16 + f0); }
                    store8(base + row * 1024 + cin, v0, v1); }
            }
    }
};
struct EpiRetIn {
    static constexpr bool PERM = true;
    bf16_t *Kb, *Vb, *Qb, *Gb; const f32x2* tabR;
    __device__ __forceinline__ void operator()(AccRef acc, const Unit& u, int wr, int wc, int fr, int fq) const {
        const int ct = u.pn * 256; bf16_t* base; int ld, c0; bool isk = false, isq = false;
        if (ct < 1024) { base = Kb; ld = 1024; c0 = ct; isk = true; } else if (ct < 3072) { base = Vb; ld = 2048; c0 = ct - 1024; }
        else if (ct < 4096) { base = Qb; ld = 1024; c0 = ct - 3072; isq = true; } else { base = Gb; ld = 2048; c0 = ct - 4096; }
        const int tb = u.pm % TPB; const bool lat = tb != 0; const bool rope = lat && (isk || isq);
        const int cin0 = c0 + wc * 32 + 8 * fq; const float sc = isk ? 0.0625f : 1.0f;
#pragma unroll
        for (int ai = 0; ai < 2; ++ai)
#pragma unroll
            for (int m = 0; m < 4; ++m) {
                asm volatile("" ::: "memory");
                const int rin = ai * HALF + wr * 64 + m * 16 + fr; const size_t row = (size_t)u.pm * BM + rin; const int p = (tb - 1) * 256 + rin;
#pragma unroll
                for (int bj = 0; bj < 2; ++bj) { f32x4 v0 = acc[ai][bj][m][0] * sc, v1 = acc[ai][bj][m][1] * sc; const int cin = cin0 + bj * HALF;
                    if (rope) { const int f0 = (cin & 255) >> 1; rope8(v0, v1, tabR + (size_t)p * 128 + f0); }
                    store8(base + row * ld + cin, v0, v1); }
            }
    }
};
struct EpiF32 {
    static constexpr bool PERM = false;
    float* C; int ldc;
    __device__ __forceinline__ void operator()(AccRef acc, const Unit& u, int wr, int wc, int fr, int fq) const {
        const int row0 = u.pm * BM + wr * 64 + fr, col0 = u.pn * BM + wc * 32 + 4 * fq;
#pragma unroll
        for (int ai = 0; ai < 2; ++ai)
#pragma unroll
            for (int m = 0; m < 4; ++m) { float* rowp = C + (size_t)(row0 + ai * HALF + m * 16) * ldc + col0;
#pragma unroll
                for (int bj = 0; bj < 2; ++bj)
#pragma unroll
                    for (int n = 0; n < 2; ++n) *(f32x4*)(rowp + bj * HALF + n * 16) = acc[ai][bj][m][n]; }
    }
};
struct EpiMlaQ {
    static constexpr bool PERM = true;
    bf16_t* Qb; const f32x2* tabA;
    __device__ __forceinline__ void operator()(AccRef acc, const Unit& u, int wr, int wc, int fr, int fq) const {
        const int tb = u.pm % TPB; const bool rope = tb != 0 && u.pn >= 4; const int c0 = u.pn * 256 + wc * 32 + 8 * fq;
#pragma unroll
        for (int ai = 0; ai < 2; ++ai)
#pragma unroll
            for (int m = 0; m < 4; ++m) {
                asm volatile("" ::: "memory");
                const int rin = ai * HALF + wr * 64 + m * 16 + fr; const size_t row = (size_t)u.pm * BM + rin; const int p = (tb - 1) * 256 + rin;
#pragma unroll
                for (int bj = 0; bj < 2; ++bj) { f32x4 v0 = acc[ai][bj][m][0], v1 = acc[ai][bj][m][1]; const int c = c0 + bj * HALF;
                    if (rope) { const int o = c & 63, axis = o >> 5, f0 = (o & 31) >> 1, pos = axis ? (p & 63) : (p >> 6); rope8(v0, v1, tabA + pos * 16 + f0); }
                    store8(Qb + row * 1536 + c, v0, v1); }
            }
    }
};
struct EpiMlaKV {
    static constexpr bool PERM = true;
    bf16_t *Kb, *Vb;
    __device__ __forceinline__ void operator()(AccRef acc, const Unit& u, int wr, int wc, int fr, int fq) const {
        const int c0 = wc * 32 + 8 * fq;
#pragma unroll
        for (int ai = 0; ai < 2; ++ai)
#pragma unroll
            for (int m = 0; m < 4; ++m) {
                const size_t row = (size_t)u.pm * BM + ai * HALF + wr * 64 + m * 16 + fr;
                store8(Kb + row * 1536 + u.pn * 192 + c0, acc[ai][0][m][0], acc[ai][0][m][1]);
                store8(Vb + row * 1024 + u.pn * 128 + c0, acc[ai][1][m][0], acc[ai][1][m][1]);
            }
    }
};
struct EpiResid {
    static constexpr bool PERM = false;
    float* X; const float* mod2;
    __device__ __forceinline__ void operator()(AccRef acc, const Unit& u, int wr, int wc, int fr, int fq) const {
        const int tb = u.pm % TPB, b = u.pm / TPB, mrow = tb == 0 ? 8 : b;
        const int row0 = u.pm * BM + wr * 64 + fr, col0 = u.pn * BM + wc * 32 + 4 * fq;
        const float* mp = mod2 + (size_t)mrow * 6144 + col0;
        f32x4 g[2][2];
#pragma unroll
        for (int bj = 0; bj < 2; ++bj)
#pragma unroll
            for (int n = 0; n < 2; ++n) g[bj][n] = *(const f32x4*)(mp + bj * HALF + n * 16);
#pragma unroll
        for (int ai = 0; ai < 2; ++ai)
#pragma unroll
            for (int m = 0; m < 4; ++m) { float* rowp = X + (size_t)(row0 + ai * HALF + m * 16) * 1024 + col0;
#pragma unroll
                for (int bj = 0; bj < 2; ++bj)
#pragma unroll
                    for (int n = 0; n < 2; ++n) { f32x4* q = (f32x4*)(rowp + bj * HALF + n * 16); *q = *q + g[bj][n] * acc[ai][bj][m][n]; } }
    }
};
struct EpiMoe1 {
    static constexpr bool PERM = true;
    bf16_t* ACT; const float* bgu;
    __device__ __forceinline__ void operator()(AccRef acc, const Unit& u, int wr, int wc, int fr, int fq) const {
        const int j0 = u.pn * 128 + wc * 16 + 4 * fq; const float* bp = bgu + (size_t)u.grp * 2048 + j0;
        f32x4 bg[2], bl[2];
#pragma unroll
        for (int bj = 0; bj < 2; ++bj) { bg[bj] = *(const f32x4*)(bp + bj * 64); bl[bj] = *(const f32x4*)(bp + 1024 + bj * 64); }
#pragma unroll
        for (int ai = 0; ai < 2; ++ai)
#pragma unroll
            for (int m = 0; m < 4; ++m) { const size_t row = (size_t)u.pm * BM + ai * HALF + wr * 64 + m * 16 + fr;
#pragma unroll
                for (int bj = 0; bj < 2; ++bj) { const f32x4 gl = acc[ai][bj][m][0] + bg[bj], li = acc[ai][bj][m][1] + bl[bj]; float a[4];
#pragma unroll
                    for (int e = 0; e < 4; ++e) { const float g = fminf(gl[e], 7.0f), l = fminf(fmaxf(li[e], -7.0f), 7.0f);
                        const float s = __builtin_amdgcn_rcpf(1.0f + __builtin_amdgcn_exp2f(g * (-1.702f * 1.4426950408889634f))); a[e] = g * s * (l + 1.0f); }
                    u32x2 w; w.x = pk2(a[0], a[1]); w.y = pk2(a[2], a[3]); *(u32x2*)(ACT + row * 1024 + j0 + bj * 64) = w; } }
    }
};
struct EpiMoe2 {
    static constexpr bool PERM = true;
    bf16_t* OUT; const float* bdn;
    __device__ __forceinline__ void operator()(AccRef acc, const Unit& u, int wr, int wc, int fr, int fq) const {
        const int c0 = u.pn * 256 + wc * 32 + 8 * fq; const float* bp = bdn + (size_t)u.grp * 1024 + c0;
        f32x4 b[2][2];
#pragma unroll
        for (int bj = 0; bj < 2; ++bj) { b[bj][0] = *(const f32x4*)(bp + bj * HALF); b[bj][1] = *(const f32x4*)(bp + bj * HALF + 4); }
#pragma unroll
        for (int ai = 0; ai < 2; ++ai)
#pragma unroll
            for (int m = 0; m < 4; ++m) { const size_t row = (size_t)u.pm * BM + ai * HALF + wr * 64 + m * 16 + fr;
#pragma unroll
                for (int bj = 0; bj < 2; ++bj) store8(OUT + row * 1024 + c0 + bj * HALF, acc[ai][bj][m][0] + b[bj][0], acc[ai][bj][m][1] + b[bj][1]); }
    }
};
}

namespace att {
constexpr int DV = 128, QBLK = 32, KVBLK = 64;
#define SBAR() __builtin_amdgcn_sched_barrier(0)
__device__ __forceinline__ int crow(int r, int hi) { return (r & 3) + 8 * (r >> 2) + 4 * hi; }
__device__ __forceinline__ int v_st(int k, int c) { const int kk = (k & ~0xC) | ((k & 4) << 1) | ((k & 8) >> 1); return ((kk >> 3) * 4 + (c >> 5)) * 512 + ((kk & 7) * 32 + (c & 31)) * 2; }
__device__ __forceinline__ int v_rd_base(int lane) { return ((lane & 3) << 3) | (((lane >> 2) & 3) << 6) | (((lane >> 4) & 1) << 5) | (((lane >> 5) & 1) << 8); }
constexpr int v_rd_off(int d0, int ks, int half) { return d0 * 512 + ks * 4096 + half * 2048; }
template <int OFF> __device__ __forceinline__ s16x4 tr_read(int vb) {
    s16x4 r; asm volatile("ds_read_b64_tr_b16 %0, %1 offset:%2" : "=&v"(r) : "v"(vb), "i"(OFF) : "memory"); return r;
}
template <int D0> __device__ __forceinline__ void pv_one(f32x16& od, int vb, bf16x8 pa0, bf16x8 pa1, bf16x8 pa2, bf16x8 pa3) {
    const s16x4 l0 = tr_read<v_rd_off(D0, 0, 0)>(vb), h0 = tr_read<v_rd_off(D0, 0, 1)>(vb), l1 = tr_read<v_rd_off(D0, 1, 0)>(vb), h1 = tr_read<v_rd_off(D0, 1, 1)>(vb);
    const s16x4 l2 = tr_read<v_rd_off(D0, 2, 0)>(vb), h2 = tr_read<v_rd_off(D0, 2, 1)>(vb), l3 = tr_read<v_rd_off(D0, 3, 0)>(vb), h3 = tr_read<v_rd_off(D0, 3, 1)>(vb);
    asm volatile("s_waitcnt lgkmcnt(0)" ::: "memory"); SBAR();
#define PK(L, H) (bf16x8){L[0], L[1], L[2], L[3], H[0], H[1], H[2], H[3]}
    od = __builtin_amdgcn_mfma_f32_32x32x16_bf16(pa0, PK(l0, h0), od, 0, 0, 0);
    od = __builtin_amdgcn_mfma_f32_32x32x16_bf16(pa1, PK(l1, h1), od, 0, 0, 0);
    od = __builtin_amdgcn_mfma_f32_32x32x16_bf16(pa2, PK(l2, h2), od, 0, 0, 0);
    od = __builtin_amdgcn_mfma_f32_32x32x16_bf16(pa3, PK(l3, h3), od, 0, 0, 0);
#undef PK
}
__device__ __forceinline__ void pv_d0(f32x16* o, int vb, bf16x8 pa0, bf16x8 pa1, bf16x8 pa2, bf16x8 pa3) {
    pv_one<0>(o[0], vb, pa0, pa1, pa2, pa3); pv_one<1>(o[1], vb, pa0, pa1, pa2, pa3); pv_one<2>(o[2], vb, pa0, pa1, pa2, pa3); pv_one<3>(o[3], vb, pa0, pa1, pa2, pa3);
}
template <int DQK> struct Cfg {
    static constexpr int KROW = DQK * 2;
    static constexpr int SHM_K = KVBLK * DQK * 2, SHM_V = KVBLK * DV * 2;
    static constexpr int NKC = DQK / 64;
    static constexpr int CH = DQK / 8;
    static constexpr int LDS_NEED = 2 * SHM_V + 2 * SHM_K + 8 * 64 * 4;
};
template <int DQK>
__device__ __forceinline__ void partialSM(f32x16& p0, f32x16& p1, float& m_reg, float& mn, float& alpha) {
    constexpr float SCALE = DQK == 64 ? 0.125f : 0.07216878364870322f;
    constexpr float C = SCALE * 1.4426950408889634f, THRS = 8.0f / SCALE;
    float pmax = p0[0];
#pragma unroll
    for (int r = 1; r < 16; ++r) pmax = fmaxf(pmax, p0[r]);
#pragma unroll
    for (int r = 0; r < 16; ++r) pmax = fmaxf(pmax, p1[r]);
    { auto rr = __builtin_amdgcn_permlane32_swap(__float_as_uint(pmax), __float_as_uint(pmax), false, false);
      pmax = fmaxf(__uint_as_float(rr[0]), __uint_as_float(rr[1])); }
    if (__builtin_expect(__all(pmax - m_reg <= THRS), 1)) { mn = m_reg; alpha = 1.f; }
    else { mn = fmaxf(m_reg, pmax); alpha = __builtin_amdgcn_exp2f((m_reg - mn) * C); m_reg = mn; }
    const float mnC = -mn * C;
#pragma unroll
    for (int r = 0; r < 16; ++r) p0[r] = fmaf(p0[r], C, mnC);
#pragma unroll
    for (int r = 0; r < 16; ++r) p1[r] = fmaf(p1[r], C, mnC);
#pragma unroll
    for (int r = 0; r < 16; ++r) p0[r] = __builtin_amdgcn_exp2f(p0[r]);
}
__device__ __forceinline__ void finishSM(f32x16& p0, f32x16& p1, float alpha, float& l_reg, bf16x8& pa0, bf16x8& pa1, bf16x8& pa2, bf16x8& pa3) {
#pragma unroll
    for (int r = 0; r < 16; ++r) p1[r] = __builtin_amdgcn_exp2f(p1[r]);
    float ps = 0;
#pragma unroll
    for (int r = 0; r < 16; ++r) ps += p0[r];
#pragma unroll
    for (int r = 0; r < 16; ++r) ps += p1[r];
    { auto rr = __builtin_amdgcn_permlane32_swap(__float_as_uint(ps), __float_as_uint(ps), false, false);
      ps = __uint_as_float(rr[0]) + __uint_as_float(rr[1]); }
    l_reg = l_reg * alpha + ps;
#define PK4(P, BASE, OUT) do { unsigned a0 = pk2(P[BASE + 0], P[BASE + 1]), a1 = pk2(P[BASE + 2], P[BASE + 3]);   \
    unsigned b0 = pk2(P[BASE + 4], P[BASE + 5]), b1 = pk2(P[BASE + 6], P[BASE + 7]);                              \
    auto r0 = __builtin_amdgcn_permlane32_swap(a0, b0, false, false); auto r1 = __builtin_amdgcn_permlane32_swap(a1, b1, false, false); \
    u32x4 w = {r0[0], r1[0], r0[1], r1[1]}; OUT = *reinterpret_cast<bf16x8*>(&w); } while (0)
    PK4(p0, 0, pa0); PK4(p0, 8, pa1); PK4(p1, 0, pa2); PK4(p1, 8, pa3);
#undef PK4
}
template <int DQK>
__device__ __forceinline__ void qkt(f32x16& p0, f32x16& p1, const LAS char* Ks, const bf16x8* qr, int r32, int hi) {
    constexpr int KROW = Cfg<DQK>::KROW;
    p0 = f32x16{}; p1 = f32x16{};
#pragma unroll
    for (int d0 = 0; d0 < DQK / 16; ++d0) { const int cb = (d0 * 16 + hi * 8) * 2;
        const bf16x8 b0 = *(const LAS bf16x8*)(Ks + r32 * KROW + (cb ^ ((r32 & 7) << 4)));
        const bf16x8 b1 = *(const LAS bf16x8*)(Ks + (32 + r32) * KROW + (cb ^ ((r32 & 7) << 4)));
        p0 = __builtin_amdgcn_mfma_f32_32x32x16_bf16(b0, qr[d0], p0, 0, 0, 0);
        p1 = __builtin_amdgcn_mfma_f32_32x32x16_bf16(b1, qr[d0], p1, 0, 0, 0); }
}
template <int DQK, int SDEPTH, int LDQ, int LDK, int LDV, int LDO>
__device__ __forceinline__ void attn_body(const bf16_t* __restrict__ Qb, const bf16_t* __restrict__ Qb2, const bf16_t* __restrict__ Kh, const bf16_t* __restrict__ Vh, bf16_t* __restrict__ Ob, const int seq, LAS char* lds, const int tid) {
    using C = Cfg<DQK>;
    constexpr int SHM_V = C::SHM_V, SHM_K = C::SHM_K, KROW = C::KROW, NKC = C::NKC, CH = C::CH;
    const int wid = tid >> 6, lane = tid & 63, r32 = lane & 31, hi = lane >> 5;
    LAS char* V_lds = lds; LAS char* K_lds = lds + 2 * SHM_V;
    LAS float* ws = (LAS float*)(lds + 2 * SHM_V + 2 * SHM_K) + wid * 64; LAS float* li_l = ws; LAS float* al_l = ws + 32;
    float m_reg = -1e30f, l_reg = 0; f32x16 o[4] = {}; bf16x8 qr[DQK / 16];
    const bf16_t* Qw = Qb + (long)(wid * QBLK + r32) * LDQ + hi * 8; const bf16_t* Qw2 = Qb2 + (long)(wid * QBLK + r32) * LDQ + hi * 8;
#pragma unroll
    for (int d0 = 0; d0 < DQK / 16; ++d0) qr[d0] = d0 < 8 ? *(const bf16x8*)(Qw + d0 * 16) : *(const bf16x8*)(Qw2 + (d0 - 8) * 16);
    const int sr = tid >> 4, sc = (tid & 15) * 8, vst0 = v_st(sr, sc), vst1 = v_st(32 + sr, sc);
    int krow[NKC], kcol[NKC], kst[NKC];
#pragma unroll
    for (int i = 0; i < NKC; ++i) { const int e = tid + 512 * i; krow[i] = e / CH; kcol[i] = (e % CH) * 8; kst[i] = krow[i] * KROW + ((kcol[i] * 2) ^ ((krow[i] & 7) << 4)); }
    const int vb0 = (int)(uintptr_t)V_lds + v_rd_base(lane);
    struct { bf16x8 vs0, vs1, ks[NKC]; } sr_[SDEPTH];
#define SLOAD(i, k0) do { sr_[i].vs0 = *(const bf16x8*)(&Vh[(long)((k0) + sr) * LDV + sc]); sr_[i].vs1 = *(const bf16x8*)(&Vh[(long)((k0) + 32 + sr) * LDV + sc]); \
    _Pragma("unroll") for (int _c = 0; _c < NKC; ++_c) sr_[i].ks[_c] = *(const bf16x8*)(&Kh[(long)((k0) + krow[_c]) * LDK + kcol[_c]]); } while (0)
#define SWRITE(b, i) do { *(LAS bf16x8*)(V_lds + (b) * SHM_V + vst0) = sr_[i].vs0; *(LAS bf16x8*)(V_lds + (b) * SHM_V + vst1) = sr_[i].vs1; \
    _Pragma("unroll") for (int _c = 0; _c < NKC; ++_c) *(LAS bf16x8*)(K_lds + (b) * SHM_K + kst[_c]) = sr_[i].ks[_c]; } while (0)
#define SWAIT() do { if constexpr (SDEPTH == 2) { if constexpr (NKC == 1) asm volatile("s_waitcnt vmcnt(3)" ::: "memory"); else asm volatile("s_waitcnt vmcnt(5)" ::: "memory"); } \
    else asm volatile("s_waitcnt vmcnt(0)" ::: "memory"); } while (0)
#define RESC(a) do { if (__any((a) < 1.f)) { if (hi == 0) al_l[r32] = (a); asm volatile("s_waitcnt lgkmcnt(0)" ::: "memory"); \
    _Pragma("unroll") for (int d = 0; d < 4; ++d) _Pragma("unroll") for (int r = 0; r < 16; ++r) o[d][r] *= al_l[crow(r, hi)]; } } while (0)
    f32x16 pA0, pA1, pB0, pB1; float mnA, mnB, alA, alB; bf16x8 pa0, pa1, pa2, pa3; const int NT = seq / KVBLK;
    constexpr int SE = 0, SO = SDEPTH - 1;
    SLOAD(SE, 0); asm volatile("s_waitcnt vmcnt(0)" ::: "memory"); SWRITE(0, SE); __syncthreads();
    qkt<DQK>(pA0, pA1, K_lds, qr, r32, hi); partialSM<DQK>(pA0, pA1, m_reg, mnA, alA);
    SLOAD(SO, KVBLK); if constexpr (SDEPTH == 2) { if (2 < NT) SLOAD(SE, 2 * KVBLK); }
    SWAIT(); SWRITE(1, SO); __syncthreads();
    for (int j = 1; j + 1 < NT; j += 2) {
        SBAR(); qkt<DQK>(pB0, pB1, K_lds + SHM_K, qr, r32, hi);
        finishSM(pA0, pA1, alA, l_reg, pa0, pa1, pa2, pa3); SBAR();
        SLOAD(SO, (j + SDEPTH) * KVBLK); SBAR();
        pv_d0(o, vb0, pa0, pa1, pa2, pa3); partialSM<DQK>(pB0, pB1, m_reg, mnB, alB);
        __syncthreads(); SWAIT(); SWRITE(0, SE);
        RESC(alB); __syncthreads();
        SBAR(); qkt<DQK>(pA0, pA1, K_lds, qr, r32, hi);
        finishSM(pB0, pB1, alB, l_reg, pa0, pa1, pa2, pa3); SBAR();
        if (SDEPTH == 1 || j + 3 < NT) SLOAD(SE, (j + 1 + SDEPTH) * KVBLK); SBAR();
        pv_d0(o, vb0 + SHM_V, pa0, pa1, pa2, pa3); partialSM<DQK>(pA0, pA1, m_reg, mnA, alA);
        __syncthreads(); SWAIT(); SWRITE(1, SO);
        RESC(alA); __syncthreads();
    }
    SBAR(); qkt<DQK>(pB0, pB1, K_lds + SHM_K, qr, r32, hi);
    finishSM(pA0, pA1, alA, l_reg, pa0, pa1, pa2, pa3); SBAR();
    pv_d0(o, vb0, pa0, pa1, pa2, pa3); partialSM<DQK>(pB0, pB1, m_reg, mnB, alB);
    __syncthreads(); RESC(alB);
    finishSM(pB0, pB1, alB, l_reg, pa0, pa1, pa2, pa3); SBAR();
    pv_d0(o, vb0 + SHM_V, pa0, pa1, pa2, pa3);
    if (hi == 0) li_l[r32] = l_reg; asm volatile("s_waitcnt lgkmcnt(0)" ::: "memory");
    float rli[16];
#pragma unroll
    for (int r = 0; r < 16; ++r) rli[r] = __builtin_amdgcn_rcpf(li_l[crow(r, hi)]);
    bf16_t* Ow = Ob + (long)(wid * QBLK) * LDO;
#pragma unroll
    for (int r = 0; r < 16; ++r) { const int orow = crow(r, hi);
#pragma unroll
        for (int d0 = 0; d0 < 4; ++d0) Ow[(long)orow * LDO + d0 * 32 + r32] = f2bf(o[d0][r] * rli[r]); }
    __syncthreads();
#undef SLOAD
#undef SWRITE
#undef SWAIT
#undef RESC
}
template <int DQK, int LDQ, int LDK, int LDV, int LDO>
__device__ __forceinline__ void attn_body_simple(const bf16_t* __restrict__ Qb, const bf16_t* __restrict__ Qb2, const bf16_t* __restrict__ Kh, const bf16_t* __restrict__ Vh, bf16_t* __restrict__ Ob, const int seq, LAS char* lds, const int tid) {
    using C = Cfg<DQK>;
    constexpr int SHM_V = C::SHM_V, SHM_K = C::SHM_K, KROW = C::KROW, NKC = C::NKC, CH = C::CH;
    const int wid = tid >> 6, lane = tid & 63, r32 = lane & 31, hi = lane >> 5;
    LAS char* V_lds = lds; LAS char* K_lds = lds + 2 * SHM_V;
    LAS float* ws = (LAS float*)(lds + 2 * SHM_V + 2 * SHM_K) + wid * 64; LAS float* li_l = ws; LAS float* al_l = ws + 32;
    float m_reg = -1e30f, l_reg = 0; f32x16 o[4] = {}; bf16x8 qr[DQK / 16];
    const bf16_t* Qw = Qb + (long)(wid * QBLK + r32) * LDQ + hi * 8; const bf16_t* Qw2 = Qb2 + (long)(wid * QBLK + r32) * LDQ + hi * 8;
#pragma unroll
    for (int d0 = 0; d0 < DQK / 16; ++d0) qr[d0] = d0 < 8 ? *(const bf16x8*)(Qw + d0 * 16) : *(const bf16x8*)(Qw2 + (d0 - 8) * 16);
    const int sr = tid >> 4, sc = (tid & 15) * 8, vst0 = v_st(sr, sc), vst1 = v_st(32 + sr, sc);
    int krow[NKC], kcol[NKC], kst[NKC];
#pragma unroll
    for (int i = 0; i < NKC; ++i) { const int e = tid + 512 * i; krow[i] = e / CH; kcol[i] = (e % CH) * 8; kst[i] = krow[i] * KROW + ((kcol[i] * 2) ^ ((krow[i] & 7) << 4)); }
    const int vb0 = (int)(uintptr_t)V_lds + v_rd_base(lane);
    bf16x8 vs0, vs1, ks[NKC];
    const unsigned voff0 = (unsigned)(sr * LDV + sc), voff1 = (unsigned)((32 + sr) * LDV + sc); unsigned koff[NKC];
#pragma unroll
    for (int i = 0; i < NKC; ++i) koff[i] = (unsigned)(krow[i] * LDK + kcol[i]);
#define SLOAD(k0) do { const bf16_t* vt_ = Vh + (size_t)(k0) * LDV; const bf16_t* kt_ = Kh + (size_t)(k0) * LDK; vs0 = *(const bf16x8*)(vt_ + voff0); vs1 = *(const bf16x8*)(vt_ + voff1); \
    _Pragma("unroll") for (int _c = 0; _c < NKC; ++_c) ks[_c] = *(const bf16x8*)(kt_ + koff[_c]); } while (0)
#define SWRITE(b) do { *(LAS bf16x8*)(V_lds + (b) * SHM_V + vst0) = vs0; *(LAS bf16x8*)(V_lds + (b) * SHM_V + vst1) = vs1; \
    _Pragma("unroll") for (int _c = 0; _c < NKC; ++_c) *(LAS bf16x8*)(K_lds + (b) * SHM_K + kst[_c]) = ks[_c]; } while (0)
    const int NT = seq / KVBLK;
    SLOAD(0); SWRITE(0); SLOAD(KVBLK); __syncthreads();
#pragma unroll 1
    for (int j = 0; j < NT; ++j) {
        const int bsel = j & 1; f32x16 p0, p1; float mn, al; bf16x8 pa0, pa1, pa2, pa3;
        qkt<DQK>(p0, p1, K_lds + bsel * SHM_K, qr, r32, hi);
        partialSM<DQK>(p0, p1, m_reg, mn, al);
        if (__any(al < 1.f)) { if (hi == 0) al_l[r32] = al; asm volatile("s_waitcnt lgkmcnt(0)" ::: "memory");
#pragma unroll
            for (int d = 0; d < 4; ++d)
#pragma unroll
                for (int r = 0; r < 16; ++r) o[d][r] *= al_l[crow(r, hi)]; }
        finishSM(p0, p1, al, l_reg, pa0, pa1, pa2, pa3); SBAR();
        pv_d0(o, vb0 + bsel * SHM_V, pa0, pa1, pa2, pa3);
        if (j + 1 < NT) { SWRITE(bsel ^ 1); if (j + 2 < NT) SLOAD((j + 2) * KVBLK); }
        __syncthreads();
    }
    if (hi == 0) li_l[r32] = l_reg; asm volatile("s_waitcnt lgkmcnt(0)" ::: "memory");
    float rli[16];
#pragma unroll
    for (int r = 0; r < 16; ++r) rli[r] = __builtin_amdgcn_rcpf(li_l[crow(r, hi)]);
    bf16_t* Ow = Ob + (long)(wid * QBLK) * LDO;
#pragma unroll
    for (int r = 0; r < 16; ++r) { const int orow = crow(r, hi);
#pragma unroll
        for (int d0 = 0; d0 < 4; ++d0) Ow[(long)orow * LDO + d0 * 32 + r32] = f2bf(o[d0][r] * rli[r]); }
    __syncthreads();
#undef SLOAD
#undef SWRITE
}
template <int DQK, int SDEPTH, int NH, int VSHARE>
__device__ __forceinline__ void attn_phase(const bf16_t* Q, const bf16_t* K, const bf16_t* V, bf16_t* O, LAS char* lds, const int tid) {
    constexpr int LDQ = NH * DQK, LDK = NH * DQK, LDV = (NH / VSHARE) * DV, LDO = NH * DV;
    const int c = blockIdx.x, xcd = c & 7, slot = c >> 3;
    constexpr int ROUNDS = NB * NH / 8;
#pragma unroll 1
    for (int i = 0; i <= ROUNDS; ++i) {
        int b, h, seq; size_t qtok;
        if (i < ROUNDS) { const int bh = i * 8 + xcd; b = bh / NH; h = bh % NH; qtok = (size_t)b * TB + CTX + (size_t)slot * 256; seq = TB; }
        else { if (c >= NB * NH) break; b = c / NH; h = c % NH; qtok = (size_t)b * TB; seq = CTX; }
        const size_t t0 = (size_t)b * TB;
        if constexpr (SDEPTH == 0) attn_body_simple<DQK, LDQ, LDK, LDV, LDO>(Q + qtok * LDQ + h * 128, Q + qtok * LDQ + NH * 128 + h * (DQK - 128), K + t0 * LDK + h * DQK, V + t0 * LDV + (h / VSHARE) * DV, O + qtok * LDO + h * DV, seq, lds, tid);
        else attn_body<DQK, (SDEPTH == 0 ? 1 : SDEPTH), LDQ, LDK, LDV, LDO>(Q + qtok * LDQ + h * DQK, Q + qtok * LDQ + h * DQK, K + t0 * LDK + h * DQK, V + t0 * LDV + (h / VSHARE) * DV, O + qtok * LDO + h * DV, seq, lds, tid);
    }
}
}

struct Params { const float* in[27]; float* out; unsigned char* ws; int ph_lo, ph_hi; };
enum { I_X = 0, I_C, I_CTX, I_CCTX, I_ADAW, I_ADAB, I_NORMG, I_FINALG, I_DA_WIN, I_DA_WOUT, I_DA_LAM, I_DA_SUBG, I_RET_WIN, I_RET_DECAY, I_RET_WOUT, I_MLA_WIN, I_MLA_QG,
       I_MLA_WQUP, I_MLA_KVG, I_MLA_WKVUP, I_MLA_WOUT, I_MOE_WR, I_MOE_BR, I_MOE_WGU, I_MOE_BGU, I_MOE_WDN, I_MOE_BDN };

struct Frame {
    const Params* p; LAS unsigned char* lds; LAS unsigned char* reg; volatile LAS int* misc; int tid, lane, wave;
    unsigned char* ws;
};

enum { PK_ID = 0, PK_DA_IN, PK_RET_IN, PK_MLA_QUP, PK_MOE_GU };
__device__ __forceinline__ int src_col(int n, int kind) {
    if (kind == PK_DA_IN) { if ((n >> 10) == 1) return n; const int o = n & 63, axis = o >> 5, p = o & 31, f = p >> 1; return (n & ~63) | (axis * 32 + ((p & 1) ? 16 + f : f)); }
    if (kind == PK_RET_IN) { if (n < 1024 || (n >= 3072 && n < 4096)) { const int o = n & 255, f = o >> 1; return (n & ~255) | ((o & 1) ? 128 + f : f); } return n; }
    if (kind == PK_MLA_QUP) { if (n < 1024) return (n >> 7) * 192 + (n & 127); const int nn = n - 1024, hd = nn >> 6, oo = nn & 63, axis = oo >> 5, p = oo & 31, f = p >> 1; return hd * 192 + 128 + axis * 32 + ((p & 1) ? 16 + f : f); }
    if (kind == PK_MOE_GU) return ((n >> 2) & 1) * 1024 + (n >> 3) * 4 + (n & 3);
    return n;
}
__device__ __forceinline__ void tr_item(const float* W, int Ksrc, int Nsrc, bf16_t* WT, int Kdst, int Ndst, int Nvalid, int kind, LAS float* scr, int item, int lane) {
    const int nblk = Ndst / 32, kb = item / nblk, nb = item % nblk, k0 = 64 * kb, n0 = 32 * nb;
    const int n = n0 + (lane & 31); const bool nv = n < Nvalid; const int scn = nv ? src_col(n, kind) : 0;
#pragma unroll 8
    for (int i = 0; i < 32; ++i) { const int kk = 2 * i + (lane >> 5), k = k0 + kk; scr[kk * 33 + (lane & 31)] = (nv && k < Ksrc) ? W[(size_t)k * Nsrc + scn] : 0.f; }
    asm volatile("s_waitcnt lgkmcnt(0)" ::: "memory");
    const int c = lane & 7;
#pragma unroll
    for (int j = 0; j < 4; ++j) { const int nn = (lane >> 3) + 8 * j; const LAS float* s = scr + (8 * c) * 33 + nn;
        u32x4 o; o.x = pk2(s[0 * 33], s[1 * 33]); o.y = pk2(s[2 * 33], s[3 * 33]); o.z = pk2(s[4 * 33], s[5 * 33]); o.w = pk2(s[6 * 33], s[7 * 33]);
        *(u32x4*)(WT + (size_t)(n0 + nn) * Kdst + k0 + 8 * c) = o; }
    asm volatile("s_waitcnt lgkmcnt(0)" ::: "memory");
}
__device__ __forceinline__ float silu_f(float x) { return x / (1.0f + __expf(-x)); }

__device__ __forceinline__ void phase_prologue(Frame& F) {
    const Params& P = *F.p; unsigned char* ws = F.ws;
    const int gw = blockIdx.x * 8 + F.wave, NGW = GRID * 8, gt = blockIdx.x * NTHR + F.tid, NGT = GRID * NTHR;
    LAS float* sc = (LAS float*)(F.reg + 72 * 1024);
    for (int i = F.tid; i < 9 * 1024; i += NTHR) { const int r = i >> 10, k = i & 1023; const float v = r < 8 ? P.in[I_C][r * 1024 + k] : P.in[I_CCTX][k]; sc[i] = silu_f(v); }
    __syncthreads();
    {
        float* MOD = (float*)(ws + WS_MOD);
        for (int u = gw; u < 4 * 96; u += NGW) { const int L = u / 96, n = (u % 96) * 64 + F.lane; const float* W = P.in[I_ADAW] + (size_t)L * 1024 * 6144 + n;
            float a[9];
#pragma unroll
            for (int r = 0; r < 9; ++r) a[r] = 0.f;
#pragma unroll 8
            for (int k = 0; k < 1024; ++k) { const float w = W[(size_t)k * 6144];
#pragma unroll
                for (int r = 0; r < 9; ++r) a[r] = fmaf(sc[r * 1024 + k], w, a[r]); }
            const float bb = P.in[I_ADAB][L * 6144 + n];
#pragma unroll
            for (int r = 0; r < 9; ++r) MOD[((size_t)L * 9 + r) * 6144 + n] = a[r] + bb; }
    }
    {
        f32x2* TA = (f32x2*)(ws + WS_TABA); f32x2* TR = (f32x2*)(ws + WS_TABR);
        for (int i = gt; i < 128 * 16; i += NGT) { const int pos = i >> 4, j = i & 15; const float inv = powf(10000.0f, -(float)(2 * j) / 32.0f), a = (float)pos * inv; float s, c; sincosf(a, &s, &c); TA[i] = (f32x2){c, s}; }
        for (int i = gt; i < 8192 * 128; i += NGT) { const int pos = i >> 7, j = i & 127; const float inv = powf(10000.0f, -(float)(2 * j) / 256.0f), a = (float)pos * inv; float s, c; sincosf(a, &s, &c); TR[i] = (f32x2){c, s}; }
    }
    {
        f32x4* X = (f32x4*)(ws + WS_XRES);
        for (size_t i = gt; i < (size_t)T * 256; i += NGT) { const size_t g = i >> 8; const int q = (int)(i & 255); const int b = (int)(g / TB), j = (int)(g % TB);
            const f32x4* src = j < CTX ? (const f32x4*)(P.in[I_CTX] + ((size_t)b * CTX + j) * 1024) : (const f32x4*)(P.in[I_X] + ((size_t)b * SEQ + (j - CTX)) * 1024);
            X[i] = src[q]; }
    }
    {
        LAS float* scr = (LAS float*)(F.reg + F.wave * 8704);
#define TR_JOB(W_, Ksrc_, Nsrc_, DST_, Kdst_, Ndst_, Nvalid_, KIND_, COUNT_) do { const int per_ = ((Kdst_) / 64) * ((Ndst_) / 32), total_ = per_ * (COUNT_); \
        _Pragma("unroll 1") for (int it_ = gw; it_ < total_; it_ += NGW) { const int mi_ = it_ / per_, item_ = it_ % per_; \
            tr_item((W_) + (size_t)mi_ * (Ksrc_) * (Nsrc_), Ksrc_, Nsrc_, (bf16_t*)(ws + (DST_)) + (size_t)mi_ * (Kdst_) * (Ndst_), Kdst_, Ndst_, Nvalid_, KIND_, scr, item_, F.lane); } } while (0)
        TR_JOB(P.in[I_DA_WIN], 1024, 3072, WS_W_DA_IN, 1024, 3072, 3072, PK_DA_IN, 2);
        TR_JOB(P.in[I_DA_WOUT], 1024, 1024, WS_W_DA_OUT, 1024, 1024, 1024, PK_ID, 2);
        TR_JOB(P.in[I_RET_WIN], 1024, 6144, WS_W_RET_IN, 1024, 6144, 6144, PK_RET_IN, 1);
        TR_JOB(P.in[I_RET_WOUT], 2048, 1024, WS_W_RET_OUT, 2048, 1024, 1024, PK_ID, 1);
        TR_JOB(P.in[I_MLA_WIN], 1024, 448, WS_W_MLA_IN, 1024, 512, 448, PK_ID, 1);
        TR_JOB(P.in[I_MLA_WQUP], 256, 1536, WS_W_MLA_QUP, 256, 1536, 1536, PK_MLA_QUP, 1);
        TR_JOB(P.in[I_MLA_WKVUP], 128, 2048, WS_W_MLA_KVUP, 256, 2048, 2048, PK_ID, 1);
        TR_JOB(P.in[I_MLA_WOUT], 1024, 1024, WS_W_MLA_OUT, 1024, 1024, 1024, PK_ID, 1);
        TR_JOB(P.in[I_MOE_WGU], 1024, 2048, WS_W_GU, 1024, 2048, 2048, PK_MOE_GU, 128);
        TR_JOB(P.in[I_MOE_WDN], 1024, 1024, WS_W_DN, 1024, 1024, 1024, PK_ID, 128);
#undef TR_JOB
    }
}

template <int L, int LC = L - 1>
__device__ __forceinline__ void phase_norm1(Frame& F) {
    const Params& P = *F.p; unsigned char* ws = F.ws;
    float* XR = (float*)(ws + WS_XRES); bf16_t* HB = (bf16_t*)(ws + WS_HBUF); const float* MOD = (const float*)(ws + WS_MOD);
    const int* SLOT = (const int*)(ws + WS_SLOT); const float* GATE = (const float*)(ws + WS_GATE); const bf16_t* OUT2 = (const bf16_t*)(ws + MO_OUT);
    const float* gain = L < 4 ? P.in[I_NORMG] + (size_t)(L * 2 + 0) * 1024 : P.in[I_FINALG];
    f32x4 gn[4];
#pragma unroll
    for (int j = 0; j < 4; ++j) gn[j] = *(const f32x4*)(gain + 4 * F.lane + 256 * j);
    for (int i = 0; i < TOK_PER_BLK / 8; ++i) {
        const int t = blockIdx.x * TOK_PER_BLK + F.wave + 8 * i; const int b = t / TB, jt = t % TB; const bool isctx = jt < CTX; const int mrow = isctx ? 8 : b;
        if (L == 4 && isctx) continue;
        f32x4 v[4]; float* xr = XR + (size_t)t * 1024 + 4 * F.lane;
#pragma unroll
        for (int j = 0; j < 4; ++j) v[j] = *(const f32x4*)(xr + 256 * j);
        if (LC >= 0) {
            const int4 sl = *(const int4*)(SLOT + (size_t)t * 4); const f32x4 gt = *(const f32x4*)(GATE + (size_t)t * 4);
            const int sls[4] = {sl.x, sl.y, sl.z, sl.w};
            f32x4 a[4];
#pragma unroll
            for (int j = 0; j < 4; ++j) a[j] = (f32x4){0.f, 0.f, 0.f, 0.f};
#pragma unroll
            for (int k = 0; k < 4; ++k) { const bf16_t* orow = OUT2 + (size_t)sls[k] * 1024 + 4 * F.lane; const float gk = gt[k];
#pragma unroll
                for (int j = 0; j < 4; ++j) { const u32x2 w = *(const u32x2*)(orow + 256 * j); a[j] += gk * (f32x4){bflo(w.x), bfhi(w.x), bflo(w.y), bfhi(w.y)}; } }
            const float* m5 = MOD + ((size_t)(LC < 0 ? 0 : LC) * 9 + mrow) * 6144 + 5 * 1024 + 4 * F.lane;
#pragma unroll
            for (int j = 0; j < 4; ++j) { v[j] += *(const f32x4*)(m5 + 256 * j) * a[j]; if (L < 4) *(f32x4*)(xr + 256 * j) = v[j]; }
        }
#ifdef DBG_NANFIX
        if (L == 4) {
#pragma unroll
            for (int j = 0; j < 4; ++j)
#pragma unroll
                for (int e = 0; e < 4; ++e) if (!(fabsf(v[j][e]) < 1e30f)) v[j][e] = 1000.0f; }
#endif
        float ss = 0.f;
#pragma unroll
        for (int j = 0; j < 4; ++j) ss += (v[j][0] * v[j][0] + v[j][1] * v[j][1]) + (v[j][2] * v[j][2] + v[j][3] * v[j][3]);
        const float rstd = rsqrtf(wave_sum(ss) * (1.0f / 1024.0f) + RMS_EPS);
        if (L < 4) {
            const float* msh = MOD + ((size_t)L * 9 + mrow) * 6144 + 4 * F.lane; bf16_t* hr = HB + (size_t)t * 1024 + 4 * F.lane;
#pragma unroll
            for (int j = 0; j < 4; ++j) { const f32x4 sh = *(const f32x4*)(msh + 256 * j), scl = *(const f32x4*)(msh + 1024 + 256 * j);
                const f32x4 y = v[j] * rstd * gn[j] * (scl + 1.0f) + sh; u32x2 w; w.x = pk2(y[0], y[1]); w.y = pk2(y[2], y[3]); *(u32x2*)(hr + 256 * j) = w; }
        } else {
            float* orow = P.out + ((size_t)b * SEQ + (jt - CTX)) * 1024 + 4 * F.lane;
#pragma unroll
            for (int j = 0; j < 4; ++j) *(f32x4*)(orow + 256 * j) = v[j] * rstd * gn[j];
        }
    }
}

template <int L>
__device__ __forceinline__ void phase_norm2(Frame& F) {
    const Params& P = *F.p; unsigned char* ws = F.ws;
    const float* XR = (const float*)(ws + WS_XRES); bf16_t* HB = (bf16_t*)(ws + WS_HBUF); const float* MOD = (const float*)(ws + WS_MOD);
    int* IDX = (int*)(ws + WS_IDX); float* GATE = (float*)(ws + WS_GATE); int* RANK = (int*)(ws + WS_RANK); int* BLKCNT = (int*)(ws + WS_BLKCNT);
    const float* gain = P.in[I_NORMG] + (size_t)(L * 2 + 1) * 1024; const float* Wr = P.in[I_MOE_WR] + (size_t)L * 1024 * 32; const float* br = P.in[I_MOE_BR] + L * 32;
    LAS float* hf = (LAS float*)F.reg;
    LAS float* part = (LAS float*)(F.reg + 32768);
    LAS float* lg = (LAS float*)(F.reg + 32768 + 2048);
    LAS int* lcnt = (LAS int*)(F.reg + 32768 + 2048 + 1024);
    if (F.tid < 32) lcnt[F.tid] = 0;
    f32x4 gn[4];
#pragma unroll
    for (int j = 0; j < 4; ++j) gn[j] = *(const f32x4*)(gain + 4 * F.lane + 256 * j);
    __syncthreads();
    for (int i = 0; i < TOK_PER_BLK / 8; ++i) {
        const int t0 = blockIdx.x * TOK_PER_BLK + 8 * i;
        {
            const int t = t0 + F.wave; const int b = t / TB, jt = t % TB; const int mrow = jt < CTX ? 8 : b;
            f32x4 v[4]; const float* xr = XR + (size_t)t * 1024 + 4 * F.lane;
#pragma unroll
            for (int j = 0; j < 4; ++j) v[j] = *(const f32x4*)(xr + 256 * j);
            float ss = 0.f;
#pragma unroll
            for (int j = 0; j < 4; ++j) ss += (v[j][0] * v[j][0] + v[j][1] * v[j][1]) + (v[j][2] * v[j][2] + v[j][3] * v[j][3]);
            const float rstd = rsqrtf(wave_sum(ss) * (1.0f / 1024.0f) + RMS_EPS);
            const float* msh = MOD + ((size_t)L * 9 + mrow) * 6144 + 3 * 1024 + 4 * F.lane; bf16_t* hr = HB + (size_t)t * 1024 + 4 * F.lane;
#pragma unroll
            for (int j = 0; j < 4; ++j) { const f32x4 sh = *(const f32x4*)(msh + 256 * j), scl = *(const f32x4*)(msh + 1024 + 256 * j);
                const f32x4 y = v[j] * rstd * gn[j] * (scl + 1.0f) + sh; u32x2 w; w.x = pk2(y[0], y[1]); w.y = pk2(y[2], y[3]); *(u32x2*)(hr + 256 * j) = w;
                *(LAS f32x4*)(hf + F.wave * 1024 + 4 * F.lane + 256 * j) = y; }
        }
        __syncthreads();
        {
            const int kh = F.tid >> 8, tok = (F.tid >> 5) & 7, e = F.tid & 31; const LAS float* hp = hf + tok * 1024 + kh * 512; const float* wp = Wr + (size_t)kh * 512 * 32 + e;
            float a0 = 0.f, a1 = 0.f;
#pragma unroll 8
            for (int d = 0; d < 512; d += 2) { a0 = fmaf(hp[d], wp[(size_t)d * 32], a0); a1 = fmaf(hp[d + 1], wp[(size_t)(d + 1) * 32], a1); }
            part[(kh * 8 + tok) * 32 + e] = a0 + a1;
        }
        __syncthreads();
        if (F.tid < 256) { const int tok = F.tid >> 5, e = F.tid & 31; lg[tok * 32 + e] = part[tok * 32 + e] + part[(8 + tok) * 32 + e] + br[e]; }
        __syncthreads();
        if (F.tid < 8) {
            const int t = t0 + F.tid; const LAS float* l = lg + F.tid * 32; int id[4]; float lv[4]; unsigned used = 0u;
#pragma unroll
            for (int k = 0; k < 4; ++k) { float best = -3.0e38f; int bi = 0;
                for (int e = 0; e < 32; ++e) { const float x = l[e]; if (!((used >> e) & 1u) && x > best) { best = x; bi = e; } }
                used |= 1u << bi; id[k] = bi; lv[k] = best; }
            float ex[4], s = 0.f;
#pragma unroll
            for (int k = 0; k < 4; ++k) { ex[k] = __expf(lv[k] - lv[0]); s += ex[k]; }
            const float inv = 1.0f / s; int rk[4];
#pragma unroll
            for (int k = 0; k < 4; ++k) rk[k] = atomicAdd((int*)(lcnt + id[k]), 1);
            *(int4*)(IDX + (size_t)t * 4) = make_int4(id[0], id[1], id[2], id[3]);
            *(f32x4*)(GATE + (size_t)t * 4) = (f32x4){ex[0] * inv, ex[1] * inv, ex[2] * inv, ex[3] * inv};
            *(int4*)(RANK + (size_t)t * 4) = make_int4(rk[0], rk[1], rk[2], rk[3]);
        }
        __syncthreads();
    }
    if (F.tid < 32) BLKCNT[blockIdx.x * 32 + F.tid] = lcnt[F.tid];
}

__device__ __forceinline__ void moe_offsets(Frame& F) {
    const int* BLKCNT = (const int*)(F.ws + WS_BLKCNT);
    __syncthreads();
    if (F.tid < 32) { int tot = 0, pre = 0;
        for (int b = 0; b < GRID; ++b) { const int c = BLKCNT[b * 32 + F.tid]; pre += (b < (int)blockIdx.x) ? c : 0; tot += c; }
        F.misc[128 + F.tid] = pre; F.misc[160 + F.tid] = (tot + 255) & ~255; }
    __syncthreads();
    if (F.tid == 0) { int s = 0; for (int e = 0; e < 32; ++e) { F.misc[64 + e] = s; s += F.misc[160 + e]; } F.misc[64 + 32] = s; }
    __syncthreads();
}
__device__ __forceinline__ void phase_scatter(Frame& F) {
    unsigned char* ws = F.ws;
    const int* IDX = (const int*)(ws + WS_IDX); const int* RANK = (const int*)(ws + WS_RANK); int* SLOT = (int*)(ws + WS_SLOT);
    const bf16_t* HB = (const bf16_t*)(ws + WS_HBUF); bf16_t* HS = (bf16_t*)(ws + MO_HS);
    moe_offsets(F);
    for (int q = F.wave; q < TOK_PER_BLK * 4; q += 8) { const int t = blockIdx.x * TOK_PER_BLK + (q >> 2), k = q & 3;
        const int e = IDX[(size_t)t * 4 + k], r = RANK[(size_t)t * 4 + k]; const int slot = F.misc[64 + e] + F.misc[128 + e] + r;
        if (F.lane == 0) SLOT[(size_t)t * 4 + k] = slot;
        const u32x4* src = (const u32x4*)(HB + (size_t)t * 1024); u32x4* dst = (u32x4*)(HS + (size_t)slot * 1024);
        dst[F.lane] = src[F.lane]; dst[64 + F.lane] = src[64 + F.lane]; }
}

template <int L>
__device__ __forceinline__ void phase_da_post(Frame& F) {
    const Params& P = *F.p; unsigned char* ws = F.ws; constexpr int J = L / 3;
    const bf16_t* O = (const bf16_t*)(ws + DA_O); bf16_t* O2 = (bf16_t*)(ws + DA_O2);
    const float* lamv = P.in[I_DA_LAM] + J * 256; const float* subg = P.in[I_DA_SUBG] + J * 128;
    const float lam_init = L == 0 ? 0.2f : 0.8f - 0.6f * 0.40656965974059917f;
    const float d01 = wave_sum(lamv[F.lane] * lamv[64 + F.lane]), d23 = wave_sum(lamv[128 + F.lane] * lamv[192 + F.lane]);
    const float lam = expf(d01) - expf(d23) + lam_init;
    const int h = F.lane >> 3, ch = F.lane & 7; float g[16];
#pragma unroll
    for (int e = 0; e < 16; ++e) g[e] = subg[ch * 16 + e] * (1.0f - lam_init);
    for (int t = blockIdx.x * 8 + F.wave; t < T; t += GRID * 8) {
        const bf16_t* r0 = O + (size_t)t * 2048 + (2 * h) * 128 + ch * 16; const bf16_t* r1 = r0 + 128;
        const u32x4 a0 = *(const u32x4*)r0, a1 = *(const u32x4*)(r0 + 8), b0 = *(const u32x4*)r1, b1 = *(const u32x4*)(r1 + 8);
        float d[16]; const unsigned aw[8] = {a0.x, a0.y, a0.z, a0.w, a1.x, a1.y, a1.z, a1.w}, bw[8] = {b0.x, b0.y, b0.z, b0.w, b1.x, b1.y, b1.z, b1.w};
        float ss = 0.f;
#pragma unroll
        for (int e = 0; e < 8; ++e) { d[2 * e] = bflo(aw[e]) - lam * bflo(bw[e]); d[2 * e + 1] = bfhi(aw[e]) - lam * bfhi(bw[e]); ss += d[2 * e] * d[2 * e] + d[2 * e + 1] * d[2 * e + 1]; }
        ss += __shfl_xor(ss, 1); ss += __shfl_xor(ss, 2); ss += __shfl_xor(ss, 4);
        const float r = rsqrtf(ss * (1.0f / 128.0f) + RMS_EPS);
        u32x4 w0, w1;
        w0.x = pk2(d[0] * r * g[0], d[1] * r * g[1]); w0.y = pk2(d[2] * r * g[2], d[3] * r * g[3]); w0.z = pk2(d[4] * r * g[4], d[5] * r * g[5]); w0.w = pk2(d[6] * r * g[6], d[7] * r * g[7]);
        w1.x = pk2(d[8] * r * g[8], d[9] * r * g[9]); w1.y = pk2(d[10] * r * g[10], d[11] * r * g[11]); w1.z = pk2(d[12] * r * g[12], d[13] * r * g[13]); w1.w = pk2(d[14] * r * g[14], d[15] * r * g[15]);
        bf16_t* orow = O2 + (size_t)t * 1024 + h * 128 + ch * 16; *(u32x4*)orow = w0; *(u32x4*)(orow + 8) = w1;
    }
}

__device__ __forceinline__ void phase_ret_post(Frame& F) {
    unsigned char* ws = F.ws;
    const bf16_t* OF = (const bf16_t*)(ws + RT_OF); const bf16_t* OB = (const bf16_t*)(ws + RT_OB); const bf16_t* Gb = (const bf16_t*)(ws + RT_G); bf16_t* A = (bf16_t*)(ws + RT_A);
    for (int t = blockIdx.x * 8 + F.wave; t < T; t += GRID * 8) {
        const size_t off = (size_t)t * 2048 + F.lane * 32; float o[32]; float ss = 0.f;
#pragma unroll
        for (int q = 0; q < 4; ++q) { const u32x4 a = *(const u32x4*)(OF + off + 8 * q), b = *(const u32x4*)(OB + off + 8 * q); const unsigned aw[4] = {a.x, a.y, a.z, a.w}, bw[4] = {b.x, b.y, b.z, b.w};
#pragma unroll
            for (int e = 0; e < 4; ++e) { const float x0 = bflo(aw[e]) + bflo(bw[e]), x1 = bfhi(aw[e]) + bfhi(bw[e]); o[8 * q + 2 * e] = x0; o[8 * q + 2 * e + 1] = x1; ss += x0 * x0 + x1 * x1; } }
        ss += __shfl_xor(ss, 1); ss += __shfl_xor(ss, 2); ss += __shfl_xor(ss, 4); ss += __shfl_xor(ss, 8);
        const float r = rsqrtf(ss * (1.0f / 512.0f) + RMS_EPS);
#pragma unroll
        for (int q = 0; q < 4; ++q) { const u32x4 gq = *(const u32x4*)(Gb + off + 8 * q); const unsigned gw[4] = {gq.x, gq.y, gq.z, gq.w}; unsigned w[4];
#pragma unroll
            for (int e = 0; e < 4; ++e) { const float g0 = bflo(gw[e]), g1 = bfhi(gw[e]); w[e] = pk2(silu_f(g0) * o[8 * q + 2 * e] * r, silu_f(g1) * o[8 * q + 2 * e + 1] * r); }
            *(u32x4*)(A + off + 8 * q) = (u32x4){w[0], w[1], w[2], w[3]}; }
    }
}

__device__ __forceinline__ void phase_mla_norm(Frame& F) {
    const Params& P = *F.p; unsigned char* ws = F.ws;
    const float* Pm = (const float*)(ws + ML_P); bf16_t* AKV = (bf16_t*)(ws + ML_AKV); bf16_t* AQ = (bf16_t*)(ws + ML_AQ); bf16_t* Kb = (bf16_t*)(ws + ML_K);
    const f32x2* TA = (const f32x2*)(ws + WS_TABA);
    const f32x2 gkv = *(const f32x2*)(P.in[I_MLA_KVG] + 2 * F.lane); const f32x4 gq = *(const f32x4*)(P.in[I_MLA_QG] + 4 * F.lane);
    for (int t = blockIdx.x * 8 + F.wave; t < T; t += GRID * 8) {
        const float* pr = Pm + (size_t)t * 512; const int jt = t % TB; const bool lat = jt >= CTX; const int p = jt - CTX;
        const f32x2 ckv = *(const f32x2*)(pr + 2 * F.lane); const f32x4 cq = *(const f32x4*)(pr + 192 + 4 * F.lane);
        const float rkv = rsqrtf(wave_sum(ckv[0] * ckv[0] + ckv[1] * ckv[1]) * (1.0f / 128.0f) + RMS_EPS);
        const float rq = rsqrtf(wave_sum((cq[0] * cq[0] + cq[1] * cq[1]) + (cq[2] * cq[2] + cq[3] * cq[3])) * (1.0f / 256.0f) + RMS_EPS);
        *(unsigned*)(AKV + (size_t)t * 256 + 2 * F.lane) = pk2(ckv[0] * rkv * gkv[0], ckv[1] * rkv * gkv[1]);
        *(unsigned*)(AKV + (size_t)t * 256 + 128 + 2 * F.lane) = 0u;
        u32x2 wq; wq.x = pk2(cq[0] * rq * gq[0], cq[1] * rq * gq[1]); wq.y = pk2(cq[2] * rq * gq[2], cq[3] * rq * gq[3]); *(u32x2*)(AQ + (size_t)t * 256 + 4 * F.lane) = wq;
        if (F.lane < 32) { const int axis = F.lane >> 4, f = F.lane & 15; float x1 = pr[128 + axis * 32 + f], x2 = pr[128 + axis * 32 + 16 + f];
            if (lat) { const int pos = axis ? (p & 63) : (p >> 6); const f32x2 cs = TA[pos * 16 + f]; const float r1 = x1 * cs[0] - x2 * cs[1], r2 = x1 * cs[1] + x2 * cs[0]; x1 = r1; x2 = r2; }
            const unsigned w = pk2(x1, x2); bf16_t* kp = Kb + (size_t)t * 1536 + 128 + axis * 32 + 2 * f;
#pragma unroll
            for (int h = 0; h < 8; ++h) *(unsigned*)(kp + h * 192) = w; }
    }
}

__device__ __forceinline__ void phase_ret_scan(Frame& F) {
    const Params& P = *F.p; unsigned char* ws = F.ws;
    const bf16_t* Qg = (const bf16_t*)(ws + RT_Q); const bf16_t* Kg = (const bf16_t*)(ws + RT_K); const bf16_t* Vg = (const bf16_t*)(ws + RT_V);
    const int u = blockIdx.x, sl = u & 3, dir = (u >> 2) & 1, h = (u >> 3) & 3, b = u >> 5;
    bf16_t* Og = (bf16_t*)(ws + (dir ? RT_OB : RT_OF));
#ifdef DBG_FAKESCAN
    for (int i = F.tid; i < TB * 128; i += NTHR) { const int tok = i >> 7, c = i & 127; const size_t g = (size_t)b * TB + tok;
        const float v = bf2f(Vg[g * 2048 + h * 512 + sl * 128 + c]) + bf2f(Kg[g * 1024 + h * 256 + c]) + bf2f(Qg[g * 1024 + h * 256 + 128 + c]);
        Og[g * 2048 + h * 512 + sl * 128 + c] = dir ? (bf16_t)0 : f2bf(v); }
    return;
#endif
    constexpr int QS = 264, TS = 72;
    LAS bf16_t* Qc = (LAS bf16_t*)F.reg;
    LAS bf16_t* Kc = Qc + 64 * QS;
    LAS bf16_t* Kt = Kc + 64 * QS;
    LAS bf16_t* Vt = Kt + 256 * TS;
    LAS bf16_t* Sb = Vt + 128 * TS;
    const float x = P.in[I_RET_DECAY][dir * 4 + h];
    const float lg2 = -log1pf(expf(-x)) * 1.4426950408889634f;
    const int tid = F.tid, lane = F.lane, w = F.wave, l15 = lane & 15, g = lane >> 4;
    f32x4 st[16];
#pragma unroll
    for (int k = 0; k < 16; ++k) st[k] = (f32x4){0.f, 0.f, 0.f, 0.f};
    const float cdec = exp2f(64.0f * lg2);
    const size_t tb0 = (size_t)b * TB;
#pragma unroll 1
    for (int s = 0; s < TB / 64; ++s) {
        int cidx; if (dir == 0) cidx = s; else cidx = s < 4 ? 3 - s : 4 + (131 - s);
        if (s == 4 && false) {}
        const size_t tok0 = tb0 + (size_t)cidx * 64;
        __syncthreads();
#pragma unroll
        for (int i = 0; i < 4; ++i) { const int e = tid + 512 * i, row = e >> 5, ch = e & 31;
            const u32x4 q = *(const u32x4*)(Qg + (tok0 + row) * 1024 + h * 256 + ch * 8), k = *(const u32x4*)(Kg + (tok0 + row) * 1024 + h * 256 + ch * 8);
            *(LAS u32x4*)(Qc + row * QS + ch * 8) = q; *(LAS u32x4*)(Kc + row * QS + ch * 8) = k;
            const float kd = exp2f((dir == 0 ? (float)(63 - row) : (float)row) * lg2); const unsigned kw[4] = {k.x, k.y, k.z, k.w};
#pragma unroll
            for (int e2 = 0; e2 < 4; ++e2) { Kt[(ch * 8 + 2 * e2) * TS + row] = f2bf(bflo(kw[e2]) * kd); Kt[(ch * 8 + 2 * e2 + 1) * TS + row] = f2bf(bfhi(kw[e2]) * kd); } }
#pragma unroll
        for (int i = 0; i < 2; ++i) { const int e = tid + 512 * i, row = e >> 4, ch = e & 15;
            const u32x4 v = *(const u32x4*)(Vg + (tok0 + row) * 2048 + h * 512 + sl * 128 + ch * 8); const unsigned vw[4] = {v.x, v.y, v.z, v.w};
#pragma unroll
            for (int e2 = 0; e2 < 4; ++e2) { Vt[(ch * 8 + 2 * e2) * TS + row] = (bf16_t)(vw[e2] & 0xffffu); Vt[(ch * 8 + 2 * e2 + 1) * TS + row] = (bf16_t)(vw[e2] >> 16); } }
        __syncthreads();
        {
            const int ti = w >> 1;
#pragma unroll
            for (int c2 = 0; c2 < 2; ++c2) { const int tj = 2 * (w & 1) + c2; f32x4 a = (f32x4){0.f, 0.f, 0.f, 0.f};
#pragma unroll
                for (int kk = 0; kk < 8; ++kk) { const bf16x8 af = *(const LAS bf16x8*)(Qc + (16 * ti + l15) * QS + 32 * kk + 8 * g), bfr = *(const LAS bf16x8*)(Kc + (16 * tj + l15) * QS + 32 * kk + 8 * g);
                    a = __builtin_amdgcn_mfma_f32_16x16x32_bf16(af, bfr, a, 0, 0, 0); }
                const int jj = 16 * tj + l15;
#pragma unroll
                for (int r = 0; r < 4; ++r) { const int ii = 16 * ti + 4 * g + r; const int df = dir == 0 ? ii - jj : jj - ii;
                    const float m = df >= 0 ? exp2f((float)df * lg2) : 0.f; Sb[ii * TS + jj] = f2bf(a[r] * m); } }
        }
        __syncthreads();
        bf16x8 vf[2];
#pragma unroll
        for (int jj = 0; jj < 2; ++jj) vf[jj] = *(const LAS bf16x8*)(Vt + (16 * w + l15) * TS + 32 * jj + 8 * g);
        bf16x8 sfrag[8];
#pragma unroll
        for (int kk = 0; kk < 8; ++kk) { u32x4 wv; wv.x = pk2(st[2 * kk][0], st[2 * kk][1]); wv.y = pk2(st[2 * kk][2], st[2 * kk][3]); wv.z = pk2(st[2 * kk + 1][0], st[2 * kk + 1][1]); wv.w = pk2(st[2 * kk + 1][2], st[2 * kk + 1][3]);
            sfrag[kk] = *reinterpret_cast<bf16x8*>(&wv); }
#pragma unroll
        for (int it = 0; it < 4; ++it) {
            f32x4 a = (f32x4){0.f, 0.f, 0.f, 0.f};
#pragma unroll
            for (int kk = 0; kk < 8; ++kk) { const LAS bf16_t* qp = Qc + (16 * it + l15) * QS + 32 * kk + 4 * g; const s16x4 lo = *(const LAS s16x4*)qp, hi4 = *(const LAS s16x4*)(qp + 16);
                const bf16x8 af = (bf16x8){lo[0], lo[1], lo[2], lo[3], hi4[0], hi4[1], hi4[2], hi4[3]};
                a = __builtin_amdgcn_mfma_f32_16x16x32_bf16(af, sfrag[kk], a, 0, 0, 0); }
#pragma unroll
            for (int r = 0; r < 4; ++r) { const int ii = 16 * it + 4 * g + r; a[r] *= exp2f((dir == 0 ? (float)(ii + 1) : (float)(64 - ii)) * lg2); }
#pragma unroll
            for (int jj = 0; jj < 2; ++jj) { const bf16x8 af = *(const LAS bf16x8*)(Sb + (16 * it + l15) * TS + 32 * jj + 8 * g); a = __builtin_amdgcn_mfma_f32_16x16x32_bf16(af, vf[jj], a, 0, 0, 0); }
#pragma unroll
            for (int r = 0; r < 4; ++r) { const int ii = 16 * it + 4 * g + r; Og[(tok0 + ii) * 2048 + h * 512 + sl * 128 + 16 * w + l15] = f2bf_c(a[r]); }
        }
        if (s == 3) {
        }
#pragma unroll
        for (int kq = 0; kq < 16; ++kq) { f32x4 a = st[kq] * cdec;
#pragma unroll
            for (int jj = 0; jj < 2; ++jj) { const bf16x8 af = *(const LAS bf16x8*)(Kt + (16 * kq + l15) * TS + 32 * jj + 8 * g); a = __builtin_amdgcn_mfma_f32_16x16x32_bf16(af, vf[jj], a, 0, 0, 0); }
            st[kq] = a; }
    }
    __syncthreads();
}

__global__ void __launch_bounds__(NTHR, 2) hybrid_fwd(Params prm) {
    extern __shared__ __attribute__((aligned(16))) unsigned char lds_raw[];
    Frame F; F.p = &prm; F.lds = (LAS unsigned char*)lds_raw; F.reg = F.lds + REG_OFF; F.misc = (volatile LAS int*)F.lds;
    F.tid = threadIdx.x; F.lane = F.tid & 63; F.wave = __builtin_amdgcn_readfirstlane(F.tid >> 6); F.ws = prm.ws;
    if (gridDim.x != GRID) return;
    for (int i = F.tid; i < MISC_BYTES / 4; i += NTHR) F.misc[i] = 0;
    __syncthreads();
    unsigned* barw = (unsigned*)(F.ws + WS_CTL);
    XcdBarrier bar; bar.bar = barw; bar.x = 0; bar.st = nullptr;
    if (!MK_MULTI) bar = xcd_barrier_post(barw, (volatile LAS unsigned*)(F.misc + 8));
    const int lo = prm.ph_lo, hi = prm.ph_hi;
    unsigned char* ws = F.ws; const Params& P = prm;
    LAS unsigned char* GR = F.reg;
#define MOD ((const float*)(ws + WS_MOD))
#define PHASE_INIT do { unsigned char* w_ = prm.ws; asm volatile("" : "+s"(w_)); F.ws = w_; ws = w_; int t_ = threadIdx.x; asm volatile("" : "+v"(t_)); F.tid = t_; F.lane = t_ & 63; } while (0)
#ifndef PH_MIN
#define PH_MIN 0
#define PH_MAX 1000
#endif
#ifndef DBG_STOP
#define DBG_STOP 1000
#define DBG_LC 3
#endif
#define IN(k) ((k) >= PH_MIN && (k) <= PH_MAX && ((k) <= DBG_STOP || (k) == 38) && lo <= (k) && (k) < hi)
#define SEAM(k) do { if (!MK_MULTI && IN(k) && IN((k) + 1)) xcd_barrier(bar); } while (0)
#define GEMM_DENSE(EPI, EOBJ, APTR, BPTR, KK, NN) do { pg8::StaticOrder S_; S_.init(NTILES, (NN) / 256, (int)blockIdx.x); \
        pg8::gemm_phase<EPI, pg8::StaticOrder>(GR, (const bf16_t*)(APTR), (const bf16_t*)(BPTR), KK, 0, S_, EOBJ, F.tid); } while (0)

    if (IN(0)) { PHASE_INIT; phase_prologue(F); } SEAM(0);

#define DA_LAYER(L, BASE) do { constexpr int J_ = (L) / 3; \
    if (IN(BASE + 0)) { PHASE_INIT; phase_norm1<L>(F); } SEAM(BASE + 0); \
    if (IN(BASE + 1)) { PHASE_INIT; pg8::EpiDaIn E_{(bf16_t*)(ws + DA_K), (const f32x2*)(ws + WS_TABA)}; \
        GEMM_DENSE(pg8::EpiDaIn, E_, ws + WS_HBUF, ws + WS_W_DA_IN + (size_t)J_ * 3072 * 1024 * 2, 1024, 3072); } SEAM(BASE + 1); \
    if (IN(BASE + 2)) { PHASE_INIT; att::attn_phase<64, 2, 16, 2>((const bf16_t*)(ws + DA_Q), (const bf16_t*)(ws + DA_K), (const bf16_t*)(ws + DA_V), (bf16_t*)(ws + DA_O), (LAS char*)GR, F.tid); } SEAM(BASE + 2); \
    if (IN(BASE + 3)) { PHASE_INIT; phase_da_post<L>(F); } SEAM(BASE + 3); \
    if (IN(BASE + 4)) { PHASE_INIT; pg8::EpiResid E_{(float*)(ws + WS_XRES), MOD + (size_t)(L) * 9 * 6144 + 2 * 1024}; \
        GEMM_DENSE(pg8::EpiResid, E_, ws + DA_O2, ws + WS_W_DA_OUT + (size_t)J_ * 1024 * 1024 * 2, 1024, 1024); } SEAM(BASE + 4); } while (0)

#define MOE_LAYER(L, BASE) do { \
    if (IN(BASE + 0)) { PHASE_INIT; phase_norm2<L>(F); } SEAM(BASE + 0); \
    if (IN(BASE + 1)) { PHASE_INIT; phase_scatter(F); } SEAM(BASE + 1); \
    if (IN(BASE + 2)) { PHASE_INIT; moe_offsets(F); pg8::MoeOrder S_; S_.init(F.misc[64 + 32] / 256, 8, (int)blockIdx.x); S_.pad_start = F.misc + 64; \
        pg8::EpiMoe1 E_{(bf16_t*)(ws + MO_ACT), P.in[I_MOE_BGU] + (size_t)(L) * 32 * 2048}; \
        pg8::gemm_phase<pg8::EpiMoe1, pg8::MoeOrder>(GR, (const bf16_t*)(ws + MO_HS), (const bf16_t*)(ws + WS_W_GU + (size_t)(L) * 32 * 2048 * 1024 * 2), 1024, (size_t)2048 * 1024 * 2, S_, E_, F.tid); } SEAM(BASE + 2); \
    if (IN(BASE + 3)) { PHASE_INIT; moe_offsets(F); pg8::MoeOrder S_; S_.init(F.misc[64 + 32] / 256, 4, (int)blockIdx.x); S_.pad_start = F.misc + 64; \
        pg8::EpiMoe2 E_{(bf16_t*)(ws + MO_OUT), P.in[I_MOE_BDN] + (size_t)(L) * 32 * 1024}; \
        pg8::gemm_phase<pg8::EpiMoe2, pg8::MoeOrder>(GR, (const bf16_t*)(ws + MO_ACT), (const bf16_t*)(ws + WS_W_DN + (size_t)(L) * 32 * 1024 * 1024 * 2), 1024, (size_t)1024 * 1024 * 2, S_, E_, F.tid); } SEAM(BASE + 3); } while (0)

    DA_LAYER(0, 1);
    MOE_LAYER(0, 6);

    if (IN(10)) { PHASE_INIT; phase_norm1<1>(F); } SEAM(10);
    if (IN(11)) { PHASE_INIT; pg8::EpiRetIn E_{(bf16_t*)(ws + RT_K), (bf16_t*)(ws + RT_V), (bf16_t*)(ws + RT_Q), (bf16_t*)(ws + RT_G), (const f32x2*)(ws + WS_TABR)};
        GEMM_DENSE(pg8::EpiRetIn, E_, ws + WS_HBUF, ws + WS_W_RET_IN, 1024, 6144); } SEAM(11);
    if (IN(12)) { PHASE_INIT; phase_ret_scan(F); } SEAM(12);
    if (IN(13)) { PHASE_INIT; phase_ret_post(F); } SEAM(13);
    if (IN(14)) { PHASE_INIT; pg8::EpiResid E_{(float*)(ws + WS_XRES), MOD + (size_t)1 * 9 * 6144 + 2 * 1024};
        GEMM_DENSE(pg8::EpiResid, E_, ws + RT_A, ws + WS_W_RET_OUT, 2048, 1024); } SEAM(14);
    MOE_LAYER(1, 15);

    if (IN(19)) { PHASE_INIT; phase_norm1<2>(F); } SEAM(19);
    if (IN(20)) { PHASE_INIT; pg8::EpiF32 E_{(float*)(ws + ML_P), 512}; GEMM_DENSE(pg8::EpiF32, E_, ws + WS_HBUF, ws + WS_W_MLA_IN, 1024, 512); } SEAM(20);
    if (IN(21)) { PHASE_INIT; phase_mla_norm(F); } SEAM(21);
    if (IN(22)) { PHASE_INIT;
#ifndef NO_QUP
 { pg8::EpiMlaQ E_{(bf16_t*)(ws + ML_Q), (const f32x2*)(ws + WS_TABA)}; GEMM_DENSE(pg8::EpiMlaQ, E_, ws + ML_AQ, ws + WS_W_MLA_QUP, 256, 1536); }
#endif
#ifndef NO_KVUP
                  { pg8::EpiMlaKV E_{(bf16_t*)(ws + ML_K), (bf16_t*)(ws + ML_V)}; GEMM_DENSE(pg8::EpiMlaKV, E_, ws + ML_AKV, ws + WS_W_MLA_KVUP, 256, 2048); }
#endif
 } SEAM(22);
    if (IN(23)) { PHASE_INIT; att::attn_phase<192, 0, 8, 1>((const bf16_t*)(ws + ML_Q), (const bf16_t*)(ws + ML_K), (const bf16_t*)(ws + ML_V), (bf16_t*)(ws + ML_O), (LAS char*)GR, F.tid); } SEAM(23);
    if (IN(24)) { PHASE_INIT; pg8::EpiResid E_{(float*)(ws + WS_XRES), MOD + (size_t)2 * 9 * 6144 + 2 * 1024};
        GEMM_DENSE(pg8::EpiResid, E_, ws + ML_O, ws + WS_W_MLA_OUT, 1024, 1024); } SEAM(24);
    MOE_LAYER(2, 25);

    DA_LAYER(3, 29);
    MOE_LAYER(3, 34);

    if (IN(38)) { PHASE_INIT; phase_norm1<4, DBG_LC>(F); }
#undef IN
#undef SEAM
}
constexpr int N_PHASES = 39;

extern "C" void kernel_launch(void* const* d_in, const int* in_sizes, int n_in, void* d_out, int out_size, void* d_ws, size_t ws_size, hipStream_t stream) {
    static int ready = 0;
    if (ready == 0) {
        if (n_in != 27 || out_size != NB * SEQ * DM || ws_size < WS_END) { fprintf(stderr, "kernel_launch: unexpected shapes (n_in %d, out %d, ws %zu, need %zu)\n", n_in, out_size, ws_size, (size_t)WS_END); ready = -1; return; }
        if (hipFuncSetAttribute((const void*)hybrid_fwd, hipFuncAttributeMaxDynamicSharedMemorySize, LDS_BYTES) != hipSuccess) { fprintf(stderr, "kernel_launch: hipFuncSetAttribute failed\n"); ready = -1; return; }
        int per_cu = 0; (void)hipOccupancyMaxActiveBlocksPerMultiprocessor(&per_cu, (const void*)hybrid_fwd, NTHR, LDS_BYTES); (void)hipGetLastError();
        if (per_cu < 1) fprintf(stderr, "kernel_launch: occupancy query reports %d\n", per_cu);
        ready = 1;
    }
    if (ready < 0) return;
    (void)hipMemsetAsync((char*)d_ws + WS_CTL, 0, CTL_BYTES, stream);
    Params p{};
    for (int i = 0; i < 27; ++i) p.in[i] = (const float*)d_in[i];
    p.out = (float*)d_out; p.ws = (unsigned char*)d_ws;
#if MK_MULTI
    for (int ph = 0; ph < N_PHASES; ++ph) { p.ph_lo = ph; p.ph_hi = ph + 1; hipLaunchKernelGGL(hybrid_fwd, dim3(GRID), dim3(NTHR), LDS_BYTES, stream, p); }
#else
    p.ph_lo = 0; p.ph_hi = N_PHASES; hipLaunchKernelGGL(hybrid_fwd, dim3(GRID), dim3(NTHR), LDS_BYTES, stream, p);
#endif
    const hipError_t le = hipPeekAtLastError();
    if (le != hipSuccess) fprintf(stderr, "kernel_launch: launch failed: %s\n", hipGetErrorName(le));
}
```

```cpp
#include <hip/hip_runtime.h>
#include <cstdio>
#include <cstdint>

#ifndef MK_MULTI
#define MK_MULTI 0
#endif

#define LAS __attribute__((address_space(3)))
typedef unsigned short bf16_t;
typedef short bf16x8 __attribute__((ext_vector_type(8)));
typedef short s16x4 __attribute__((ext_vector_type(4)));
typedef float f32x4 __attribute__((ext_vector_type(4)));
typedef float f32x2 __attribute__((ext_vector_type(2)));
typedef float f32x16 __attribute__((ext_vector_type(16)));
typedef unsigned u32x4 __attribute__((ext_vector_type(4)));
typedef unsigned u32x2 __attribute__((ext_vector_type(2)));

constexpr int DM = 1024, NB = 8, SEQ = 8192, CTX = 256, TB = SEQ + CTX, T = NB * TB;
constexpr int NTILES = T / 256, TPB = TB / 256;
constexpr int NEXP = 32, TOPK = 4;
constexpr int GRID = 256, NTHR = 512, TOK_PER_BLK = T / GRID;
constexpr int MOE_MAXTILES = (T * TOPK) / 256 + NEXP;
constexpr float RMS_EPS = 1e-6f;
constexpr int LDS_BYTES = 144 * 1024, MISC_BYTES = 1024, REG_OFF = MISC_BYTES;

constexpr size_t AL(size_t x) { return (x + 255) / 256 * 256; }
constexpr size_t WS_CTL = 0, CTL_BYTES = 1u << 20;
constexpr size_t WS_MOD = WS_CTL + CTL_BYTES;
constexpr size_t WS_TABA = WS_MOD + AL((size_t)4 * 9 * 6144 * 4);
constexpr size_t WS_TABR = WS_TABA + AL(128 * 16 * 8);
constexpr size_t WS_BLKCNT = WS_TABR + AL((size_t)8192 * 128 * 8);
constexpr size_t WS_IDX = WS_BLKCNT + AL(256 * 32 * 4);
constexpr size_t WS_GATE = WS_IDX + AL((size_t)T * 16);
constexpr size_t WS_RANK = WS_GATE + AL((size_t)T * 16);
constexpr size_t WS_SLOT = WS_RANK + AL((size_t)T * 16);
constexpr size_t WS_W_DA_IN = WS_SLOT + AL((size_t)T * 16);
constexpr size_t WS_W_DA_OUT = WS_W_DA_IN + (size_t)2 * 3072 * 1024 * 2;
constexpr size_t WS_W_RET_IN = WS_W_DA_OUT + (size_t)2 * 1024 * 1024 * 2;
constexpr size_t WS_W_RET_OUT = WS_W_RET_IN + (size_t)6144 * 1024 * 2;
constexpr size_t WS_W_MLA_IN = WS_W_RET_OUT + (size_t)1024 * 2048 * 2;
constexpr size_t WS_W_MLA_QUP = WS_W_MLA_IN + (size_t)512 * 1024 * 2;
constexpr size_t WS_W_MLA_KVUP = WS_W_MLA_QUP + (size_t)1536 * 256 * 2;
constexpr size_t WS_W_MLA_OUT = WS_W_MLA_KVUP + (size_t)2048 * 256 * 2;
constexpr size_t WS_W_GU = WS_W_MLA_OUT + (size_t)1024 * 1024 * 2;
constexpr size_t WS_W_DN = WS_W_GU + (size_t)128 * 2048 * 1024 * 2;
constexpr size_t WS_XRES = WS_W_DN + (size_t)128 * 1024 * 1024 * 2;
constexpr size_t WS_HBUF = WS_XRES + (size_t)T * 1024 * 4;
constexpr size_t WS_BIG = WS_HBUF + (size_t)T * 1024 * 2;
constexpr size_t ROW1K = (size_t)T * 1024 * 2;
constexpr size_t DA_K = WS_BIG, DA_V = DA_K + ROW1K, DA_Q = DA_V + ROW1K, DA_O = DA_Q + ROW1K  , DA_O2 = DA_O + 2 * ROW1K, DA_END = DA_O2 + ROW1K;
constexpr size_t RT_K = WS_BIG, RT_V = RT_K + ROW1K  , RT_Q = RT_V + 2 * ROW1K, RT_G = RT_Q + ROW1K  , RT_OF = RT_G + 2 * ROW1K, RT_OB = RT_OF + 2 * ROW1K,
                 RT_A = RT_OB + 2 * ROW1K, RT_END = RT_A + 2 * ROW1K;
constexpr size_t ML_P = WS_BIG  , ML_AKV = ML_P + ROW1K  , ML_AQ = ML_AKV + ROW1K / 4, ML_Q = ML_AQ + ROW1K / 4  , ML_K = ML_Q + ROW1K * 3 / 2,
                 ML_V = ML_K + ROW1K * 3 / 2, ML_O = ML_V + ROW1K, ML_END = ML_O + ROW1K;
constexpr size_t MOE_ROWS = (size_t)MOE_MAXTILES * 256;
constexpr size_t MO_HS = WS_BIG, MO_ACT = MO_HS + MOE_ROWS * 2048, MO_OUT = MO_ACT + MOE_ROWS * 2048, MO_END = MO_OUT + MOE_ROWS * 2048;
constexpr size_t cmax(size_t a, size_t b) { return a > b ? a : b; }
constexpr size_t WS_END = cmax(cmax(DA_END, RT_END), cmax(ML_END, MO_END));

__device__ __forceinline__ float wave_sum(float v) {
#pragma unroll
    for (int o = 1; o < 64; o <<= 1) v += __shfl_xor(v, o);
    return v;
}
__device__ __forceinline__ unsigned pk2(float lo, float hi) { unsigned r; asm volatile("v_cvt_pk_bf16_f32 %0, %1, %2" : "=v"(r) : "v"(lo), "v"(hi)); return r; }
__device__ __forceinline__ float bflo(unsigned w) { return __uint_as_float(w << 16); }
__device__ __forceinline__ float bfhi(unsigned w) { return __uint_as_float(w & 0xffff0000u); }
__device__ __forceinline__ float bf2f(bf16_t h) { return __uint_as_float((unsigned)h << 16); }
__device__ __forceinline__ bf16_t f2bf(float f) { return (bf16_t)(pk2(f, 0.f) & 0xffffu); }
__device__ __forceinline__ bf16_t f2bf_c(float f) { unsigned u = __float_as_uint(f); u += 0x7fffu + ((u >> 16) & 1u); return (bf16_t)(u >> 16); }

#define XB_TMO      128
#define XB_XCNT(j)  (256  + 64 * (j))
#define XB_XSUB(j)  (1280 + 64 * (j))
#define XB_XGEN(j)  (2304 + 64 * (j))
#define XB_TOP      3328
#define XB_TOPGEN   3392
#define XCD_BAR_WORDS 3456
#define XB_SPIN_CAP (1u << 22)
__device__ __forceinline__ unsigned xb_ld(unsigned* p)              { return __hip_atomic_load(p, __ATOMIC_RELAXED, __HIP_MEMORY_SCOPE_AGENT); }
__device__ __forceinline__ unsigned xb_add(unsigned* p, unsigned v) { return __hip_atomic_fetch_add(p, v, __ATOMIC_RELAXED, __HIP_MEMORY_SCOPE_AGENT); }
__device__ __forceinline__ unsigned xb_xcc_id() { return (unsigned)__builtin_amdgcn_s_getreg((3 << 11) | 20) & 0xFu; }
#define XB_SPIN(cond, bar) do { unsigned _sp = 0; while (cond) { __builtin_amdgcn_s_sleep(1); \
    if ((++_sp & 255u) == 0u) { if (xb_ld(&(bar)[XB_TMO])) break; if (_sp > XB_SPIN_CAP) { atomicAdd(&(bar)[XB_TMO], 1u); break; } } } } while (0)
struct XcdBarrier { unsigned* bar; unsigned x; volatile LAS unsigned* st; };
__device__ __forceinline__ XcdBarrier xcd_barrier_post(unsigned* bar, volatile LAS unsigned* st) {
    XcdBarrier b; b.bar = bar; b.x = xb_xcc_id(); b.st = st;
    if (threadIdx.x == 0) (void)xb_add(&bar[XB_XCNT(b.x)], 1u);
    return b;
}
__device__ __forceinline__ void xcd_barrier_complete(unsigned* bar, unsigned x, unsigned& nloc, unsigned& nx) {
    const unsigned G = gridDim.x * gridDim.y * gridDim.z;
    unsigned sum, cnt, mine, sp = 0u;
    for (;;) {
        sum = 0u; cnt = 0u; mine = 0u;
#pragma unroll
        for (unsigned j = 0; j < 16; ++j) { const unsigned c = xb_ld(&bar[XB_XCNT(j)]); sum += c; cnt += (c > 0u) ? 1u : 0u; mine = (j == x) ? c : mine; }
        if (sum == G) break;
        __builtin_amdgcn_s_sleep(1);
        if ((++sp & 255u) == 0u) { if (xb_ld(&bar[XB_TMO])) break; if (sp > XB_SPIN_CAP) { atomicAdd(&bar[XB_TMO], 1u); break; } }
    }
    nloc = mine > 0u ? mine : 1u; nx = cnt > 0u ? cnt : 1u;
}
__device__ __forceinline__ void xcd_barrier(const XcdBarrier& b) {
    asm volatile("s_waitcnt vmcnt(0)" ::: "memory");
    __syncthreads();
    if (threadIdx.x == 0) {
        unsigned* bar = b.bar;
        __builtin_amdgcn_s_waitcnt(0);
        unsigned nloc = b.st[0], nx = b.st[1];
        if (nloc == 0u) { xcd_barrier_complete(bar, b.x, nloc, nx); b.st[0] = nloc; b.st[1] = nx; }
        const unsigned old = xb_add(&bar[XB_XSUB(b.x)], 1u);
        const unsigned gen = old / nloc;
        if (old + 1u == (gen + 1u) * nloc) {
            __builtin_amdgcn_fence(__ATOMIC_RELEASE, "agent");
            asm volatile("s_waitcnt vmcnt(0)" ::: "memory");
            const unsigned og = xb_add(&bar[XB_TOP], 1u);
            const unsigned tg = og / nx;
            if (og + 1u == (tg + 1u) * nx) xb_add(&bar[XB_TOPGEN], 1u);
            else XB_SPIN(xb_ld(&bar[XB_TOPGEN]) == tg, bar);
            __builtin_amdgcn_fence(__ATOMIC_ACQUIRE, "agent");
            xb_add(&bar[XB_XGEN(b.x)], 1u);
            asm volatile("s_waitcnt vmcnt(0)" ::: "memory");
        } else {
            XB_SPIN(xb_ld(&bar[XB_XGEN(b.x)]) == gen, bar);
            __builtin_amdgcn_fence(__ATOMIC_ACQUIRE, "agent");
            asm volatile("s_waitcnt vmcnt(0)" ::: "memory");
        }
    }
    __syncthreads();
}

namespace pg8 {
constexpr int BM = 256, BK = 64, HALF = 128, HTB = HALF * BK * 2, STAGE_BYTES = 8 * HTB, NXCD = 8, WGM = 8;
__host__ __device__ __forceinline__ int lds_byte(int r, int c) { const int st = (r >> 4) * 2 + (c >> 5), rr = r & 15, cc = c & 31, ob = rr * 64 + cc * 2; return st * 1024 + (ob ^ (((ob >> 9) & 1) << 5)); }
__host__ __device__ __forceinline__ void stage_rc(int b, int& R, int& C) { const int st = b / 1024, sb = b % 1024, swz = sb ^ (((sb >> 9) & 1) << 5); R = (st >> 1) * 16 + swz / 64; C = (st & 1) * 32 + (swz % 64) / 2; }
__host__ __device__ __forceinline__ int perm32(int rho) { const int n = rho >> 4, i = rho & 15; return 8 * (i >> 2) + 4 * n + (i & 3); }
struct Unit { int pm, pn, grp; };
struct StaticOrder {
    int nM, nN, nwg, c;
    __device__ __forceinline__ void init(int nM_, int nN_, int c_) { nM = nM_; nN = nN_; nwg = nM * nN; c = c_; }
    __device__ __forceinline__ bool next(int i, Unit& u) const {
        const long L = (long)i * GRID + c; if (L >= nwg) return false;
        int wgid = (int)L; { const int q = nwg / NXCD, r = nwg % NXCD, xcd = wgid % NXCD, off = wgid / NXCD; wgid = (xcd < r ? xcd * (q + 1) : r * (q + 1) + (xcd - r) * q) + off; }
        const int nig = WGM * nN, gid = wgid / nig, fm = gid * WGM, gsz = (nM - fm) < WGM ? (nM - fm) : WGM;
        u.pm = fm + ((wgid % nig) % gsz); u.pn = (wgid % nig) / gsz; u.grp = 0; return true;
    }
};
struct MoeOrder : StaticOrder {
    const volatile LAS int* pad_start;
    __device__ __forceinline__ bool next(int i, Unit& u) const {
        if (!StaticOrder::next(i, u)) return false;
        const int r0 = u.pm * 256; int e = 0;
#pragma unroll 1
        for (int k = 1; k < NEXP; ++k) e += (pad_start[k] <= r0) ? 1 : 0;
        u.grp = e; return true;
    }
};

template <class Epi, class Sched>
__device__ __forceinline__ void gemm_phase(LAS unsigned char* lds, const bf16_t* Aptr, const bf16_t* Btptr, const int K, const size_t grp_stride_bytes, const Sched& S, const Epi& E, const int tid) {
    const int wid = __builtin_amdgcn_readfirstlane(tid >> 6), lane = tid & 63, wr = wid >> 2, wc = wid & 3, fr = lane & 15, fq = lane >> 4;
    const int nt = K / BK;
    unsigned voffA[2], voffB[2];
#pragma unroll
    for (int i = 0; i < 2; ++i) { int R, C; stage_rc(tid * 16 + i * 8192, R, C); const int Rb = Epi::PERM ? ((R & ~31) + perm32(R & 31)) : R;
        voffA[i] = (unsigned)(R * K + C) * 2u; voffB[i] = (unsigned)(Rb * K + C) * 2u; }
    const size_t kstep = (size_t)(BK * 2);
    const size_t hstep = (size_t)HALF * K * 2;
    const size_t tstep = 2 * hstep;
    const unsigned ldsw = (unsigned)wid * 1024u;
    const int aoff = lds_byte(wr * 64 + fr, fq * 8), boff = lds_byte(wc * 32 + fr, fq * 8);
#define PG8_SA(b, h) (((b) * 2 + (h)) * HTB)
#define PG8_SB(b, h) ((4 + (b) * 2 + (h)) * HTB)
#define PG8_STAGE(bufoff, gbase, voff) do { _Pragma("unroll") for (int _i = 0; _i < 2; ++_i) \
        __builtin_amdgcn_global_load_lds((const unsigned*)((const char*)(gbase) + (voff)[_i]), (LAS unsigned*)(lds + (bufoff) + ldsw + _i * 8192), 16, 0, 0); } while (0)
#define PG8_LDA(dst, b, h) do { _Pragma("unroll") for (int m = 0; m < 4; ++m) _Pragma("unroll") for (int k = 0; k < 2; ++k) dst[m][k] = *(const LAS bf16x8*)(lds + PG8_SA(b, h) + aoff + m * 2048 + k * 1024); } while (0)
#define PG8_LDB(dst, b, h) do { _Pragma("unroll") for (int n = 0; n < 2; ++n) _Pragma("unroll") for (int k = 0; k < 2; ++k) dst[n][k] = *(const LAS bf16x8*)(lds + PG8_SB(b, h) + boff + n * 2048 + k * 1024); } while (0)
#define PG8_MMA(ai, bj, At, Bt) do { __builtin_amdgcn_s_setprio(1); _Pragma("unroll") for (int m = 0; m < 4; ++m) _Pragma("unroll") for (int n = 0; n < 2; ++n) _Pragma("unroll") for (int k = 0; k < 2; ++k) \
        acc[ai][bj][m][n] = __builtin_amdgcn_mfma_f32_16x16x32_bf16(Bt[n][k], At[m][k], acc[ai][bj][m][n], 0, 0, 0); __builtin_amdgcn_s_setprio(0); } while (0)
#define PG8_WAIT_V(n) asm volatile("s_waitcnt vmcnt(" #n ")" ::: "memory")
#define PG8_WAIT_L(n) asm volatile("s_waitcnt lgkmcnt(" #n ")" ::: "memory")
#define PG8_BAR __builtin_amdgcn_s_barrier()
#define PG8_SCHED __builtin_amdgcn_sched_barrier(0)
    Unit cur, nxt; int ui = 0;
    if (!S.next(0, cur)) return;
    f32x4 acc[2][2][4][2];
#pragma unroll
    for (int a = 0; a < 2; ++a)
#pragma unroll
        for (int b = 0; b < 2; ++b)
#pragma unroll
            for (int m = 0; m < 4; ++m)
#pragma unroll
                for (int n = 0; n < 2; ++n) acc[a][b][m][n] = (f32x4){0.f, 0.f, 0.f, 0.f};
    bf16x8 At[4][2], B0[2][2], B1[2][2];
    const char* cA = (const char*)Aptr + (size_t)cur.pm * tstep; const char* cB = (const char*)Btptr + (size_t)cur.grp * grp_stride_bytes + (size_t)cur.pn * tstep;
    PG8_STAGE(PG8_SB(0, 0), cB, voffB); PG8_STAGE(PG8_SA(0, 0), cA, voffA); PG8_STAGE(PG8_SB(0, 1), cB + hstep, voffB); PG8_STAGE(PG8_SA(0, 1), cA + hstep, voffA);
    if (wr == 1) PG8_BAR;
    PG8_WAIT_V(4); PG8_BAR;
    PG8_STAGE(PG8_SB(1, 0), cB + kstep, voffB); PG8_STAGE(PG8_SA(1, 0), cA + kstep, voffA); PG8_STAGE(PG8_SB(1, 1), cB + hstep + kstep, voffB);
    PG8_WAIT_V(6); PG8_BAR;
    for (;;) {
        const bool has_next = S.next(ui + 1, nxt);
        const char* nA = has_next ? (const char*)Aptr + (size_t)nxt.pm * tstep : cA;
        const char* nB = has_next ? (const char*)Btptr + (size_t)nxt.grp * grp_stride_bytes + (size_t)nxt.pn * tstep : cB;
#pragma unroll 1
        for (int t = 0; t < nt; t += 2) {
            const bool last = (t == nt - 2);
            const char* a1 = cA + (size_t)(t + 1) * kstep;
            const char* a2 = last ? nA : cA + (size_t)(t + 2) * kstep; const char* b2 = last ? nB : cB + (size_t)(t + 2) * kstep;
            const char* a3 = a2 + kstep; const char* b3 = b2 + kstep;
            PG8_LDB(B0, 0, 0); PG8_SCHED; PG8_LDA(At, 0, 0); PG8_STAGE(PG8_SA(1, 1), a1 + hstep, voffA);
            PG8_WAIT_L(8); PG8_BAR; PG8_WAIT_L(0); PG8_MMA(0, 0, At, B0); PG8_BAR; PG8_SCHED;
            PG8_LDB(B1, 0, 1); PG8_STAGE(PG8_SB(0, 0), b2, voffB);
            PG8_BAR; PG8_WAIT_L(0); PG8_MMA(0, 1, At, B1); PG8_BAR;
            PG8_LDA(At, 0, 1); PG8_STAGE(PG8_SA(0, 0), a2, voffA);
            PG8_BAR; PG8_WAIT_L(0); PG8_MMA(1, 0, At, B0); PG8_BAR; PG8_SCHED;
            PG8_STAGE(PG8_SB(0, 1), b2 + hstep, voffB);
            PG8_WAIT_V(6); PG8_BAR; PG8_MMA(1, 1, At, B1); PG8_BAR;
            PG8_LDB(B0, 1, 0); PG8_SCHED; PG8_LDA(At, 1, 0); PG8_STAGE(PG8_SA(0, 1), a2 + hstep, voffA);
            PG8_WAIT_L(8); PG8_BAR; PG8_WAIT_L(0); PG8_MMA(0, 0, At, B0); PG8_BAR; PG8_SCHED;
            PG8_LDB(B1, 1, 1); PG8_STAGE(PG8_SB(1, 0), b3, voffB);
            PG8_BAR; PG8_WAIT_L(0); PG8_MMA(0, 1, At, B1); PG8_BAR;
            PG8_LDA(At, 1, 1); PG8_STAGE(PG8_SA(1, 0), a3, voffA);
            PG8_BAR; PG8_WAIT_L(0); PG8_MMA(1, 0, At, B0); PG8_BAR; PG8_SCHED;
            PG8_STAGE(PG8_SB(1, 1), b3 + hstep, voffB);
            PG8_WAIT_V(6); PG8_BAR; PG8_MMA(1, 1, At, B1); PG8_BAR;
        }
        E(acc, cur, wr, wc, fr, fq);
        if (!has_next) break;
#pragma unroll
        for (int a = 0; a < 2; ++a)
#pragma unroll
            for (int b = 0; b < 2; ++b)
#pragma unroll
                for (int m = 0; m < 4; ++m)
#pragma unroll
                    for (int n = 0; n < 2; ++n) acc[a][b][m][n] = (f32x4){0.f, 0.f, 0.f, 0.f};
        cur = nxt; cA = nA; cB = nB; ++ui;
    }
    PG8_WAIT_V(0);
    if (wr == 0) PG8_BAR;
    PG8_BAR;
#undef PG8_SA
#undef PG8_SB
#undef PG8_STAGE
#undef PG8_LDA
#undef PG8_LDB
#undef PG8_MMA
#undef PG8_WAIT_V
#undef PG8_WAIT_L
#undef PG8_BAR
#undef PG8_SCHED
}

typedef const f32x4 (&AccRef)[2][2][4][2];

__device__ __forceinline__ void rope8(f32x4& v0, f32x4& v1, const f32x2* cs) {
    const f32x4 c01 = *(const f32x4*)cs, c23 = *(const f32x4*)(cs + 2);
    f32x4 a = v0, b = v1;
    v0[0] = a[0] * c01[0] - a[1] * c01[1]; v0[1] = a[0] * c01[1] + a[1] * c01[0];
    v0[2] = a[2] * c01[2] - a[3] * c01[3]; v0[3] = a[2] * c01[3] + a[3] * c01[2];
    v1[0] = b[0] * c23[0] - b[1] * c23[1]; v1[1] = b[0] * c23[1] + b[1] * c23[0];
    v1[2] = b[2] * c23[2] - b[3] * c23[3]; v1[3] = b[2] * c23[3] + b[3] * c23[2];
}
__device__ __forceinline__ void store8(bf16_t* p, f32x4 v0, f32x4 v1) {
    u32x4 w; w.x = pk2(v0[0], v0[1]); w.y = pk2(v0[2], v0[3]); w.z = pk2(v1[0], v1[1]); w.w = pk2(v1[2], v1[3]); *(u32x4*)p = w;
}

struct EpiDaIn {
    static constexpr bool PERM = true;
    bf16_t* KVQ; const f32x2* tabA;
    __device__ __forceinline__ void operator()(AccRef acc, const Unit& u, int wr, int wc, int fr, int fq) const {
        const int part = u.pn >> 2; bf16_t* base = KVQ + (size_t)part * ((size_t)T * 1024);
        const int tb = u.pm % TPB; const bool lat = tb != 0; const bool rope = lat && part != 1;
        const int cin0 = (u.pn & 3) * 256 + wc * 32 + 8 * fq;
#pragma unroll
        for (int ai = 0; ai < 2; ++ai)
#pragma unroll
            for (int m = 0; m < 4; ++m) {
                asm volatile("" ::: "memory");
                const int rin = ai * HALF + wr * 64 + m * 16 + fr; const size_t row = (size_t)u.pm * BM + rin; const int p = (tb - 1) * 256 + rin;
#pragma unroll
                for (int bj = 0; bj < 2; ++bj) { f32x4 v0 = acc[ai][bj][m][0], v1 = acc[ai][bj][m][1]; const int cin = cin0 + bj * HALF;
                    if (rope) { const int o = cin & 63, axis = o >> 5, f0 = (o & 31) >> 1, pos = axis ? (p & 63) : (p >> 6); rope8(v0, v1, tabA + pos * 16 + f0); }
                    store8(base + row * 1024 + cin, v0, v1); }
            }
    }
};
struct EpiRetIn {
    static constexpr bool PERM = true;
    bf16_t *Kb, *Vb, *Qb, *Gb; const f32x2* tabR;
    __device__ __forceinline__ void operator()(AccRef acc, const Unit& u, int wr, int wc, int fr, int fq) const {
        const int ct = u.pn * 256; bf16_t* base; int ld, c0; bool isk = false, isq = false;
        if (ct < 1024) { base = Kb; ld = 1024; c0 = ct; isk = true; } else if (ct < 3072) { base = Vb; ld = 2048; c0 = ct - 1024; }
        else if (ct < 4096) { base = Qb; ld = 1024; c0 = ct - 3072; isq = true; } else { base = Gb; ld = 2048; c0 = ct - 4096; }
        const int tb = u.pm % TPB; const bool lat = tb != 0; const bool rope = lat && (isk || isq);
        const int cin0 = c0 + wc * 32 + 8 * fq; const float sc = isk ? 0.0625f : 1.0f;
#pragma unroll
        for (int ai = 0; ai < 2; ++ai)
#pragma unroll
            for (int m = 0; m < 4; ++m) {
                asm volatile("" ::: "memory");
                const int rin = ai * HALF + wr * 64 + m * 16 + fr; const size_t row = (size_t)u.pm * BM + rin; const int p = (tb - 1) * 256 + rin;
#pragma unroll
                for (int bj = 0; bj < 2; ++bj) { f32x4 v0 = acc[ai][bj][m][0] * sc, v1 = acc[ai][bj][m][1] * sc; const int cin = cin0 + bj * HALF;
                    if (rope) { const int f0 = (cin & 255) >> 1; rope8(v0, v1, tabR + (size_t)p * 128 + f0); }
                    store8(base + row * ld + cin, v0, v1); }
            }
    }
};
struct EpiF32 {
    static constexpr bool PERM = false;
    float* C; int ldc;
    __device__ __forceinline__ void operator()(AccRef acc, const Unit& u, int wr, int wc, int fr, int fq) const {
        const int row0 = u.pm * BM + wr * 64 + fr, col0 = u.pn * BM + wc * 32 + 4 * fq;
#pragma unroll
        for (int ai = 0; ai < 2; ++ai)
#pragma unroll
            for (int m = 0; m < 4; ++m) { float* rowp = C + (size_t)(row0 + ai * HALF + m * 16) * ldc + col0;
#pragma unroll
                for (int bj = 0; bj < 2; ++bj)
#pragma unroll
                    for (int n = 0; n < 2; ++n) *(f32x4*)(rowp + bj * HALF + n * 16) = acc[ai][bj][m][n]; }
    }
};
struct EpiMlaQ {
    static constexpr bool PERM = true;
    bf16_t* Qb; const f32x2* tabA;
    __device__ __forceinline__ void operator()(AccRef acc, const Unit& u, int wr, int wc, int fr, int fq) const {
        const int tb = u.pm % TPB; const bool rope = tb != 0 && u.pn >= 4; const int c0 = u.pn * 256 + wc * 32 + 8 * fq;
#pragma unroll
        for (int ai = 0; ai < 2; ++ai)
#pragma unroll
            for (int m = 0; m < 4; ++m) {
                asm volatile("" ::: "memory");
                const int rin = ai * HALF + wr * 64 + m * 16 + fr; const size_t row = (size_t)u.pm * BM + rin; const int p = (tb - 1) * 256 + rin;
#pragma unroll
                for (int bj = 0; bj < 2; ++bj) { f32x4 v0 = acc[ai][bj][m][0], v1 = acc[ai][bj][m][1]; const int c = c0 + bj * HALF;
                    if (rope) { const int o = c & 63, axis = o >> 5, f0 = (o & 31) >> 1, pos = axis ? (p & 63) : (p >> 6); rope8(v0, v1, tabA + pos * 16 + f0); }
                    store8(Qb + row * 1536 + c, v0, v1); }
            }
    }
};
struct EpiMlaKV {
    static constexpr bool PERM = true;
    bf16_t *Kb, *Vb;
    __device__ __forceinline__ void operator()(AccRef acc, const Unit& u, int wr, int wc, int fr, int fq) const {
        const int c0 = wc * 32 + 8 * fq;
#pragma unroll
        for (int ai = 0; ai < 2; ++ai)
#pragma unroll
            for (int m = 0; m < 4; ++m) {
                const size_t row = (size_t)u.pm * BM + ai * HALF + wr * 64 + m * 16 + fr;
                store8(Kb + row * 1536 + u.pn * 192 + c0, acc[ai][0][m][0], acc[ai][0][m][1]);
                store8(Vb + row * 1024 + u.pn * 128 + c0, acc[ai][1][m][0], acc[ai][1][m][1]);
            }
    }
};
struct EpiResid {
    static constexpr bool PERM = false;
    float* X; const float* mod2;
    __device__ __forceinline__ void operator()(AccRef acc, const Unit& u, int wr, int wc, int fr, int fq) const {
        const int tb = u.pm % TPB, b = u.pm / TPB, mrow = tb == 0 ? 8 : b;
        const int row0 = u.pm * BM + wr * 64 + fr, col0 = u.pn * BM + wc * 32 + 4 * fq;
        const float* mp = mod2 + (size_t)mrow * 6144 + col0;
        f32x4 g[2][2];
#pragma unroll
        for (int bj = 0; bj < 2; ++bj)
#pragma unroll
            for (int n = 0; n < 2; ++n) g[bj][n] = *(const f32x4*)(mp + bj * HALF + n * 16);
#pragma unroll
        for (int ai = 0; ai < 2; ++ai)
#pragma unroll
            for (int m = 0; m < 4; ++m) { float* rowp = X + (size_t)(row0 + ai * HALF + m * 16) * 1024 + col0;
#pragma unroll
                for (int bj = 0; bj < 2; ++bj)
#pragma unroll
                    for (int n = 0; n < 2; ++n) { f32x4* q = (f32x4*)(rowp + bj * HALF + n * 16); *q = *q + g[bj][n] * acc[ai][bj][m][n]; } }
    }
};
struct EpiMoe1 {
    static constexpr bool PERM = true;
    bf16_t* ACT; const float* bgu;
    __device__ __forceinline__ void operator()(AccRef acc, const Unit& u, int wr, int wc, int fr, int fq) const {
        const int j0 = u.pn * 128 + wc * 16 + 4 * fq; const float* bp = bgu + (size_t)u.grp * 2048 + j0;
        f32x4 bg[2], bl[2];
#pragma unroll
        for (int bj = 0; bj < 2; ++bj) { bg[bj] = *(const f32x4*)(bp + bj * 64); bl[bj] = *(const f32x4*)(bp + 1024 + bj * 64); }
#pragma unroll
        for (int ai = 0; ai < 2; ++ai)
#pragma unroll
            for (int m = 0; m < 4; ++m) { const size_t row = (size_t)u.pm * BM + ai * HALF + wr * 64 + m * 16 + fr;
#pragma unroll
                for (int bj = 0; bj < 2; ++bj) { const f32x4 gl = acc[ai][bj][m][0] + bg[bj], li = acc[ai][bj][m][1] + bl[bj]; float a[4];
#pragma unroll
                    for (int e = 0; e < 4; ++e) { const float g = fminf(gl[e], 7.0f), l = fminf(fmaxf(li[e], -7.0f), 7.0f);
                        const float s = __builtin_amdgcn_rcpf(1.0f + __builtin_amdgcn_exp2f(g * (-1.702f * 1.4426950408889634f))); a[e] = g * s * (l + 1.0f); }
                    u32x2 w; w.x = pk2(a[0], a[1]); w.y = pk2(a[2], a[3]); *(u32x2*)(ACT + row * 1024 + j0 + bj * 64) = w; } }
    }
};
struct EpiMoe2 {
    static constexpr bool PERM = true;
    bf16_t* OUT; const float* bdn;
    __device__ __forceinline__ void operator()(AccRef acc, const Unit& u, int wr, int wc, int fr, int fq) const {
        const int c0 = u.pn * 256 + wc * 32 + 8 * fq; const float* bp = bdn + (size_t)u.grp * 1024 + c0;
        f32x4 b[2][2];
#pragma unroll
        for (int bj = 0; bj < 2; ++bj) { b[bj][0] = *(const f32x4*)(bp + bj * HALF); b[bj][1] = *(const f32x4*)(bp + bj * HALF + 4); }
#pragma unroll
        for (int ai = 0; ai < 2; ++ai)
#pragma unroll
            for (int m = 0; m < 4; ++m) { const size_t row = (size_t)u.pm * BM + ai * HALF + wr * 64 + m * 16 + fr;
#pragma unroll
                for (int bj = 0; bj < 2; ++bj) store8(OUT + row * 1024 + c0 + bj * HALF, acc[ai][bj][m][0] + b[bj][0], acc[ai][bj][m][1] + b[bj][1]); }
    }
};
}

namespace att {
constexpr int DV = 128, QBLK = 32, KVBLK = 64;
#define SBAR() __builtin_amdgcn_sched_barrier(0)
__device__ __forceinline__ int crow(int r, int hi) { return (r & 3) + 8 * (r >> 2) + 4 * hi; }
__device__ __forceinline__ int v_st(int k, int c) { const int kk = (k & ~0xC) | ((k & 4) << 1) | ((k & 8) >> 1); return ((kk >> 3) * 4 + (c >> 5)) * 512 + ((kk & 7) * 32 + (c & 31)) * 2; }
__device__ __forceinline__ int v_rd_base(int lane) { return ((lane & 3) << 3) | (((lane >> 2) & 3) << 6) | (((lane >> 4) & 1) << 5) | (((lane >> 5) & 1) << 8); }
constexpr int v_rd_off(int d0, int ks, int half) { return d0 * 512 + ks * 4096 + half * 2048; }
template <int OFF> __device__ __forceinline__ s16x4 tr_read(int vb) {
    s16x4 r; asm volatile("ds_read_b64_tr_b16 %0, %1 offset:%2" : "=&v"(r) : "v"(vb), "i"(OFF) : "memory"); return r;
}
template <int D0> __device__ __forceinline__ void pv_one(f32x16& od, int vb, bf16x8 pa0, bf16x8 pa1, bf16x8 pa2, bf16x8 pa3) {
    const s16x4 l0 = tr_read<v_rd_off(D0, 0, 0)>(vb), h0 = tr_read<v_rd_off(D0, 0, 1)>(vb), l1 = tr_read<v_rd_off(D0, 1, 0)>(vb), h1 = tr_read<v_rd_off(D0, 1, 1)>(vb);
    const s16x4 l2 = tr_read<v_rd_off(D0, 2, 0)>(vb), h2 = tr_read<v_rd_off(D0, 2, 1)>(vb), l3 = tr_read<v_rd_off(D0, 3, 0)>(vb), h3 = tr_read<v_rd_off(D0, 3, 1)>(vb);
    asm volatile("s_waitcnt lgkmcnt(0)" ::: "memory"); SBAR();
#define PK(L, H) (bf16x8){L[0], L[1], L[2], L[3], H[0], H[1], H[2], H[3]}
    od = __builtin_amdgcn_mfma_f32_32x32x16_bf16(pa0, PK(l0, h0), od, 0, 0, 0);
    od = __builtin_amdgcn_mfma_f32_32x32x16_bf16(pa1, PK(l1, h1), od, 0, 0, 0);
    od = __builtin_amdgcn_mfma_f32_32x32x16_bf16(pa2, PK(l2, h2), od, 0, 0, 0);
    od = __builtin_amdgcn_mfma_f32_32x32x16_bf16(pa3, PK(l3, h3), od, 0, 0, 0);
#undef PK
}
__device__ __forceinline__ void pv_d0(f32x16* o, int vb, bf16x8 pa0, bf16x8 pa1, bf16x8 pa2, bf16x8 pa3) {
    pv_one<0>(o[0], vb, pa0, pa1, pa2, pa3); pv_one<1>(o[1], vb, pa0, pa1, pa2, pa3); pv_one<2>(o[2], vb, pa0, pa1, pa2, pa3); pv_one<3>(o[3], vb, pa0, pa1, pa2, pa3);
}
template <int DQK> struct Cfg {
    static constexpr int KROW = DQK * 2;
    static constexpr int SHM_K = KVBLK * DQK * 2, SHM_V = KVBLK * DV * 2;
    static constexpr int NKC = DQK / 64;
    static constexpr int CH = DQK / 8;
    static constexpr int LDS_NEED = 2 * SHM_V + 2 * SHM_K + 8 * 64 * 4;
};
template <int DQK>
__device__ __forceinline__ void partialSM(f32x16& p0, f32x16& p1, float& m_reg, float& mn, float& alpha) {
    constexpr float SCALE = DQK == 64 ? 0.125f : 0.07216878364870322f;
    constexpr float C = SCALE * 1.4426950408889634f, THRS = 8.0f / SCALE;
    float pmax = p0[0];
#pragma unroll
    for (int r = 1; r < 16; ++r) pmax = fmaxf(pmax, p0[r]);
#pragma unroll
    for (int r = 0; r < 16; ++r) pmax = fmaxf(pmax, p1[r]);
    { auto rr = __builtin_amdgcn_permlane32_swap(__float_as_uint(pmax), __float_as_uint(pmax), false, false);
      pmax = fmaxf(__uint_as_float(rr[0]), __uint_as_float(rr[1])); }
    if (__builtin_expect(__all(pmax - m_reg <= THRS), 1)) { mn = m_reg; alpha = 1.f; }
    else { mn = fmaxf(m_reg, pmax); alpha = __builtin_amdgcn_exp2f((m_reg - mn) * C); m_reg = mn; }
    const float mnC = -mn * C;
#pragma unroll
    for (int r = 0; r < 16; ++r) p0[r] = fmaf(p0[r], C, mnC);
#pragma unroll
    for (int r = 0; r < 16; ++r) p1[r] = fmaf(p1[r], C, mnC);
#pragma unroll
    for (int r = 0; r < 16; ++r) p0[r] = __builtin_amdgcn_exp2f(p0[r]);
}
__device__ __forceinline__ void finishSM(f32x16& p0, f32x16& p1, float alpha, float& l_reg, bf16x8& pa0, bf16x8& pa1, bf16x8& pa2, bf16x8& pa3) {
#pragma unroll
    for (int r = 0; r < 16; ++r) p1[r] = __builtin_amdgcn_exp2f(p1[r]);
    float ps = 0;
#pragma unroll
    for (int r = 0; r < 16; ++r) ps += p0[r];
#pragma unroll
    for (int r = 0; r < 16; ++r) ps += p1[r];
    { auto rr = __builtin_amdgcn_permlane32_swap(__float_as_uint(ps), __float_as_uint(ps), false, false);
      ps = __uint_as_float(rr[0]) + __uint_as_float(rr[1]); }
    l_reg = l_reg * alpha + ps;
#define PK4(P, BASE, OUT) do { unsigned a0 = pk2(P[BASE + 0], P[BASE + 1]), a1 = pk2(P[BASE + 2], P[BASE + 3]);   \
    unsigned b0 = pk2(P[BASE + 4], P[BASE + 5]), b1 = pk2(P[BASE + 6], P[BASE + 7]);                              \
    auto r0 = __builtin_amdgcn_permlane32_swap(a0, b0, false, false); auto r1 = __builtin_amdgcn_permlane32_swap(a1, b1, false, false); \
    u32x4 w = {r0[0], r1[0], r0[1], r1[1]}; OUT = *reinterpret_cast<bf16x8*>(&w); } while (0)
    PK4(p0, 0, pa0); PK4(p0, 8, pa1); PK4(p1, 0, pa2); PK4(p1, 8, pa3);
#undef PK4
}
template <int DQK>
__device__ __forceinline__ void qkt(f32x16& p0, f32x16& p1, const LAS char* Ks, const bf16x8* qr, int r32, int hi) {
    constexpr int KROW = Cfg<DQK>::KROW;
    p0 = f32x16{}; p1 = f32x16{};
#pragma unroll
    for (int d0 = 0; d0 < DQK / 16; ++d0) { const int cb = (d0 * 16 + hi * 8) * 2;
        const bf16x8 b0 = *(const LAS bf16x8*)(Ks + r32 * KROW + (cb ^ ((r32 & 7) << 4)));
        const bf16x8 b1 = *(const LAS bf16x8*)(Ks + (32 + r32) * KROW + (cb ^ ((r32 & 7) << 4)));
        p0 = __builtin_amdgcn_mfma_f32_32x32x16_bf16(b0, qr[d0], p0, 0, 0, 0);
        p1 = __builtin_amdgcn_mfma_f32_32x32x16_bf16(b1, qr[d0], p1, 0, 0, 0); }
}
template <int DQK, int SDEPTH, int LDQ, int LDK, int LDV, int LDO>
__device__ __forceinline__ void attn_body(const bf16_t* __restrict__ Qb, const bf16_t* __restrict__ Qb2, const bf16_t* __restrict__ Kh, const bf16_t* __restrict__ Vh, bf16_t* __restrict__ Ob, const int seq, LAS char* lds, const int tid) {
    using C = Cfg<DQK>;
    constexpr int SHM_V = C::SHM_V, SHM_K = C::SHM_K, KROW = C::KROW, NKC = C::NKC, CH = C::CH;
    const int wid = tid >> 6, lane = tid & 63, r32 = lane & 31, hi = lane >> 5;
    LAS char* V_lds = lds; LAS char* K_lds = lds + 2 * SHM_V;
    LAS float* ws = (LAS float*)(lds + 2 * SHM_V + 2 * SHM_K) + wid * 64; LAS float* li_l = ws; LAS float* al_l = ws + 32;
    float m_reg = -1e30f, l_reg = 0; f32x16 o[4] = {}; bf16x8 qr[DQK / 16];
    const bf16_t* Qw = Qb + (long)(wid * QBLK + r32) * LDQ + hi * 8; const bf16_t* Qw2 = Qb2 + (long)(wid * QBLK + r32) * LDQ + hi * 8;
#pragma unroll
    for (int d0 = 0; d0 < DQK / 16; ++d0) qr[d0] = d0 < 8 ? *(const bf16x8*)(Qw + d0 * 16) : *(const bf16x8*)(Qw2 + (d0 - 8) * 16);
    const int sr = tid >> 4, sc = (tid & 15) * 8, vst0 = v_st(sr, sc), vst1 = v_st(32 + sr, sc);
    int krow[NKC], kcol[NKC], kst[NKC];
#pragma unroll
    for (int i = 0; i < NKC; ++i) { const int e = tid + 512 * i; krow[i] = e / CH; kcol[i] = (e % CH) * 8; kst[i] = krow[i] * KROW + ((kcol[i] * 2) ^ ((krow[i] & 7) << 4)); }
    const int vb0 = (int)(uintptr_t)V_lds + v_rd_base(lane);
    struct { bf16x8 vs0, vs1, ks[NKC]; } sr_[SDEPTH];
#define SLOAD(i, k0) do { sr_[i].vs0 = *(const bf16x8*)(&Vh[(long)((k0) + sr) * LDV + sc]); sr_[i].vs1 = *(const bf16x8*)(&Vh[(long)((k0) + 32 + sr) * LDV + sc]); \
    _Pragma("unroll") for (int _c = 0; _c < NKC; ++_c) sr_[i].ks[_c] = *(const bf16x8*)(&Kh[(long)((k0) + krow[_c]) * LDK + kcol[_c]]); } while (0)
#define SWRITE(b, i) do { *(LAS bf16x8*)(V_lds + (b) * SHM_V + vst0) = sr_[i].vs0; *(LAS bf16x8*)(V_lds + (b) * SHM_V + vst1) = sr_[i].vs1; \
    _Pragma("unroll") for (int _c = 0; _c < NKC; ++_c) *(LAS bf16x8*)(K_lds + (b) * SHM_K + kst[_c]) = sr_[i].ks[_c]; } while (0)
#define SWAIT() do { if constexpr (SDEPTH == 2) { if constexpr (NKC == 1) asm volatile("s_waitcnt vmcnt(3)" ::: "memory"); else asm volatile("s_waitcnt vmcnt(5)" ::: "memory"); } \
    else asm volatile("s_waitcnt vmcnt(0)" ::: "memory"); } while (0)
#define RESC(a) do { if (__any((a) < 1.f)) { if (hi == 0) al_l[r32] = (a); asm volatile("s_waitcnt lgkmcnt(0)" ::: "memory"); \
    _Pragma("unroll") for (int d = 0; d < 4; ++d) _Pragma("unroll") for (int r = 0; r < 16; ++r) o[d][r] *= al_l[crow(r, hi)]; } } while (0)
    f32x16 pA0, pA1, pB0, pB1; float mnA, mnB, alA, alB; bf16x8 pa0, pa1, pa2, pa3; const int NT = seq / KVBLK;
    constexpr int SE = 0, SO = SDEPTH - 1;
    SLOAD(SE, 0); asm volatile("s_waitcnt vmcnt(0)" ::: "memory"); SWRITE(0, SE); __syncthreads();
    qkt<DQK>(pA0, pA1, K_lds, qr, r32, hi); partialSM<DQK>(pA0, pA1, m_reg, mnA, alA);
    SLOAD(SO, KVBLK); if constexpr (SDEPTH == 2) { if (2 < NT) SLOAD(SE, 2 * KVBLK); }
    SWAIT(); SWRITE(1, SO); __syncthreads();
    for (int j = 1; j + 1 < NT; j += 2) {
        SBAR(); qkt<DQK>(pB0, pB1, K_lds + SHM_K, qr, r32, hi);
        finishSM(pA0, pA1, alA, l_reg, pa0, pa1, pa2, pa3); SBAR();
        SLOAD(SO, (j + SDEPTH) * KVBLK); SBAR();
        pv_d0(o, vb0, pa0, pa1, pa2, pa3); partialSM<DQK>(pB0, pB1, m_reg, mnB, alB);
        __syncthreads(); SWAIT(); SWRITE(0, SE);
        RESC(alB); __syncthreads();
        SBAR(); qkt<DQK>(pA0, pA1, K_lds, qr, r32, hi);
        finishSM(pB0, pB1, alB, l_reg, pa0, pa1, pa2, pa3); SBAR();
        if (SDEPTH == 1 || j + 3 < NT) SLOAD(SE, (j + 1 + SDEPTH) * KVBLK); SBAR();
        pv_d0(o, vb0 + SHM_V, pa0, pa1, pa2, pa3); partialSM<DQK>(pA0, pA1, m_reg, mnA, alA);
        __syncthreads(); SWAIT(); SWRITE(1, SO);
        RESC(alA); __syncthreads();
    }
    SBAR(); qkt<DQK>(pB0, pB1, K_lds + SHM_K, qr, r32, hi);
    finishSM(pA0, pA1, alA, l_reg, pa0, pa1, pa2, pa3); SBAR();
    pv_d0(o, vb0, pa0, pa1, pa2, pa3); partialSM<DQK>(pB0, pB1, m_reg, mnB, alB);
    __syncthreads(); RESC(alB);
    finishSM(pB0, pB1, alB, l_reg, pa0, pa1, pa2, pa3); SBAR();
    pv_d0(o, vb0 + SHM_V, pa0, pa1, pa2, pa3);
    if (hi == 0) li_l[r32] = l_reg; asm volatile("s_waitcnt lgkmcnt(0)" ::: "memory");
    float rli[16];
#pragma unroll
    for (int r = 0; r < 16; ++r) rli[r] = __builtin_amdgcn_rcpf(li_l[crow(r, hi)]);
    bf16_t* Ow = Ob + (long)(wid * QBLK) * LDO;
#pragma unroll
    for (int r = 0; r < 16; ++r) { const int orow = crow(r, hi);
#pragma unroll
        for (int d0 = 0; d0 < 4; ++d0) Ow[(long)orow * LDO + d0 * 32 + r32] = f2bf(o[d0][r] * rli[r]); }
    __syncthreads();
#undef SLOAD
#undef SWRITE
#undef SWAIT
#undef RESC
}
template <int DQK, int LDQ, int LDK, int LDV, int LDO>
__device__ __forceinline__ void attn_body_simple(const bf16_t* __restrict__ Qb, const bf16_t* __restrict__ Qb2, const bf16_t* __restrict__ Kh, const bf16_t* __restrict__ Vh, bf16_t* __restrict__ Ob, const int seq, LAS char* lds, const int tid) {
    using C = Cfg<DQK>;
    constexpr int SHM_V = C::SHM_V, SHM_K = C::SHM_K, KROW = C::KROW, NKC = C::NKC, CH = C::CH;
    const int wid = tid >> 6, lane = tid & 63, r32 = lane & 31, hi = lane >> 5;
    LAS char* V_lds = lds; LAS char* K_lds = lds + 2 * SHM_V;
    LAS float* ws = (LAS float*)(lds + 2 * SHM_V + 2 * SHM_K) + wid * 64; LAS float* li_l = ws; LAS float* al_l = ws + 32;
    float m_reg = -1e30f, l_reg = 0; f32x16 o[4] = {}; bf16x8 qr[DQK / 16];
    const bf16_t* Qw = Qb + (long)(wid * QBLK + r32) * LDQ + hi * 8; const bf16_t* Qw2 = Qb2 + (long)(wid * QBLK + r32) * LDQ + hi * 8;
#pragma unroll
    for (int d0 = 0; d0 < DQK / 16; ++d0) qr[d0] = d0 < 8 ? *(const bf16x8*)(Qw + d0 * 16) : *(const bf16x8*)(Qw2 + (d0 - 8) * 16);
    const int sr = tid >> 4, sc = (tid & 15) * 8, vst0 = v_st(sr, sc), vst1 = v_st(32 + sr, sc);
    int krow[NKC], kcol[NKC], kst[NKC];
#pragma unroll
    for (int i = 0; i < NKC; ++i) { const int e = tid + 512 * i; krow[i] = e / CH; kcol[i] = (e % CH) * 8; kst[i] = krow[i] * KROW + ((kcol[i] * 2) ^ ((krow[i] & 7) << 4)); }
    const int vb0 = (int)(uintptr_t)V_lds + v_rd_base(lane);
    bf16x8 vs0, vs1, ks[NKC];
    const unsigned voff0 = (unsigned)(sr * LDV + sc), voff1 = (unsigned)((32 + sr) * LDV + sc); unsigned koff[NKC];
#pragma unroll
    for (int i = 0; i < NKC; ++i) koff[i] = (unsigned)(krow[i] * LDK + kcol[i]);
#define SLOAD(k0) do { const bf16_t* vt_ = Vh + (size_t)(k0) * LDV; const bf16_t* kt_ = Kh + (size_t)(k0) * LDK; vs0 = *(const bf16x8*)(vt_ + voff0); vs1 = *(const bf16x8*)(vt_ + voff1); \
    _Pragma("unroll") for (int _c = 0; _c < NKC; ++_c) ks[_c] = *(const bf16x8*)(kt_ + koff[_c]); } while (0)
#define SWRITE(b) do { *(LAS bf16x8*)(V_lds + (b) * SHM_V + vst0) = vs0; *(LAS bf16x8*)(V_lds + (b) * SHM_V + vst1) = vs1; \
    _Pragma("unroll") for (int _c = 0; _c < NKC; ++_c) *(LAS bf16x8*)(K_lds + (b) * SHM_K + kst[_c]) = ks[_c]; } while (0)
    const int NT = seq / KVBLK;
    SLOAD(0); SWRITE(0); SLOAD(KVBLK); __syncthreads();
#pragma unroll 1
    for (int j = 0; j < NT; ++j) {
        const int bsel = j & 1; f32x16 p0, p1; float mn, al; bf16x8 pa0, pa1, pa2, pa3;
        qkt<DQK>(p0, p1, K_lds + bsel * SHM_K, qr, r32, hi);
        partialSM<DQK>(p0, p1, m_reg, mn, al);
        if (__any(al < 1.f)) { if (hi == 0) al_l[r32] = al; asm volatile("s_waitcnt lgkmcnt(0)" ::: "memory");
#pragma unroll
            for (int d = 0; d < 4; ++d)
#pragma unroll
                for (int r = 0; r < 16; ++r) o[d][r] *= al_l[crow(r, hi)]; }
        finishSM(p0, p1, al, l_reg, pa0, pa1, pa2, pa3); SBAR();
        pv_d0(o, vb0 + bsel * SHM_V, pa0, pa1, pa2, pa3);
        if (j + 1 < NT) { SWRITE(bsel ^ 1); if (j + 2 < NT) SLOAD((j + 2) * KVBLK); }
        __syncthreads();
    }
    if (hi == 0) li_l[r32] = l_reg; asm volatile("s_waitcnt lgkmcnt(0)" ::: "memory");
    float rli[16];
#pragma unroll
    for (int r = 0; r < 16; ++r) rli[r] = __builtin_amdgcn_rcpf(li_l[crow(r, hi)]);
    bf16_t* Ow = Ob + (long)(wid * QBLK) * LDO;
#pragma unroll
    for (int r = 0; r < 16; ++r) { const int orow = crow(r, hi);
#pragma unroll
        for (int d0 = 0; d0 < 4; ++d0) Ow[(long)orow * LDO + d0 * 32 + r32] = f2bf(o[d0][r] * rli[r]); }
    __syncthreads();
#undef SLOAD
#undef SWRITE
}
template <int DQK, int SDEPTH, int NH, int VSHARE>
__device__ __forceinline__ void attn_phase(const bf16_t* Q, const bf16_t* K, const bf16_t* V, bf16_t* O, LAS char* lds, const int tid) {
    constexpr int LDQ = NH * DQK, LDK = NH * DQK, LDV = (NH / VSHARE) * DV, LDO = NH * DV;
    const int c = blockIdx.x, xcd = c & 7, slot = c >> 3;
    constexpr int ROUNDS = NB * NH / 8;
#pragma unroll 1
    for (int i = 0; i <= ROUNDS; ++i) {
        int b, h, seq; size_t qtok;
        if (i < ROUNDS) { const int bh = i * 8 + xcd; b = bh / NH; h = bh % NH; qtok = (size_t)b * TB + CTX + (size_t)slot * 256; seq = TB; }
        else { if (c >= NB * NH) break; b = c / NH; h = c % NH; qtok = (size_t)b * TB; seq = CTX; }
        const size_t t0 = (size_t)b * TB;
        if constexpr (SDEPTH == 0) attn_body_simple<DQK, LDQ, LDK, LDV, LDO>(Q + qtok * LDQ + h * 128, Q + qtok * LDQ + NH * 128 + h * (DQK - 128), K + t0 * LDK + h * DQK, V + t0 * LDV + (h / VSHARE) * DV, O + qtok * LDO + h * DV, seq, lds, tid);
        else attn_body<DQK, (SDEPTH == 0 ? 1 : SDEPTH), LDQ, LDK, LDV, LDO>(Q + qtok * LDQ + h * DQK, Q + qtok * LDQ + h * DQK, K + t0 * LDK + h * DQK, V + t0 * LDV + (h / VSHARE) * DV, O + qtok * LDO + h * DV, seq, lds, tid);
    }
}
}

struct Params { const float* in[27]; float* out; unsigned char* ws; int ph_lo, ph_hi; };
enum { I_X = 0, I_C, I_CTX, I_CCTX, I_ADAW, I_ADAB, I_NORMG, I_FINALG, I_DA_WIN, I_DA_WOUT, I_DA_LAM, I_DA_SUBG, I_RET_WIN, I_RET_DECAY, I_RET_WOUT, I_MLA_WIN, I_MLA_QG,
       I_MLA_WQUP, I_MLA_KVG, I_MLA_WKVUP, I_MLA_WOUT, I_MOE_WR, I_MOE_BR, I_MOE_WGU, I_MOE_BGU, I_MOE_WDN, I_MOE_BDN };

struct Frame {
    const Params* p; LAS unsigned char* lds; LAS unsigned char* reg; volatile LAS int* misc; int tid, lane, wave;
    unsigned char* ws;
};

enum { PK_ID = 0, PK_DA_IN, PK_RET_IN, PK_MLA_QUP, PK_MOE_GU };
__device__ __forceinline__ int src_col(int n, int kind) {
    if (kind == PK_DA_IN) { if ((n >> 10) == 1) return n; const int o = n & 63, axis = o >> 5, p = o & 31, f = p >> 1; return (n & ~63) | (axis * 32 + ((p & 1) ? 16 + f : f)); }
    if (kind == PK_RET_IN) { if (n < 1024 || (n >= 3072 && n < 4096)) { const int o = n & 255, f = o >> 1; return (n & ~255) | ((o & 1) ? 128 + f : f); } return n; }
    if (kind == PK_MLA_QUP) { if (n < 1024) return (n >> 7) * 192 + (n & 127); const int nn = n - 1024, hd = nn >> 6, oo = nn & 63, axis = oo >> 5, p = oo & 31, f = p >> 1; return hd * 192 + 128 + axis * 32 + ((p & 1) ? 16 + f : f); }
    if (kind == PK_MOE_GU) return ((n >> 2) & 1) * 1024 + (n >> 3) * 4 + (n & 3);
    return n;
}
__device__ __forceinline__ void tr_item(const float* W, int Ksrc, int Nsrc, bf16_t* WT, int Kdst, int Ndst, int Nvalid, int kind, LAS float* scr, int item, int lane) {
    const int nblk = Ndst / 32, kb = item / nblk, nb = item % nblk, k0 = 64 * kb, n0 = 32 * nb;
    const int n = n0 + (lane & 31); const bool nv = n < Nvalid; const int scn = nv ? src_col(n, kind) : 0;
#pragma unroll 8
    for (int i = 0; i < 32; ++i) { const int kk = 2 * i + (lane >> 5), k = k0 + kk; scr[kk * 33 + (lane & 31)] = (nv && k < Ksrc) ? W[(size_t)k * Nsrc + scn] : 0.f; }
    asm volatile("s_waitcnt lgkmcnt(0)" ::: "memory");
    const int c = lane & 7;
#pragma unroll
    for (int j = 0; j < 4; ++j) { const int nn = (lane >> 3) + 8 * j; const LAS float* s = scr + (8 * c) * 33 + nn;
        u32x4 o; o.x = pk2(s[0 * 33], s[1 * 33]); o.y = pk2(s[2 * 33], s[3 * 33]); o.z = pk2(s[4 * 33], s[5 * 33]); o.w = pk2(s[6 * 33], s[7 * 33]);
        *(u32x4*)(WT + (size_t)(n0 + nn) * Kdst + k0 + 8 * c) = o; }
    asm volatile("s_waitcnt lgkmcnt(0)" ::: "memory");
}
__device__ __forceinline__ float silu_f(float x) { return x / (1.0f + __expf(-x)); }

__device__ __forceinline__ void phase_prologue(Frame& F) {
    const Params& P = *F.p; unsigned char* ws = F.ws;
    const int gw = blockIdx.x * 8 + F.wave, NGW = GRID * 8, gt = blockIdx.x * NTHR + F.tid, NGT = GRID * NTHR;
    LAS float* sc = (LAS float*)(F.reg + 72 * 1024);
    for (int i = F.tid; i < 9 * 1024; i += NTHR) { const int r = i >> 10, k = i & 1023; const float v = r < 8 ? P.in[I_C][r * 1024 + k] : P.in[I_CCTX][k]; sc[i] = silu_f(v); }
    __syncthreads();
    {
        float* MOD = (float*)(ws + WS_MOD);
        for (int u = gw; u < 4 * 96; u += NGW) { const int L = u / 96, n = (u % 96) * 64 + F.lane; const float* W = P.in[I_ADAW] + (size_t)L * 1024 * 6144 + n;
            float a[9];
#pragma unroll
            for (int r = 0; r < 9; ++r) a[r] = 0.f;
#pragma unroll 8
            for (int k = 0; k < 1024; ++k) { const float w = W[(size_t)k * 6144];
#pragma unroll
                for (int r = 0; r < 9; ++r) a[r] = fmaf(sc[r * 1024 + k], w, a[r]); }
            const float bb = P.in[I_ADAB][L * 6144 + n];
#pragma unroll
            for (int r = 0; r < 9; ++r) MOD[((size_t)L * 9 + r) * 6144 + n] = a[r] + bb; }
    }
    {
        f32x2* TA = (f32x2*)(ws + WS_TABA); f32x2* TR = (f32x2*)(ws + WS_TABR);
        for (int i = gt; i < 128 * 16; i += NGT) { const int pos = i >> 4, j = i & 15; const float inv = powf(10000.0f, -(float)(2 * j) / 32.0f), a = (float)pos * inv; float s, c; sincosf(a, &s, &c); TA[i] = (f32x2){c, s}; }
        for (int i = gt; i < 8192 * 128; i += NGT) { const int pos = i >> 7, j = i & 127; const float inv = powf(10000.0f, -(float)(2 * j) / 256.0f), a = (float)pos * inv; float s, c; sincosf(a, &s, &c); TR[i] = (f32x2){c, s}; }
    }
    {
        f32x4* X = (f32x4*)(ws + WS_XRES);
        for (size_t i = gt; i < (size_t)T * 256; i += NGT) { const size_t g = i >> 8; const int q = (int)(i & 255); const int b = (int)(g / TB), j = (int)(g % TB);
            const f32x4* src = j < CTX ? (const f32x4*)(P.in[I_CTX] + ((size_t)b * CTX + j) * 1024) : (const f32x4*)(P.in[I_X] + ((size_t)b * SEQ + (j - CTX)) * 1024);
            X[i] = src[q]; }
    }
    {
        LAS float* scr = (LAS float*)(F.reg + F.wave * 8704);
#define TR_JOB(W_, Ksrc_, Nsrc_, DST_, Kdst_, Ndst_, Nvalid_, KIND_, COUNT_) do { const int per_ = ((Kdst_) / 64) * ((Ndst_) / 32), total_ = per_ * (COUNT_); \
        _Pragma("unroll 1") for (int it_ = gw; it_ < total_; it_ += NGW) { const int mi_ = it_ / per_, item_ = it_ % per_; \
            tr_item((W_) + (size_t)mi_ * (Ksrc_) * (Nsrc_), Ksrc_, Nsrc_, (bf16_t*)(ws + (DST_)) + (size_t)mi_ * (Kdst_) * (Ndst_), Kdst_, Ndst_, Nvalid_, KIND_, scr, item_, F.lane); } } while (0)
        TR_JOB(P.in[I_DA_WIN], 1024, 3072, WS_W_DA_IN, 1024, 3072, 3072, PK_DA_IN, 2);
        TR_JOB(P.in[I_DA_WOUT], 1024, 1024, WS_W_DA_OUT, 1024, 1024, 1024, PK_ID, 2);
        TR_JOB(P.in[I_RET_WIN], 1024, 6144, WS_W_RET_IN, 1024, 6144, 6144, PK_RET_IN, 1);
        TR_JOB(P.in[I_RET_WOUT], 2048, 1024, WS_W_RET_OUT, 2048, 1024, 1024, PK_ID, 1);
        TR_JOB(P.in[I_MLA_WIN], 1024, 448, WS_W_MLA_IN, 1024, 512, 448, PK_ID, 1);
        TR_JOB(P.in[I_MLA_WQUP], 256, 1536, WS_W_MLA_QUP, 256, 1536, 1536, PK_MLA_QUP, 1);
        TR_JOB(P.in[I_MLA_WKVUP], 128, 2048, WS_W_MLA_KVUP, 256, 2048, 2048, PK_ID, 1);
        TR_JOB(P.in[I_MLA_WOUT], 1024, 1024, WS_W_MLA_OUT, 1024, 1024, 1024, PK_ID, 1);
        TR_JOB(P.in[I_MOE_WGU], 1024, 2048, WS_W_GU, 1024, 2048, 2048, PK_MOE_GU, 128);
        TR_JOB(P.in[I_MOE_WDN], 1024, 1024, WS_W_DN, 1024, 1024, 1024, PK_ID, 128);
#undef TR_JOB
    }
}

template <int L, int LC = L - 1>
__device__ __forceinline__ void phase_norm1(Frame& F) {
    const Params& P = *F.p; unsigned char* ws = F.ws;
    float* XR = (float*)(ws + WS_XRES); bf16_t* HB = (bf16_t*)(ws + WS_HBUF); const float* MOD = (const float*)(ws + WS_MOD);
    const int* SLOT = (const int*)(ws + WS_SLOT); const float* GATE = (const float*)(ws + WS_GATE); const bf16_t* OUT2 = (const bf16_t*)(ws + MO_OUT);
    const float* gain = L < 4 ? P.in[I_NORMG] + (size_t)(L * 2 + 0) * 1024 : P.in[I_FINALG];
    f32x4 gn[4];
#pragma unroll
    for (int j = 0; j < 4; ++j) gn[j] = *(const f32x4*)(gain + 4 * F.lane + 256 * j);
    for (int i = 0; i < TOK_PER_BLK / 8; ++i) {
        const int t = blockIdx.x * TOK_PER_BLK + F.wave + 8 * i; const int b = t / TB, jt = t % TB; const bool isctx = jt < CTX; const int mrow = isctx ? 8 : b;
        if (L == 4 && isctx) continue;
        f32x4 v[4]; float* xr = XR + (size_t)t * 1024 + 4 * F.lane;
#pragma unroll
        for (int j = 0; j < 4; ++j) v[j] = *(const f32x4*)(xr + 256 * j);
        if (LC >= 0) {
            const int4 sl = *(const int4*)(SLOT + (size_t)t * 4); const f32x4 gt = *(const f32x4*)(GATE + (size_t)t * 4);
            const int sls[4] = {sl.x, sl.y, sl.z, sl.w};
            f32x4 a[4];
#pragma unroll
            for (int j = 0; j < 4; ++j) a[j] = (f32x4){0.f, 0.f, 0.f, 0.f};
#pragma unroll
            for (int k = 0; k < 4; ++k) { const bf16_t* orow = OUT2 + (size_t)sls[k] * 1024 + 4 * F.lane; const float gk = gt[k];
#pragma unroll
                for (int j = 0; j < 4; ++j) { const u32x2 w = *(const u32x2*)(orow + 256 * j); a[j] += gk * (f32x4){bflo(w.x), bfhi(w.x), bflo(w.y), bfhi(w.y)}; } }
            const float* m5 = MOD + ((size_t)(LC < 0 ? 0 : LC) * 9 + mrow) * 6144 + 5 * 1024 + 4 * F.lane;
#pragma unroll
            for (int j = 0; j < 4; ++j) { v[j] += *(const f32x4*)(m5 + 256 * j) * a[j]; if (L < 4) *(f32x4*)(xr + 256 * j) = v[j]; }
        }
#ifdef DBG_NANFIX
        if (L == 4) {
#pragma unroll
            for (int j = 0; j < 4; ++j)
#pragma unroll
                for (int e = 0; e < 4; ++e) if (!(fabsf(v[j][e]) < 1e30f)) v[j][e] = 1000.0f; }
#endif
        float ss = 0.f;
#pragma unroll
        for (int j = 0; j < 4; ++j) ss += (v[j][0] * v[j][0] + v[j][1] * v[j][1]) + (v[j][2] * v[j][2] + v[j][3] * v[j][3]);
        const float rstd = rsqrtf(wave_sum(ss) * (1.0f / 1024.0f) + RMS_EPS);
        if (L < 4) {
            const float* msh = MOD + ((size_t)L * 9 + mrow) * 6144 + 4 * F.lane; bf16_t* hr = HB + (size_t)t * 1024 + 4 * F.lane;
#pragma unroll
            for (int j = 0; j < 4; ++j) { const f32x4 sh = *(const f32x4*)(msh + 256 * j), scl = *(const f32x4*)(msh + 1024 + 256 * j);
                const f32x4 y = v[j] * rstd * gn[j] * (scl + 1.0f) + sh; u32x2 w; w.x = pk2(y[0], y[1]); w.y = pk2(y[2], y[3]); *(u32x2*)(hr + 256 * j) = w; }
        } else {
            float* orow = P.out + ((size_t)b * SEQ + (jt - CTX)) * 1024 + 4 * F.lane;
#pragma unroll
            for (int j = 0; j < 4; ++j) *(f32x4*)(orow + 256 * j) = v[j] * rstd * gn[j];
        }
    }
}

template <int L>
__device__ __forceinline__ void phase_norm2(Frame& F) {
    const Params& P = *F.p; unsigned char* ws = F.ws;
    const float* XR = (const float*)(ws + WS_XRES); bf16_t* HB = (bf16_t*)(ws + WS_HBUF); const float* MOD = (const float*)(ws + WS_MOD);
    int* IDX = (int*)(ws + WS_IDX); float* GATE = (float*)(ws + WS_GATE); int* RANK = (int*)(ws + WS_RANK); int* BLKCNT = (int*)(ws + WS_BLKCNT);
    const float* gain = P.in[I_NORMG] + (size_t)(L * 2 + 1) * 1024; const float* Wr = P.in[I_MOE_WR] + (size_t)L * 1024 * 32; const float* br = P.in[I_MOE_BR] + L * 32;
    LAS float* hf = (LAS float*)F.reg;
    LAS float* part = (LAS float*)(F.reg + 32768);
    LAS float* lg = (LAS float*)(F.reg + 32768 + 2048);
    LAS int* lcnt = (LAS int*)(F.reg + 32768 + 2048 + 1024);
    if (F.tid < 32) lcnt[F.tid] = 0;
    f32x4 gn[4];
#pragma unroll
    for (int j = 0; j < 4; ++j) gn[j] = *(const f32x4*)(gain + 4 * F.lane + 256 * j);
    __syncthreads();
    for (int i = 0; i < TOK_PER_BLK / 8; ++i) {
        const int t0 = blockIdx.x * TOK_PER_BLK + 8 * i;
        {
            const int t = t0 + F.wave; const int b = t / TB, jt = t % TB; const int mrow = jt < CTX ? 8 : b;
            f32x4 v[4]; const float* xr = XR + (size_t)t * 1024 + 4 * F.lane;
#pragma unroll
            for (int j = 0; j < 4; ++j) v[j] = *(const f32x4*)(xr + 256 * j);
            float ss = 0.f;
#pragma unroll
            for (int j = 0; j < 4; ++j) ss += (v[j][0] * v[j][0] + v[j][1] * v[j][1]) + (v[j][2] * v[j][2] + v[j][3] * v[j][3]);
            const float rstd = rsqrtf(wave_sum(ss) * (1.0f / 1024.0f) + RMS_EPS);
            const float* msh = MOD + ((size_t)L * 9 + mrow) * 6144 + 3 * 1024 + 4 * F.lane; bf16_t* hr = HB + (size_t)t * 1024 + 4 * F.lane;
#pragma unroll
            for (int j = 0; j < 4; ++j) { const f32x4 sh = *(const f32x4*)(msh + 256 * j), scl = *(const f32x4*)(msh + 1024 + 256 * j);
                const f32x4 y = v[j] * rstd * gn[j] * (scl + 1.0f) + sh; u32x2 w; w.x = pk2(y[0], y[1]); w.y = pk2(y[2], y[3]); *(u32x2*)(hr + 256 * j) = w;
                *(LAS f32x4*)(hf + F.wave * 1024 + 4 * F.lane + 256 * j) = y; }
        }
        __syncthreads();
        {
            const int kh = F.tid >> 8, tok = (F.tid >> 5) & 7, e = F.tid & 31; const LAS float* hp = hf + tok * 1024 + kh * 512; const float* wp = Wr + (size_t)kh * 512 * 32 + e;
            float a0 = 0.f, a1 = 0.f;
#pragma unroll 8
            for (int d = 0; d < 512; d += 2) { a0 = fmaf(hp[d], wp[(size_t)d * 32], a0); a1 = fmaf(hp[d + 1], wp[(size_t)(d + 1) * 32], a1); }
            part[(kh * 8 + tok) * 32 + e] = a0 + a1;
        }
        __syncthreads();
        if (F.tid < 256) { const int tok = F.tid >> 5, e = F.tid & 31; lg[tok * 32 + e] = part[tok * 32 + e] + part[(8 + tok) * 32 + e] + br[e]; }
        __syncthreads();
        if (F.tid < 8) {
            const int t = t0 + F.tid; const LAS float* l = lg + F.tid * 32; int id[4]; float lv[4]; unsigned used = 0u;
#pragma unroll
            for (int k = 0; k < 4; ++k) { float best = -3.0e38f; int bi = 0;
                for (int e = 0; e < 32; ++e) { const float x = l[e]; if (!((used >> e) & 1u) && x > best) { best = x; bi = e; } }
                used |= 1u << bi; id[k] = bi; lv[k] = best; }
            float ex[4], s = 0.f;
#pragma unroll
            for (int k = 0; k < 4; ++k) { ex[k] = __expf(lv[k] - lv[0]); s += ex[k]; }
            const float inv = 1.0f / s; int rk[4];
#pragma unroll
            for (int k = 0; k < 4; ++k) rk[k] = atomicAdd((int*)(lcnt + id[k]), 1);
            *(int4*)(IDX + (size_t)t * 4) = make_int4(id[0], id[1], id[2], id[3]);
            *(f32x4*)(GATE + (size_t)t * 4) = (f32x4){ex[0] * inv, ex[1] * inv, ex[2] * inv, ex[3] * inv};
            *(int4*)(RANK + (size_t)t * 4) = make_int4(rk[0], rk[1], rk[2], rk[3]);
        }
        __syncthreads();
    }
    if (F.tid < 32) BLKCNT[blockIdx.x * 32 + F.tid] = lcnt[F.tid];
}

__device__ __forceinline__ void moe_offsets(Frame& F) {
    const int* BLKCNT = (const int*)(F.ws + WS_BLKCNT);
    __syncthreads();
    if (F.tid < 32) { int tot = 0, pre = 0;
        for (int b = 0; b < GRID; ++b) { const int c = BLKCNT[b * 32 + F.tid]; pre += (b < (int)blockIdx.x) ? c : 0; tot += c; }
        F.misc[128 + F.tid] = pre; F.misc[160 + F.tid] = (tot + 255) & ~255; }
    __syncthreads();
    if (F.tid == 0) { int s = 0; for (int e = 0; e < 32; ++e) { F.misc[64 + e] = s; s += F.misc[160 + e]; } F.misc[64 + 32] = s; }
    __syncthreads();
}
__device__ __forceinline__ void phase_scatter(Frame& F) {
    unsigned char* ws = F.ws;
    const int* IDX = (const int*)(ws + WS_IDX); const int* RANK = (const int*)(ws + WS_RANK); int* SLOT = (int*)(ws + WS_SLOT);
    const bf16_t* HB = (const bf16_t*)(ws + WS_HBUF); bf16_t* HS = (bf16_t*)(ws + MO_HS);
    moe_offsets(F);
    for (int q = F.wave; q < TOK_PER_BLK * 4; q += 8) { const int t = blockIdx.x * TOK_PER_BLK + (q >> 2), k = q & 3;
        const int e = IDX[(size_t)t * 4 + k], r = RANK[(size_t)t * 4 + k]; const int slot = F.misc[64 + e] + F.misc[128 + e] + r;
        if (F.lane == 0) SLOT[(size_t)t * 4 + k] = slot;
        const u32x4* src = (const u32x4*)(HB + (size_t)t * 1024); u32x4* dst = (u32x4*)(HS + (size_t)slot * 1024);
        dst[F.lane] = src[F.lane]; dst[64 + F.lane] = src[64 + F.lane]; }
}

template <int L>
__device__ __forceinline__ void phase_da_post(Frame& F) {
    const Params& P = *F.p; unsigned char* ws = F.ws; constexpr int J = L / 3;
    const bf16_t* O = (const bf16_t*)(ws + DA_O); bf16_t* O2 = (bf16_t*)(ws + DA_O2);
    const float* lamv = P.in[I_DA_LAM] + J * 256; const float* subg = P.in[I_DA_SUBG] + J * 128;
    const float lam_init = L == 0 ? 0.2f : 0.8f - 0.6f * 0.40656965974059917f;
    const float d01 = wave_sum(lamv[F.lane] * lamv[64 + F.lane]), d23 = wave_sum(lamv[128 + F.lane] * lamv[192 + F.lane]);
    const float lam = expf(d01) - expf(d23) + lam_init;
    const int h = F.lane >> 3, ch = F.lane & 7; float g[16];
#pragma unroll
    for (int e = 0; e < 16; ++e) g[e] = subg[ch * 16 + e] * (1.0f - lam_init);
    for (int t = blockIdx.x * 8 + F.wave; t < T; t += GRID * 8) {
        const bf16_t* r0 = O + (size_t)t * 2048 + (2 * h) * 128 + ch * 16; const bf16_t* r1 = r0 + 128;
        const u32x4 a0 = *(const u32x4*)r0, a1 = *(const u32x4*)(r0 + 8), b0 = *(const u32x4*)r1, b1 = *(const u32x4*)(r1 + 8);
        float d[16]; const unsigned aw[8] = {a0.x, a0.y, a0.z, a0.w, a1.x, a1.y, a1.z, a1.w}, bw[8] = {b0.x, b0.y, b0.z, b0.w, b1.x, b1.y, b1.z, b1.w};
        float ss = 0.f;
#pragma unroll
        for (int e = 0; e < 8; ++e) { d[2 * e] = bflo(aw[e]) - lam * bflo(bw[e]); d[2 * e + 1] = bfhi(aw[e]) - lam * bfhi(bw[e]); ss += d[2 * e] * d[2 * e] + d[2 * e + 1] * d[2 * e + 1]; }
        ss += __shfl_xor(ss, 1); ss += __shfl_xor(ss, 2); ss += __shfl_xor(ss, 4);
        const float r = rsqrtf(ss * (1.0f / 128.0f) + RMS_EPS);
        u32x4 w0, w1;
        w0.x = pk2(d[0] * r * g[0], d[1] * r * g[1]); w0.y = pk2(d[2] * r * g[2], d[3] * r * g[3]); w0.z = pk2(d[4] * r * g[4], d[5] * r * g[5]); w0.w = pk2(d[6] * r * g[6], d[7] * r * g[7]);
        w1.x = pk2(d[8] * r * g[8], d[9] * r * g[9]); w1.y = pk2(d[10] * r * g[10], d[11] * r * g[11]); w1.z = pk2(d[12] * r * g[12], d[13] * r * g[13]); w1.w = pk2(d[14] * r * g[14], d[15] * r * g[15]);
        bf16_t* orow = O2 + (size_t)t * 1024 + h * 128 + ch * 16; *(u32x4*)orow = w0; *(u32x4*)(orow + 8) = w1;
    }
}

__device__ __forceinline__ void phase_ret_post(Frame& F) {
    unsigned char* ws = F.ws;
    const bf16_t* OF = (const bf16_t*)(ws + RT_OF); const bf16_t* OB = (const bf16_t*)(ws + RT_OB); const bf16_t* Gb = (const bf16_t*)(ws + RT_G); bf16_t* A = (bf16_t*)(ws + RT_A);
    for (int t = blockIdx.x * 8 + F.wave; t < T; t += GRID * 8) {
        const size_t off = (size_t)t * 2048 + F.lane * 32; float o[32]; float ss = 0.f;
#pragma unroll
        for (int q = 0; q < 4; ++q) { const u32x4 a = *(const u32x4*)(OF + off + 8 * q), b = *(const u32x4*)(OB + off + 8 * q); const unsigned aw[4] = {a.x, a.y, a.z, a.w}, bw[4] = {b.x, b.y, b.z, b.w};
#pragma unroll
            for (int e = 0; e < 4; ++e) { const float x0 = bflo(aw[e]) + bflo(bw[e]), x1 = bfhi(aw[e]) + bfhi(bw[e]); o[8 * q + 2 * e] = x0; o[8 * q + 2 * e + 1] = x1; ss += x0 * x0 + x1 * x1; } }
        ss += __shfl_xor(ss, 1); ss += __shfl_xor(ss, 2); ss += __shfl_xor(ss, 4); ss += __shfl_xor(ss, 8);
        const float r = rsqrtf(ss * (1.0f / 512.0f) + RMS_EPS);
#pragma unroll
        for (int q = 0; q < 4; ++q) { const u32x4 gq = *(const u32x4*)(Gb + off + 8 * q); const unsigned gw[4] = {gq.x, gq.y, gq.z, gq.w}; unsigned w[4];
#pragma unroll
            for (int e = 0; e < 4; ++e) { const float g0 = bflo(gw[e]), g1 = bfhi(gw[e]); w[e] = pk2(silu_f(g0) * o[8 * q + 2 * e] * r, silu_f(g1) * o[8 * q + 2 * e + 1] * r); }
            *(u32x4*)(A + off + 8 * q) = (u32x4){w[0], w[1], w[2], w[3]}; }
    }
}

__device__ __forceinline__ void phase_mla_norm(Frame& F) {
    const Params& P = *F.p; unsigned char* ws = F.ws;
    const float* Pm = (const float*)(ws + ML_P); bf16_t* AKV = (bf16_t*)(ws + ML_AKV); bf16_t* AQ = (bf16_t*)(ws + ML_AQ); bf16_t* Kb = (bf16_t*)(ws + ML_K);
    const f32x2* TA = (const f32x2*)(ws + WS_TABA);
    const f32x2 gkv = *(const f32x2*)(P.in[I_MLA_KVG] + 2 * F.lane); const f32x4 gq = *(const f32x4*)(P.in[I_MLA_QG] + 4 * F.lane);
    for (int t = blockIdx.x * 8 + F.wave; t < T; t += GRID * 8) {
        const float* pr = Pm + (size_t)t * 512; const int jt = t % TB; const bool lat = jt >= CTX; const int p = jt - CTX;
        const f32x2 ckv = *(const f32x2*)(pr + 2 * F.lane); const f32x4 cq = *(const f32x4*)(pr + 192 + 4 * F.lane);
        const float rkv = rsqrtf(wave_sum(ckv[0] * ckv[0] + ckv[1] * ckv[1]) * (1.0f / 128.0f) + RMS_EPS);
        const float rq = rsqrtf(wave_sum((cq[0] * cq[0] + cq[1] * cq[1]) + (cq[2] * cq[2] + cq[3] * cq[3])) * (1.0f / 256.0f) + RMS_EPS);
        *(unsigned*)(AKV + (size_t)t * 256 + 2 * F.lane) = pk2(ckv[0] * rkv * gkv[0], ckv[1] * rkv * gkv[1]);
        *(unsigned*)(AKV + (size_t)t * 256 + 128 + 2 * F.lane) = 0u;
        u32x2 wq; wq.x = pk2(cq[0] * rq * gq[0], cq[1] * rq * gq[1]); wq.y = pk2(cq[2] * rq * gq[2], cq[3] * rq * gq[3]); *(u32x2*)(AQ + (size_t)t * 256 + 4 * F.lane) = wq;
        if (F.lane < 32) { const int axis = F.lane >> 4, f = F.lane & 15; float x1 = pr[128 + axis * 32 + f], x2 = pr[128 + axis * 32 + 16 + f];
            if (lat) { const int pos = axis ? (p & 63) : (p >> 6); const f32x2 cs = TA[pos * 16 + f]; const float r1 = x1 * cs[0] - x2 * cs[1], r2 = x1 * cs[1] + x2 * cs[0]; x1 = r1; x2 = r2; }
            const unsigned w = pk2(x1, x2); bf16_t* kp = Kb + (size_t)t * 1536 + 128 + axis * 32 + 2 * f;
#pragma unroll
            for (int h = 0; h < 8; ++h) *(unsigned*)(kp + h * 192) = w; }
    }
}

__device__ __forceinline__ void phase_ret_scan(Frame& F) {
    const Params& P = *F.p; unsigned char* ws = F.ws;
    const bf16_t* Qg = (const bf16_t*)(ws + RT_Q); const bf16_t* Kg = (const bf16_t*)(ws + RT_K); const bf16_t* Vg = (const bf16_t*)(ws + RT_V);
    const int u = blockIdx.x, sl = u & 3, dir = (u >> 2) & 1, h = (u >> 3) & 3, b = u >> 5;
    bf16_t* Og = (bf16_t*)(ws + (dir ? RT_OB : RT_OF));
#ifdef DBG_FAKESCAN
    for (int i = F.tid; i < TB * 128; i += NTHR) { const int tok = i >> 7, c = i & 127; const size_t g = (size_t)b * TB + tok;
        const float v = bf2f(Vg[g * 2048 + h * 512 + sl * 128 + c]) + bf2f(Kg[g * 1024 + h * 256 + c]) + bf2f(Qg[g * 1024 + h * 256 + 128 + c]);
        Og[g * 2048 + h * 512 + sl * 128 + c] = dir ? (bf16_t)0 : f2bf(v); }
    return;
#endif
    constexpr int QS = 264, TS = 72;
    LAS bf16_t* Qc = (LAS bf16_t*)F.reg;
    LAS bf16_t* Kc = Qc + 64 * QS;
    LAS bf16_t* Kt = Kc + 64 * QS;
    LAS bf16_t* Vt = Kt + 256 * TS;
    LAS bf16_t* Sb = Vt + 128 * TS;
    const float x = P.in[I_RET_DECAY][dir * 4 + h];
    const float lg2 = -log1pf(expf(-x)) * 1.4426950408889634f;
    const int tid = F.tid, lane = F.lane, w = F.wave, l15 = lane & 15, g = lane >> 4;
    f32x4 st[16];
#pragma unroll
    for (int k = 0; k < 16; ++k) st[k] = (f32x4){0.f, 0.f, 0.f, 0.f};
    const float cdec = exp2f(64.0f * lg2);
    const size_t tb0 = (size_t)b * TB;
#pragma unroll 1
    for (int s = 0; s < TB / 64; ++s) {
        int cidx; if (dir == 0) cidx = s; else cidx = s < 4 ? 3 - s : 4 + (131 - s);
        if (s == 4 && false) {}
        const size_t tok0 = tb0 + (size_t)cidx * 64;
        __syncthreads();
#pragma unroll
        for (int i = 0; i < 4; ++i) { const int e = tid + 512 * i, row = e >> 5, ch = e & 31;
            const u32x4 q = *(const u32x4*)(Qg + (tok0 + row) * 1024 + h * 256 + ch * 8), k = *(const u32x4*)(Kg + (tok0 + row) * 1024 + h * 256 + ch * 8);
            *(LAS u32x4*)(Qc + row * QS + ch * 8) = q; *(LAS u32x4*)(Kc + row * QS + ch * 8) = k;
            const float kd = exp2f((dir == 0 ? (float)(63 - row) : (float)row) * lg2); const unsigned kw[4] = {k.x, k.y, k.z, k.w};
#pragma unroll
            for (int e2 = 0; e2 < 4; ++e2) { Kt[(ch * 8 + 2 * e2) * TS + row] = f2bf(bflo(kw[e2]) * kd); Kt[(ch * 8 + 2 * e2 + 1) * TS + row] = f2bf(bfhi(kw[e2]) * kd); } }
#pragma unroll
        for (int i = 0; i < 2; ++i) { const int e = tid + 512 * i, row = e >> 4, ch = e & 15;
            const u32x4 v = *(const u32x4*)(Vg + (tok0 + row) * 2048 + h * 512 + sl * 128 + ch * 8); const unsigned vw[4] = {v.x, v.y, v.z, v.w};
#pragma unroll
            for (int e2 = 0; e2 < 4; ++e2) { Vt[(ch * 8 + 2 * e2) * TS + row] = (bf16_t)(vw[e2] & 0xffffu); Vt[(ch * 8 + 2 * e2 + 1) * TS + row] = (bf16_t)(vw[e2] >> 16); } }
        __syncthreads();
        {
            const int ti = w >> 1;
#pragma unroll
            for (int c2 = 0; c2 < 2; ++c2) { const int tj = 2 * (w & 1) + c2; f32x4 a = (f32x4){0.f, 0.f, 0.f, 0.f};
#pragma unroll
                for (int kk = 0; kk < 8; ++kk) { const bf16x8 af = *(const LAS bf16x8*)(Qc + (16 * ti + l15) * QS + 32 * kk + 8 * g), bfr = *(const LAS bf16x8*)(Kc + (16 * tj + l15) * QS + 32 * kk + 8 * g);
                    a = __builtin_amdgcn_mfma_f32_16x16x32_bf16(af, bfr, a, 0, 0, 0); }
                const int jj = 16 * tj + l15;
#pragma unroll
                for (int r = 0; r < 4; ++r) { const int ii = 16 * ti + 4 * g + r; const int df = dir == 0 ? ii - jj : jj - ii;
                    const float m = df >= 0 ? exp2f((float)df * lg2) : 0.f; Sb[ii * TS + jj] = f2bf(a[r] * m); } }
        }
        __syncthreads();
        bf16x8 vf[2];
#pragma unroll
        for (int jj = 0; jj < 2; ++jj) vf[jj] = *(const LAS bf16x8*)(Vt + (16 * w + l15) * TS + 32 * jj + 8 * g);
        bf16x8 sfrag[8];
#pragma unroll
        for (int kk = 0; kk < 8; ++kk) { u32x4 wv; wv.x = pk2(st[2 * kk][0], st[2 * kk][1]); wv.y = pk2(st[2 * kk][2], st[2 * kk][3]); wv.z = pk2(st[2 * kk + 1][0], st[2 * kk + 1][1]); wv.w = pk2(st[2 * kk + 1][2], st[2 * kk + 1][3]);
            sfrag[kk] = *reinterpret_cast<bf16x8*>(&wv); }
#pragma unroll
        for (int it = 0; it < 4; ++it) {
            f32x4 a = (f32x4){0.f, 0.f, 0.f, 0.f};
#pragma unroll
            for (int kk = 0; kk < 8; ++kk) { const LAS bf16_t* qp = Qc + (16 * it + l15) * QS + 32 * kk + 4 * g; const s16x4 lo = *(const LAS s16x4*)qp, hi4 = *(const LAS s16x4*)(qp + 16);
                const bf16x8 af = (bf16x8){lo[0], lo[1], lo[2], lo[3], hi4[0], hi4[1], hi4[2], hi4[3]};
                a = __builtin_amdgcn_mfma_f32_16x16x32_bf16(af, sfrag[kk], a, 0, 0, 0); }
#pragma unroll
            for (int r = 0; r < 4; ++r) { const int ii = 16 * it + 4 * g + r; a[r] *= exp2f((dir == 0 ? (float)(ii + 1) : (float)(64 - ii)) * lg2); }
#pragma unroll
            for (int jj = 0; jj < 2; ++jj) { const bf16x8 af = *(const LAS bf16x8*)(Sb + (16 * it + l15) * TS + 32 * jj + 8 * g); a = __builtin_amdgcn_mfma_f32_16x16x32_bf16(af, vf[jj], a, 0, 0, 0); }
#pragma unroll
            for (int r = 0; r < 4; ++r) { const int ii = 16 * it + 4 * g + r; Og[(tok0 + ii) * 2048 + h * 512 + sl * 128 + 16 * w + l15] = f2bf_c(a[r]); }
        }
        if (s == 3) {
        }
#pragma unroll
        for (int kq = 0; kq < 16; ++kq) { f32x4 a = st[kq] * cdec;
#pragma unroll
            for (int jj = 0; jj < 2; ++jj) { const bf16x8 af = *(const LAS bf16x8*)(Kt + (16 * kq + l15) * TS + 32 * jj + 8 * g); a = __builtin_amdgcn_mfma_f32_16x16x32_bf16(af, vf[jj], a, 0, 0, 0); }
            st[kq] = a; }
    }
    __syncthreads();
}

__global__ void __launch_bounds__(NTHR, 2) hybrid_fwd(Params prm) {
    extern __shared__ __attribute__((aligned(16))) unsigned char lds_raw[];
    Frame F; F.p = &prm; F.lds = (LAS unsigned char*)lds_raw; F.reg = F.lds + REG_OFF; F.misc = (volatile LAS int*)F.lds;
    F.tid = threadIdx.x; F.lane = F.tid & 63; F.wave = __builtin_amdgcn_readfirstlane(F.tid >> 6); F.ws = prm.ws;
    if (gridDim.x != GRID) return;
    for (int i = F.tid; i < MISC_BYTES / 4; i += NTHR) F.misc[i] = 0;
    __syncthreads();
    unsigned* barw = (unsigned*)(F.ws + WS_CTL);
    XcdBarrier bar; bar.bar = barw; bar.x = 0; bar.st = nullptr;
    if (!MK_MULTI) bar = xcd_barrier_post(barw, (volatile LAS unsigned*)(F.misc + 8));
    const int lo = prm.ph_lo, hi = prm.ph_hi;
    unsigned char* ws = F.ws; const Params& P = prm;
    LAS unsigned char* GR = F.reg;
#define MOD ((const float*)(ws + WS_MOD))
#define PHASE_INIT do { unsigned char* w_ = prm.ws; asm volatile("" : "+s"(w_)); F.ws = w_; ws = w_; int t_ = threadIdx.x; asm volatile("" : "+v"(t_)); F.tid = t_; F.lane = t_ & 63; } while (0)
#ifndef PH_MIN
#define PH_MIN 0
#define PH_MAX 1000
#endif
#ifndef DBG_STOP
#define DBG_STOP 1000
#define DBG_LC 3
#endif
#define IN(k) ((k) >= PH_MIN && (k) <= PH_MAX && ((k) <= DBG_STOP || (k) == 38) && lo <= (k) && (k) < hi)
#define SEAM(k) do { if (!MK_MULTI && IN(k) && IN((k) + 1)) xcd_barrier(bar); } while (0)
#define GEMM_DENSE(EPI, EOBJ, APTR, BPTR, KK, NN) do { pg8::StaticOrder S_; S_.init(NTILES, (NN) / 256, (int)blockIdx.x); \
        pg8::gemm_phase<EPI, pg8::StaticOrder>(GR, (const bf16_t*)(APTR), (const bf16_t*)(BPTR), KK, 0, S_, EOBJ, F.tid); } while (0)

    if (IN(0)) { PHASE_INIT; phase_prologue(F); } SEAM(0);

#define DA_LAYER(L, BASE) do { constexpr int J_ = (L) / 3; \
    if (IN(BASE + 0)) { PHASE_INIT; phase_norm1<L>(F); } SEAM(BASE + 0); \
    if (IN(BASE + 1)) { PHASE_INIT; pg8::EpiDaIn E_{(bf16_t*)(ws + DA_K), (const f32x2*)(ws + WS_TABA)}; \
        GEMM_DENSE(pg8::EpiDaIn, E_, ws + WS_HBUF, ws + WS_W_DA_IN + (size_t)J_ * 3072 * 1024 * 2, 1024, 3072); } SEAM(BASE + 1); \
    if (IN(BASE + 2)) { PHASE_INIT; att::attn_phase<64, 2, 16, 2>((const bf16_t*)(ws + DA_Q), (const bf16_t*)(ws + DA_K), (const bf16_t*)(ws + DA_V), (bf16_t*)(ws + DA_O), (LAS char*)GR, F.tid); } SEAM(BASE + 2); \
    if (IN(BASE + 3)) { PHASE_INIT; phase_da_post<L>(F); } SEAM(BASE + 3); \
    if (IN(BASE + 4)) { PHASE_INIT; pg8::EpiResid E_{(float*)(ws + WS_XRES), MOD + (size_t)(L) * 9 * 6144 + 2 * 1024}; \
        GEMM_DENSE(pg8::EpiResid, E_, ws + DA_O2, ws + WS_W_DA_OUT + (size_t)J_ * 1024 * 1024 * 2, 1024, 1024); } SEAM(BASE + 4); } while (0)

#define MOE_LAYER(L, BASE) do { \
    if (IN(BASE + 0)) { PHASE_INIT; phase_norm2<L>(F); } SEAM(BASE + 0); \
    if (IN(BASE + 1)) { PHASE_INIT; phase_scatter(F); } SEAM(BASE + 1); \
    if (IN(BASE + 2)) { PHASE_INIT; moe_offsets(F); pg8::MoeOrder S_; S_.init(F.misc[64 + 32] / 256, 8, (int)blockIdx.x); S_.pad_start = F.misc + 64; \
        pg8::EpiMoe1 E_{(bf16_t*)(ws + MO_ACT), P.in[I_MOE_BGU] + (size_t)(L) * 32 * 2048}; \
        pg8::gemm_phase<pg8::EpiMoe1, pg8::MoeOrder>(GR, (const bf16_t*)(ws + MO_HS), (const bf16_t*)(ws + WS_W_GU + (size_t)(L) * 32 * 2048 * 1024 * 2), 1024, (size_t)2048 * 1024 * 2, S_, E_, F.tid); } SEAM(BASE + 2); \
    if (IN(BASE + 3)) { PHASE_INIT; moe_offsets(F); pg8::MoeOrder S_; S_.init(F.misc[64 + 32] / 256, 4, (int)blockIdx.x); S_.pad_start = F.misc + 64; \
        pg8::EpiMoe2 E_{(bf16_t*)(ws + MO_OUT), P.in[I_MOE_BDN] + (size_t)(L) * 32 * 1024}; \
        pg8::gemm_phase<pg8::EpiMoe2, pg8::MoeOrder>(GR, (const bf16_t*)(ws + MO_ACT), (const bf16_t*)(ws + WS_W_DN + (size_t)(L) * 32 * 1024 * 1024 * 2), 1024, (size_t)1024 * 1024 * 2, S_, E_, F.tid); } SEAM(BASE + 3); } while (0)

    DA_LAYER(0, 1);
    MOE_LAYER(0, 6);

    if (IN(10)) { PHASE_INIT; phase_norm1<1>(F); } SEAM(10);
    if (IN(11)) { PHASE_INIT; pg8::EpiRetIn E_{(bf16_t*)(ws + RT_K), (bf16_t*)(ws + RT_V), (bf16_t*)(ws + RT_Q), (bf16_t*)(ws + RT_G), (const f32x2*)(ws + WS_TABR)};
        GEMM_DENSE(pg8::EpiRetIn, E_, ws + WS_HBUF, ws + WS_W_RET_IN, 1024, 6144); } SEAM(11);
    if (IN(12)) { PHASE_INIT; phase_ret_scan(F); } SEAM(12);
    if (IN(13)) { PHASE_INIT; phase_ret_post(F); } SEAM(13);
    if (IN(14)) { PHASE_INIT; pg8::EpiResid E_{(float*)(ws + WS_XRES), MOD + (size_t)1 * 9 * 6144 + 2 * 1024};
        GEMM_DENSE(pg8::EpiResid, E_, ws + RT_A, ws + WS_W_RET_OUT, 2048, 1024); } SEAM(14);
    MOE_LAYER(1, 15);

    if (IN(19)) { PHASE_INIT; phase_norm1<2>(F); } SEAM(19);
    if (IN(20)) { PHASE_INIT; pg8::EpiF32 E_{(float*)(ws + ML_P), 512}; GEMM_DENSE(pg8::EpiF32, E_, ws + WS_HBUF, ws + WS_W_MLA_IN, 1024, 512); } SEAM(20);
    if (IN(21)) { PHASE_INIT; phase_mla_norm(F); } SEAM(21);
    if (IN(22)) { PHASE_INIT;
#ifndef NO_QUP
 { pg8::EpiMlaQ E_{(bf16_t*)(ws + ML_Q), (const f32x2*)(ws + WS_TABA)}; GEMM_DENSE(pg8::EpiMlaQ, E_, ws + ML_AQ, ws + WS_W_MLA_QUP, 256, 1536); }
#endif
#ifndef NO_KVUP
                  { pg8::EpiMlaKV E_{(bf16_t*)(ws + ML_K), (bf16_t*)(ws + ML_V)}; GEMM_DENSE(pg8::EpiMlaKV, E_, ws + ML_AKV, ws + WS_W_MLA_KVUP, 256, 2048); }
#endif
 } SEAM(22);
    if (IN(23)) { PHASE_INIT; att::attn_phase<192, 0, 8, 1>((const bf16_t*)(ws + ML_Q), (const bf16_t*)(ws + ML_K), (const bf16_t*)(ws + ML_V), (bf16_t*)(ws + ML_O), (LAS char*)GR, F.tid); } SEAM(23);
    if (IN(24)) { PHASE_INIT; pg8::EpiResid E_{(float*)(ws + WS_XRES), MOD + (size_t)2 * 9 * 6144 + 2 * 1024};
        GEMM_DENSE(pg8::EpiResid, E_, ws + ML_O, ws + WS_W_MLA_OUT, 1024, 1024); } SEAM(24);
    MOE_LAYER(2, 25);

    DA_LAYER(3, 29);
    MOE_LAYER(3, 34);

    if (IN(38)) { PHASE_INIT; phase_norm1<4, DBG_LC>(F); }
#undef IN
#undef SEAM
}
constexpr int N_PHASES = 39;

extern "C" void kernel_launch(void* const* d_in, const int* in_sizes, int n_in, void* d_out, int out_size, void* d_ws, size_t ws_size, hipStream_t stream) {
    static int ready = 0;
    if (ready == 0) {
        if (n_in != 27 || out_size != NB * SEQ * DM || ws_size < WS_END) { fprintf(stderr, "kernel_launch: unexpected shapes (n_in %d, out %d, ws %zu, need %zu)\n", n_in, out_size, ws_size, (size_t)WS_END); ready = -1; return; }
        if (hipFuncSetAttribute((const void*)hybrid_fwd, hipFuncAttributeMaxDynamicSharedMemorySize, LDS_BYTES) != hipSuccess) { fprintf(stderr, "kernel_launch: hipFuncSetAttribute failed\n"); ready = -1; return; }
        int per_cu = 0; (void)hipOccupancyMaxActiveBlocksPerMultiprocessor(&per_cu, (const void*)hybrid_fwd, NTHR, LDS_BYTES); (void)hipGetLastError();
        if (per_cu < 1) fprintf(stderr, "kernel_launch: occupancy query reports %d\n", per_cu);
        ready = 1;
    }
    if (ready < 0) return;
    (void)hipMemsetAsync((char*)d_ws + WS_CTL, 0, CTL_BYTES, stream);
    Params p{};
    for (int i = 0; i < 27; ++i) p.in[i] = (const float*)d_in[i];
    p.out = (float*)d_out; p.ws = (unsigned char*)d_ws;
#if MK_MULTI
    for (int ph = 0; ph < N_PHASES; ++ph) { p.ph_lo = ph; p.ph_hi = ph + 1; hipLaunchKernelGGL(hybrid_fwd, dim3(GRID), dim3(NTHR), LDS_BYTES, stream, p); }
#else
    p.ph_lo = 0; p.ph_hi = N_PHASES; hipLaunchKernelGGL(hybrid_fwd, dim3(GRID), dim3(NTHR), LDS_BYTES, stream, p);
#endif
    const hipError_t le = hipPeekAtLastError();
    if (le != hipSuccess) fprintf(stderr, "kernel_launch: launch failed: %s\n", hipGetErrorName(le));
}
```

```cpp
#include <hip/hip_runtime.h>
#include <cstdio>
#include <cstdint>

#ifndef MK_MULTI
#define MK_MULTI 0
#endif

#define LAS __attribute__((address_space(3)))
typedef unsigned short bf16_t;
typedef short bf16x8 __attribute__((ext_vector_type(8)));
typedef short s16x4 __attribute__((ext_vector_type(4)));
typedef float f32x4 __attribute__((ext_vector_type(4)));
typedef float f32x2 __attribute__((ext_vector_type(2)));
typedef float f32x16 __attribute__((ext_vector_type(16)));
typedef unsigned u32x4 __attribute__((ext_vector_type(4)));
typedef unsigned u32x2 __attribute__((ext_vector_type(2)));

constexpr int DM = 1024, NB = 8, SEQ = 8192, CTX = 256, TB = SEQ + CTX, T = NB * TB;
constexpr int NTILES = T / 256, TPB = TB / 256;
constexpr int NEXP = 32, TOPK = 4;
constexpr int GRID = 256, NTHR = 512, TOK_PER_BLK = T / GRID;
constexpr int MOE_MAXTILES = (T * TOPK) / 256 + NEXP;
constexpr float RMS_EPS = 1e-6f;
constexpr int LDS_BYTES = 144 * 1024, MISC_BYTES = 1024, REG_OFF = MISC_BYTES;

constexpr size_t AL(size_t x) { return (x + 255) / 256 * 256; }
constexpr size_t WS_CTL = 0, CTL_BYTES = 1u << 20;
constexpr size_t WS_MOD = WS_CTL + CTL_BYTES;
constexpr size_t WS_TABA = WS_MOD + AL((size_t)4 * 9 * 6144 * 4);
constexpr size_t WS_TABR = WS_TABA + AL(128 * 16 * 8);
constexpr size_t WS_BLKCNT = WS_TABR + AL((size_t)8192 * 128 * 8);
constexpr size_t WS_IDX = WS_BLKCNT + AL(256 * 32 * 4);
constexpr size_t WS_GATE = WS_IDX + AL((size_t)T * 16);
constexpr size_t WS_RANK = WS_GATE + AL((size_t)T * 16);
constexpr size_t WS_SLOT = WS_RANK + AL((size_t)T * 16);
constexpr size_t WS_W_DA_IN = WS_SLOT + AL((size_t)T * 16);
constexpr size_t WS_W_DA_OUT = WS_W_DA_IN + (size_t)2 * 3072 * 1024 * 2;
constexpr size_t WS_W_RET_IN = WS_W_DA_OUT + (size_t)2 * 1024 * 1024 * 2;
constexpr size_t WS_W_RET_OUT = WS_W_RET_IN + (size_t)6144 * 1024 * 2;
constexpr size_t WS_W_MLA_IN = WS_W_RET_OUT + (size_t)1024 * 2048 * 2;
constexpr size_t WS_W_MLA_QUP = WS_W_MLA_IN + (size_t)512 * 1024 * 2;
constexpr size_t WS_W_MLA_KVUP = WS_W_MLA_QUP + (size_t)1536 * 256 * 2;
constexpr size_t WS_W_MLA_OUT = WS_W_MLA_KVUP + (size_t)2048 * 256 * 2;
constexpr size_t WS_W_GU = WS_W_MLA_OUT + (size_t)1024 * 1024 * 2;
constexpr size_t WS_W_DN = WS_W_GU + (size_t)128 * 2048 * 1024 * 2;
constexpr size_t WS_XRES = WS_W_DN + (size_t)128 * 1024 * 1024 * 2;
constexpr size_t WS_HBUF = WS_XRES + (size_t)T * 1024 * 4;
constexpr size_t WS_BIG = WS_HBUF + (size_t)T * 1024 * 2;
constexpr size_t ROW1K = (size_t)T * 1024 * 2;
constexpr size_t DA_K = WS_BIG, DA_V = DA_K + ROW1K, DA_Q = DA_V + ROW1K, DA_O = DA_Q + ROW1K  , DA_O2 = DA_O + 2 * ROW1K, DA_END = DA_O2 + ROW1K;
constexpr size_t RT_K = WS_BIG, RT_V = RT_K + ROW1K  , RT_Q = RT_V + 2 * ROW1K, RT_G = RT_Q + ROW1K  , RT_OF = RT_G + 2 * ROW1K, RT_OB = RT_OF + 2 * ROW1K,
                 RT_A = RT_OB + 2 * ROW1K, RT_END = RT_A + 2 * ROW1K;
constexpr size_t ML_P = WS_BIG  , ML_AKV = ML_P + ROW1K  , ML_AQ = ML_AKV + ROW1K / 4, ML_Q = ML_AQ + ROW1K / 4  , ML_K = ML_Q + ROW1K * 3 / 2,
                 ML_V = ML_K + ROW1K * 3 / 2, ML_O = ML_V + ROW1K, ML_END = ML_O + ROW1K;
constexpr size_t MOE_ROWS = (size_t)MOE_MAXTILES * 256;
constexpr size_t MO_HS = WS_BIG, MO_ACT = MO_HS + MOE_ROWS * 2048, MO_OUT = MO_ACT + MOE_ROWS * 2048, MO_END = MO_OUT + MOE_ROWS * 2048;
constexpr size_t cmax(size_t a, size_t b) { return a > b ? a : b; }
constexpr size_t WS_END = cmax(cmax(DA_END, RT_END), cmax(ML_END, MO_END));

__device__ __forceinline__ float wave_sum(float v) {
#pragma unroll
    for (int o = 1; o < 64; o <<= 1) v += __shfl_xor(v, o);
    return v;
}
__device__ __forceinline__ unsigned pk2(float lo, float hi) { unsigned r; asm volatile("v_cvt_pk_bf16_f32 %0, %1, %2" : "=v"(r) : "v"(lo), "v"(hi)); return r; }
__device__ __forceinline__ float bflo(unsigned w) { return __uint_as_float(w << 16); }
__device__ __forceinline__ float bfhi(unsigned w) { return __uint_as_float(w & 0xffff0000u); }
__device__ __forceinline__ float bf2f(bf16_t h) { return __uint_as_float((unsigned)h << 16); }
__device__ __forceinline__ bf16_t f2bf(float f) { return (bf16_t)(pk2(f, 0.f) & 0xffffu); }
__device__ __forceinline__ bf16_t f2bf_c(float f) { unsigned u = __float_as_uint(f); u += 0x7fffu + ((u >> 16) & 1u); return (bf16_t)(u >> 16); }

#define XB_TMO      128
#define XB_XCNT(j)  (256  + 64 * (j))
#define XB_XSUB(j)  (1280 + 64 * (j))
#define XB_XGEN(j)  (2304 + 64 * (j))
#define XB_TOP      3328
#define XB_TOPGEN   3392
#define XCD_BAR_WORDS 3456
#define XB_SPIN_CAP (1u << 22)
__device__ __forceinline__ unsigned xb_ld(unsigned* p)              { return __hip_atomic_load(p, __ATOMIC_RELAXED, __HIP_MEMORY_SCOPE_AGENT); }
__device__ __forceinline__ unsigned xb_add(unsigned* p, unsigned v) { return __hip_atomic_fetch_add(p, v, __ATOMIC_RELAXED, __HIP_MEMORY_SCOPE_AGENT); }
__device__ __forceinline__ unsigned xb_xcc_id() { return (unsigned)__builtin_amdgcn_s_getreg((3 << 11) | 20) & 0xFu; }
#define XB_SPIN(cond, bar) do { unsigned _sp = 0; while (cond) { __builtin_amdgcn_s_sleep(1); \
    if ((++_sp & 255u) == 0u) { if (xb_ld(&(bar)[XB_TMO])) break; if (_sp > XB_SPIN_CAP) { atomicAdd(&(bar)[XB_TMO], 1u); break; } } } } while (0)
struct XcdBarrier { unsigned* bar; unsigned x; volatile LAS unsigned* st; };
__device__ __forceinline__ XcdBarrier xcd_barrier_post(unsigned* bar, volatile LAS unsigned* st) {
    XcdBarrier b; b.bar = bar; b.x = xb_xcc_id(); b.st = st;
    if (threadIdx.x == 0) (void)xb_add(&bar[XB_XCNT(b.x)], 1u);
    return b;
}
__device__ __forceinline__ void xcd_barrier_complete(unsigned* bar, unsigned x, unsigned& nloc, unsigned& nx) {
    const unsigned G = gridDim.x * gridDim.y * gridDim.z;
    unsigned sum, cnt, mine, sp = 0u;
    for (;;) {
        sum = 0u; cnt = 0u; mine = 0u;
#pragma unroll
        for (unsigned j = 0; j < 16; ++j) { const unsigned c = xb_ld(&bar[XB_XCNT(j)]); sum += c; cnt += (c > 0u) ? 1u : 0u; mine = (j == x) ? c : mine; }
        if (sum == G) break;
        __builtin_amdgcn_s_sleep(1);
        if ((++sp & 255u) == 0u) { if (xb_ld(&bar[XB_TMO])) break; if (sp > XB_SPIN_CAP) { atomicAdd(&bar[XB_TMO], 1u); break; } }
    }
    nloc = mine > 0u ? mine : 1u; nx = cnt > 0u ? cnt : 1u;
}
__device__ __forceinline__ void xcd_barrier(const XcdBarrier& b) {
    asm volatile("s_waitcnt vmcnt(0)" ::: "memory");
    __syncthreads();
    if (threadIdx.x == 0) {
        unsigned* bar = b.bar;
        __builtin_amdgcn_s_waitcnt(0);
        unsigned nloc = b.st[0], nx = b.st[1];
        if (nloc == 0u) { xcd_barrier_complete(bar, b.x, nloc, nx); b.st[0] = nloc; b.st[1] = nx; }
        const unsigned old = xb_add(&bar[XB_XSUB(b.x)], 1u);
        const unsigned gen = old / nloc;
        if (old + 1u == (gen + 1u) * nloc) {
            __builtin_amdgcn_fence(__ATOMIC_RELEASE, "agent");
            asm volatile("s_waitcnt vmcnt(0)" ::: "memory");
            const unsigned og = xb_add(&bar[XB_TOP], 1u);
            const unsigned tg = og / nx;
            if (og + 1u == (tg + 1u) * nx) xb_add(&bar[XB_TOPGEN], 1u);
            else XB_SPIN(xb_ld(&bar[XB_TOPGEN]) == tg, bar);
            __builtin_amdgcn_fence(__ATOMIC_ACQUIRE, "agent");
            xb_add(&bar[XB_XGEN(b.x)], 1u);
            asm volatile("s_waitcnt vmcnt(0)" ::: "memory");
        } else {
            XB_SPIN(xb_ld(&bar[XB_XGEN(b.x)]) == gen, bar);
            __builtin_amdgcn_fence(__ATOMIC_ACQUIRE, "agent");
            asm volatile("s_waitcnt vmcnt(0)" ::: "memory");
        }
    }
    __syncthreads();
}

namespace pg8 {
constexpr int BM = 256, BK = 64, HALF = 128, HTB = HALF * BK * 2, STAGE_BYTES = 8 * HTB, NXCD = 8, WGM = 8;
__host__ __device__ __forceinline__ int lds_byte(int r, int c) { const int st = (r >> 4) * 2 + (c >> 5), rr = r & 15, cc = c & 31, ob = rr * 64 + cc * 2; return st * 1024 + (ob ^ (((ob >> 9) & 1) << 5)); }
__host__ __device__ __forceinline__ void stage_rc(int b, int& R, int& C) { const int st = b / 1024, sb = b % 1024, swz = sb ^ (((sb >> 9) & 1) << 5); R = (st >> 1) * 16 + swz / 64; C = (st & 1) * 32 + (swz % 64) / 2; }
__host__ __device__ __forceinline__ int perm32(int rho) { const int n = rho >> 4, i = rho & 15; return 8 * (i >> 2) + 4 * n + (i & 3); }
struct Unit { int pm, pn, grp; };
struct StaticOrder {
    int nM, nN, nwg, c;
    __device__ __forceinline__ void init(int nM_, int nN_, int c_) { nM = nM_; nN = nN_; nwg = nM * nN; c = c_; }
    __device__ __forceinline__ bool next(int i, Unit& u) const {
        const long L = (long)i * GRID + c; if (L >= nwg) return false;
        int wgid = (int)L; { const int q = nwg / NXCD, r = nwg % NXCD, xcd = wgid % NXCD, off = wgid / NXCD; wgid = (xcd < r ? xcd * (q + 1) : r * (q + 1) + (xcd - r) * q) + off; }
        const int nig = WGM * nN, gid = wgid / nig, fm = gid * WGM, gsz = (nM - fm) < WGM ? (nM - fm) : WGM;
        u.pm = fm + ((wgid % nig) % gsz); u.pn = (wgid % nig) / gsz; u.grp = 0; return true;
    }
};
struct MoeOrder : StaticOrder {
    const volatile LAS int* pad_start;
    __device__ __forceinline__ bool next(int i, Unit& u) const {
        if (!StaticOrder::next(i, u)) return false;
        const int r0 = u.pm * 256; int e = 0;
#pragma unroll 1
        for (int k = 1; k < NEXP; ++k) e += (pad_start[k] <= r0) ? 1 : 0;
        u.grp = e; return true;
    }
};

template <class Epi, class Sched>
__device__ __forceinline__ void gemm_phase(LAS unsigned char* lds, const bf16_t* Aptr, const bf16_t* Btptr, const int K, const size_t grp_stride_bytes, const Sched& S, const Epi& E, const int tid) {
    const int wid = __builtin_amdgcn_readfirstlane(tid >> 6), lane = tid & 63, wr = wid >> 2, wc = wid & 3, fr = lane & 15, fq = lane >> 4;
    const int nt = K / BK;
    unsigned voffA[2], voffB[2];
#pragma unroll
    for (int i = 0; i < 2; ++i) { int R, C; stage_rc(tid * 16 + i * 8192, R, C); const int Rb = Epi::PERM ? ((R & ~31) + perm32(R & 31)) : R;
        voffA[i] = (unsigned)(R * K + C) * 2u; voffB[i] = (unsigned)(Rb * K + C) * 2u; }
    const size_t kstep = (size_t)(BK * 2);
    const size_t hstep = (size_t)HALF * K * 2;
    const size_t tstep = 2 * hstep;
    const unsigned ldsw = (unsigned)wid * 1024u;
    const int aoff = lds_byte(wr * 64 + fr, fq * 8), boff = lds_byte(wc * 32 + fr, fq * 8);
#define PG8_SA(b, h) (((b) * 2 + (h)) * HTB)
#define PG8_SB(b, h) ((4 + (b) * 2 + (h)) * HTB)
#define PG8_STAGE(bufoff, gbase, voff) do { _Pragma("unroll") for (int _i = 0; _i < 2; ++_i) \
        __builtin_amdgcn_global_load_lds((const unsigned*)((const char*)(gbase) + (voff)[_i]), (LAS unsigned*)(lds + (bufoff) + ldsw + _i * 8192), 16, 0, 0); } while (0)
#define PG8_LDA(dst, b, h) do { _Pragma("unroll") for (int m = 0; m < 4; ++m) _Pragma("unroll") for (int k = 0; k < 2; ++k) dst[m][k] = *(const LAS bf16x8*)(lds + PG8_SA(b, h) + aoff + m * 2048 + k * 1024); } while (0)
#define PG8_LDB(dst, b, h) do { _Pragma("unroll") for (int n = 0; n < 2; ++n) _Pragma("unroll") for (int k = 0; k < 2; ++k) dst[n][k] = *(const LAS bf16x8*)(lds + PG8_SB(b, h) + boff + n * 2048 + k * 1024); } while (0)
#define PG8_MMA(ai, bj, At, Bt) do { __builtin_amdgcn_s_setprio(1); _Pragma("unroll") for (int m = 0; m < 4; ++m) _Pragma("unroll") for (int n = 0; n < 2; ++n) _Pragma("unroll") for (int k = 0; k < 2; ++k) \
        acc[ai][bj][m][n] = __builtin_amdgcn_mfma_f32_16x16x32_bf16(Bt[n][k], At[m][k], acc[ai][bj][m][n], 0, 0, 0); __builtin_amdgcn_s_setprio(0); } while (0)
#define PG8_WAIT_V(n) asm volatile("s_waitcnt vmcnt(" #n ")" ::: "memory")
#define PG8_WAIT_L(n) asm volatile("s_waitcnt lgkmcnt(" #n ")" ::: "memory")
#define PG8_BAR __builtin_amdgcn_s_barrier()
#define PG8_SCHED __builtin_amdgcn_sched_barrier(0)
    Unit cur, nxt; int ui = 0;
    if (!S.next(0, cur)) return;
    f32x4 acc[2][2][4][2];
#pragma unroll
    for (int a = 0; a < 2; ++a)
#pragma unroll
        for (int b = 0; b < 2; ++b)
#pragma unroll
            for (int m = 0; m < 4; ++m)
#pragma unroll
                for (int n = 0; n < 2; ++n) acc[a][b][m][n] = (f32x4){0.f, 0.f, 0.f, 0.f};
    bf16x8 At[4][2], B0[2][2], B1[2][2];
    const char* cA = (const char*)Aptr + (size_t)cur.pm * tstep; const char* cB = (const char*)Btptr + (size_t)cur.grp * grp_stride_bytes + (size_t)cur.pn * tstep;
    PG8_STAGE(PG8_SB(0, 0), cB, voffB); PG8_STAGE(PG8_SA(0, 0), cA, voffA); PG8_STAGE(PG8_SB(0, 1), cB + hstep, voffB); PG8_STAGE(PG8_SA(0, 1), cA + hstep, voffA);
    if (wr == 1) PG8_BAR;
    PG8_WAIT_V(4); PG8_BAR;
    PG8_STAGE(PG8_SB(1, 0), cB + kstep, voffB); PG8_STAGE(PG8_SA(1, 0), cA + kstep, voffA); PG8_STAGE(PG8_SB(1, 1), cB + hstep + kstep, voffB);
    PG8_WAIT_V(6); PG8_BAR;
    for (;;) {
        const bool has_next = S.next(ui + 1, nxt);
        const char* nA = has_next ? (const char*)Aptr + (size_t)nxt.pm * tstep : cA;
        const char* nB = has_next ? (const char*)Btptr + (size_t)nxt.grp * grp_stride_bytes + (size_t)nxt.pn * tstep : cB;
#pragma unroll 1
        for (int t = 0; t < nt; t += 2) {
            const bool last = (t == nt - 2);
            const char* a1 = cA + (size_t)(t + 1) * kstep;
            const char* a2 = last ? nA : cA + (size_t)(t + 2) * kstep; const char* b2 = last ? nB : cB + (size_t)(t + 2) * kstep;
            const char* a3 = a2 + kstep; const char* b3 = b2 + kstep;
            PG8_LDB(B0, 0, 0); PG8_SCHED; PG8_LDA(At, 0, 0); PG8_STAGE(PG8_SA(1, 1), a1 + hstep, voffA);
            PG8_WAIT_L(8); PG8_BAR; PG8_WAIT_L(0); PG8_MMA(0, 0, At, B0); PG8_BAR; PG8_SCHED;
            PG8_LDB(B1, 0, 1); PG8_STAGE(PG8_SB(0, 0), b2, voffB);
            PG8_BAR; PG8_WAIT_L(0); PG8_MMA(0, 1, At, B1); PG8_BAR;
            PG8_LDA(At, 0, 1); PG8_STAGE(PG8_SA(0, 0), a2, voffA);
            PG8_BAR; PG8_WAIT_L(0); PG8_MMA(1, 0, At, B0); PG8_BAR; PG8_SCHED;
            PG8_STAGE(PG8_SB(0, 1), b2 + hstep, voffB);
            PG8_WAIT_V(6); PG8_BAR; PG8_MMA(1, 1, At, B1); PG8_BAR;
            PG8_LDB(B0, 1, 0); PG8_SCHED; PG8_LDA(At, 1, 0); PG8_STAGE(PG8_SA(0, 1), a2 + hstep, voffA);
            PG8_WAIT_L(8); PG8_BAR; PG8_WAIT_L(0); PG8_MMA(0, 0, At, B0); PG8_BAR; PG8_SCHED;
            PG8_LDB(B1, 1, 1); PG8_STAGE(PG8_SB(1, 0), b3, voffB);
            PG8_BAR; PG8_WAIT_L(0); PG8_MMA(0, 1, At, B1); PG8_BAR;
            PG8_LDA(At, 1, 1); PG8_STAGE(PG8_SA(1, 0), a3, voffA);
            PG8_BAR; PG8_WAIT_L(0); PG8_MMA(1, 0, At, B0); PG8_BAR; PG8_SCHED;
            PG8_STAGE(PG8_SB(1, 1), b3 + hstep, voffB);
            PG8_WAIT_V(6); PG8_BAR; PG8_MMA(1, 1, At, B1); PG8_BAR;
        }
        E(acc, cur, wr, wc, fr, fq);
        if (!has_next) break;
#pragma unroll
        for (int a = 0; a < 2; ++a)
#pragma unroll
            for (int b = 0; b < 2; ++b)
#pragma unroll
                for (int m = 0; m < 4; ++m)
#pragma unroll
                    for (int n = 0; n < 2; ++n) acc[a][b][m][n] = (f32x4){0.f, 0.f, 0.f, 0.f};
        cur = nxt; cA = nA; cB = nB; ++ui;
    }
    PG8_WAIT_V(0);
    if (wr == 0) PG8_BAR;
    PG8_BAR;
#undef PG8_SA
#undef PG8_SB
#undef PG8_STAGE
#undef PG8_LDA
#undef PG8_LDB
#undef PG8_MMA
#undef PG8_WAIT_V
#undef PG8_WAIT_L
#undef PG8_BAR
#undef PG8_SCHED
}

typedef const f32x4 (&AccRef)[2][2][4][2];

__device__ __forceinline__ void rope8(f32x4& v0, f32x4& v1, const f32x2* cs) {
    const f32x4 c01 = *(const f32x4*)cs, c23 = *(const f32x4*)(cs + 2);
    f32x4 a = v0, b = v1;
    v0[0] = a[0] * c01[0] - a[1] * c01[1]; v0[1] = a[0] * c01[1] + a[1] * c01[0];
    v0[2] = a[2] * c01[2] - a[3] * c01[3]; v0[3] = a[2] * c01[3] + a[3] * c01[2];
    v1[0] = b[0] * c23[0] - b[1] * c23[1]; v1[1] = b[0] * c23[1] + b[1] * c23[0];
    v1[2] = b[2] * c23[2] - b[3] * c23[3]; v1[3] = b[2] * c23[3] + b[3] * c23[2];
}
__device__ __forceinline__ void store8(bf16_t* p, f32x4 v0, f32x4 v1) {
    u32x4 w; w.x = pk2(v0[0], v0[1]); w.y = pk2(v0[2], v0[3]); w.z = pk2(v1[0], v1[1]); w.w = pk2(v1[2], v1[3]); *(u32x4*)p = w;
}

struct EpiDaIn {
    static constexpr bool PERM = true;
    bf16_t* KVQ; const f32x2* tabA;
    __device__ __forceinline__ void operator()(AccRef acc, const Unit& u, int wr, int wc, int fr, int fq) const {
        const int part = u.pn >> 2; bf16_t* base = KVQ + (size_t)part * ((size_t)T * 1024);
        const int tb = u.pm % TPB; const bool lat = tb != 0; const bool rope = lat && part != 1;
        const int cin0 = (u.pn & 3) * 256 + wc * 32 + 8 * fq;
#pragma unroll
        for (int ai = 0; ai < 2; ++ai)
#pragma unroll
            for (int m = 0; m < 4; ++m) {
                asm volatile("" ::: "memory");
                const int rin = ai * HALF + wr * 64 + m * 16 + fr; const size_t row = (size_t)u.pm * BM + rin; const int p = (tb - 1) * 256 + rin;
#pragma unroll
                for (int bj = 0; bj < 2; ++bj) { f32x4 v0 = acc[ai][bj][m][0], v1 = acc[ai][bj][m][1]; const int cin = cin0 + bj * HALF;
                    if (rope) { const int o = cin & 63, axis = o >> 5, f0 = (o & 31) >> 1, pos = axis ? (p & 63) : (p >> 6); rope8(v0, v1, tabA + pos * 16 + f0); }
                    store8(base + row * 1024 + cin, v0, v1); }
            }
    }
};
struct EpiRetIn {
    static constexpr bool PERM = true;
    bf16_t *Kb, *Vb, *Qb, *Gb; const f32x2* tabR;
    __device__ __forceinline__ void operator()(AccRef acc, const Unit& u, int wr, int wc, int fr, int fq) const {
        const int ct = u.pn * 256; bf16_t* base; int ld, c0; bool isk = false, isq = false;
        if (ct < 1024) { base = Kb; ld = 1024; c0 = ct; isk = true; } else if (ct < 3072) { base = Vb; ld = 2048; c0 = ct - 1024; }
        else if (ct < 4096) { base = Qb; ld = 1024; c0 = ct - 3072; isq = true; } else { base = Gb; ld = 2048; c0 = ct - 4096; }
        const int tb = u.pm % TPB; const bool lat = tb != 0; const bool rope = lat && (isk || isq);
        const int cin0 = c0 + wc * 32 + 8 * fq; const float sc = isk ? 0.0625f : 1.0f;
#pragma unroll
        for (int ai = 0; ai < 2; ++ai)
#pragma unroll
            for (int m = 0; m < 4; ++m) {
                asm volatile("" ::: "memory");
                const int rin = ai * HALF + wr * 64 + m * 16 + fr; const size_t row = (size_t)u.pm * BM + rin; const int p = (tb - 1) * 256 + rin;
#pragma unroll
                for (int bj = 0; bj < 2; ++bj) { f32x4 v0 = acc[ai][bj][m][0] * sc, v1 = acc[ai][bj][m][1] * sc; const int cin = cin0 + bj * HALF;
                    if (rope) { const int f0 = (cin & 255) >> 1; rope8(v0, v1, tabR + (size_t)p * 128 + f0); }
                    store8(base + row * ld + cin, v0, v1); }
            }
    }
};
struct EpiF32 {
    static constexpr bool PERM = false;
    float* C; int ldc;
    __device__ __forceinline__ void operator()(AccRef acc, const Unit& u, int wr, int wc, int fr, int fq) const {
        const int row0 = u.pm * BM + wr * 64 + fr, col0 = u.pn * BM + wc * 32 + 4 * fq;
#pragma unroll
        for (int ai = 0; ai < 2; ++ai)
#pragma unroll
            for (int m = 0; m < 4; ++m) { float* rowp = C + (size_t)(row0 + ai * HALF + m * 16) * ldc + col0;
#pragma unroll
                for (int bj = 0; bj < 2; ++bj)
#pragma unroll
                    for (int n = 0; n < 2; ++n) *(f32x4*)(rowp + bj * HALF + n * 16) = acc[ai][bj][m][n]; }
    }
};
struct EpiMlaQ {
    static constexpr bool PERM = true;
    bf16_t* Qb; const f32x2* tabA;
    __device__ __forceinline__ void operator()(AccRef acc, const Unit& u, int wr, int wc, int fr, int fq) const {
        const int tb = u.pm % TPB; const bool rope = tb != 0 && u.pn >= 4; const int c0 = u.pn * 256 + wc * 32 + 8 * fq;
#pragma unroll
        for (int ai = 0; ai < 2; ++ai)
#pragma unroll
            for (int m = 0; m < 4; ++m) {
                asm volatile("" ::: "memory");
                const int rin = ai * HALF + wr * 64 + m * 16 + fr; const size_t row = (size_t)u.pm * BM + rin; const int p = (tb - 1) * 256 + rin;
#pragma unroll
                for (int bj = 0; bj < 2; ++bj) { f32x4 v0 = acc[ai][bj][m][0], v1 = acc[ai][bj][m][1]; const int c = c0 + bj * HALF;
                    if (rope) { const int o = c & 63, axis = o >> 5, f0 = (o & 31) >> 1, pos = axis ? (p & 63) : (p >> 6); rope8(v0, v1, tabA + pos * 16 + f0); }
                    store8(Qb + row * 1536 + c, v0, v1); }
            }
    }
};
struct EpiMlaKV {
    static constexpr bool PERM = true;
    bf16_t *Kb, *Vb;
    __device__ __forceinline__ void operator()(AccRef acc, const Unit& u, int wr, int wc, int fr, int fq) const {
        const int c0 = wc * 32 + 8 * fq;
#pragma unroll
        for (int ai = 0; ai < 2; ++ai)
#pragma unroll
            for (int m = 0; m < 4; ++m) {
                const size_t row = (size_t)u.pm * BM + ai * HALF + wr * 64 + m * 16 + fr;
                store8(Kb + row * 1536 + u.pn * 192 + c0, acc[ai][0][m][0], acc[ai][0][m][1]);
                store8(Vb + row * 1024 + u.pn * 128 + c0, acc[ai][1][m][0], acc[ai][1][m][1]);
            }
    }
};
struct EpiResid {
    static constexpr bool PERM = false;
    float* X; const float* mod2;
    __device__ __forceinline__ void operator()(AccRef acc, const Unit& u, int wr, int wc, int fr, int fq) const {
        const int tb = u.pm % TPB, b = u.pm / TPB, mrow = tb == 0 ? 8 : b;
        const int row0 = u.pm * BM + wr * 64 + fr, col0 = u.pn * BM + wc * 32 + 4 * fq;
        const float* mp = mod2 + (size_t)mrow * 6144 + col0;
        f32x4 g[2][2];
#pragma unroll
        for (int bj = 0; bj < 2; ++bj)
#pragma unroll
            for (int n = 0; n < 2; ++n) g[bj][n] = *(const f32x4*)(mp + bj * HALF + n * 16);
#pragma unroll
        for (int ai = 0; ai < 2; ++ai)
#pragma unroll
            for (int m = 0; m < 4; ++m) { float* rowp = X + (size_t)(row0 + ai * HALF + m * 16) * 1024 + col0;
#pragma unroll
                for (int bj = 0; bj < 2; ++bj)
#pragma unroll
                    for (int n = 0; n < 2; ++n) { f32x4* q = (f32x4*)(rowp + bj * HALF + n * 16); *q = *q + g[bj][n] * acc[ai][bj][m][n]; } }
    }
};
struct EpiMoe1 {
    static constexpr bool PERM = true;
    bf16_t* ACT; const float* bgu;
    __device__ __forceinline__ void operator()(AccRef acc, const Unit& u, int wr, int wc, int fr, int fq) const {
        const int j0 = u.pn * 128 + wc * 16 + 4 * fq; const float* bp = bgu + (size_t)u.grp * 2048 + j0;
        f32x4 bg[2], bl[2];
#pragma unroll
        for (int bj = 0; bj < 2; ++bj) { bg[bj] = *(const f32x4*)(bp + bj * 64); bl[bj] = *(const f32x4*)(bp + 1024 + bj * 64); }
#pragma unroll
        for (int ai = 0; ai < 2; ++ai)
#pragma unroll
            for (int m = 0; m < 4; ++m) { const size_t row = (size_t)u.pm * BM + ai * HALF + wr * 64 + m * 16 + fr;
#pragma unroll
                for (int bj = 0; bj < 2; ++bj) { const f32x4 gl = acc[ai][bj][m][0] + bg[bj], li = acc[ai][bj][m][1] + bl[bj]; float a[4];
#pragma unroll
                    for (int e = 0; e < 4; ++e) { const float g = fminf(gl[e], 7.0f), l = fminf(fmaxf(li[e], -7.0f), 7.0f);
                        const float s = __builtin_amdgcn_rcpf(1.0f + __builtin_amdgcn_exp2f(g * (-1.702f * 1.4426950408889634f))); a[e] = g * s * (l + 1.0f); }
                    u32x2 w; w.x = pk2(a[0], a[1]); w.y = pk2(a[2], a[3]); *(u32x2*)(ACT + row * 1024 + j0 + bj * 64) = w; } }
    }
};
struct EpiMoe2 {
    static constexpr bool PERM = true;
    bf16_t* OUT; const float* bdn;
    __device__ __forceinline__ void operator()(AccRef acc, const Unit& u, int wr, int wc, int fr, int fq) const {
        const int c0 = u.pn * 256 + wc * 32 + 8 * fq; const float* bp = bdn + (size_t)u.grp * 1024 + c0;
        f32x4 b[2][2];
#pragma unroll
        for (int bj = 0; bj < 2; ++bj) { b[bj][0] = *(const f32x4*)(bp + bj * HALF); b[bj][1] = *(const f32x4*)(bp + bj * HALF + 4); }
#pragma unroll
        for (int ai = 0; ai < 2; ++ai)
#pragma unroll
            for (int m = 0; m < 4; ++m) { const size_t row = (size_t)u.pm * BM + ai * HALF + wr * 64 + m * 16 + fr;
#pragma unroll
                for (int bj = 0; bj < 2; ++bj) store8(OUT + row * 1024 + c0 + bj * HALF, acc[ai][bj][m][0] + b[bj][0], acc[ai][bj][m][1] + b[bj][1]); }
    }
};
}

namespace att {
constexpr int DV = 128, QBLK = 32, KVBLK = 64;
#define SBAR() __builtin_amdgcn_sched_barrier(0)
__device__ __forceinline__ int crow(int r, int hi) { return (r & 3) + 8 * (r >> 2) + 4 * hi; }
__device__ __forceinline__ int v_st(int k, int c) { const int kk = (k & ~0xC) | ((k & 4) << 1) | ((k & 8) >> 1); return ((kk >> 3) * 4 + (c >> 5)) * 512 + ((kk & 7) * 32 + (c & 31)) * 2; }
__device__ __forceinline__ int v_rd_base(int lane) { return ((lane & 3) << 3) | (((lane >> 2) & 3) << 6) | (((lane >> 4) & 1) << 5) | (((lane >> 5) & 1) << 8); }
constexpr int v_rd_off(int d0, int ks, int half) { return d0 * 512 + ks * 4096 + half * 2048; }
template <int OFF> __device__ __forceinline__ s16x4 tr_read(int vb) {
    s16x4 r; asm volatile("ds_read_b64_tr_b16 %0, %1 offset:%2" : "=&v"(r) : "v"(vb), "i"(OFF) : "memory"); return r;
}
template <int D0> __device__ __forceinline__ void pv_one(f32x16& od, int vb, bf16x8 pa0, bf16x8 pa1, bf16x8 pa2, bf16x8 pa3) {
    const s16x4 l0 = tr_read<v_rd_off(D0, 0, 0)>(vb), h0 = tr_read<v_rd_off(D0, 0, 1)>(vb), l1 = tr_read<v_rd_off(D0, 1, 0)>(vb), h1 = tr_read<v_rd_off(D0, 1, 1)>(vb);
    const s16x4 l2 = tr_read<v_rd_off(D0, 2, 0)>(vb), h2 = tr_read<v_rd_off(D0, 2, 1)>(vb), l3 = tr_read<v_rd_off(D0, 3, 0)>(vb), h3 = tr_read<v_rd_off(D0, 3, 1)>(vb);
    asm volatile("s_waitcnt lgkmcnt(0)" ::: "memory"); SBAR();
#define PK(L, H) (bf16x8){L[0], L[1], L[2], L[3], H[0], H[1], H[2], H[3]}
    od = __builtin_amdgcn_mfma_f32_32x32x16_bf16(pa0, PK(l0, h0), od, 0, 0, 0);
    od = __builtin_amdgcn_mfma_f32_32x32x16_bf16(pa1, PK(l1, h1), od, 0, 0, 0);
    od = __builtin_amdgcn_mfma_f32_32x32x16_bf16(pa2, PK(l2, h2), od, 0, 0, 0);
    od = __builtin_amdgcn_mfma_f32_32x32x16_bf16(pa3, PK(l3, h3), od, 0, 0, 0);
#undef PK
}
__device__ __forceinline__ void pv_d0(f32x16* o, int vb, bf16x8 pa0, bf16x8 pa1, bf16x8 pa2, bf16x8 pa3) {
    pv_one<0>(o[0], vb, pa0, pa1, pa2, pa3); pv_one<1>(o[1], vb, pa0, pa1, pa2, pa3); pv_one<2>(o[2], vb, pa0, pa1, pa2, pa3); pv_one<3>(o[3], vb, pa0, pa1, pa2, pa3);
}
#define PV_RD(D0, S) S##0 = tr_read<v_rd_off(D0, 0, 0)>(vb); S##1 = tr_read<v_rd_off(D0, 0, 1)>(vb); S##2 = tr_read<v_rd_off(D0, 1, 0)>(vb); S##3 = tr_read<v_rd_off(D0, 1, 1)>(vb); \
                     S##4 = tr_read<v_rd_off(D0, 2, 0)>(vb); S##5 = tr_read<v_rd_off(D0, 2, 1)>(vb); S##6 = tr_read<v_rd_off(D0, 3, 0)>(vb); S##7 = tr_read<v_rd_off(D0, 3, 1)>(vb)
#define PV_PK(L, H) (bf16x8){L[0], L[1], L[2], L[3], H[0], H[1], H[2], H[3]}
#define PV_MM(OD, S) OD = __builtin_amdgcn_mfma_f32_32x32x16_bf16(pa0, PV_PK(S##0, S##1), OD, 0, 0, 0); OD = __builtin_amdgcn_mfma_f32_32x32x16_bf16(pa1, PV_PK(S##2, S##3), OD, 0, 0, 0); \
                     OD = __builtin_amdgcn_mfma_f32_32x32x16_bf16(pa2, PV_PK(S##4, S##5), OD, 0, 0, 0); OD = __builtin_amdgcn_mfma_f32_32x32x16_bf16(pa3, PV_PK(S##6, S##7), OD, 0, 0, 0)
__device__ __forceinline__ void pv_pipe(f32x16* o, int vb, bf16x8 pa0, bf16x8 pa1, bf16x8 pa2, bf16x8 pa3) {
    s16x4 a0, a1, a2, a3, a4, a5, a6, a7, b0, b1, b2, b3, b4, b5, b6, b7;
    asm volatile("s_waitcnt lgkmcnt(0)" ::: "memory"); SBAR();
    PV_RD(0, a); PV_RD(1, b);
    asm volatile("s_waitcnt lgkmcnt(8)" ::: "memory"); SBAR();
    PV_MM(o[0], a); SBAR();
    PV_RD(2, a);
    asm volatile("s_waitcnt lgkmcnt(8)" ::: "memory"); SBAR();
    PV_MM(o[1], b); SBAR();
    PV_RD(3, b);
    asm volatile("s_waitcnt lgkmcnt(8)" ::: "memory"); SBAR();
    PV_MM(o[2], a); SBAR();
    asm volatile("s_waitcnt lgkmcnt(0)" ::: "memory"); SBAR();
    PV_MM(o[3], b);
}
#undef PV_RD
#undef PV_PK
#undef PV_MM
template <int DQK> struct Cfg {
    static constexpr int KROW = DQK * 2;
    static constexpr int SHM_K = KVBLK * DQK * 2, SHM_V = KVBLK * DV * 2;
    static constexpr int NKC = DQK / 64;
    static constexpr int CH = DQK / 8;
    static constexpr int LDS_NEED = 2 * SHM_V + 2 * SHM_K + 8 * 64 * 4;
};
template <int DQK>
__device__ __forceinline__ void partialSM(f32x16& p0, f32x16& p1, float& m_reg, float& mn, float& alpha) {
    constexpr float SCALE = DQK == 64 ? 0.125f : 0.07216878364870322f;
    constexpr float C = SCALE * 1.4426950408889634f, THRS = 8.0f / SCALE;
    float pm0 = fmaxf(p0[0], p0[1]), pm1 = fmaxf(p0[2], p0[3]), pm2 = fmaxf(p1[0], p1[1]), pm3 = fmaxf(p1[2], p1[3]);
#pragma unroll
    for (int r = 4; r < 16; r += 4) { pm0 = fmaxf(pm0, fmaxf(p0[r], p0[r + 1])); pm1 = fmaxf(pm1, fmaxf(p0[r + 2], p0[r + 3])); pm2 = fmaxf(pm2, fmaxf(p1[r], p1[r + 1])); pm3 = fmaxf(pm3, fmaxf(p1[r + 2], p1[r + 3])); }
    float pmax = fmaxf(fmaxf(pm0, pm1), fmaxf(pm2, pm3));
    { auto rr = __builtin_amdgcn_permlane32_swap(__float_as_uint(pmax), __float_as_uint(pmax), false, false);
      pmax = fmaxf(__uint_as_float(rr[0]), __uint_as_float(rr[1])); }
    if (__builtin_expect(__all(pmax - m_reg <= THRS), 1)) { mn = m_reg; alpha = 1.f; }
    else { mn = fmaxf(m_reg, pmax); alpha = __builtin_amdgcn_exp2f((m_reg - mn) * C); m_reg = mn; }
    const float mnC = -mn * C;
#pragma unroll
    for (int r = 0; r < 16; ++r) p0[r] = fmaf(p0[r], C, mnC);
#pragma unroll
    for (int r = 0; r < 16; ++r) p1[r] = fmaf(p1[r], C, mnC);
#pragma unroll
    for (int r = 0; r < 16; ++r) p0[r] = __builtin_amdgcn_exp2f(p0[r]);
}
__device__ __forceinline__ void finishSM(f32x16& p0, f32x16& p1, float alpha, float& l_reg, bf16x8& pa0, bf16x8& pa1, bf16x8& pa2, bf16x8& pa3) {
#pragma unroll
    for (int r = 0; r < 16; ++r) p1[r] = __builtin_amdgcn_exp2f(p1[r]);
    float ps0 = p0[0] + p0[1], ps1 = p0[2] + p0[3], ps2 = p1[0] + p1[1], ps3 = p1[2] + p1[3];
#pragma unroll
    for (int r = 4; r < 16; r += 4) { ps0 += p0[r] + p0[r + 1]; ps1 += p0[r + 2] + p0[r + 3]; ps2 += p1[r] + p1[r + 1]; ps3 += p1[r + 2] + p1[r + 3]; }
    float ps = (ps0 + ps1) + (ps2 + ps3);
    { auto rr = __builtin_amdgcn_permlane32_swap(__float_as_uint(ps), __float_as_uint(ps), false, false);
      ps = __uint_as_float(rr[0]) + __uint_as_float(rr[1]); }
    l_reg = l_reg * alpha + ps;
#define PK4(P, BASE, OUT) do { unsigned a0 = pk2(P[BASE + 0], P[BASE + 1]), a1 = pk2(P[BASE + 2], P[BASE + 3]);   \
    unsigned b0 = pk2(P[BASE + 4], P[BASE + 5]), b1 = pk2(P[BASE + 6], P[BASE + 7]);                              \
    auto r0 = __builtin_amdgcn_permlane32_swap(a0, b0, false, false); auto r1 = __builtin_amdgcn_permlane32_swap(a1, b1, false, false); \
    u32x4 w = {r0[0], r1[0], r0[1], r1[1]}; OUT = *reinterpret_cast<bf16x8*>(&w); } while (0)
    PK4(p0, 0, pa0); PK4(p0, 8, pa1); PK4(p1, 0, pa2); PK4(p1, 8, pa3);
#undef PK4
}
template <int DQK>
__device__ __forceinline__ void qkt(f32x16& p0, f32x16& p1, const LAS char* Ks, const bf16x8* qr, int r32, int hi) {
    constexpr int KROW = Cfg<DQK>::KROW;
    p0 = f32x16{}; p1 = f32x16{};
#pragma unroll
    for (int d0 = 0; d0 < DQK / 16; ++d0) { const int cb = (d0 * 16 + hi * 8) * 2;
        const bf16x8 b0 = *(const LAS bf16x8*)(Ks + r32 * KROW + (cb ^ ((r32 & 7) << 4)));
        const bf16x8 b1 = *(const LAS bf16x8*)(Ks + (32 + r32) * KROW + (cb ^ ((r32 & 7) << 4)));
        p0 = __builtin_amdgcn_mfma_f32_32x32x16_bf16(b0, qr[d0], p0, 0, 0, 0);
        p1 = __builtin_amdgcn_mfma_f32_32x32x16_bf16(b1, qr[d0], p1, 0, 0, 0); }
}
template <int DQK, int SDEPTH, int LDQ, int LDK, int LDV, int LDO>
__device__ __forceinline__ void attn_body(const bf16_t* __restrict__ Qb, const bf16_t* __restrict__ Qb2, const bf16_t* __restrict__ Kh, const bf16_t* __restrict__ Vh, bf16_t* __restrict__ Ob, const int seq, LAS char* lds, const int tid) {
    using C = Cfg<DQK>;
    constexpr int SHM_V = C::SHM_V, SHM_K = C::SHM_K, KROW = C::KROW, NKC = C::NKC, CH = C::CH;
    const int wid = tid >> 6, lane = tid & 63, r32 = lane & 31, hi = lane >> 5;
    LAS char* V_lds = lds; LAS char* K_lds = lds + 2 * SHM_V;
    LAS float* ws = (LAS float*)(lds + 2 * SHM_V + 2 * SHM_K) + wid * 64; LAS float* li_l = ws; LAS float* al_l = ws + 32;
    float m_reg = -1e30f, l_reg = 0; f32x16 o[4] = {}; bf16x8 qr[DQK / 16];
    const bf16_t* Qw = Qb + (long)(wid * QBLK + r32) * LDQ + hi * 8; const bf16_t* Qw2 = Qb2 + (long)(wid * QBLK + r32) * LDQ + hi * 8;
#pragma unroll
    for (int d0 = 0; d0 < DQK / 16; ++d0) qr[d0] = d0 < 8 ? *(const bf16x8*)(Qw + d0 * 16) : *(const bf16x8*)(Qw2 + (d0 - 8) * 16);
    const int sr = tid >> 4, sc = (tid & 15) * 8, vst0 = v_st(sr, sc), vst1 = v_st(32 + sr, sc);
    int krow[NKC], kcol[NKC], kst[NKC];
#pragma unroll
    for (int i = 0; i < NKC; ++i) { const int e = tid + 512 * i; krow[i] = e / CH; kcol[i] = (e % CH) * 8; kst[i] = krow[i] * KROW + ((kcol[i] * 2) ^ ((krow[i] & 7) << 4)); }
    const int vb0 = (int)(uintptr_t)V_lds + v_rd_base(lane);
    struct { bf16x8 vs0, vs1, ks[NKC]; } sr_[SDEPTH];
#define SLOAD(i, k0) do { sr_[i].vs0 = *(const bf16x8*)(&Vh[(long)((k0) + sr) * LDV + sc]); sr_[i].vs1 = *(const bf16x8*)(&Vh[(long)((k0) + 32 + sr) * LDV + sc]); \
    _Pragma("unroll") for (int _c = 0; _c < NKC; ++_c) sr_[i].ks[_c] = *(const bf16x8*)(&Kh[(long)((k0) + krow[_c]) * LDK + kcol[_c]]); } while (0)
#define SWRITE(b, i) do { *(LAS bf16x8*)(V_lds + (b) * SHM_V + vst0) = sr_[i].vs0; *(LAS bf16x8*)(V_lds + (b) * SHM_V + vst1) = sr_[i].vs1; \
    _Pragma("unroll") for (int _c = 0; _c < NKC; ++_c) *(LAS bf16x8*)(K_lds + (b) * SHM_K + kst[_c]) = sr_[i].ks[_c]; } while (0)
#define SWAIT() do { if constexpr (SDEPTH == 2) { if constexpr (NKC == 1) asm volatile("s_waitcnt vmcnt(3)" ::: "memory"); else asm volatile("s_waitcnt vmcnt(5)" ::: "memory"); } \
    else asm volatile("s_waitcnt vmcnt(0)" ::: "memory"); } while (0)
#define RESC(a) do { if (__any((a) < 1.f)) { if (hi == 0) al_l[r32] = (a); asm volatile("s_waitcnt lgkmcnt(0)" ::: "memory"); \
    _Pragma("unroll") for (int d = 0; d < 4; ++d) _Pragma("unroll") for (int r = 0; r < 16; ++r) o[d][r] *= al_l[crow(r, hi)]; } } while (0)
    f32x16 pA0, pA1, pB0, pB1; float mnA, mnB, alA, alB; bf16x8 pa0, pa1, pa2, pa3; const int NT = seq / KVBLK;
    constexpr int SE = 0, SO = SDEPTH - 1;
    SLOAD(SE, 0); asm volatile("s_waitcnt vmcnt(0)" ::: "memory"); SWRITE(0, SE); __syncthreads();
    qkt<DQK>(pA0, pA1, K_lds, qr, r32, hi); partialSM<DQK>(pA0, pA1, m_reg, mnA, alA);
    SLOAD(SO, KVBLK); if constexpr (SDEPTH == 2) { if (2 < NT) SLOAD(SE, 2 * KVBLK); }
    SWAIT(); SWRITE(1, SO); __syncthreads();
    for (int j = 1; j + 1 < NT; j += 2) {
        SBAR(); qkt<DQK>(pB0, pB1, K_lds + SHM_K, qr, r32, hi);
        finishSM(pA0, pA1, alA, l_reg, pa0, pa1, pa2, pa3); SBAR();
        SLOAD(SO, (j + SDEPTH) * KVBLK); SBAR();
        pv_d0(o, vb0, pa0, pa1, pa2, pa3); partialSM<DQK>(pB0, pB1, m_reg, mnB, alB);
        __syncthreads(); SWAIT(); SWRITE(0, SE);
        RESC(alB); __syncthreads();
        SBAR(); qkt<DQK>(pA0, pA1, K_lds, qr, r32, hi);
        finishSM(pB0, pB1, alB, l_reg, pa0, pa1, pa2, pa3); SBAR();
        if (SDEPTH == 1 || j + 3 < NT) SLOAD(SE, (j + 1 + SDEPTH) * KVBLK); SBAR();
        pv_d0(o, vb0 + SHM_V, pa0, pa1, pa2, pa3); partialSM<DQK>(pA0, pA1, m_reg, mnA, alA);
        __syncthreads(); SWAIT(); SWRITE(1, SO);
        RESC(alA); __syncthreads();
    }
    SBAR(); qkt<DQK>(pB0, pB1, K_lds + SHM_K, qr, r32, hi);
    finishSM(pA0, pA1, alA, l_reg, pa0, pa1, pa2, pa3); SBAR();
    pv_d0(o, vb0, pa0, pa1, pa2, pa3); partialSM<DQK>(pB0, pB1, m_reg, mnB, alB);
    __syncthreads(); RESC(alB);
    finishSM(pB0, pB1, alB, l_reg, pa0, pa1, pa2, pa3); SBAR();
    pv_d0(o, vb0 + SHM_V, pa0, pa1, pa2, pa3);
    if (hi == 0) li_l[r32] = l_reg; asm volatile("s_waitcnt lgkmcnt(0)" ::: "memory");
    float rli[16];
#pragma unroll
    for (int r = 0; r < 16; ++r) rli[r] = __builtin_amdgcn_rcpf(li_l[crow(r, hi)]);
    bf16_t* Ow = Ob + (long)(wid * QBLK) * LDO;
#pragma unroll
    for (int r = 0; r < 16; ++r) { const int orow = crow(r, hi);
#pragma unroll
        for (int d0 = 0; d0 < 4; ++d0) Ow[(long)orow * LDO + d0 * 32 + r32] = f2bf(o[d0][r] * rli[r]); }
    __syncthreads();
#undef SLOAD
#undef SWRITE
#undef SWAIT
#undef RESC
}
template <int DQK, int LDQ, int LDK, int LDV, int LDO>
__device__ __forceinline__ void attn_body_simple(const bf16_t* __restrict__ Qb, const bf16_t* __restrict__ Qb2, const bf16_t* __restrict__ Kh, const bf16_t* __restrict__ Vh, bf16_t* __restrict__ Ob, const int seq, LAS char* lds, const int tid) {
    using C = Cfg<DQK>;
    constexpr int SHM_V = C::SHM_V, SHM_K = C::SHM_K, KROW = C::KROW, NKC = C::NKC, CH = C::CH;
    const int wid = tid >> 6, lane = tid & 63, r32 = lane & 31, hi = lane >> 5;
    LAS char* V_lds = lds; LAS char* K_lds = lds + 2 * SHM_V;
    LAS float* ws = (LAS float*)(lds + 2 * SHM_V + 2 * SHM_K) + wid * 64; LAS float* li_l = ws; LAS float* al_l = ws + 32;
    float m_reg = -1e30f, l_reg = 0; f32x16 o[4] = {}; bf16x8 qr[DQK / 16];
    const bf16_t* Qw = Qb + (long)(wid * QBLK + r32) * LDQ + hi * 8; const bf16_t* Qw2 = Qb2 + (long)(wid * QBLK + r32) * LDQ + hi * 8;
#pragma unroll
    for (int d0 = 0; d0 < DQK / 16; ++d0) qr[d0] = d0 < 8 ? *(const bf16x8*)(Qw + d0 * 16) : *(const bf16x8*)(Qw2 + (d0 - 8) * 16);
    const int sr = tid >> 4, sc = (tid & 15) * 8, vst0 = v_st(sr, sc), vst1 = v_st(32 + sr, sc);
    int krow[NKC], kcol[NKC], kst[NKC];
#pragma unroll
    for (int i = 0; i < NKC; ++i) { const int e = tid + 512 * i; krow[i] = e / CH; kcol[i] = (e % CH) * 8; kst[i] = krow[i] * KROW + ((kcol[i] * 2) ^ ((krow[i] & 7) << 4)); }
    const int vb0 = (int)(uintptr_t)V_lds + v_rd_base(lane);
    bf16x8 vs0, vs1, ks[NKC];
    const unsigned voff0 = (unsigned)(sr * LDV + sc), voff1 = (unsigned)((32 + sr) * LDV + sc); unsigned koff[NKC];
#pragma unroll
    for (int i = 0; i < NKC; ++i) koff[i] = (unsigned)(krow[i] * LDK + kcol[i]);
#define SLOAD(k0) do { const bf16_t* vt_ = Vh + (size_t)(k0) * LDV; const bf16_t* kt_ = Kh + (size_t)(k0) * LDK; vs0 = *(const bf16x8*)(vt_ + voff0); vs1 = *(const bf16x8*)(vt_ + voff1); \
    _Pragma("unroll") for (int _c = 0; _c < NKC; ++_c) ks[_c] = *(const bf16x8*)(kt_ + koff[_c]); } while (0)
#define SWRITE(b) do { *(LAS bf16x8*)(V_lds + (b) * SHM_V + vst0) = vs0; *(LAS bf16x8*)(V_lds + (b) * SHM_V + vst1) = vs1; \
    _Pragma("unroll") for (int _c = 0; _c < NKC; ++_c) *(LAS bf16x8*)(K_lds + (b) * SHM_K + kst[_c]) = ks[_c]; } while (0)
    const int NT = seq / KVBLK;
    SLOAD(0); SWRITE(0); SLOAD(KVBLK); __syncthreads();
#pragma unroll 1
    for (int j = 0; j < NT; ++j) {
        const int bsel = j & 1; f32x16 p0, p1; float mn, al; bf16x8 pa0, pa1, pa2, pa3;
        qkt<DQK>(p0, p1, K_lds + bsel * SHM_K, qr, r32, hi);
        partialSM<DQK>(p0, p1, m_reg, mn, al);
        if (__any(al < 1.f)) { if (hi == 0) al_l[r32] = al; asm volatile("s_waitcnt lgkmcnt(0)" ::: "memory");
#pragma unroll
            for (int d = 0; d < 4; ++d)
#pragma unroll
                for (int r = 0; r < 16; ++r) o[d][r] *= al_l[crow(r, hi)]; }
        finishSM(p0, p1, al, l_reg, pa0, pa1, pa2, pa3); SBAR();
        pv_d0(o, vb0 + bsel * SHM_V, pa0, pa1, pa2, pa3);
        if (j + 1 < NT) { SWRITE(bsel ^ 1); if (j + 2 < NT) SLOAD((j + 2) * KVBLK); }
        __syncthreads();
    }
    if (hi == 0) li_l[r32] = l_reg; asm volatile("s_waitcnt lgkmcnt(0)" ::: "memory");
    float rli[16];
#pragma unroll
    for (int r = 0; r < 16; ++r) rli[r] = __builtin_amdgcn_rcpf(li_l[crow(r, hi)]);
    bf16_t* Ow = Ob + (long)(wid * QBLK) * LDO;
#pragma unroll
    for (int r = 0; r < 16; ++r) { const int orow = crow(r, hi);
#pragma unroll
        for (int d0 = 0; d0 < 4; ++d0) Ow[(long)orow * LDO + d0 * 32 + r32] = f2bf(o[d0][r] * rli[r]); }
    __syncthreads();
#undef SLOAD
#undef SWRITE
}
template <int DQK, int LDQ, int LDK, int LDV, int LDO>
__device__ __forceinline__ void attn_body_stag(const bf16_t* __restrict__ Qb, const bf16_t* __restrict__ Qb2, const bf16_t* __restrict__ Kh, const bf16_t* __restrict__ Vh, bf16_t* __restrict__ Ob, const int seq, LAS char* lds, const int tid) {
    using C = Cfg<DQK>;
    constexpr int SHM_V = C::SHM_V, SHM_K = C::SHM_K, KROW = C::KROW, NKC = C::NKC, CH = C::CH;
    const int wid = __builtin_amdgcn_readfirstlane(tid >> 6), lane = tid & 63, r32 = lane & 31, hi = lane >> 5, half = wid >> 2;
    LAS char* V_lds = lds; LAS char* K_lds = lds + 2 * SHM_V;
    LAS float* ws = (LAS float*)(lds + 2 * SHM_V + 2 * SHM_K) + wid * 64; LAS float* li_l = ws; LAS float* al_l = ws + 32;
    float m_reg = -1e30f, l_reg = 0; f32x16 o[4] = {}; bf16x8 qr[DQK / 16];
    const bf16_t* Qw = Qb + (long)(wid * QBLK + r32) * LDQ + hi * 8; const bf16_t* Qw2 = Qb2 + (long)(wid * QBLK + r32) * LDQ + hi * 8;
#pragma unroll
    for (int d0 = 0; d0 < DQK / 16; ++d0) qr[d0] = d0 < 8 ? *(const bf16x8*)(Qw + d0 * 16) : *(const bf16x8*)(Qw2 + (d0 - 8) * 16);
    const int sr = tid >> 4, sc = (tid & 15) * 8, vst0 = v_st(sr, sc), vst1 = v_st(32 + sr, sc);
    int kst[NKC]; unsigned koff[NKC];
#pragma unroll
    for (int i = 0; i < NKC; ++i) { const int e = tid + 512 * i, krow = e / CH, kcol = (e % CH) * 8; kst[i] = krow * KROW + ((kcol * 2) ^ ((krow & 7) << 4)); koff[i] = (unsigned)(krow * LDK + kcol); }
    const unsigned voff0 = (unsigned)(sr * LDV + sc), voff1 = (unsigned)((32 + sr) * LDV + sc);
    const int vb0 = (int)(uintptr_t)V_lds + v_rd_base(lane);
    bf16x8 vs0, vs1, ks[NKC];
#define KLOAD(k0) do { const bf16_t* kt_ = Kh + (size_t)(k0) * LDK; _Pragma("unroll") for (int _c = 0; _c < NKC; ++_c) ks[_c] = *(const bf16x8*)(kt_ + koff[_c]); } while (0)
#define VLOAD(k0) do { const bf16_t* vt_ = Vh + (size_t)(k0) * LDV; vs0 = *(const bf16x8*)(vt_ + voff0); vs1 = *(const bf16x8*)(vt_ + voff1); } while (0)
#define KWRITE(b) do { _Pragma("unroll") for (int _c = 0; _c < NKC; ++_c) *(LAS bf16x8*)(K_lds + (b) * SHM_K + kst[_c]) = ks[_c]; } while (0)
#define VWRITE(b) do { *(LAS bf16x8*)(V_lds + (b) * SHM_V + vst0) = vs0; *(LAS bf16x8*)(V_lds + (b) * SHM_V + vst1) = vs1; } while (0)
    const int NT = seq / KVBLK;
    KLOAD(0); VLOAD(0); KWRITE(0); VWRITE(0); KLOAD(KVBLK); VLOAD(KVBLK);
    __syncthreads();
    f32x16 p0 = {}, p1 = {}; float mn = 0.f, al = 1.f;
#define STG_K(J_) do { if ((J_) + 1 < NT) { KWRITE(((J_) + 1) & 1); if ((J_) + 2 < NT) KLOAD(((J_) + 2) * KVBLK); } } while (0)
#define STG_V(J_) do { if ((J_) + 1 < NT) { VWRITE(((J_) + 1) & 1); if ((J_) + 2 < NT) VLOAD(((J_) + 2) * KVBLK); } } while (0)
#define SP0(j_) do { qkt<DQK>(p0, p1, K_lds + ((j_) & 1) * SHM_K, qr, r32, hi); partialSM<DQK>(p0, p1, m_reg, mn, al); } while (0)
#define SP1(j_) do { bf16x8 pa0, pa1, pa2, pa3; \
        if (__any(al < 1.f)) { if (hi == 0) al_l[r32] = al; asm volatile("s_waitcnt lgkmcnt(0)" ::: "memory"); \
            _Pragma("unroll") for (int d = 0; d < 4; ++d) _Pragma("unroll") for (int r = 0; r < 16; ++r) o[d][r] *= al_l[crow(r, hi)]; } \
        finishSM(p0, p1, al, l_reg, pa0, pa1, pa2, pa3); SBAR(); \
        pv_pipe(o, vb0 + ((j_) & 1) * SHM_V, pa0, pa1, pa2, pa3); } while (0)
    if (half == 0) {
#pragma unroll 1
        for (int J = 0; J < NT; ++J) { STG_K(J); SP0(J); __syncthreads(); STG_V(J); SP1(J); __syncthreads(); }
        __syncthreads();
    } else {
        STG_K(0); __syncthreads(); STG_V(0); SP0(0); __syncthreads();
#pragma unroll 1
        for (int J = 1; J < NT; ++J) { STG_K(J); SP1(J - 1); __syncthreads(); STG_V(J); SP0(J); __syncthreads(); }
        SP1(NT - 1); __syncthreads();
    }
#undef STG_K
#undef STG_V
#undef SP0
#undef SP1
    if (hi == 0) li_l[r32] = l_reg; asm volatile("s_waitcnt lgkmcnt(0)" ::: "memory");
    float rli[16];
#pragma unroll
    for (int r = 0; r < 16; ++r) rli[r] = __builtin_amdgcn_rcpf(li_l[crow(r, hi)]);
    bf16_t* Ow = Ob + (long)(wid * QBLK) * LDO;
#pragma unroll
    for (int r = 0; r < 16; ++r) { const int orow = crow(r, hi);
#pragma unroll
        for (int d0 = 0; d0 < 4; ++d0) Ow[(long)orow * LDO + d0 * 32 + r32] = f2bf(o[d0][r] * rli[r]); }
    __syncthreads();
#undef KLOAD
#undef VLOAD
#undef KWRITE
#undef VWRITE
}
template <int DQK, int SDEPTH, int NH, int VSHARE>
__device__ __forceinline__ void attn_phase(const bf16_t* Q, const bf16_t* K, const bf16_t* V, bf16_t* O, LAS char* lds, const int tid) {
    constexpr int LDQ = NH * DQK, LDK = NH * DQK, LDV = (NH / VSHARE) * DV, LDO = NH * DV;
    const int c = blockIdx.x, xcd = c & 7, slot = c >> 3;
    constexpr int ROUNDS = NB * NH / 8;
#pragma unroll 1
    for (int i = 0; i <= ROUNDS; ++i) {
        int b, h, seq; size_t qtok;
        if (i < ROUNDS) { const int bh = i * 8 + xcd; b = bh / NH; h = bh % NH; qtok = (size_t)b * TB + CTX + (size_t)slot * 256; seq = TB; }
        else { if (c >= NB * NH) break; b = c / NH; h = c % NH; qtok = (size_t)b * TB; seq = CTX; }
        const size_t t0 = (size_t)b * TB;
        if constexpr (SDEPTH == 3) attn_body_stag<DQK, LDQ, LDK, LDV, LDO>(Q + qtok * LDQ + h * (DQK > 128 ? 128 : DQK), Q + qtok * LDQ + NH * 128 + h * (DQK > 128 ? DQK - 128 : 0), K + t0 * LDK + h * DQK, V + t0 * LDV + (h / VSHARE) * DV, O + qtok * LDO + h * DV, seq, lds, tid);
        else if constexpr (SDEPTH == 0) attn_body_simple<DQK, LDQ, LDK, LDV, LDO>(Q + qtok * LDQ + h * (DQK > 128 ? 128 : DQK), Q + qtok * LDQ + NH * 128 + h * (DQK > 128 ? DQK - 128 : 0), K + t0 * LDK + h * DQK, V + t0 * LDV + (h / VSHARE) * DV, O + qtok * LDO + h * DV, seq, lds, tid);
        else attn_body<DQK, ((SDEPTH == 0 || SDEPTH == 3) ? 1 : SDEPTH), LDQ, LDK, LDV, LDO>(Q + qtok * LDQ + h * DQK, Q + qtok * LDQ + h * DQK, K + t0 * LDK + h * DQK, V + t0 * LDV + (h / VSHARE) * DV, O + qtok * LDO + h * DV, seq, lds, tid);
    }
}
}

struct Params { const float* in[27]; float* out; unsigned char* ws; int ph_lo, ph_hi; };
enum { I_X = 0, I_C, I_CTX, I_CCTX, I_ADAW, I_ADAB, I_NORMG, I_FINALG, I_DA_WIN, I_DA_WOUT, I_DA_LAM, I_DA_SUBG, I_RET_WIN, I_RET_DECAY, I_RET_WOUT, I_MLA_WIN, I_MLA_QG,
       I_MLA_WQUP, I_MLA_KVG, I_MLA_WKVUP, I_MLA_WOUT, I_MOE_WR, I_MOE_BR, I_MOE_WGU, I_MOE_BGU, I_MOE_WDN, I_MOE_BDN };

struct Frame {
    const Params* p; LAS unsigned char* lds; LAS unsigned char* reg; volatile LAS int* misc; int tid, lane, wave;
    unsigned char* ws;
};

enum { PK_ID = 0, PK_DA_IN, PK_RET_IN, PK_MLA_QUP, PK_MOE_GU };
__device__ __forceinline__ int src_col(int n, int kind) {
    if (kind == PK_DA_IN) { if ((n >> 10) == 1) return n; const int o = n & 63, axis = o >> 5, p = o & 31, f = p >> 1; return (n & ~63) | (axis * 32 + ((p & 1) ? 16 + f : f)); }
    if (kind == PK_RET_IN) { if (n < 1024 || (n >= 3072 && n < 4096)) { const int o = n & 255, f = o >> 1; return (n & ~255) | ((o & 1) ? 128 + f : f); } return n; }
    if (kind == PK_MLA_QUP) { if (n < 1024) return (n >> 7) * 192 + (n & 127); const int nn = n - 1024, hd = nn >> 6, oo = nn & 63, axis = oo >> 5, p = oo & 31, f = p >> 1; return hd * 192 + 128 + axis * 32 + ((p & 1) ? 16 + f : f); }
    if (kind == PK_MOE_GU) return ((n >> 2) & 1) * 1024 + (n >> 3) * 4 + (n & 3);
    return n;
}
__device__ __forceinline__ void tr_item(const float* W, int Ksrc, int Nsrc, bf16_t* WT, int Kdst, int Ndst, int Nvalid, int kind, LAS float* scr, int item, int lane) {
    const int nblk = Ndst / 32, kb = item / nblk, nb = item % nblk, k0 = 64 * kb, n0 = 32 * nb;
    const int n = n0 + (lane & 31); const bool nv = n < Nvalid; const int scn = nv ? src_col(n, kind) : 0;
#pragma unroll 8
    for (int i = 0; i < 32; ++i) { const int kk = 2 * i + (lane >> 5), k = k0 + kk; scr[kk * 33 + (lane & 31)] = (nv && k < Ksrc) ? W[(size_t)k * Nsrc + scn] : 0.f; }
    asm volatile("s_waitcnt lgkmcnt(0)" ::: "memory");
    const int c = lane & 7;
#pragma unroll
    for (int j = 0; j < 4; ++j) { const int nn = (lane >> 3) + 8 * j; const LAS float* s = scr + (8 * c) * 33 + nn;
        u32x4 o; o.x = pk2(s[0 * 33], s[1 * 33]); o.y = pk2(s[2 * 33], s[3 * 33]); o.z = pk2(s[4 * 33], s[5 * 33]); o.w = pk2(s[6 * 33], s[7 * 33]);
        *(u32x4*)(WT + (size_t)(n0 + nn) * Kdst + k0 + 8 * c) = o; }
    asm volatile("s_waitcnt lgkmcnt(0)" ::: "memory");
}
__device__ __forceinline__ float silu_f(float x) { return x / (1.0f + __expf(-x)); }

__device__ __forceinline__ void phase_prologue(Frame& F) {
    const Params& P = *F.p; unsigned char* ws = F.ws;
    const int gw = blockIdx.x * 8 + F.wave, NGW = GRID * 8, gt = blockIdx.x * NTHR + F.tid, NGT = GRID * NTHR;
    LAS float* sc = (LAS float*)(F.reg + 72 * 1024);
    for (int i = F.tid; i < 9 * 1024; i += NTHR) { const int r = i >> 10, k = i & 1023; const float v = r < 8 ? P.in[I_C][r * 1024 + k] : P.in[I_CCTX][k]; sc[i] = silu_f(v); }
    __syncthreads();
    {
        float* MOD = (float*)(ws + WS_MOD);
        for (int u = gw; u < 4 * 96; u += NGW) { const int L = u / 96, n = (u % 96) * 64 + F.lane; const float* W = P.in[I_ADAW] + (size_t)L * 1024 * 6144 + n;
            float a[9];
#pragma unroll
            for (int r = 0; r < 9; ++r) a[r] = 0.f;
#pragma unroll 8
            for (int k = 0; k < 1024; ++k) { const float w = W[(size_t)k * 6144];
#pragma unroll
                for (int r = 0; r < 9; ++r) a[r] = fmaf(sc[r * 1024 + k], w, a[r]); }
            const float bb = P.in[I_ADAB][L * 6144 + n];
#pragma unroll
            for (int r = 0; r < 9; ++r) MOD[((size_t)L * 9 + r) * 6144 + n] = a[r] + bb; }
    }
    {
        f32x2* TA = (f32x2*)(ws + WS_TABA); f32x2* TR = (f32x2*)(ws + WS_TABR);
        for (int i = gt; i < 128 * 16; i += NGT) { const int pos = i >> 4, j = i & 15; const float inv = powf(10000.0f, -(float)(2 * j) / 32.0f), a = (float)pos * inv; float s, c; sincosf(a, &s, &c); TA[i] = (f32x2){c, s}; }
        for (int i = gt; i < 8192 * 128; i += NGT) { const int pos = i >> 7, j = i & 127; const float inv = powf(10000.0f, -(float)(2 * j) / 256.0f), a = (float)pos * inv; float s, c; sincosf(a, &s, &c); TR[i] = (f32x2){c, s}; }
    }
    {
        f32x4* X = (f32x4*)(ws + WS_XRES);
        for (size_t i = gt; i < (size_t)T * 256; i += NGT) { const size_t g = i >> 8; const int q = (int)(i & 255); const int b = (int)(g / TB), j = (int)(g % TB);
            const f32x4* src = j < CTX ? (const f32x4*)(P.in[I_CTX] + ((size_t)b * CTX + j) * 1024) : (const f32x4*)(P.in[I_X] + ((size_t)b * SEQ + (j - CTX)) * 1024);
            X[i] = src[q]; }
    }
    {
        LAS float* scr = (LAS float*)(F.reg + F.wave * 8704);
#define TR_JOB(W_, Ksrc_, Nsrc_, DST_, Kdst_, Ndst_, Nvalid_, KIND_, COUNT_) do { const int per_ = ((Kdst_) / 64) * ((Ndst_) / 32), total_ = per_ * (COUNT_); \
        _Pragma("unroll 1") for (int it_ = gw; it_ < total_; it_ += NGW) { const int mi_ = it_ / per_, item_ = it_ % per_; \
            tr_item((W_) + (size_t)mi_ * (Ksrc_) * (Nsrc_), Ksrc_, Nsrc_, (bf16_t*)(ws + (DST_)) + (size_t)mi_ * (Kdst_) * (Ndst_), Kdst_, Ndst_, Nvalid_, KIND_, scr, item_, F.lane); } } while (0)
        TR_JOB(P.in[I_DA_WIN], 1024, 3072, WS_W_DA_IN, 1024, 3072, 3072, PK_DA_IN, 2);
        TR_JOB(P.in[I_DA_WOUT], 1024, 1024, WS_W_DA_OUT, 1024, 1024, 1024, PK_ID, 2);
        TR_JOB(P.in[I_RET_WIN], 1024, 6144, WS_W_RET_IN, 1024, 6144, 6144, PK_RET_IN, 1);
        TR_JOB(P.in[I_RET_WOUT], 2048, 1024, WS_W_RET_OUT, 2048, 1024, 1024, PK_ID, 1);
        TR_JOB(P.in[I_MLA_WIN], 1024, 448, WS_W_MLA_IN, 1024, 512, 448, PK_ID, 1);
        TR_JOB(P.in[I_MLA_WQUP], 256, 1536, WS_W_MLA_QUP, 256, 1536, 1536, PK_MLA_QUP, 1);
        TR_JOB(P.in[I_MLA_WKVUP], 128, 2048, WS_W_MLA_KVUP, 256, 2048, 2048, PK_ID, 1);
        TR_JOB(P.in[I_MLA_WOUT], 1024, 1024, WS_W_MLA_OUT, 1024, 1024, 1024, PK_ID, 1);
        TR_JOB(P.in[I_MOE_WGU], 1024, 2048, WS_W_GU, 1024, 2048, 2048, PK_MOE_GU, 128);
        TR_JOB(P.in[I_MOE_WDN], 1024, 1024, WS_W_DN, 1024, 1024, 1024, PK_ID, 128);
#undef TR_JOB
    }
}

template <int L, int LC = L - 1>
__device__ __forceinline__ void phase_norm1(Frame& F) {
    const Params& P = *F.p; unsigned char* ws = F.ws;
    float* XR = (float*)(ws + WS_XRES); bf16_t* HB = (bf16_t*)(ws + WS_HBUF); const float* MOD = (const float*)(ws + WS_MOD);
    const int* SLOT = (const int*)(ws + WS_SLOT); const float* GATE = (const float*)(ws + WS_GATE); const bf16_t* OUT2 = (const bf16_t*)(ws + MO_OUT);
    const float* gain = L < 4 ? P.in[I_NORMG] + (size_t)(L * 2 + 0) * 1024 : P.in[I_FINALG];
    f32x4 gn[4];
#pragma unroll
    for (int j = 0; j < 4; ++j) gn[j] = *(const f32x4*)(gain + 4 * F.lane + 256 * j);
#pragma unroll 3
    for (int i = 0; i < TOK_PER_BLK / 8; ++i) {
        const int t = blockIdx.x * TOK_PER_BLK + F.wave + 8 * i; const int b = t / TB, jt = t % TB; const bool isctx = jt < CTX; const int mrow = isctx ? 8 : b;
        if (L == 4 && isctx) continue;
        f32x4 v[4]; float* xr = XR + (size_t)t * 1024 + 4 * F.lane;
#pragma unroll
        for (int j = 0; j < 4; ++j) v[j] = *(const f32x4*)(xr + 256 * j);
        if (LC >= 0) {
            const int4 sl = *(const int4*)(SLOT + (size_t)t * 4); const f32x4 gt = *(const f32x4*)(GATE + (size_t)t * 4);
            const int sls[4] = {sl.x, sl.y, sl.z, sl.w};
            f32x4 a[4];
#pragma unroll
            for (int j = 0; j < 4; ++j) a[j] = (f32x4){0.f, 0.f, 0.f, 0.f};
#pragma unroll
            for (int k = 0; k < 4; ++k) { const bf16_t* orow = OUT2 + (size_t)sls[k] * 1024 + 4 * F.lane; const float gk = gt[k];
#pragma unroll
                for (int j = 0; j < 4; ++j) { const u32x2 w = *(const u32x2*)(orow + 256 * j); a[j] += gk * (f32x4){bflo(w.x), bfhi(w.x), bflo(w.y), bfhi(w.y)}; } }
            const float* m5 = MOD + ((size_t)(LC < 0 ? 0 : LC) * 9 + mrow) * 6144 + 5 * 1024 + 4 * F.lane;
#pragma unroll
            for (int j = 0; j < 4; ++j) { v[j] += *(const f32x4*)(m5 + 256 * j) * a[j]; if (L < 4) *(f32x4*)(xr + 256 * j) = v[j]; }
        }
#ifdef DBG_NANFIX
        if (L == 4) {
#pragma unroll
            for (int j = 0; j < 4; ++j)
#pragma unroll
                for (int e = 0; e < 4; ++e) if (!(fabsf(v[j][e]) < 1e30f)) v[j][e] = 1000.0f; }
#endif
        float ss = 0.f;
#pragma unroll
        for (int j = 0; j < 4; ++j) ss += (v[j][0] * v[j][0] + v[j][1] * v[j][1]) + (v[j][2] * v[j][2] + v[j][3] * v[j][3]);
        const float rstd = rsqrtf(wave_sum(ss) * (1.0f / 1024.0f) + RMS_EPS);
        if (L < 4) {
            const float* msh = MOD + ((size_t)L * 9 + mrow) * 6144 + 4 * F.lane; bf16_t* hr = HB + (size_t)t * 1024 + 4 * F.lane;
#pragma unroll
            for (int j = 0; j < 4; ++j) { const f32x4 sh = *(const f32x4*)(msh + 256 * j), scl = *(const f32x4*)(msh + 1024 + 256 * j);
                const f32x4 y = v[j] * rstd * gn[j] * (scl + 1.0f) + sh; u32x2 w; w.x = pk2(y[0], y[1]); w.y = pk2(y[2], y[3]); *(u32x2*)(hr + 256 * j) = w; }
        } else {
            float* orow = P.out + ((size_t)b * SEQ + (jt - CTX)) * 1024 + 4 * F.lane;
#pragma unroll
            for (int j = 0; j < 4; ++j) *(f32x4*)(orow + 256 * j) = v[j] * rstd * gn[j];
        }
    }
}

template <int L>
__device__ __forceinline__ void phase_norm2(Frame& F) {
    const Params& P = *F.p; unsigned char* ws = F.ws;
    const float* XR = (const float*)(ws + WS_XRES); bf16_t* HB = (bf16_t*)(ws + WS_HBUF); const float* MOD = (const float*)(ws + WS_MOD);
    int* IDX = (int*)(ws + WS_IDX); float* GATE = (float*)(ws + WS_GATE); int* RANK = (int*)(ws + WS_RANK); int* BLKCNT = (int*)(ws + WS_BLKCNT);
    const float* gain = P.in[I_NORMG] + (size_t)(L * 2 + 1) * 1024; const float* Wr = P.in[I_MOE_WR] + (size_t)L * 1024 * 32; const float* br = P.in[I_MOE_BR] + L * 32;
    constexpr int HS_ = 1028;
    LAS float* hf = (LAS float*)F.reg;
    LAS float* part = (LAS float*)(F.reg + 16 * HS_ * 4);
    LAS int* lcnt = (LAS int*)(F.reg + 16 * HS_ * 4 + 8 * 16 * 32 * 4);
    if (F.tid < 32) lcnt[F.tid] = 0;
    const int w = F.wave, l15 = F.lane & 15, g = F.lane >> 4;
    float wb[2][32];
#pragma unroll
    for (int ks = 0; ks < 32; ++ks)
#pragma unroll
        for (int nt = 0; nt < 2; ++nt) wb[nt][ks] = Wr[(size_t)(128 * w + 4 * ks + g) * 32 + 16 * nt + l15];
    f32x4 gn[4];
#pragma unroll
    for (int j = 0; j < 4; ++j) gn[j] = *(const f32x4*)(gain + 4 * F.lane + 256 * j);
    const float bre = br[F.lane & 31];
    __syncthreads();
    constexpr int NIT = (TOK_PER_BLK + 15) / 16;
#pragma unroll 1
    for (int i = 0; i < NIT; ++i) {
        const int tl0 = 16 * i;
#pragma unroll
        for (int rr = 0; rr < 2; ++rr) {
            const int tl = tl0 + 2 * w + rr;
            if (tl < TOK_PER_BLK) {
                const int t = blockIdx.x * TOK_PER_BLK + tl; const int b = t / TB, jt = t % TB; const int mrow = jt < CTX ? 8 : b;
                f32x4 v[4]; const float* xr = XR + (size_t)t * 1024 + 4 * F.lane;
#pragma unroll
                for (int j = 0; j < 4; ++j) v[j] = *(const f32x4*)(xr + 256 * j);
                float ss = 0.f;
#pragma unroll
                for (int j = 0; j < 4; ++j) ss += (v[j][0] * v[j][0] + v[j][1] * v[j][1]) + (v[j][2] * v[j][2] + v[j][3] * v[j][3]);
                const float rstd = rsqrtf(wave_sum(ss) * (1.0f / 1024.0f) + RMS_EPS);
                const float* msh = MOD + ((size_t)L * 9 + mrow) * 6144 + 3 * 1024 + 4 * F.lane; bf16_t* hr = HB + (size_t)t * 1024 + 4 * F.lane;
#pragma unroll
                for (int j = 0; j < 4; ++j) { const f32x4 sh = *(const f32x4*)(msh + 256 * j), scl = *(const f32x4*)(msh + 1024 + 256 * j);
                    const f32x4 y = v[j] * rstd * gn[j] * (scl + 1.0f) + sh; u32x2 wv; wv.x = pk2(y[0], y[1]); wv.y = pk2(y[2], y[3]); *(u32x2*)(hr + 256 * j) = wv;
                    *(LAS f32x4*)(hf + (2 * w + rr) * HS_ + 4 * F.lane + 256 * j) = y; }
            }
        }
        __syncthreads();
        {
            f32x4 a0 = (f32x4){0.f, 0.f, 0.f, 0.f}, a1 = a0; const LAS float* hp = hf + l15 * HS_ + 128 * w + g;
#pragma unroll
            for (int ks = 0; ks < 32; ++ks) { const float av = hp[4 * ks];
                a0 = __builtin_amdgcn_mfma_f32_16x16x4f32(av, wb[0][ks], a0, 0, 0, 0); a1 = __builtin_amdgcn_mfma_f32_16x16x4f32(av, wb[1][ks], a1, 0, 0, 0); }
#pragma unroll
            for (int r = 0; r < 4; ++r) { part[(w * 16 + 4 * g + r) * 32 + l15] = a0[r]; part[(w * 16 + 4 * g + r) * 32 + 16 + l15] = a1[r]; }
        }
        __syncthreads();
        {
            const int tok = F.tid >> 5, e = F.tid & 31; float v = bre;
#pragma unroll
            for (int ww = 0; ww < 8; ++ww) v += part[(ww * 16 + tok) * 32 + e];
            int id[4]; float lv[4];
#pragma unroll
            for (int k = 0; k < 4; ++k) { float bv = v; int bi = e;
#pragma unroll
                for (int m = 16; m >= 1; m >>= 1) { const float ov = __shfl_xor(bv, m, 32); const int oi = __shfl_xor(bi, m, 32); if (ov > bv || (ov == bv && oi < bi)) { bv = ov; bi = oi; } }
                id[k] = bi; lv[k] = bv; if (e == bi) v = -3.0e38f; }
            const int tl = tl0 + tok;
            if (e == 0 && tl < TOK_PER_BLK) {
                const int t = blockIdx.x * TOK_PER_BLK + tl;
                float ex[4], s = 0.f;
#pragma unroll
                for (int k = 0; k < 4; ++k) { ex[k] = __expf(lv[k] - lv[0]); s += ex[k]; }
                const float inv = 1.0f / s; int rk[4];
#pragma unroll
                for (int k = 0; k < 4; ++k) rk[k] = atomicAdd((int*)(lcnt + id[k]), 1);
                *(int4*)(IDX + (size_t)t * 4) = make_int4(id[0], id[1], id[2], id[3]);
                *(f32x4*)(GATE + (size_t)t * 4) = (f32x4){ex[0] * inv, ex[1] * inv, ex[2] * inv, ex[3] * inv};
                *(int4*)(RANK + (size_t)t * 4) = make_int4(rk[0], rk[1], rk[2], rk[3]);
            }
        }
    }
    __syncthreads();
    if (F.tid < 32) BLKCNT[blockIdx.x * 32 + F.tid] = lcnt[F.tid];
}

__device__ __forceinline__ void moe_offsets(Frame& F) {
    const int* BLKCNT = (const int*)(F.ws + WS_BLKCNT);
    __syncthreads();
    if (F.tid < 32) { int tot = 0, pre = 0;
        for (int b = 0; b < GRID; ++b) { const int c = BLKCNT[b * 32 + F.tid]; pre += (b < (int)blockIdx.x) ? c : 0; tot += c; }
        F.misc[128 + F.tid] = pre; F.misc[160 + F.tid] = (tot + 255) & ~255; }
    __syncthreads();
    if (F.tid == 0) { int s = 0; for (int e = 0; e < 32; ++e) { F.misc[64 + e] = s; s += F.misc[160 + e]; } F.misc[64 + 32] = s; }
    __syncthreads();
}
__device__ __forceinline__ void phase_scatter(Frame& F) {
    unsigned char* ws = F.ws;
    const int* IDX = (const int*)(ws + WS_IDX); const int* RANK = (const int*)(ws + WS_RANK); int* SLOT = (int*)(ws + WS_SLOT);
    const bf16_t* HB = (const bf16_t*)(ws + WS_HBUF); bf16_t* HS = (bf16_t*)(ws + MO_HS);
    moe_offsets(F);
#pragma unroll 3
    for (int tl = F.wave; tl < TOK_PER_BLK; tl += 8) { const int t = blockIdx.x * TOK_PER_BLK + tl;
        const int4 id = *(const int4*)(IDX + (size_t)t * 4), rk = *(const int4*)(RANK + (size_t)t * 4);
        const int s0 = F.misc[64 + id.x] + F.misc[128 + id.x] + rk.x, s1 = F.misc[64 + id.y] + F.misc[128 + id.y] + rk.y,
                  s2 = F.misc[64 + id.z] + F.misc[128 + id.z] + rk.z, s3 = F.misc[64 + id.w] + F.misc[128 + id.w] + rk.w;
        if (F.lane == 0) *(int4*)(SLOT + (size_t)t * 4) = make_int4(s0, s1, s2, s3);
        const u32x4* src = (const u32x4*)(HB + (size_t)t * 1024); const u32x4 a = src[F.lane], b = src[64 + F.lane];
        u32x4* d0 = (u32x4*)(HS + (size_t)s0 * 1024); u32x4* d1 = (u32x4*)(HS + (size_t)s1 * 1024); u32x4* d2 = (u32x4*)(HS + (size_t)s2 * 1024); u32x4* d3 = (u32x4*)(HS + (size_t)s3 * 1024);
        d0[F.lane] = a; d0[64 + F.lane] = b; d1[F.lane] = a; d1[64 + F.lane] = b; d2[F.lane] = a; d2[64 + F.lane] = b; d3[F.lane] = a; d3[64 + F.lane] = b; }
}

template <int L>
__device__ __forceinline__ void phase_da_post(Frame& F) {
    const Params& P = *F.p; unsigned char* ws = F.ws; constexpr int J = L / 3;
    const bf16_t* O = (const bf16_t*)(ws + DA_O); bf16_t* O2 = (bf16_t*)(ws + DA_O2);
    const float* lamv = P.in[I_DA_LAM] + J * 256; const float* subg = P.in[I_DA_SUBG] + J * 128;
    const float lam_init = L == 0 ? 0.2f : 0.8f - 0.6f * 0.40656965974059917f;
    const float d01 = wave_sum(lamv[F.lane] * lamv[64 + F.lane]), d23 = wave_sum(lamv[128 + F.lane] * lamv[192 + F.lane]);
    const float lam = expf(d01) - expf(d23) + lam_init;
    const int h = F.lane >> 3, ch = F.lane & 7; float g[16];
#pragma unroll
    for (int e = 0; e < 16; ++e) g[e] = subg[ch * 16 + e] * (1.0f - lam_init);
    for (int t = blockIdx.x * 8 + F.wave; t < T; t += GRID * 8) {
        const bf16_t* r0 = O + (size_t)t * 2048 + (2 * h) * 128 + ch * 16; const bf16_t* r1 = r0 + 128;
        const u32x4 a0 = *(const u32x4*)r0, a1 = *(const u32x4*)(r0 + 8), b0 = *(const u32x4*)r1, b1 = *(const u32x4*)(r1 + 8);
        float d[16]; const unsigned aw[8] = {a0.x, a0.y, a0.z, a0.w, a1.x, a1.y, a1.z, a1.w}, bw[8] = {b0.x, b0.y, b0.z, b0.w, b1.x, b1.y, b1.z, b1.w};
        float ss = 0.f;
#pragma unroll
        for (int e = 0; e < 8; ++e) { d[2 * e] = bflo(aw[e]) - lam * bflo(bw[e]); d[2 * e + 1] = bfhi(aw[e]) - lam * bfhi(bw[e]); ss += d[2 * e] * d[2 * e] + d[2 * e + 1] * d[2 * e + 1]; }
        ss += __shfl_xor(ss, 1); ss += __shfl_xor(ss, 2); ss += __shfl_xor(ss, 4);
        const float r = rsqrtf(ss * (1.0f / 128.0f) + RMS_EPS);
        u32x4 w0, w1;
        w0.x = pk2(d[0] * r * g[0], d[1] * r * g[1]); w0.y = pk2(d[2] * r * g[2], d[3] * r * g[3]); w0.z = pk2(d[4] * r * g[4], d[5] * r * g[5]); w0.w = pk2(d[6] * r * g[6], d[7] * r * g[7]);
        w1.x = pk2(d[8] * r * g[8], d[9] * r * g[9]); w1.y = pk2(d[10] * r * g[10], d[11] * r * g[11]); w1.z = pk2(d[12] * r * g[12], d[13] * r * g[13]); w1.w = pk2(d[14] * r * g[14], d[15] * r * g[15]);
        bf16_t* orow = O2 + (size_t)t * 1024 + h * 128 + ch * 16; *(u32x4*)orow = w0; *(u32x4*)(orow + 8) = w1;
    }
}

__device__ __forceinline__ void phase_ret_post(Frame& F) {
    unsigned char* ws = F.ws;
    const bf16_t* OF = (const bf16_t*)(ws + RT_OF); const bf16_t* OB = (const bf16_t*)(ws + RT_OB); const bf16_t* Gb = (const bf16_t*)(ws + RT_G); bf16_t* A = (bf16_t*)(ws + RT_A);
    for (int t = blockIdx.x * 8 + F.wave; t < T; t += GRID * 8) {
        const size_t off = (size_t)t * 2048 + F.lane * 32; float o[32]; float ss = 0.f;
#pragma unroll
        for (int q = 0; q < 4; ++q) { const u32x4 a = *(const u32x4*)(OF + off + 8 * q), b = *(const u32x4*)(OB + off + 8 * q); const unsigned aw[4] = {a.x, a.y, a.z, a.w}, bw[4] = {b.x, b.y, b.z, b.w};
#pragma unroll
            for (int e = 0; e < 4; ++e) { const float x0 = bflo(aw[e]) + bflo(bw[e]), x1 = bfhi(aw[e]) + bfhi(bw[e]); o[8 * q + 2 * e] = x0; o[8 * q + 2 * e + 1] = x1; ss += x0 * x0 + x1 * x1; } }
        ss += __shfl_xor(ss, 1); ss += __shfl_xor(ss, 2); ss += __shfl_xor(ss, 4); ss += __shfl_xor(ss, 8);
        const float r = rsqrtf(ss * (1.0f / 512.0f) + RMS_EPS);
#pragma unroll
        for (int q = 0; q < 4; ++q) { const u32x4 gq = *(const u32x4*)(Gb + off + 8 * q); const unsigned gw[4] = {gq.x, gq.y, gq.z, gq.w}; unsigned w[4];
#pragma unroll
            for (int e = 0; e < 4; ++e) { const float g0 = bflo(gw[e]), g1 = bfhi(gw[e]); w[e] = pk2(silu_f(g0) * o[8 * q + 2 * e] * r, silu_f(g1) * o[8 * q + 2 * e + 1] * r); }
            *(u32x4*)(A + off + 8 * q) = (u32x4){w[0], w[1], w[2], w[3]}; }
    }
}

__device__ __forceinline__ void phase_mla_norm(Frame& F) {
    const Params& P = *F.p; unsigned char* ws = F.ws;
    const float* Pm = (const float*)(ws + ML_P); bf16_t* AKV = (bf16_t*)(ws + ML_AKV); bf16_t* AQ = (bf16_t*)(ws + ML_AQ); bf16_t* Kb = (bf16_t*)(ws + ML_K);
    const f32x2* TA = (const f32x2*)(ws + WS_TABA);
    const f32x2 gkv = *(const f32x2*)(P.in[I_MLA_KVG] + 2 * F.lane); const f32x4 gq = *(const f32x4*)(P.in[I_MLA_QG] + 4 * F.lane);
    for (int t = blockIdx.x * 8 + F.wave; t < T; t += GRID * 8) {
        const float* pr = Pm + (size_t)t * 512; const int jt = t % TB; const bool lat = jt >= CTX; const int p = jt - CTX;
        const f32x2 ckv = *(const f32x2*)(pr + 2 * F.lane); const f32x4 cq = *(const f32x4*)(pr + 192 + 4 * F.lane);
        const float rkv = rsqrtf(wave_sum(ckv[0] * ckv[0] + ckv[1] * ckv[1]) * (1.0f / 128.0f) + RMS_EPS);
        const float rq = rsqrtf(wave_sum((cq[0] * cq[0] + cq[1] * cq[1]) + (cq[2] * cq[2] + cq[3] * cq[3])) * (1.0f / 256.0f) + RMS_EPS);
        *(unsigned*)(AKV + (size_t)t * 256 + 2 * F.lane) = pk2(ckv[0] * rkv * gkv[0], ckv[1] * rkv * gkv[1]);
        *(unsigned*)(AKV + (size_t)t * 256 + 128 + 2 * F.lane) = 0u;
        u32x2 wq; wq.x = pk2(cq[0] * rq * gq[0], cq[1] * rq * gq[1]); wq.y = pk2(cq[2] * rq * gq[2], cq[3] * rq * gq[3]); *(u32x2*)(AQ + (size_t)t * 256 + 4 * F.lane) = wq;
        if (F.lane < 32) { const int axis = F.lane >> 4, f = F.lane & 15; float x1 = pr[128 + axis * 32 + f], x2 = pr[128 + axis * 32 + 16 + f];
            if (lat) { const int pos = axis ? (p & 63) : (p >> 6); const f32x2 cs = TA[pos * 16 + f]; const float r1 = x1 * cs[0] - x2 * cs[1], r2 = x1 * cs[1] + x2 * cs[0]; x1 = r1; x2 = r2; }
            const unsigned w = pk2(x1, x2); bf16_t* kp = Kb + (size_t)t * 1536 + 128 + axis * 32 + 2 * f;
#pragma unroll
            for (int h = 0; h < 8; ++h) *(unsigned*)(kp + h * 192) = w; }
    }
}

__device__ __forceinline__ s16x4 tr_rd(int addr) { s16x4 r; asm volatile("ds_read_b64_tr_b16 %0, %1" : "=&v"(r) : "v"(addr) : "memory"); return r; }
template <int OFF> __device__ __forceinline__ s16x4 tr_rdo(int base) { s16x4 r; asm volatile("ds_read_b64_tr_b16 %0, %1 offset:%2" : "=&v"(r) : "v"(base), "i"(OFF) : "memory"); return r; }
#define PK8_(L, H) (bf16x8){L[0], L[1], L[2], L[3], H[0], H[1], H[2], H[3]}
template <int KQ, int QS2> __device__ __forceinline__ void ret_state2(f32x4* st, int trK, bf16x8 bs0, bf16x8 bs1, float cdec) {
    const s16x4 al0 = tr_rdo<32 * KQ>(trK), ah0 = tr_rdo<4 * QS2 + 32 * KQ>(trK), al1 = tr_rdo<32 * QS2 + 32 * KQ>(trK), ah1 = tr_rdo<36 * QS2 + 32 * KQ>(trK);
    const s16x4 bl0 = tr_rdo<32 * (KQ + 1)>(trK), bh0 = tr_rdo<4 * QS2 + 32 * (KQ + 1)>(trK), bl1 = tr_rdo<32 * QS2 + 32 * (KQ + 1)>(trK), bh1 = tr_rdo<36 * QS2 + 32 * (KQ + 1)>(trK);
    asm volatile("s_waitcnt lgkmcnt(0)" ::: "memory"); __builtin_amdgcn_sched_barrier(0);
    f32x4 a = st[KQ] * cdec, b = st[KQ + 1] * cdec;
    a = __builtin_amdgcn_mfma_f32_16x16x32_bf16(PK8_(al0, ah0), bs0, a, 0, 0, 0); b = __builtin_amdgcn_mfma_f32_16x16x32_bf16(PK8_(bl0, bh0), bs0, b, 0, 0, 0);
    a = __builtin_amdgcn_mfma_f32_16x16x32_bf16(PK8_(al1, ah1), bs1, a, 0, 0, 0); b = __builtin_amdgcn_mfma_f32_16x16x32_bf16(PK8_(bl1, bh1), bs1, b, 0, 0, 0);
    st[KQ] = a; st[KQ + 1] = b;
}
#define LGK0_PIN() do { asm volatile("s_waitcnt lgkmcnt(0)" ::: "memory"); __builtin_amdgcn_sched_barrier(0); } while (0)
#define PK8(L, H) (bf16x8){L[0], L[1], L[2], L[3], H[0], H[1], H[2], H[3]}
__device__ __forceinline__ void phase_ret_scan(Frame& F) {
    const Params& P = *F.p; unsigned char* ws = F.ws;
    const bf16_t* Qg = (const bf16_t*)(ws + RT_Q); const bf16_t* Kg = (const bf16_t*)(ws + RT_K); const bf16_t* Vg = (const bf16_t*)(ws + RT_V);
    const int u = blockIdx.x, sl = u & 3, dir = (u >> 2) & 1, h = (u >> 3) & 3, b = u >> 5;
    bf16_t* Og = (bf16_t*)(ws + (dir ? RT_OB : RT_OF));
    constexpr int QS = 264, VS = 136, TS = 72;
    LAS bf16_t* Qc = (LAS bf16_t*)F.reg;
    LAS bf16_t* Kc = Qc + 64 * QS;
    LAS bf16_t* Vc = Kc + 64 * QS;
    LAS bf16_t* Vs = Vc + 64 * VS;
    LAS bf16_t* Sb = Vs + 64 * VS;
    const float x = P.in[I_RET_DECAY][dir * 4 + h];
    const float lg2 = -log1pf(expf(-x)) * 1.4426950408889634f;
    const int tid = F.tid, lane = F.lane, w = F.wave, l15 = lane & 15, g = lane >> 4, tq = l15 >> 2, tp = l15 & 3;
    f32x4 st[16];
#pragma unroll
    for (int k = 0; k < 16; ++k) st[k] = (f32x4){0.f, 0.f, 0.f, 0.f};
    const float cdec = exp2f(64.0f * lg2);
    const size_t tb0 = (size_t)b * TB;
    unsigned gqk[4], lqk[4], gv[2], lv[2]; float kdv[2];
#pragma unroll
    for (int i = 0; i < 4; ++i) { const int e = tid + 512 * i, row = e >> 5, ch = e & 31; gqk[i] = (unsigned)(row * 1024 + h * 256 + ch * 8); lqk[i] = (unsigned)(row * QS + ch * 8); }
#pragma unroll
    for (int i = 0; i < 2; ++i) { const int e = tid + 512 * i, row = e >> 4, ch = e & 15; gv[i] = (unsigned)(row * 2048 + h * 512 + sl * 128 + ch * 8); lv[i] = (unsigned)(row * VS + ch * 8);
        kdv[i] = exp2f((dir == 0 ? (float)(63 - row) : (float)row) * lg2); }
    const int trK = (int)(uintptr_t)Kc + ((8 * g + tq) * QS + 4 * tp) * 2;
    const int trV = (int)(uintptr_t)Vc + ((8 * g + tq) * VS + 16 * w + 4 * tp) * 2;
    u32x4 rq[4], rk[4], rv[2];
#define RS_CHUNK(s_) ((dir == 0) ? (s_) : ((s_) < 4 ? 3 - (s_) : 4 + (131 - (s_))))
#define RS_LOAD(s_) do { const size_t t0_ = tb0 + (size_t)RS_CHUNK(s_) * 64; const bf16_t* q_ = Qg + t0_ * 1024; const bf16_t* k_ = Kg + t0_ * 1024; const bf16_t* v_ = Vg + t0_ * 2048; \
    _Pragma("unroll") for (int i_ = 0; i_ < 4; ++i_) { rq[i_] = *(const u32x4*)(q_ + gqk[i_]); rk[i_] = *(const u32x4*)(k_ + gqk[i_]); } \
    _Pragma("unroll") for (int i_ = 0; i_ < 2; ++i_) rv[i_] = *(const u32x4*)(v_ + gv[i_]); } while (0)
    RS_LOAD(0);
#pragma unroll 1
    for (int s = 0; s < TB / 64; ++s) {
        const size_t tok0 = tb0 + (size_t)RS_CHUNK(s) * 64;
        __syncthreads();
#pragma unroll
        for (int i = 0; i < 4; ++i) { *(LAS u32x4*)(Qc + lqk[i]) = rq[i]; *(LAS u32x4*)(Kc + lqk[i]) = rk[i]; }
#pragma unroll
        for (int i = 0; i < 2; ++i) { *(LAS u32x4*)(Vc + lv[i]) = rv[i]; const unsigned vw[4] = {rv[i].x, rv[i].y, rv[i].z, rv[i].w}; u32x4 sv;
            sv.x = pk2(bflo(vw[0]) * kdv[i], bfhi(vw[0]) * kdv[i]); sv.y = pk2(bflo(vw[1]) * kdv[i], bfhi(vw[1]) * kdv[i]);
            sv.z = pk2(bflo(vw[2]) * kdv[i], bfhi(vw[2]) * kdv[i]); sv.w = pk2(bflo(vw[3]) * kdv[i], bfhi(vw[3]) * kdv[i]); *(LAS u32x4*)(Vs + lv[i]) = sv; }
        if (s + 1 < TB / 64) RS_LOAD(s + 1);
        __syncthreads();
        {
            const int ti = w >> 1;
#pragma unroll
            for (int c2 = 0; c2 < 2; ++c2) { const int tj = 2 * (w & 1) + c2; f32x4 a = (f32x4){0.f, 0.f, 0.f, 0.f};
#pragma unroll
                for (int kk = 0; kk < 8; ++kk) { const bf16x8 af = *(const LAS bf16x8*)(Qc + (16 * ti + l15) * QS + 32 * kk + 8 * g), bfr = *(const LAS bf16x8*)(Kc + (16 * tj + l15) * QS + 32 * kk + 8 * g);
                    a = __builtin_amdgcn_mfma_f32_16x16x32_bf16(af, bfr, a, 0, 0, 0); }
                const int jj = 16 * tj + l15;
#pragma unroll
                for (int r = 0; r < 4; ++r) { const int ii = 16 * ti + 4 * g + r; const int df = dir == 0 ? ii - jj : jj - ii;
                    const float m = df >= 0 ? exp2f((float)df * lg2) : 0.f; Sb[ii * TS + jj] = f2bf(a[r] * m); } }
        }
        __syncthreads();
        {
            f32x4 a[4];
#pragma unroll
            for (int it = 0; it < 4; ++it) a[it] = (f32x4){0.f, 0.f, 0.f, 0.f};
#pragma unroll
            for (int kk = 0; kk < 8; ++kk) { u32x4 wv; wv.x = pk2(st[2 * kk][0], st[2 * kk][1]); wv.y = pk2(st[2 * kk][2], st[2 * kk][3]); wv.z = pk2(st[2 * kk + 1][0], st[2 * kk + 1][1]); wv.w = pk2(st[2 * kk + 1][2], st[2 * kk + 1][3]);
                const bf16x8 sf = *reinterpret_cast<bf16x8*>(&wv);
#pragma unroll
                for (int it = 0; it < 4; ++it) { const LAS bf16_t* qp = Qc + (16 * it + l15) * QS + 32 * kk + 4 * g; const s16x4 lo = *(const LAS s16x4*)qp, hi4 = *(const LAS s16x4*)(qp + 16);
                    a[it] = __builtin_amdgcn_mfma_f32_16x16x32_bf16(PK8(lo, hi4), sf, a[it], 0, 0, 0); }
                __builtin_amdgcn_sched_barrier(0); }
#pragma unroll
            for (int it = 0; it < 4; ++it)
#pragma unroll
                for (int r = 0; r < 4; ++r) { const int ii = 16 * it + 4 * g + r; a[it][r] *= exp2f((dir == 0 ? (float)(ii + 1) : (float)(64 - ii)) * lg2); }
            const s16x4 v0l = tr_rdo<0>(trV), v0h = tr_rdo<4 * VS * 2>(trV), v1l = tr_rdo<32 * VS * 2>(trV), v1h = tr_rdo<36 * VS * 2>(trV);
            LGK0_PIN();
            const bf16x8 vf0 = PK8(v0l, v0h), vf1 = PK8(v1l, v1h);
#pragma unroll
            for (int it = 0; it < 4; ++it) { const bf16x8 s0 = *(const LAS bf16x8*)(Sb + (16 * it + l15) * TS + 8 * g), s1 = *(const LAS bf16x8*)(Sb + (16 * it + l15) * TS + 32 + 8 * g);
                a[it] = __builtin_amdgcn_mfma_f32_16x16x32_bf16(s0, vf0, a[it], 0, 0, 0); a[it] = __builtin_amdgcn_mfma_f32_16x16x32_bf16(s1, vf1, a[it], 0, 0, 0); }
#pragma unroll
            for (int it = 0; it < 4; ++it)
#pragma unroll
                for (int r = 0; r < 4; ++r) { const int ii = 16 * it + 4 * g + r; Og[(tok0 + ii) * 2048 + h * 512 + sl * 128 + 16 * w + l15] = f2bf_c(a[it][r]); }
        }
        {
            const s16x4 b0l = tr_rdo<64 * VS * 2>(trV), b0h = tr_rdo<68 * VS * 2>(trV), b1l = tr_rdo<96 * VS * 2>(trV), b1h = tr_rdo<100 * VS * 2>(trV);
            LGK0_PIN();
            const bf16x8 bs0 = PK8(b0l, b0h), bs1 = PK8(b1l, b1h);
            ret_state2<0, QS * 2>(st, trK, bs0, bs1, cdec); ret_state2<2, QS * 2>(st, trK, bs0, bs1, cdec); ret_state2<4, QS * 2>(st, trK, bs0, bs1, cdec); ret_state2<6, QS * 2>(st, trK, bs0, bs1, cdec);
            ret_state2<8, QS * 2>(st, trK, bs0, bs1, cdec); ret_state2<10, QS * 2>(st, trK, bs0, bs1, cdec); ret_state2<12, QS * 2>(st, trK, bs0, bs1, cdec); ret_state2<14, QS * 2>(st, trK, bs0, bs1, cdec);
        }
    }
    __syncthreads();
#undef RS_CHUNK
#undef RS_LOAD
}
#undef PK8

__global__ void __launch_bounds__(NTHR, 2) hybrid_fwd(Params prm) {
    extern __shared__ __attribute__((aligned(16))) unsigned char lds_raw[];
    Frame F; F.p = &prm; F.lds = (LAS unsigned char*)lds_raw; F.reg = F.lds + REG_OFF; F.misc = (volatile LAS int*)F.lds;
    F.tid = threadIdx.x; F.lane = F.tid & 63; F.wave = __builtin_amdgcn_readfirstlane(F.tid >> 6); F.ws = prm.ws;
    if (gridDim.x != GRID) return;
    for (int i = F.tid; i < MISC_BYTES / 4; i += NTHR) F.misc[i] = 0;
    __syncthreads();
    unsigned* barw = (unsigned*)(F.ws + WS_CTL);
    XcdBarrier bar; bar.bar = barw; bar.x = 0; bar.st = nullptr;
    if (!MK_MULTI) bar = xcd_barrier_post(barw, (volatile LAS unsigned*)(F.misc + 8));
    const int lo = prm.ph_lo, hi = prm.ph_hi;
    unsigned char* ws = F.ws; const Params& P = prm;
    LAS unsigned char* GR = F.reg;
#define MOD ((const float*)(ws + WS_MOD))
#ifndef DUP_PHASE
#define DUP_PHASE -1
#endif
#define REP(k) for (int rep_ = 0; rep_ < ((k) == DUP_PHASE ? 2 : 1); ++rep_)
#define PHASE_INIT do { unsigned char* w_ = prm.ws; asm volatile("" : "+s"(w_)); F.ws = w_; ws = w_; int t_ = threadIdx.x; asm volatile("" : "+v"(t_)); F.tid = t_; F.lane = t_ & 63; } while (0)
#ifndef PH_MIN
#define PH_MIN 0
#define PH_MAX 1000
#endif
#ifndef DBG_STOP
#define DBG_STOP 1000
#define DBG_LC 3
#endif
#define IN(k) ((k) >= PH_MIN && (k) <= PH_MAX && ((k) <= DBG_STOP || (k) == 38) && lo <= (k) && (k) < hi)
#define SEAM(k) do { if (!MK_MULTI && IN(k) && IN((k) + 1)) xcd_barrier(bar); } while (0)
#define GEMM_DENSE(EPI, EOBJ, APTR, BPTR, KK, NN) do { pg8::StaticOrder S_; S_.init(NTILES, (NN) / 256, (int)blockIdx.x); \
        pg8::gemm_phase<EPI, pg8::StaticOrder>(GR, (const bf16_t*)(APTR), (const bf16_t*)(BPTR), KK, 0, S_, EOBJ, F.tid); } while (0)

    if (IN(0)) { PHASE_INIT; REP(0) { phase_prologue(F); } } SEAM(0);

#define DA_LAYER(L, BASE) do { constexpr int J_ = (L) / 3; \
    if (IN(BASE + 0)) { PHASE_INIT; REP(BASE + 0) { phase_norm1<L>(F); } } SEAM(BASE + 0); \
    if (IN(BASE + 1)) { PHASE_INIT; REP(BASE + 1) { pg8::EpiDaIn E_{(bf16_t*)(ws + DA_K), (const f32x2*)(ws + WS_TABA)}; \
        GEMM_DENSE(pg8::EpiDaIn, E_, ws + WS_HBUF, ws + WS_W_DA_IN + (size_t)J_ * 3072 * 1024 * 2, 1024, 3072); } } SEAM(BASE + 1); \
    if (IN(BASE + 2)) { PHASE_INIT; REP(BASE + 2) { att::attn_phase<64, 2, 16, 2>((const bf16_t*)(ws + DA_Q), (const bf16_t*)(ws + DA_K), (const bf16_t*)(ws + DA_V), (bf16_t*)(ws + DA_O), (LAS char*)GR, F.tid); } } SEAM(BASE + 2); \
    if (IN(BASE + 3)) { PHASE_INIT; REP(BASE + 3) { phase_da_post<L>(F); } } SEAM(BASE + 3); \
    if (IN(BASE + 4)) { PHASE_INIT; REP(BASE + 4) { pg8::EpiResid E_{(float*)(ws + WS_XRES), MOD + (size_t)(L) * 9 * 6144 + 2 * 1024}; \
        GEMM_DENSE(pg8::EpiResid, E_, ws + DA_O2, ws + WS_W_DA_OUT + (size_t)J_ * 1024 * 1024 * 2, 1024, 1024); } } SEAM(BASE + 4); } while (0)

#define MOE_LAYER(L, BASE) do { \
    if (IN(BASE + 0)) { PHASE_INIT; REP(BASE + 0) { phase_norm2<L>(F); } } SEAM(BASE + 0); \
    if (IN(BASE + 1)) { PHASE_INIT; REP(BASE + 1) { phase_scatter(F); } } SEAM(BASE + 1); \
    if (IN(BASE + 2)) { PHASE_INIT; REP(BASE + 2) { moe_offsets(F); pg8::MoeOrder S_; S_.init(F.misc[64 + 32] / 256, 8, (int)blockIdx.x); S_.pad_start = F.misc + 64; \
        pg8::EpiMoe1 E_{(bf16_t*)(ws + MO_ACT), P.in[I_MOE_BGU] + (size_t)(L) * 32 * 2048}; \
        pg8::gemm_phase<pg8::EpiMoe1, pg8::MoeOrder>(GR, (const bf16_t*)(ws + MO_HS), (const bf16_t*)(ws + WS_W_GU + (size_t)(L) * 32 * 2048 * 1024 * 2), 1024, (size_t)2048 * 1024 * 2, S_, E_, F.tid); } } SEAM(BASE + 2); \
    if (IN(BASE + 3)) { PHASE_INIT; REP(BASE + 3) { moe_offsets(F); pg8::MoeOrder S_; S_.init(F.misc[64 + 32] / 256, 4, (int)blockIdx.x); S_.pad_start = F.misc + 64; \
        pg8::EpiMoe2 E_{(bf16_t*)(ws + MO_OUT), P.in[I_MOE_BDN] + (size_t)(L) * 32 * 1024}; \
        pg8::gemm_phase<pg8::EpiMoe2, pg8::MoeOrder>(GR, (const bf16_t*)(ws + MO_ACT), (const bf16_t*)(ws + WS_W_DN + (size_t)(L) * 32 * 1024 * 1024 * 2), 1024, (size_t)1024 * 1024 * 2, S_, E_, F.tid); } } SEAM(BASE + 3); } while (0)

    DA_LAYER(0, 1);
    MOE_LAYER(0, 6);

    if (IN(10)) { PHASE_INIT; REP(10) { phase_norm1<1>(F); } } SEAM(10);
    if (IN(11)) { PHASE_INIT; REP(11) { pg8::EpiRetIn E_{(bf16_t*)(ws + RT_K), (bf16_t*)(ws + RT_V), (bf16_t*)(ws + RT_Q), (bf16_t*)(ws + RT_G), (const f32x2*)(ws + WS_TABR)};
        GEMM_DENSE(pg8::EpiRetIn, E_, ws + WS_HBUF, ws + WS_W_RET_IN, 1024, 6144); } } SEAM(11);
    if (IN(12)) { PHASE_INIT; REP(12) { phase_ret_scan(F); } } SEAM(12);
    if (IN(13)) { PHASE_INIT; REP(13) { phase_ret_post(F); } } SEAM(13);
    if (IN(14)) { PHASE_INIT; REP(14) { pg8::EpiResid E_{(float*)(ws + WS_XRES), MOD + (size_t)1 * 9 * 6144 + 2 * 1024};
        GEMM_DENSE(pg8::EpiResid, E_, ws + RT_A, ws + WS_W_RET_OUT, 2048, 1024); } } SEAM(14);
    MOE_LAYER(1, 15);

    if (IN(19)) { PHASE_INIT; REP(19) { phase_norm1<2>(F); } } SEAM(19);
    if (IN(20)) { PHASE_INIT; REP(20) { pg8::EpiF32 E_{(float*)(ws + ML_P), 512}; GEMM_DENSE(pg8::EpiF32, E_, ws + WS_HBUF, ws + WS_W_MLA_IN, 1024, 512); } } SEAM(20);
    if (IN(21)) { PHASE_INIT; REP(21) { phase_mla_norm(F); } } SEAM(21);
    if (IN(22)) { PHASE_INIT; REP(22) {
#ifndef NO_QUP
 { pg8::EpiMlaQ E_{(bf16_t*)(ws + ML_Q), (const f32x2*)(ws + WS_TABA)}; GEMM_DENSE(pg8::EpiMlaQ, E_, ws + ML_AQ, ws + WS_W_MLA_QUP, 256, 1536); }
#endif
#ifndef NO_KVUP
                  { pg8::EpiMlaKV E_{(bf16_t*)(ws + ML_K), (bf16_t*)(ws + ML_V)}; GEMM_DENSE(pg8::EpiMlaKV, E_, ws + ML_AKV, ws + WS_W_MLA_KVUP, 256, 2048); }
#endif
 } } SEAM(22);
    if (IN(23)) { PHASE_INIT; REP(23) { att::attn_phase<192, 0, 8, 1>((const bf16_t*)(ws + ML_Q), (const bf16_t*)(ws + ML_K), (const bf16_t*)(ws + ML_V), (bf16_t*)(ws + ML_O), (LAS char*)GR, F.tid); } } SEAM(23);
    if (IN(24)) { PHASE_INIT; REP(24) { pg8::EpiResid E_{(float*)(ws + WS_XRES), MOD + (size_t)2 * 9 * 6144 + 2 * 1024};
        GEMM_DENSE(pg8::EpiResid, E_, ws + ML_O, ws + WS_W_MLA_OUT, 1024, 1024); } } SEAM(24);
    MOE_LAYER(2, 25);

    DA_LAYER(3, 29);
    MOE_LAYER(3, 34);

    if (IN(38)) { PHASE_INIT; REP(38) { phase_norm1<4, DBG_LC>(F); } }
#undef IN
#undef SEAM
}
constexpr int N_PHASES = 39;

extern "C" void kernel_launch(void* const* d_in, const int* in_sizes, int n_in, void* d_out, int out_size, void* d_ws, size_t ws_size, hipStream_t stream) {
    static int ready = 0;
    if (ready == 0) {
        if (n_in != 27 || out_size != NB * SEQ * DM || ws_size < WS_END) { fprintf(stderr, "kernel_launch: unexpected shapes (n_in %d, out %d, ws %zu, need %zu)\n", n_in, out_size, ws_size, (size_t)WS_END); ready = -1; return; }
        if (hipFuncSetAttribute((const void*)hybrid_fwd, hipFuncAttributeMaxDynamicSharedMemorySize, LDS_BYTES) != hipSuccess) { fprintf(stderr, "kernel_launch: hipFuncSetAttribute failed\n"); ready = -1; return; }
        int per_cu = 0; (void)hipOccupancyMaxActiveBlocksPerMultiprocessor(&per_cu, (const void*)hybrid_fwd, NTHR, LDS_BYTES); (void)hipGetLastError();
        if (per_cu < 1) fprintf(stderr, "kernel_launch: occupancy query reports %d\n", per_cu);
        ready = 1;
    }
    if (ready < 0) return;
    (void)hipMemsetAsync((char*)d_ws + WS_CTL, 0, CTL_BYTES, stream);
    Params p{};
    for (int i = 0; i < 27; ++i) p.in[i] = (const float*)d_in[i];
    p.out = (float*)d_out; p.ws = (unsigned char*)d_ws;
#if MK_MULTI
    for (int ph = 0; ph < N_PHASES; ++ph) { p.ph_lo = ph; p.ph_hi = ph + 1; hipLaunchKernelGGL(hybrid_fwd, dim3(GRID), dim3(NTHR), LDS_BYTES, stream, p); }
#else
    p.ph_lo = 0; p.ph_hi = N_PHASES; hipLaunchKernelGGL(hybrid_fwd, dim3(GRID), dim3(NTHR), LDS_BYTES, stream, p);
#endif
    const hipError_t le = hipPeekAtLastError();
    if (le != hipSuccess) fprintf(stderr, "kernel_launch: launch failed: %s\n", hipGetErrorName(le));
}
```

```cpp
#include <hip/hip_runtime.h>
#include <cstdio>
#include <cstdint>
#include <type_traits>


#ifndef MK_MULTI
#define MK_MULTI 0
#endif

#define LAS __attribute__((address_space(3)))
typedef unsigned short bf16_t;
typedef short bf16x8 __attribute__((ext_vector_type(8)));
typedef short s16x4 __attribute__((ext_vector_type(4)));
typedef float f32x4 __attribute__((ext_vector_type(4)));
typedef float f32x2 __attribute__((ext_vector_type(2)));
typedef float f32x16 __attribute__((ext_vector_type(16)));
typedef unsigned u32x4 __attribute__((ext_vector_type(4)));
typedef unsigned u32x2 __attribute__((ext_vector_type(2)));
typedef int i32x4 __attribute__((ext_vector_type(4)));

constexpr int DM = 1024, NB = 8, SEQ = 8192, CTX = 256, TB = SEQ + CTX, T = NB * TB;
constexpr int NTILES = T / 256, TPB = TB / 256;
constexpr int NEXP = 32, TOPK = 4;
constexpr int GRID = 256, NTHR = 512, TOK_PER_BLK = T / GRID;
constexpr int MOE_MAXTILES = (T * TOPK) / 256 + NEXP;
constexpr float RMS_EPS = 1e-6f;
constexpr int LDS_BYTES = 144 * 1024, MISC_BYTES = 4096, REG_OFF = MISC_BYTES;

constexpr size_t AL(size_t x) { return (x + 255) / 256 * 256; }
constexpr size_t WS_CTL = 0, CTL_BYTES = 3u << 20;
constexpr size_t WS_RAWGU = WS_CTL + (1u << 20), WS_RAWP = WS_CTL + (2u << 20);
constexpr size_t WS_MOD = WS_CTL + CTL_BYTES;
constexpr size_t WS_TABA = WS_MOD + AL((size_t)4 * 9 * 6144 * 4);
constexpr size_t WS_TABR = WS_TABA + AL(128 * 16 * 8);
constexpr size_t WS_BLKCNT = WS_TABR + AL((size_t)8192 * 128 * 8);
constexpr size_t WS_IDX = WS_BLKCNT + AL(256 * 32 * 4);
constexpr size_t WS_GATE = WS_IDX + AL((size_t)T * 16);
constexpr size_t WS_RANK = WS_GATE + AL((size_t)T * 16);
constexpr size_t WS_SLOT = WS_RANK + AL((size_t)T * 16);
constexpr size_t WS_TOKOF = WS_SLOT + AL((size_t)T * 16);
constexpr size_t WS_SW = WS_TOKOF + AL((size_t)MOE_MAXTILES * 256 * 4);
constexpr size_t WS_SWP = WS_SW + AL((size_t)128 * 2048 * 4);
constexpr size_t SWP_DA = 0, SWP_RET = 2 * 3072, SWP_MLA = SWP_RET + 6144, SWP_RETO = SWP_MLA + 512, SWP_N = SWP_RETO + 1024;
constexpr size_t RAW_DA = 0, RAW_RET = 2 * 3072, RAW_MLA = RAW_RET + 6144, RAW_RETO = RAW_MLA + 448;
constexpr size_t WS_W_DA_IN = WS_SWP + AL(SWP_N * 4);
constexpr size_t WS_W_DA_OUT = WS_W_DA_IN + (size_t)2 * 3072 * 1024 * 2;
constexpr size_t WS_W_RET_IN = WS_W_DA_OUT + (size_t)2 * 1024 * 1024 * 2;
constexpr size_t WS_W_RET_OUT = WS_W_RET_IN + (size_t)6144 * 1024 * 2;
constexpr size_t WS_W_MLA_IN = WS_W_RET_OUT + (size_t)1024 * 2048 * 2;
constexpr size_t WS_W_MLA_QUP = WS_W_MLA_IN + (size_t)512 * 1024 * 2;
constexpr size_t WS_W_MLA_KVUP = WS_W_MLA_QUP + (size_t)1536 * 256 * 2;
constexpr size_t WS_W_MLA_OUT = WS_W_MLA_KVUP + (size_t)2048 * 256 * 2;
constexpr size_t WS_W_GU = WS_W_MLA_OUT + (size_t)1024 * 1024 * 2;
constexpr size_t WS_W_DN = WS_W_GU + (size_t)128 * 2048 * 1024 * 2;
constexpr size_t WS_XRES = WS_W_DN + (size_t)128 * 1024 * 1024 * 2;
constexpr size_t WS_HBUF = WS_XRES + (size_t)T * 1024 * 4;
constexpr size_t WS_HQ1 = WS_HBUF  , WS_SA1 = WS_HBUF + (size_t)T * 1024  ;
constexpr size_t WS_BIG = WS_HBUF + (size_t)T * 1024 * 2;
constexpr size_t ROW1K = (size_t)T * 1024 * 2;
constexpr size_t DA_K = WS_BIG, DA_V = DA_K + ROW1K, DA_Q = DA_V + ROW1K, DA_O = DA_Q + ROW1K  , DA_O2 = DA_O + 2 * ROW1K, DA_END = DA_O2 + ROW1K;
constexpr size_t RT_K = WS_BIG, RT_V = RT_K + ROW1K  , RT_Q = RT_V + 2 * ROW1K, RT_G = RT_Q + ROW1K  , RT_OF = RT_G + 2 * ROW1K, RT_OB = RT_OF + 2 * ROW1K,
                 RT_A = RT_OB + 2 * ROW1K  , RT_SA = RT_A + ROW1K  , RT_END = RT_A + 2 * ROW1K;
constexpr size_t ML_P = WS_BIG  , ML_AKV = ML_P + ROW1K  , ML_AQ = ML_AKV + ROW1K / 4, ML_Q = ML_AQ + ROW1K / 4  , ML_K = ML_Q + ROW1K * 3 / 2,
                 ML_V = ML_K + ROW1K * 3 / 2, ML_O = ML_V + ROW1K, ML_END = ML_O + ROW1K;
constexpr size_t MOE_ROWS = (size_t)MOE_MAXTILES * 256;
constexpr size_t MO_HQ = WS_BIG  , MO_SA = MO_HQ + (size_t)T * 1024  , MO_SASLOT = MO_SA + AL((size_t)T * 4)  ;
constexpr size_t MO_ROWMAX = MO_SASLOT + AL(MOE_ROWS * 4)  , MO_SA2 = MO_ROWMAX + AL(MOE_ROWS * 4)  , MO_ACT8 = WS_BIG + ((size_t)80 << 20)  ;
constexpr size_t WS_SWD = WS_W_MLA_KVUP;
constexpr size_t MO_HS = WS_BIG, MO_ACT = MO_HS + MOE_ROWS * 2048, MO_OUT = MO_ACT + MOE_ROWS * 2048, MO_END = MO_OUT + MOE_ROWS * 2048;
constexpr size_t cmax(size_t a, size_t b) { return a > b ? a : b; }
constexpr size_t WS_END = cmax(cmax(DA_END, RT_END), cmax(ML_END, MO_END));
static_assert(MO_SA2 + MOE_ROWS * 4 <= MO_ACT8 && MO_ACT8 + MOE_ROWS * 1024 <= MO_ACT, "MoE int8 activation buffers overlap");
static_assert((size_t)128 * 1024 * 4 <= (size_t)2048 * 256 * 2, "down scale table does not fit its slot");

template <class T> __device__ __forceinline__ T* gp(T* p) { return p; }
__device__ __forceinline__ float wave_sum(float v) {
#pragma unroll
    for (int o = 1; o < 64; o <<= 1) v += __shfl_xor(v, o);
    return v;
}
__device__ __forceinline__ unsigned pk2(float lo, float hi) { unsigned r; asm volatile("v_cvt_pk_bf16_f32 %0, %1, %2" : "=v"(r) : "v"(lo), "v"(hi)); return r; }
__device__ __forceinline__ float bflo(unsigned w) { return __uint_as_float(w << 16); }
__device__ __forceinline__ float bfhi(unsigned w) { return __uint_as_float(w & 0xffff0000u); }
__device__ __forceinline__ float bf2f(bf16_t h) { return __uint_as_float((unsigned)h << 16); }
__device__ __forceinline__ bf16_t f2bf(float f) { return (bf16_t)(pk2(f, 0.f) & 0xffffu); }
__device__ __forceinline__ f32x4 ld4bf(const bf16_t* p) { const u32x2 w = *(const u32x2*)p; return (f32x4){bflo(w.x), bfhi(w.x), bflo(w.y), bfhi(w.y)}; }
__device__ __forceinline__ void st4bf(bf16_t* p, f32x4 v) { u32x2 w; w.x = pk2(v[0], v[1]); w.y = pk2(v[2], v[3]); *(u32x2*)p = w; }
__device__ __forceinline__ bf16_t f2bf_c(float f) { unsigned u = __float_as_uint(f); u += 0x7fffu + ((u >> 16) & 1u); return (bf16_t)(u >> 16); }

#define XB_TMO      128
#define XB_XCNT(j)  (256  + 64 * (j))
#define XB_XSUB(j)  (1280 + 64 * (j))
#define XB_XGEN(j)  (2304 + 64 * (j))
#define XB_TOP      3328
#define XB_TOPGEN   3392
#define XCD_BAR_WORDS 3456
#define XB_SPIN_CAP (1u << 22)
__device__ __forceinline__ unsigned xb_ld(unsigned* p)              { return __hip_atomic_load(p, __ATOMIC_RELAXED, __HIP_MEMORY_SCOPE_AGENT); }
__device__ __forceinline__ unsigned xb_add(unsigned* p, unsigned v) { return __hip_atomic_fetch_add(p, v, __ATOMIC_RELAXED, __HIP_MEMORY_SCOPE_AGENT); }
__device__ __forceinline__ unsigned xb_xcc_id() { return (unsigned)__builtin_amdgcn_s_getreg((3 << 11) | 20) & 0xFu; }
#define XB_SPIN(cond, bar) do { unsigned _sp = 0; while (cond) { __builtin_amdgcn_s_sleep(1); \
    if ((++_sp & 255u) == 0u) { if (xb_ld(&(bar)[XB_TMO])) break; if (_sp > XB_SPIN_CAP) { atomicAdd(&(bar)[XB_TMO], 1u); break; } } } } while (0)
struct XcdBarrier { unsigned* bar; unsigned x; volatile LAS unsigned* st; };
__device__ __forceinline__ XcdBarrier xcd_barrier_post(unsigned* bar, volatile LAS unsigned* st) {
    XcdBarrier b; b.bar = bar; b.x = xb_xcc_id(); b.st = st;
    if (threadIdx.x == 0) (void)xb_add(&bar[XB_XCNT(b.x)], 1u);
    return b;
}
__device__ __forceinline__ void xcd_barrier_complete(unsigned* bar, unsigned x, unsigned& nloc, unsigned& nx) {
    const unsigned G = gridDim.x * gridDim.y * gridDim.z;
    unsigned sum, cnt, mine, sp = 0u;
    for (;;) {
        sum = 0u; cnt = 0u; mine = 0u;
#pragma unroll
        for (unsigned j = 0; j < 16; ++j) { const unsigned c = xb_ld(&bar[XB_XCNT(j)]); sum += c; cnt += (c > 0u) ? 1u : 0u; mine = (j == x) ? c : mine; }
        if (sum == G) break;
        __builtin_amdgcn_s_sleep(1);
        if ((++sp & 255u) == 0u) { if (xb_ld(&bar[XB_TMO])) break; if (sp > XB_SPIN_CAP) { atomicAdd(&bar[XB_TMO], 1u); break; } }
    }
    nloc = mine > 0u ? mine : 1u; nx = cnt > 0u ? cnt : 1u;
}
__device__ __forceinline__ void xcd_barrier(const XcdBarrier& b) {
    asm volatile("s_waitcnt vmcnt(0)" ::: "memory");
    __syncthreads();
    if (threadIdx.x == 0) {
        unsigned* bar = b.bar;
        __builtin_amdgcn_s_waitcnt(0);
        unsigned nloc = b.st[0], nx = b.st[1];
        if (nloc == 0u) { xcd_barrier_complete(bar, b.x, nloc, nx); b.st[0] = nloc; b.st[1] = nx; }
        const unsigned old = xb_add(&bar[XB_XSUB(b.x)], 1u);
        const unsigned gen = old / nloc;
        if (old + 1u == (gen + 1u) * nloc) {
            __builtin_amdgcn_fence(__ATOMIC_RELEASE, "agent");
            asm volatile("s_waitcnt vmcnt(0)" ::: "memory");
            const unsigned og = xb_add(&bar[XB_TOP], 1u);
            const unsigned tg = og / nx;
            if (og + 1u == (tg + 1u) * nx) xb_add(&bar[XB_TOPGEN], 1u);
            else XB_SPIN(xb_ld(&bar[XB_TOPGEN]) == tg, bar);
            __builtin_amdgcn_fence(__ATOMIC_ACQUIRE, "agent");
            xb_add(&bar[XB_XGEN(b.x)], 1u);
            asm volatile("s_waitcnt vmcnt(0)" ::: "memory");
        } else {
            XB_SPIN(xb_ld(&bar[XB_XGEN(b.x)]) == gen, bar);
            __builtin_amdgcn_fence(__ATOMIC_ACQUIRE, "agent");
            asm volatile("s_waitcnt vmcnt(0)" ::: "memory");
        }
    }
    __syncthreads();
}

namespace pg8 {
constexpr int BM = 256, BK = 64, HALF = 128, HTB = HALF * BK * 2, STAGE_BYTES = 8 * HTB, NXCD = 8, WGM = 8;
__host__ __device__ __forceinline__ int lds_byte(int r, int c) { const int st = (r >> 4) * 2 + (c >> 5), rr = r & 15, cc = c & 31, ob = rr * 64 + cc * 2; return st * 1024 + (ob ^ (((ob >> 9) & 1) << 5)); }
__host__ __device__ __forceinline__ void stage_rc(int b, int& R, int& C) { const int st = b / 1024, sb = b % 1024, swz = sb ^ (((sb >> 9) & 1) << 5); R = (st >> 1) * 16 + swz / 64; C = (st & 1) * 32 + (swz % 64) / 2; }
__host__ __device__ __forceinline__ int perm32(int rho) { const int n = rho >> 4, i = rho & 15; return 8 * (i >> 2) + 4 * n + (i & 3); }
struct Unit { int pm, pn, grp; };
struct StaticOrder {
    static constexpr bool GATHER = false; const int* tok;
    int nM, nN, nwg, c; bool latonly;
    __device__ __forceinline__ void init(int nM_, int nN_, int c_, bool lat_ = false) { nM = nM_; nN = nN_; nwg = nM * nN; c = c_; latonly = lat_; }
    __device__ __forceinline__ bool next(int i, Unit& u) const {
        const long L = (long)i * GRID + c; if (L >= nwg) return false;
        int wgid = (int)L; { const int q = nwg / NXCD, r = nwg % NXCD, xcd = wgid % NXCD, off = wgid / NXCD; wgid = (xcd < r ? xcd * (q + 1) : r * (q + 1) + (xcd - r) * q) + off; }
        const int nig = WGM * nN, gid = wgid / nig, fm = gid * WGM, gsz = (nM - fm) < WGM ? (nM - fm) : WGM;
        u.pm = fm + ((wgid % nig) % gsz); u.pn = (wgid % nig) / gsz; u.grp = 0; if (latonly) u.pm += u.pm / 32 + 1; return true;
    }
};
struct MoeOrder : StaticOrder {
    static constexpr bool GATHER = true;
    const volatile LAS int* pad_start;
    __device__ __forceinline__ bool next(int i, Unit& u) const {
        if (!StaticOrder::next(i, u)) return false;
        u.grp = ((const volatile LAS unsigned char*)(pad_start - 64))[1024 + u.pm]; return true;
    }
};

struct MoeOrderPlain : MoeOrder { static constexpr bool GATHER = false; };

template <class Epi, class Sched, bool I8 = false>
__device__ __forceinline__ void gemm_phase(LAS unsigned char* lds, const bf16_t* Aptr, const bf16_t* Btptr, const int K, const size_t grp_stride_bytes, const Sched& S, const Epi& E, const int tid) {
    const int wid = __builtin_amdgcn_readfirstlane(tid >> 6), lane = tid & 63, wr = wid >> 2, wc = wid & 3, fr = lane & 15, fq = lane >> 4;
    const int nt = K / BK;
    constexpr bool GATHER = Sched::GATHER;
    unsigned voffB[2], voC[2][2], voN[2][2]; int rowA[2]; unsigned colA[2];
#pragma unroll
    for (int i = 0; i < 2; ++i) { int R, C; stage_rc(tid * 16 + i * 8192, R, C); const int Rb = Epi::PERM ? ((R & ~31) + perm32(R & 31)) : R;
        rowA[i] = R; colA[i] = (unsigned)C * 2u; voffB[i] = (unsigned)(Rb * K + C) * 2u;
        voC[0][i] = (unsigned)(R * K + C) * 2u; voC[1][i] = voC[0][i] + (unsigned)(HALF * K * 2); voN[0][i] = voC[0][i]; voN[1][i] = voC[1][i]; }
#define PG8_TOK(u_, vo_) do { const int* tp_ = S.tok + (size_t)(u_).pm * 256; _Pragma("unroll") for (int h_ = 0; h_ < 2; ++h_) _Pragma("unroll") for (int i_ = 0; i_ < 2; ++i_) \
        vo_[h_][i_] = (unsigned)tp_[h_ * 128 + rowA[i_]] * (unsigned)(K * 2) + colA[i_]; } while (0)
    const size_t kstep = (size_t)(BK * 2);
    const size_t hstep = (size_t)HALF * K * 2;
    const size_t tstep = 2 * hstep;
    const unsigned ldsw = (unsigned)wid * 1024u;
    const int aoff = lds_byte(wr * 64 + fr, fq * 8), boff = lds_byte(wc * 32 + fr, fq * 8);
#define PG8_SA(b, h) (((b) * 2 + (h)) * HTB)
#define PG8_SB(b, h) ((4 + (b) * 2 + (h)) * HTB)
#define PG8_STAGE(bufoff, gbase, voff) do { _Pragma("unroll") for (int _i = 0; _i < 2; ++_i) \
        __builtin_amdgcn_global_load_lds((const unsigned*)((const char*)(gbase) + (voff)[_i]), (LAS unsigned*)(lds + (bufoff) + ldsw + _i * 8192), 16, 0, 0); } while (0)
    using FragT = std::conditional_t<I8, i32x4, bf16x8>; using AccT = std::conditional_t<I8, i32x4, f32x4>;
#define PG8_LDA(dst, b, h) do { _Pragma("unroll") for (int m = 0; m < 4; ++m) _Pragma("unroll") for (int k = 0; k < 2; ++k) dst[m][k] = *(const LAS FragT*)(lds + PG8_SA(b, h) + aoff + m * 2048 + k * 1024); } while (0)
#define PG8_LDB(dst, b, h) do { _Pragma("unroll") for (int n = 0; n < 2; ++n) _Pragma("unroll") for (int k = 0; k < 2; ++k) dst[n][k] = *(const LAS FragT*)(lds + PG8_SB(b, h) + boff + n * 2048 + k * 1024); } while (0)
#define PG8_MMA(ai, bj, At, Bt) do { __builtin_amdgcn_s_setprio(1); _Pragma("unroll") for (int m = 0; m < 4; ++m) _Pragma("unroll") for (int n = 0; n < 2; ++n) _Pragma("unroll") for (int k = 0; k < 2; ++k) \
        { if constexpr (I8) acc[ai][bj][m][n] = __builtin_amdgcn_mfma_i32_16x16x64_i8(Bt[n][k], At[m][k], acc[ai][bj][m][n], 0, 0, 0); else acc[ai][bj][m][n] = __builtin_amdgcn_mfma_f32_16x16x32_bf16(Bt[n][k], At[m][k], acc[ai][bj][m][n], 0, 0, 0); } __builtin_amdgcn_s_setprio(0); } while (0)
#define PG8_WAIT_V(n) asm volatile("s_waitcnt vmcnt(" #n ")" ::: "memory")
#define PG8_WAIT_L(n) asm volatile("s_waitcnt lgkmcnt(" #n ")" ::: "memory")
#define PG8_BAR __builtin_amdgcn_s_barrier()
#define PG8_SCHED __builtin_amdgcn_sched_barrier(0)
    Unit cur, nxt; int ui = 0;
    if (!S.next(0, cur)) return;
    AccT acc[2][2][4][2];
#pragma unroll
    for (int a = 0; a < 2; ++a)
#pragma unroll
        for (int b = 0; b < 2; ++b)
#pragma unroll
            for (int m = 0; m < 4; ++m)
#pragma unroll
                for (int n = 0; n < 2; ++n) acc[a][b][m][n] = (AccT){0, 0, 0, 0};
    FragT At[4][2], B0[2][2], B1[2][2];
    const char* cA = (const char*)Aptr + (GATHER ? (size_t)0 : (size_t)cur.pm * tstep); const char* cB = (const char*)Btptr + (size_t)cur.grp * grp_stride_bytes + (size_t)cur.pn * tstep;
    if constexpr (GATHER) PG8_TOK(cur, voC);
    PG8_STAGE(PG8_SB(0, 0), cB, voffB); PG8_STAGE(PG8_SA(0, 0), cA, voC[0]); PG8_STAGE(PG8_SB(0, 1), cB + hstep, voffB); PG8_STAGE(PG8_SA(0, 1), cA, voC[1]);
    if (wr == 1) PG8_BAR;
    PG8_WAIT_V(4); PG8_BAR;
    PG8_STAGE(PG8_SB(1, 0), cB + kstep, voffB); PG8_STAGE(PG8_SA(1, 0), cA + kstep, voC[0]); PG8_STAGE(PG8_SB(1, 1), cB + hstep + kstep, voffB);
    PG8_WAIT_V(6); PG8_BAR;
    for (;;) {
        const bool has_next = S.next(ui + 1, nxt);
        const char* nA = GATHER ? cA : (has_next ? (const char*)Aptr + (size_t)nxt.pm * tstep : cA);
        const char* nB = has_next ? (const char*)Btptr + (size_t)nxt.grp * grp_stride_bytes + (size_t)nxt.pn * tstep : cB;
        if constexpr (GATHER) { if (has_next) PG8_TOK(nxt, voN); }
#pragma unroll 1
        for (int t = 0; t < nt; t += 2) {
            const bool last = (t == nt - 2);
            if constexpr (Epi::LDSPRE) { if (last) E.pre(lds + 8 * HTB, cur, wid, lane); }
            const char* a1 = cA + (size_t)(t + 1) * kstep;
            const char* a2 = last ? nA : cA + (size_t)(t + 2) * kstep; const char* b2 = last ? nB : cB + (size_t)(t + 2) * kstep;
            const char* a3 = a2 + kstep; const char* b3 = b2 + kstep;
            unsigned s0[2], s1[2];
#pragma unroll
            for (int i = 0; i < 2; ++i) { s0[i] = (GATHER && last) ? voN[0][i] : voC[0][i]; s1[i] = (GATHER && last) ? voN[1][i] : voC[1][i]; }
            PG8_LDB(B0, 0, 0); PG8_SCHED; PG8_LDA(At, 0, 0); PG8_STAGE(PG8_SA(1, 1), a1, voC[1]);
            PG8_WAIT_L(8); PG8_BAR; PG8_WAIT_L(0); PG8_MMA(0, 0, At, B0); PG8_BAR; PG8_SCHED;
            PG8_LDB(B1, 0, 1); PG8_STAGE(PG8_SB(0, 0), b2, voffB);
            PG8_BAR; PG8_WAIT_L(0); PG8_MMA(0, 1, At, B1); PG8_BAR;
            PG8_LDA(At, 0, 1); PG8_STAGE(PG8_SA(0, 0), a2, s0);
            PG8_BAR; PG8_WAIT_L(0); PG8_MMA(1, 0, At, B0); PG8_BAR; PG8_SCHED;
            PG8_STAGE(PG8_SB(0, 1), b2 + hstep, voffB);
            PG8_WAIT_V(6); PG8_BAR; PG8_MMA(1, 1, At, B1); PG8_BAR;
            PG8_LDB(B0, 1, 0); PG8_SCHED; PG8_LDA(At, 1, 0); PG8_STAGE(PG8_SA(0, 1), a2, s1);
            PG8_WAIT_L(8); PG8_BAR; PG8_WAIT_L(0); PG8_MMA(0, 0, At, B0); PG8_BAR; PG8_SCHED;
            PG8_LDB(B1, 1, 1); PG8_STAGE(PG8_SB(1, 0), b3, voffB);
            PG8_BAR; PG8_WAIT_L(0); PG8_MMA(0, 1, At, B1); PG8_BAR;
            PG8_LDA(At, 1, 1); PG8_STAGE(PG8_SA(1, 0), a3, s0);
            PG8_BAR; PG8_WAIT_L(0); PG8_MMA(1, 0, At, B0); PG8_BAR; PG8_SCHED;
            PG8_STAGE(PG8_SB(1, 1), b3 + hstep, voffB);
            PG8_WAIT_V(6); PG8_BAR; PG8_MMA(1, 1, At, B1); PG8_BAR;
        }
        if constexpr (Epi::LDSPRE) E(acc, cur, wr, wc, fr, fq, lds + 8 * HTB); else E(acc, cur, wr, wc, fr, fq);
        if (!has_next) break;
        if constexpr (GATHER) {
#pragma unroll
            for (int h = 0; h < 2; ++h)
#pragma unroll
                for (int i = 0; i < 2; ++i) voC[h][i] = voN[h][i]; }
#pragma unroll
        for (int a = 0; a < 2; ++a)
#pragma unroll
            for (int b = 0; b < 2; ++b)
#pragma unroll
                for (int m = 0; m < 4; ++m)
#pragma unroll
                    for (int n = 0; n < 2; ++n) acc[a][b][m][n] = (AccT){0, 0, 0, 0};
        cur = nxt; cA = nA; cB = nB; ++ui;
    }
    PG8_WAIT_V(0);
    if (wr == 0) PG8_BAR;
    PG8_BAR;
#undef PG8_TOK
#undef PG8_SA
#undef PG8_SB
#undef PG8_STAGE
#undef PG8_LDA
#undef PG8_LDB
#undef PG8_MMA
#undef PG8_WAIT_V
#undef PG8_WAIT_L
#undef PG8_BAR
#undef PG8_SCHED
}

typedef const f32x4 (&AccRef)[2][2][4][2];

template <bool Q> struct AccSel { typedef f32x4 T; typedef const f32x4 (&Ref)[2][2][4][2]; };
template <> struct AccSel<true> { typedef i32x4 T; typedef const i32x4 (&Ref)[2][2][4][2]; };
template <bool Q> __device__ __forceinline__ f32x4 deq(const typename AccSel<Q>::T a, const float sr, const f32x4 sc) {
    if constexpr (Q) return (f32x4){(float)a[0], (float)a[1], (float)a[2], (float)a[3]} * (sc * sr); else return a;
}
__device__ __forceinline__ void rope8(f32x4& v0, f32x4& v1, const f32x2* cs) {
    const f32x4 c01 = *(const f32x4*)cs, c23 = *(const f32x4*)(cs + 2);
    f32x4 a = v0, b = v1;
    v0[0] = a[0] * c01[0] - a[1] * c01[1]; v0[1] = a[0] * c01[1] + a[1] * c01[0];
    v0[2] = a[2] * c01[2] - a[3] * c01[3]; v0[3] = a[2] * c01[3] + a[3] * c01[2];
    v1[0] = b[0] * c23[0] - b[1] * c23[1]; v1[1] = b[0] * c23[1] + b[1] * c23[0];
    v1[2] = b[2] * c23[2] - b[3] * c23[3]; v1[3] = b[2] * c23[3] + b[3] * c23[2];
}
__device__ __forceinline__ void rope8r(f32x4& v0, f32x4& v1, const f32x4 c01, const f32x4 c23) {
    f32x4 a = v0, b = v1;
    v0[0] = a[0] * c01[0] - a[1] * c01[1]; v0[1] = a[0] * c01[1] + a[1] * c01[0];
    v0[2] = a[2] * c01[2] - a[3] * c01[3]; v0[3] = a[2] * c01[3] + a[3] * c01[2];
    v1[0] = b[0] * c23[0] - b[1] * c23[1]; v1[1] = b[0] * c23[1] + b[1] * c23[0];
    v1[2] = b[2] * c23[2] - b[3] * c23[3]; v1[3] = b[2] * c23[3] + b[3] * c23[2];
}
__device__ __forceinline__ void store8(bf16_t* p, f32x4 v0, f32x4 v1) {
    u32x4 w; w.x = pk2(v0[0], v0[1]); w.y = pk2(v0[2], v0[3]); w.z = pk2(v1[0], v1[1]); w.w = pk2(v1[2], v1[3]); *(u32x4*)p = w;
}

__device__ __forceinline__ void store8q(bf16_t* base, int ld, f32x4 v0, f32x4 v1, int fr, int fq) {
    const int L = fq * 16 + fr, src = (((L & 3) << 4) | (L >> 2)) << 2;
    u32x4 w; w.x = pk2(v0[0], v0[1]); w.y = pk2(v0[2], v0[3]); w.z = pk2(v1[0], v1[1]); w.w = pk2(v1[2], v1[3]);
    u32x4 r; r.x = (unsigned)__builtin_amdgcn_ds_bpermute(src, (int)w.x); r.y = (unsigned)__builtin_amdgcn_ds_bpermute(src, (int)w.y); r.z = (unsigned)__builtin_amdgcn_ds_bpermute(src, (int)w.z); r.w = (unsigned)__builtin_amdgcn_ds_bpermute(src, (int)w.w);
    *(u32x4*)(base + (size_t)(L >> 2) * ld + (L & 3) * 8) = r;
}
__device__ __forceinline__ u32x4 pack8(f32x4 v0, f32x4 v1) { u32x4 w; w.x = pk2(v0[0], v0[1]); w.y = pk2(v0[2], v0[3]); w.z = pk2(v1[0], v1[1]); w.w = pk2(v1[2], v1[3]); return w; }
__device__ __forceinline__ u32x4 qperm4(u32x4 w, int src) { u32x4 r; r.x = (unsigned)__builtin_amdgcn_ds_bpermute(src, (int)w.x); r.y = (unsigned)__builtin_amdgcn_ds_bpermute(src, (int)w.y); r.z = (unsigned)__builtin_amdgcn_ds_bpermute(src, (int)w.z); r.w = (unsigned)__builtin_amdgcn_ds_bpermute(src, (int)w.w); return r; }
template <bool Q> struct EpiDaIn {
    static constexpr bool PERM = true; static constexpr bool LDSPRE = false;
    bf16_t* KVQ; const f32x2* tabA; const float* sa; const float* swp;
    __device__ __forceinline__ void operator()(typename AccSel<Q>::Ref acc, const Unit& u, int wr, int wc, int fr, int fq) const {
        const int part = u.pn >> 2; bf16_t* base = KVQ + (size_t)part * ((size_t)T * 1024);
        const int tb = u.pm % TPB; const bool lat = tb != 0; const bool rope = lat && part != 1;
        const int cin0 = (u.pn & 3) * 256 + wc * 32 + 8 * fq; const float qs = part == 2 ? 0.125f * 1.4426950408889634f : 1.0f;
        f32x4 swc[2][2];
        if constexpr (Q) {
#pragma unroll
            for (int bj = 0; bj < 2; ++bj)
#pragma unroll
                for (int n = 0; n < 2; ++n) swc[bj][n] = *(const f32x4*)(swp + u.pn * 256 + wc * 32 + 8 * fq + bj * HALF + 4 * n) * qs; }
#pragma unroll
        for (int ai = 0; ai < 2; ++ai) {
            f32x4 t[4][2][2]; float sr[4];
#pragma unroll
            for (int m = 0; m < 4; ++m) sr[m] = Q ? sa[(size_t)u.pm * BM + ai * HALF + wr * 64 + m * 16 + fr] : qs;
            if (rope) {
#pragma unroll
                for (int m = 0; m < 4; ++m) { const int p = (tb - 1) * 256 + ai * HALF + wr * 64 + m * 16 + fr;
#pragma unroll
                    for (int bj = 0; bj < 2; ++bj) { const int o = (cin0 + bj * HALF) & 63, axis = o >> 5, f0 = (o & 31) >> 1, pos = axis ? (p & 63) : (p >> 6); const f32x2* cs = tabA + pos * 16 + f0;
                        t[m][bj][0] = *(const f32x4*)cs; t[m][bj][1] = *(const f32x4*)(cs + 2); } }
            }
            asm volatile("" ::: "memory");
            const int L_ = fq * 16 + fr, src_ = (((L_ & 3) << 4) | (L_ >> 2)) << 2; const unsigned lo_ = (unsigned)(L_ >> 2) * 2048u + (unsigned)(L_ & 3) * 16u;
#pragma unroll
            for (int mh = 0; mh < 2; ++mh) { u32x4 pr[2][2];
#pragma unroll
                for (int mm = 0; mm < 2; ++mm) { const int m = 2 * mh + mm;
#pragma unroll
                    for (int bj = 0; bj < 2; ++bj) { f32x4 v0, v1;
                        if constexpr (Q) { v0 = deq<true>(acc[ai][bj][m][0], sr[m], swc[bj][0]); v1 = deq<true>(acc[ai][bj][m][1], sr[m], swc[bj][1]); }
                        else { v0 = acc[ai][bj][m][0] * qs; v1 = acc[ai][bj][m][1] * qs; }
                        if (rope) rope8r(v0, v1, t[m][bj][0], t[m][bj][1]);
                        pr[mm][bj] = qperm4(pack8(v0, v1), src_); } }
#pragma unroll
                for (int mm = 0; mm < 2; ++mm)
#pragma unroll
                    for (int bj = 0; bj < 2; ++bj) { char* bp_ = (char*)(base + ((size_t)u.pm * BM + ai * HALF + wr * 64 + (2 * mh + mm) * 16) * 1024 + (cin0 - 8 * fq) + bj * HALF);
                        *(u32x4*)(bp_ + lo_) = pr[mm][bj]; } }
        }
    }
};
template <bool Q> struct EpiRetIn {
    static constexpr bool PERM = true; static constexpr bool LDSPRE = false;
    bf16_t *Kb, *Vb, *Qb, *Gb; const f32x2* tabR; const float* sa; const float* swp;
    __device__ __forceinline__ void operator()(typename AccSel<Q>::Ref acc, const Unit& u, int wr, int wc, int fr, int fq) const {
        const int ct = u.pn * 256; bf16_t* base; int ld, c0; bool isk = false, isq = false;
        if (ct < 1024) { base = Kb; ld = 1024; c0 = ct; isk = true; } else if (ct < 3072) { base = Vb; ld = 2048; c0 = ct - 1024; }
        else if (ct < 4096) { base = Qb; ld = 1024; c0 = ct - 3072; isq = true; } else { base = Gb; ld = 2048; c0 = ct - 4096; }
        const int tb = u.pm % TPB; const bool lat = tb != 0; const bool rope = lat && (isk || isq);
        const int cin0 = c0 + wc * 32 + 8 * fq; const float sc = isk ? 0.0625f : 1.0f;
        f32x4 swc[2][2];
        if constexpr (Q) {
#pragma unroll
            for (int bj = 0; bj < 2; ++bj)
#pragma unroll
                for (int n = 0; n < 2; ++n) swc[bj][n] = *(const f32x4*)(swp + u.pn * 256 + wc * 32 + 8 * fq + bj * HALF + 4 * n) * sc; }
#pragma unroll
        for (int ai = 0; ai < 2; ++ai)
#pragma unroll
            for (int mh = 0; mh < 2; ++mh) {
                f32x4 t[2][2][2]; float sr[2];
#pragma unroll
                for (int mm = 0; mm < 2; ++mm) sr[mm] = Q ? sa[(size_t)u.pm * BM + ai * HALF + wr * 64 + (2 * mh + mm) * 16 + fr] : sc;
                if (rope) {
#pragma unroll
                    for (int mm = 0; mm < 2; ++mm) { const int p = (tb - 1) * 256 + ai * HALF + wr * 64 + (2 * mh + mm) * 16 + fr;
#pragma unroll
                        for (int bj = 0; bj < 2; ++bj) { const int f0 = ((cin0 + bj * HALF) & 255) >> 1; const f32x2* cs = tabR + (size_t)p * 128 + f0;
                            t[mm][bj][0] = *(const f32x4*)cs; t[mm][bj][1] = *(const f32x4*)(cs + 2); } }
                }
                asm volatile("" ::: "memory");
                const int L_ = fq * 16 + fr, src_ = (((L_ & 3) << 4) | (L_ >> 2)) << 2; const unsigned lo_ = (unsigned)(L_ >> 2) * (unsigned)(ld * 2) + (unsigned)(L_ & 3) * 16u;
                u32x4 pr[2][2];
#pragma unroll
                for (int mm = 0; mm < 2; ++mm) { const int m = 2 * mh + mm;
#pragma unroll
                    for (int bj = 0; bj < 2; ++bj) { f32x4 v0, v1;
                        if constexpr (Q) { v0 = deq<true>(acc[ai][bj][m][0], sr[mm], swc[bj][0]); v1 = deq<true>(acc[ai][bj][m][1], sr[mm], swc[bj][1]); }
                        else { v0 = acc[ai][bj][m][0] * sc; v1 = acc[ai][bj][m][1] * sc; }
                        if (rope) rope8r(v0, v1, t[mm][bj][0], t[mm][bj][1]);
                        pr[mm][bj] = qperm4(pack8(v0, v1), src_); } }
#pragma unroll
                for (int mm = 0; mm < 2; ++mm)
#pragma unroll
                    for (int bj = 0; bj < 2; ++bj) { char* bp_ = (char*)(base + ((size_t)u.pm * BM + ai * HALF + wr * 64 + (2 * mh + mm) * 16) * ld + (cin0 - 8 * fq) + bj * HALF);
                        *(u32x4*)(bp_ + lo_) = pr[mm][bj]; }
            }
    }
};
template <bool Q> struct EpiF32 {
    static constexpr bool PERM = false; static constexpr bool LDSPRE = false;
    float* C; int ldc; const float* sa; const float* swp;
    __device__ __forceinline__ void operator()(typename AccSel<Q>::Ref acc, const Unit& u, int wr, int wc, int fr, int fq) const {
        const int row0 = u.pm * BM + wr * 64 + fr, col0 = u.pn * BM + wc * 32 + 4 * fq;
        f32x4 swc[2][2];
        if constexpr (Q) {
#pragma unroll
            for (int bj = 0; bj < 2; ++bj)
#pragma unroll
                for (int n = 0; n < 2; ++n) swc[bj][n] = *(const f32x4*)(swp + col0 + bj * HALF + n * 16); }
#pragma unroll
        for (int ai = 0; ai < 2; ++ai)
#pragma unroll
            for (int m = 0; m < 4; ++m) { float* rowp = C + (size_t)(row0 + ai * HALF + m * 16) * ldc + col0; const float sr = Q ? sa[row0 + ai * HALF + m * 16] : 1.0f;
#pragma unroll
                for (int bj = 0; bj < 2; ++bj)
#pragma unroll
                    for (int n = 0; n < 2; ++n) *(f32x4*)(rowp + bj * HALF + n * 16) = deq<Q>(acc[ai][bj][m][n], sr, swc[bj][n]); }
    }
};
struct EpiMlaQ {
    static constexpr bool PERM = true; static constexpr bool LDSPRE = false;
    bf16_t* Qb; const f32x2* tabA;
    __device__ __forceinline__ void operator()(AccRef acc, const Unit& u, int wr, int wc, int fr, int fq) const {
        const int tb = u.pm % TPB; const bool rope = tb != 0 && u.pn >= 4; const int c0 = u.pn * 256 + wc * 32 + 8 * fq; const float qs = 0.07216878364870322f * 1.4426950408889634f;
#pragma unroll
        for (int ai = 0; ai < 2; ++ai) {
            f32x4 t[4][2][2];
            if (rope) {
#pragma unroll
                for (int m = 0; m < 4; ++m) { const int p = (tb - 1) * 256 + ai * HALF + wr * 64 + m * 16 + fr;
#pragma unroll
                    for (int bj = 0; bj < 2; ++bj) { const int o = (c0 + bj * HALF) & 63, axis = o >> 5, f0 = (o & 31) >> 1, pos = axis ? (p & 63) : (p >> 6); const f32x2* cs = tabA + pos * 16 + f0;
                        t[m][bj][0] = *(const f32x4*)cs; t[m][bj][1] = *(const f32x4*)(cs + 2); } }
            }
            asm volatile("" ::: "memory");
#pragma unroll
            for (int m = 0; m < 4; ++m) { const size_t row = (size_t)u.pm * BM + ai * HALF + wr * 64 + m * 16 + fr;
#pragma unroll
                for (int bj = 0; bj < 2; ++bj) { f32x4 v0 = acc[ai][bj][m][0] * qs, v1 = acc[ai][bj][m][1] * qs;
                    if (rope) rope8r(v0, v1, t[m][bj][0], t[m][bj][1]);
                    store8(Qb + row * 1536 + c0 + bj * HALF, v0, v1); } }
        }
    }
};
struct EpiMlaKV {
    static constexpr bool PERM = true; static constexpr bool LDSPRE = false;
    bf16_t *Kb, *Vb;
    __device__ __forceinline__ void operator()(AccRef acc, const Unit& u, int wr, int wc, int fr, int fq) const {
        const int c0 = wc * 32 + 8 * fq;
#pragma unroll
        for (int ai = 0; ai < 2; ++ai)
#pragma unroll
            for (int m = 0; m < 4; ++m) {
                const size_t row = (size_t)u.pm * BM + ai * HALF + wr * 64 + m * 16 + fr;
                store8(Kb + row * 1536 + u.pn * 192 + c0, acc[ai][0][m][0], acc[ai][0][m][1]);
                store8(Vb + row * 1024 + u.pn * 128 + c0, acc[ai][1][m][0], acc[ai][1][m][1]);
            }
    }
};
template <bool Q> struct EpiResid {
    static constexpr bool PERM = true; static constexpr bool LDSPRE = false;
    bf16_t* X; const float* mod2; const float* sa; const float* swp;
    __device__ __forceinline__ void operator()(typename AccSel<Q>::Ref acc, const Unit& u, int wr, int wc, int fr, int fq) const {
        const int tb = u.pm % TPB, b = u.pm / TPB, mrow = tb == 0 ? 8 : b;
        const int row0 = u.pm * BM + wr * 64 + fr, col0 = u.pn * BM + wc * 32 + 8 * fq;
        const float* mp = mod2 + (size_t)mrow * 6144 + col0;
        f32x4 g[2][2];
#pragma unroll
        for (int bj = 0; bj < 2; ++bj)
#pragma unroll
            for (int n = 0; n < 2; ++n) { g[bj][n] = *(const f32x4*)(mp + bj * HALF + 4 * n); if constexpr (Q) g[bj][n] = g[bj][n] * *(const f32x4*)(swp + col0 + bj * HALF + 4 * n); }
#pragma unroll
        for (int ai = 0; ai < 2; ++ai) {
            u32x4 x[4][2]; float sr[4];
#pragma unroll
            for (int m = 0; m < 4; ++m) { const bf16_t* rowp = X + (size_t)(row0 + ai * HALF + m * 16) * 1024 + col0; sr[m] = Q ? sa[row0 + ai * HALF + m * 16] : 1.0f;
#pragma unroll
                for (int bj = 0; bj < 2; ++bj) x[m][bj] = *(const u32x4*)(rowp + bj * HALF); }
            asm volatile("" ::: "memory");
#pragma unroll
            for (int m = 0; m < 4; ++m) { bf16_t* rowp = X + (size_t)(row0 + ai * HALF + m * 16) * 1024 + col0;
#pragma unroll
                for (int bj = 0; bj < 2; ++bj) { const f32x4 lo = (f32x4){bflo(x[m][bj].x), bfhi(x[m][bj].x), bflo(x[m][bj].y), bfhi(x[m][bj].y)}, hi4 = (f32x4){bflo(x[m][bj].z), bfhi(x[m][bj].z), bflo(x[m][bj].w), bfhi(x[m][bj].w)};
                    f32x4 d0, d1;
                    if constexpr (Q) { d0 = deq<true>(acc[ai][bj][m][0], sr[m], g[bj][0]); d1 = deq<true>(acc[ai][bj][m][1], sr[m], g[bj][1]); }
                    else { d0 = g[bj][0] * acc[ai][bj][m][0]; d1 = g[bj][1] * acc[ai][bj][m][1]; }
                    store8(rowp + bj * HALF, lo + d0, hi4 + d1); } }
            asm volatile("" ::: "memory");
        }
    }
};
struct EpiMoe1 {
    static constexpr bool PERM = true; static constexpr bool LDSPRE = false;
    bf16_t* ACT; const float* bgu;
    __device__ __forceinline__ void operator()(AccRef acc, const Unit& u, int wr, int wc, int fr, int fq) const {
        const int j0 = u.pn * 128 + wc * 32 + 8 * fq; const float* bp = bgu + (size_t)u.grp * 2048 + j0;
        const f32x4 bg0 = *(const f32x4*)bp, bg1 = *(const f32x4*)(bp + 4), bl0 = *(const f32x4*)(bp + 1024), bl1 = *(const f32x4*)(bp + 1028);
#pragma unroll
        for (int ai = 0; ai < 2; ++ai)
#pragma unroll
            for (int m = 0; m < 4; ++m) { const size_t row = (size_t)u.pm * BM + ai * HALF + wr * 64 + m * 16 + fr;
                const f32x4 gl[2] = {acc[ai][0][m][0] + bg0, acc[ai][0][m][1] + bg1}, li[2] = {acc[ai][1][m][0] + bl0, acc[ai][1][m][1] + bl1}; f32x4 a[2];
#pragma unroll
                for (int n = 0; n < 2; ++n)
#pragma unroll
                    for (int e = 0; e < 4; ++e) { const float g = fminf(gl[n][e], 7.0f), l = fminf(fmaxf(li[n][e], -7.0f), 7.0f);
                        const float s = __builtin_amdgcn_rcpf(1.0f + __builtin_amdgcn_exp2f(g * (-1.702f * 1.4426950408889634f))); a[n][e] = g * s * (l + 1.0f); }
                store8(ACT + row * 1024 + j0, a[0], a[1]); }
    }
};
typedef const i32x4 (&AccRefI)[2][2][4][2];
__device__ __forceinline__ f32x2 pk_mul(f32x2 a, f32x2 b) { f32x2 d; asm("v_pk_mul_f32 %0, %1, %2" : "=v"(d) : "v"(a), "v"(b)); return d; }
__device__ __forceinline__ f32x2 pk_fma(f32x2 a, f32x2 b, f32x2 c) { f32x2 d; asm("v_pk_fma_f32 %0, %1, %2, %3" : "=v"(d) : "v"(a), "v"(b), "v"(c)); return d; }
__device__ __forceinline__ float min_asm(float a, float b) { float d; asm("v_min_f32 %0, %1, %2" : "=v"(d) : "v"(a), "v"(b)); return d; }
__device__ __forceinline__ float med3_asm(float a, float lo, float hi) { float d; asm("v_med3_f32 %0, %1, %2, %3" : "=v"(d) : "v"(a), "v"(lo), "v"(hi)); return d; }
struct EpiMoe1Q {
    static constexpr bool PERM = true; static constexpr bool LDSPRE = true;
    bf16_t* ACT; const float* bgu; const float* sw; const float* saslot;
    __device__ __forceinline__ void pre(LAS unsigned char* ep, const Unit& u, int wid, int lane) const {
        if (wid > 2) return;
        const float* g = wid == 2 ? saslot + (size_t)u.pm * BM + 4 * lane : (wid == 0 ? bgu : sw) + (size_t)u.grp * 2048 + (lane >> 5) * 1024 + u.pn * 128 + 4 * (lane & 31);
        __builtin_amdgcn_global_load_lds((const unsigned*)g, (LAS unsigned*)(ep + wid * 1024), 16, 0, 0);
    }
    __device__ __forceinline__ void operator()(AccRefI acc, const Unit& u, int wr, int wc, int fr, int fq, const LAS unsigned char* ep) const {
        const int j0 = u.pn * 128 + wc * 32 + 8 * fq; const LAS float* bp = (const LAS float*)ep + wc * 32 + 8 * fq; const LAS float* sp = bp + 256;
        f32x2 bg[4], bl[4], sg[4], sl[4];
#pragma unroll
        for (int q = 0; q < 4; ++q) { bg[q] = *(const LAS f32x2*)(bp + 2 * q); bl[q] = *(const LAS f32x2*)(bp + 128 + 2 * q) + 1.0f; sg[q] = *(const LAS f32x2*)(sp + 2 * q); sl[q] = *(const LAS f32x2*)(sp + 128 + 2 * q); }
        const f32x2 cc = {-1.702f * 1.4426950408889634f, -1.702f * 1.4426950408889634f}; float c7 = 7.0f, cm6 = -6.0f, c8 = 8.0f; asm volatile("" : "+v"(c7), "+v"(cm6), "+v"(c8));
        float sa[2][4];
#pragma unroll
        for (int ai = 0; ai < 2; ++ai)
#pragma unroll
            for (int m = 0; m < 4; ++m) sa[ai][m] = ((const LAS float*)ep)[512 + ai * HALF + wr * 64 + m * 16 + fr];
#pragma unroll
        for (int ai = 0; ai < 2; ++ai)
#pragma unroll
            for (int m = 0; m < 4; ++m) { const size_t row = (size_t)u.pm * BM + ai * HALF + wr * 64 + m * 16 + fr; const f32x2 ss = {sa[ai][m], sa[ai][m]};
                unsigned w[4]; f32x2 sgs[4], sls[4], g[4], l[4], gm[4], lc[4], t[4], gl[4];
#pragma unroll
                for (int q = 0; q < 4; ++q) { sgs[q] = pk_mul(sg[q], ss); sls[q] = pk_mul(sl[q], ss); }
#pragma unroll
                for (int q = 0; q < 4; ++q) { const int n = q >> 1, e0 = 2 * (q & 1); const i32x4 ig = acc[ai][0][m][n], il = acc[ai][1][m][n];
                    g[q] = pk_fma((f32x2){(float)ig[e0], (float)ig[e0 + 1]}, sgs[q], bg[q]); l[q] = pk_fma((f32x2){(float)il[e0], (float)il[e0 + 1]}, sls[q], bl[q]); }
#pragma unroll
                for (int q = 0; q < 4; ++q) { gm[q] = (f32x2){min_asm(g[q][0], c7), min_asm(g[q][1], c7)}; lc[q] = (f32x2){med3_asm(l[q][0], cm6, c8), med3_asm(l[q][1], cm6, c8)}; }
#pragma unroll
                for (int q = 0; q < 4; ++q) { t[q] = pk_mul(gm[q], cc); gl[q] = pk_mul(gm[q], lc[q]); }
#pragma unroll
                for (int q = 0; q < 4; ++q) { const float r0 = __builtin_amdgcn_rcpf(1.0f + __builtin_amdgcn_exp2f(t[q][0])), r1 = __builtin_amdgcn_rcpf(1.0f + __builtin_amdgcn_exp2f(t[q][1]));
                    w[q] = pk2(gl[q][0] * r0, gl[q][1] * r1); }
                *(u32x4*)(ACT + row * 1024 + j0) = (u32x4){w[0], w[1], w[2], w[3]}; }
    }
};
struct EpiMoe2 {
    static constexpr bool PERM = true; static constexpr bool LDSPRE = true;
    bf16_t* OUT; const float* bdn; int abl;
    __device__ __forceinline__ void pre(LAS unsigned char* ep, const Unit& u, int wid, int lane) const {
        if (wid == 0) __builtin_amdgcn_global_load_lds((const unsigned*)(bdn + (size_t)u.grp * 1024 + u.pn * 256 + 4 * lane), (LAS unsigned*)ep, 16, 0, 0);
    }
    __device__ __forceinline__ void operator()(AccRef acc, const Unit& u, int wr, int wc, int fr, int fq, const LAS unsigned char* ep) const {
        const int c0 = u.pn * 256 + wc * 32 + 8 * fq; const LAS float* bp = (const LAS float*)ep + wc * 32 + 8 * fq;
        f32x4 b[2][2];
#pragma unroll
        for (int bj = 0; bj < 2; ++bj) { b[bj][0] = *(const LAS f32x4*)(bp + bj * HALF); b[bj][1] = *(const LAS f32x4*)(bp + bj * HALF + 4); }
#pragma unroll
        for (int ai = 0; ai < 2; ++ai)
#pragma unroll
            for (int m = 0; m < 4; ++m) { const size_t row = (size_t)u.pm * BM + ai * HALF + wr * 64 + m * 16 + fr;
#pragma unroll
                for (int bj = 0; bj < 2; ++bj) {
                    if (abl) { const f32x4 t0_ = acc[ai][bj][m][0] + b[bj][0], t1_ = acc[ai][bj][m][1] + b[bj][1]; asm volatile("" :: "v"(t0_[0] + t0_[1] + t0_[2] + t0_[3] + t1_[0] + t1_[1] + t1_[2] + t1_[3])); }
                    else store8q(OUT + (row - fr) * 1024 + (c0 - 8 * fq) + bj * HALF, 1024, acc[ai][bj][m][0] + b[bj][0], acc[ai][bj][m][1] + b[bj][1], fr, fq);
                } }
    }
};
struct EpiMoe2Q {
    static constexpr bool PERM = true; static constexpr bool LDSPRE = false;
    bf16_t* OUT; const float* bdn; const float* swd; const float* sa2;
    __device__ __forceinline__ void operator()(AccRefI acc, const Unit& u, int wr, int wc, int fr, int fq) const {
        const int c0 = u.pn * 256 + wc * 32 + 8 * fq; const unsigned lc_ = (unsigned)(wc * 32 + 8 * fq), lr_ = (unsigned)(wr * 64 + fr);
        const float* bp = bdn + (size_t)u.grp * 1024 + u.pn * 256 + lc_; const float* sp = swd + (size_t)u.grp * 1024 + u.pn * 256 + lc_; const float* rp_ = sa2 + (size_t)u.pm * BM;
        float sr[2][4];
#pragma unroll
        for (int ai = 0; ai < 2; ++ai)
#pragma unroll
            for (int m = 0; m < 4; ++m) sr[ai][m] = rp_[lr_ + (unsigned)(ai * HALF + m * 16)];
#pragma unroll
        for (int bj = 0; bj < 2; ++bj) {
            const f32x4 b0 = *(const f32x4*)(bp + bj * HALF), b1 = *(const f32x4*)(bp + bj * HALF + 4), s0 = *(const f32x4*)(sp + bj * HALF), s1 = *(const f32x4*)(sp + bj * HALF + 4);
#pragma unroll
            for (int ai = 0; ai < 2; ++ai)
#pragma unroll
                for (int m = 0; m < 4; ++m) { const size_t row0 = (size_t)u.pm * BM + ai * HALF + wr * 64 + m * 16;
                    store8q(OUT + row0 * 1024 + (c0 - 8 * fq) + bj * HALF, 1024, deq<true>(acc[ai][bj][m][0], sr[ai][m], s0) + b0, deq<true>(acc[ai][bj][m][1], sr[ai][m], s1) + b1, fr, fq); }
            asm volatile("" ::: "memory");
        }
    }
};
}

namespace att {
constexpr int DV = 128, QBLK = 32, KVBLK = 64;
#define SBAR() __builtin_amdgcn_sched_barrier(0)
__device__ __forceinline__ int crow(int r, int hi) { return (r & 3) + 8 * (r >> 2) + 4 * hi; }
__device__ __forceinline__ int v_st(int k, int c) { const int kk = (k & ~0xC) | ((k & 4) << 1) | ((k & 8) >> 1); return ((kk >> 3) * 4 + (c >> 5)) * 512 + ((kk & 7) * 32 + (c & 31)) * 2; }
__device__ __forceinline__ int v_rd_base(int lane) { return ((lane & 3) << 3) | (((lane >> 2) & 3) << 6) | (((lane >> 4) & 1) << 5) | (((lane >> 5) & 1) << 8); }
constexpr int v_rd_off(int d0, int ks, int half) { return d0 * 512 + ks * 4096 + half * 2048; }
template <int OFF> __device__ __forceinline__ s16x4 tr_read(int vb) {
    s16x4 r; asm volatile("ds_read_b64_tr_b16 %0, %1 offset:%2" : "=&v"(r) : "v"(vb), "i"(OFF) : "memory"); return r;
}
template <int D0> __device__ __forceinline__ void pv_one(f32x16& od, int vb, bf16x8 pa0, bf16x8 pa1, bf16x8 pa2, bf16x8 pa3) {
    const s16x4 l0 = tr_read<v_rd_off(D0, 0, 0)>(vb), h0 = tr_read<v_rd_off(D0, 0, 1)>(vb), l1 = tr_read<v_rd_off(D0, 1, 0)>(vb), h1 = tr_read<v_rd_off(D0, 1, 1)>(vb);
    const s16x4 l2 = tr_read<v_rd_off(D0, 2, 0)>(vb), h2 = tr_read<v_rd_off(D0, 2, 1)>(vb), l3 = tr_read<v_rd_off(D0, 3, 0)>(vb), h3 = tr_read<v_rd_off(D0, 3, 1)>(vb);
    asm volatile("s_waitcnt lgkmcnt(0)" ::: "memory"); SBAR();
#define PK(L, H) (bf16x8){L[0], L[1], L[2], L[3], H[0], H[1], H[2], H[3]}
    od = __builtin_amdgcn_mfma_f32_32x32x16_bf16(pa0, PK(l0, h0), od, 0, 0, 0);
    od = __builtin_amdgcn_mfma_f32_32x32x16_bf16(pa1, PK(l1, h1), od, 0, 0, 0);
    od = __builtin_amdgcn_mfma_f32_32x32x16_bf16(pa2, PK(l2, h2), od, 0, 0, 0);
    od = __builtin_amdgcn_mfma_f32_32x32x16_bf16(pa3, PK(l3, h3), od, 0, 0, 0);
#undef PK
}
__device__ __forceinline__ void pv_d0(f32x16* o, int vb, bf16x8 pa0, bf16x8 pa1, bf16x8 pa2, bf16x8 pa3) {
    pv_one<0>(o[0], vb, pa0, pa1, pa2, pa3); pv_one<1>(o[1], vb, pa0, pa1, pa2, pa3); pv_one<2>(o[2], vb, pa0, pa1, pa2, pa3); pv_one<3>(o[3], vb, pa0, pa1, pa2, pa3);
}
#define PV_RD(D0, S) S##0 = tr_read<v_rd_off(D0, 0, 0)>(vb); S##1 = tr_read<v_rd_off(D0, 0, 1)>(vb); S##2 = tr_read<v_rd_off(D0, 1, 0)>(vb); S##3 = tr_read<v_rd_off(D0, 1, 1)>(vb); \
                     S##4 = tr_read<v_rd_off(D0, 2, 0)>(vb); S##5 = tr_read<v_rd_off(D0, 2, 1)>(vb); S##6 = tr_read<v_rd_off(D0, 3, 0)>(vb); S##7 = tr_read<v_rd_off(D0, 3, 1)>(vb)
#define PV_PK(L, H) (bf16x8){L[0], L[1], L[2], L[3], H[0], H[1], H[2], H[3]}
#define PV_MM(OD, S) OD = __builtin_amdgcn_mfma_f32_32x32x16_bf16(pa0, PV_PK(S##0, S##1), OD, 0, 0, 0); OD = __builtin_amdgcn_mfma_f32_32x32x16_bf16(pa1, PV_PK(S##2, S##3), OD, 0, 0, 0); \
                     OD = __builtin_amdgcn_mfma_f32_32x32x16_bf16(pa2, PV_PK(S##4, S##5), OD, 0, 0, 0); OD = __builtin_amdgcn_mfma_f32_32x32x16_bf16(pa3, PV_PK(S##6, S##7), OD, 0, 0, 0)
__device__ __forceinline__ void pv_pipe(f32x16* o, int vb, bf16x8 pa0, bf16x8 pa1, bf16x8 pa2, bf16x8 pa3) {
    s16x4 a0, a1, a2, a3, a4, a5, a6, a7, b0, b1, b2, b3, b4, b5, b6, b7;
    asm volatile("s_waitcnt lgkmcnt(0)" ::: "memory"); SBAR();
    PV_RD(0, a); PV_RD(1, b);
    asm volatile("s_waitcnt lgkmcnt(8)" ::: "memory"); SBAR();
    PV_MM(o[0], a); SBAR();
    PV_RD(2, a);
    asm volatile("s_waitcnt lgkmcnt(8)" ::: "memory"); SBAR();
    PV_MM(o[1], b); SBAR();
    PV_RD(3, b);
    asm volatile("s_waitcnt lgkmcnt(8)" ::: "memory"); SBAR();
    PV_MM(o[2], a); SBAR();
    asm volatile("s_waitcnt lgkmcnt(0)" ::: "memory"); SBAR();
    PV_MM(o[3], b);
}
#undef PV_RD
#undef PV_PK
#undef PV_MM
template <int DQK> struct Cfg {
    static constexpr int KROW = DQK * 2;
    static constexpr int SHM_K = KVBLK * DQK * 2, SHM_V = KVBLK * DV * 2;
    static constexpr int NKC = DQK / 64;
    static constexpr int CH = DQK / 8;
    static constexpr int LDS_NEED = 2 * SHM_V + 2 * SHM_K + 8 * 64 * 4;
};
template <bool GUARD>
__device__ __forceinline__ void partialSM(f32x16& p0, f32x16& p1, float& m_ref, float& alpha, const bool first) {
    constexpr float THR2 = 8.0f * 1.4426950408889634f;
    if constexpr (GUARD) { __builtin_amdgcn_sched_barrier(0); asm volatile("s_nop 15\n\ts_nop 15" ::: "memory"); __builtin_amdgcn_sched_barrier(0); }
#define MAX3(a, b, c) ({ float r_; asm volatile("v_max3_f32 %0, %1, %2, %3" : "=v"(r_) : "v"(a), "v"(b), "v"(c)); r_; })
    float pm0 = MAX3(p0[0], p0[1], p0[2]), pm1 = MAX3(p0[3], p0[4], p0[5]), pm2 = MAX3(p1[0], p1[1], p1[2]), pm3 = MAX3(p1[3], p1[4], p1[5]);
#pragma unroll
    for (int r = 6; r < 16; r += 2) { pm0 = MAX3(pm0, p0[r], p0[r + 1]); pm2 = MAX3(pm2, p1[r], p1[r + 1]); }
    float pmax = MAX3(pm0, pm1, pm2); pmax = fmaxf(pmax, pm3);
#undef MAX3
    { auto rr = __builtin_amdgcn_permlane32_swap(__float_as_uint(pmax), __float_as_uint(pmax), false, false);
      pmax = fmaxf(__uint_as_float(rr[0]), __uint_as_float(rr[1])); }
    if (__builtin_expect(!first && __all(pmax <= THR2), 1)) { alpha = 1.f; }
    else { const float d = first ? pmax : fmaxf(pmax, 0.f); alpha = first ? 1.f : __builtin_amdgcn_exp2f(-d); m_ref += d;
#pragma unroll
        for (int r = 0; r < 16; ++r) { p0[r] -= d; p1[r] -= d; } }
#pragma unroll
    for (int r = 0; r < 16; ++r) p0[r] = __builtin_amdgcn_exp2f(p0[r]);
}
__device__ __forceinline__ void finishSM(f32x16& p0, f32x16& p1, float alpha, float& l_reg, bf16x8& pa0, bf16x8& pa1, bf16x8& pa2, bf16x8& pa3) {
#pragma unroll
    for (int r = 0; r < 16; ++r) p1[r] = __builtin_amdgcn_exp2f(p1[r]);
    float ps0 = p0[0] + p0[1], ps1 = p0[2] + p0[3], ps2 = p1[0] + p1[1], ps3 = p1[2] + p1[3];
#pragma unroll
    for (int r = 4; r < 16; r += 4) { ps0 += p0[r] + p0[r + 1]; ps1 += p0[r + 2] + p0[r + 3]; ps2 += p1[r] + p1[r + 1]; ps3 += p1[r + 2] + p1[r + 3]; }
    float ps = (ps0 + ps1) + (ps2 + ps3);
    { auto rr = __builtin_amdgcn_permlane32_swap(__float_as_uint(ps), __float_as_uint(ps), false, false);
      ps = __uint_as_float(rr[0]) + __uint_as_float(rr[1]); }
    l_reg = l_reg * alpha + ps;
#define PK4(P, BASE, OUT) do { unsigned a0 = pk2(P[BASE + 0], P[BASE + 1]), a1 = pk2(P[BASE + 2], P[BASE + 3]);   \
    unsigned b0 = pk2(P[BASE + 4], P[BASE + 5]), b1 = pk2(P[BASE + 6], P[BASE + 7]);                              \
    auto r0 = __builtin_amdgcn_permlane32_swap(a0, b0, false, false); auto r1 = __builtin_amdgcn_permlane32_swap(a1, b1, false, false); \
    u32x4 w = {r0[0], r1[0], r0[1], r1[1]}; OUT = *reinterpret_cast<bf16x8*>(&w); } while (0)
    PK4(p0, 0, pa0); PK4(p0, 8, pa1); PK4(p1, 0, pa2); PK4(p1, 8, pa3);
#undef PK4
}
template <int DQK>
__device__ __forceinline__ void qkt(f32x16& p0, f32x16& p1, const LAS char* Ks, const bf16x8* qr, int r32, int hi, const float m_ref) {
    constexpr int KROW = Cfg<DQK>::KROW;
    const float nm = -m_ref;
#pragma unroll
    for (int r = 0; r < 16; ++r) { p0[r] = nm; p1[r] = nm; }
#pragma unroll
    for (int d0 = 0; d0 < DQK / 16; ++d0) { const int cb = (d0 * 16 + hi * 8) * 2;
        const bf16x8 b0 = *(const LAS bf16x8*)(Ks + r32 * KROW + (cb ^ (((r32 >> 1) & 7) << 4)));
        const bf16x8 b1 = *(const LAS bf16x8*)(Ks + (32 + r32) * KROW + (cb ^ (((r32 >> 1) & 7) << 4)));
        p0 = __builtin_amdgcn_mfma_f32_32x32x16_bf16(b0, qr[d0], p0, 0, 0, 0);
        p1 = __builtin_amdgcn_mfma_f32_32x32x16_bf16(b1, qr[d0], p1, 0, 0, 0); }
}
template <int DQK, int SDEPTH, int LDQ, int LDK, int LDV, int LDO, int DA = 0>
__device__ __forceinline__ void attn_body(const bf16_t* __restrict__ Qb, const bf16_t* __restrict__ Qb2, const bf16_t* __restrict__ Kh, const bf16_t* __restrict__ Vh, bf16_t* __restrict__ Ob, const int seq, LAS char* lds, const int tid,
                                          const int msel = 0, const float lam = 0.f, const float gsc = 0.f, const float* subg = nullptr, LAS bf16_t* stash = nullptr) {
    using C = Cfg<DQK>;
    constexpr int SHM_V = C::SHM_V, SHM_K = C::SHM_K, KROW = C::KROW, NKC = C::NKC, CH = C::CH;
    const int wid = tid >> 6, lane = tid & 63, r32 = lane & 31, hi = lane >> 5;
    LAS char* V_lds = lds; LAS char* K_lds = lds + 2 * SHM_V;
    LAS float* ws = (LAS float*)(lds + 2 * SHM_V + 2 * SHM_K) + wid * 64; LAS float* li_l = ws; LAS float* al_l = ws + 32;
    float m_reg = 0.f, l_reg = 0; f32x16 o[4] = {}; bf16x8 qr[DQK / 16];
    const bf16_t* Qw = Qb + (long)(wid * QBLK + r32) * LDQ + hi * 8; const bf16_t* Qw2 = Qb2 + (long)(wid * QBLK + r32) * LDQ + hi * 8;
#pragma unroll
    for (int d0 = 0; d0 < DQK / 16; ++d0) qr[d0] = d0 < 8 ? *(const bf16x8*)(Qw + d0 * 16) : *(const bf16x8*)(Qw2 + (d0 - 8) * 16);
    const int sr = tid >> 4, sc = (tid & 15) * 8, vst0 = v_st(sr, sc), vst1 = v_st(32 + sr, sc);
    int krow[NKC], kcol[NKC], kst[NKC];
#pragma unroll
    for (int i = 0; i < NKC; ++i) { const int e = tid + 512 * i; krow[i] = e / CH; kcol[i] = (e % CH) * 8; kst[i] = krow[i] * KROW + ((kcol[i] * 2) ^ (((krow[i] >> 1) & 7) << 4)); }
    const int vb0 = (int)(uintptr_t)V_lds + v_rd_base(lane);
    struct { bf16x8 vs0, vs1, ks[NKC]; } sr_[SDEPTH];
    const unsigned voff0 = (unsigned)(sr * LDV + sc), voff1 = (unsigned)((32 + sr) * LDV + sc); unsigned koff[NKC];
#pragma unroll
    for (int i = 0; i < NKC; ++i) koff[i] = (unsigned)(krow[i] * LDK + kcol[i]);
#define SLOAD(i, k0) do { const bf16_t* vt_ = Vh + (size_t)(k0) * LDV; const bf16_t* kt_ = Kh + (size_t)(k0) * LDK; sr_[i].vs0 = *(const bf16x8*)(vt_ + voff0); sr_[i].vs1 = *(const bf16x8*)(vt_ + voff1); \
    _Pragma("unroll") for (int _c = 0; _c < NKC; ++_c) sr_[i].ks[_c] = *(const bf16x8*)(kt_ + koff[_c]); } while (0)
#define SWRITE(b, i) do { *(LAS bf16x8*)(V_lds + (b) * SHM_V + vst0) = sr_[i].vs0; *(LAS bf16x8*)(V_lds + (b) * SHM_V + vst1) = sr_[i].vs1; \
    _Pragma("unroll") for (int _c = 0; _c < NKC; ++_c) *(LAS bf16x8*)(K_lds + (b) * SHM_K + kst[_c]) = sr_[i].ks[_c]; } while (0)
#define SWAIT() do { if constexpr (SDEPTH == 2) { if constexpr (NKC == 1) asm volatile("s_waitcnt vmcnt(3)" ::: "memory"); else asm volatile("s_waitcnt vmcnt(5)" ::: "memory"); } \
    else asm volatile("s_waitcnt vmcnt(0)" ::: "memory"); } while (0)
#define RESC(a) do { if (__any((a) < 1.f)) { if (hi == 0) al_l[r32] = (a); asm volatile("s_waitcnt lgkmcnt(0)" ::: "memory"); \
    _Pragma("unroll") for (int d = 0; d < 4; ++d) _Pragma("unroll") for (int r = 0; r < 16; ++r) o[d][r] *= al_l[crow(r, hi)]; } } while (0)
    f32x16 pA0, pA1, pB0, pB1; float alA, alB; bf16x8 pa0, pa1, pa2, pa3; const int NT = seq / KVBLK;
    constexpr int SE = 0, SO = SDEPTH - 1;
    SLOAD(SE, 0); asm volatile("s_waitcnt vmcnt(0)" ::: "memory"); SWRITE(0, SE); __syncthreads();
    qkt<DQK>(pA0, pA1, K_lds, qr, r32, hi, m_reg); partialSM<true>(pA0, pA1, m_reg, alA, true);
    SLOAD(SO, KVBLK); if constexpr (SDEPTH == 2) { if (2 < NT) SLOAD(SE, 2 * KVBLK); }
    SWAIT(); SWRITE(1, SO); __syncthreads();
    for (int j = 1; j + 1 < NT; j += 2) {
        SBAR(); qkt<DQK>(pB0, pB1, K_lds + SHM_K, qr, r32, hi, m_reg);
        finishSM(pA0, pA1, alA, l_reg, pa0, pa1, pa2, pa3); SBAR();
        SLOAD(SO, (j + SDEPTH) * KVBLK); SBAR();
        pv_d0(o, vb0, pa0, pa1, pa2, pa3); partialSM<false>(pB0, pB1, m_reg, alB, false);
        __syncthreads(); SWAIT(); SWRITE(0, SE);
        RESC(alB); __syncthreads();
        SBAR(); qkt<DQK>(pA0, pA1, K_lds, qr, r32, hi, m_reg);
        finishSM(pB0, pB1, alB, l_reg, pa0, pa1, pa2, pa3); SBAR();
        if (SDEPTH == 1 || j + 3 < NT) SLOAD(SE, (j + 1 + SDEPTH) * KVBLK); SBAR();
        pv_d0(o, vb0 + SHM_V, pa0, pa1, pa2, pa3); partialSM<false>(pA0, pA1, m_reg, alA, false);
        __syncthreads(); SWAIT(); SWRITE(1, SO);
        RESC(alA); __syncthreads();
    }
    SBAR(); qkt<DQK>(pB0, pB1, K_lds + SHM_K, qr, r32, hi, m_reg);
    finishSM(pA0, pA1, alA, l_reg, pa0, pa1, pa2, pa3); SBAR();
    pv_d0(o, vb0, pa0, pa1, pa2, pa3); partialSM<false>(pB0, pB1, m_reg, alB, false);
    __syncthreads(); RESC(alB);
    finishSM(pB0, pB1, alB, l_reg, pa0, pa1, pa2, pa3); SBAR();
    pv_d0(o, vb0 + SHM_V, pa0, pa1, pa2, pa3);
    if (hi == 0) li_l[r32] = l_reg; asm volatile("s_waitcnt lgkmcnt(0)" ::: "memory");
    float rli[16];
#pragma unroll
    for (int r = 0; r < 16; ++r) rli[r] = __builtin_amdgcn_rcpf(li_l[crow(r, hi)]);
    bf16_t* Ow = Ob + (long)(wid * QBLK) * LDO;
    if constexpr (DA == 0) {
#pragma unroll
        for (int r = 0; r < 16; ++r) { const int orow = crow(r, hi);
#pragma unroll
            for (int d0 = 0; d0 < 4; ++d0) Ow[(long)orow * LDO + d0 * 32 + r32] = f2bf(o[d0][r] * rli[r]); }
    } else {
        int t2 = threadIdx.x; asm volatile("" : "+v"(t2));
        const int wid2 = t2 >> 6, lane2 = t2 & 63, r32l = lane2 & 31, hi2 = lane2 >> 5; bf16_t* Ow2 = Ob + (long)(wid2 * QBLK) * LDO;
        LAS bf16_t* stw = stash + wid2 * 4096 + lane2;
        if (msel == 0) {
#pragma unroll
            for (int r = 0; r < 16; ++r)
#pragma unroll
                for (int d0 = 0; d0 < 4; ++d0) stw[(r * 4 + d0) * 64] = f2bf(o[d0][r] * rli[r]);
        } else {
            float ds[16];
#pragma unroll
            for (int r = 0; r < 16; ++r) { float s = 0.f; if ((r & 3) == 0) asm volatile("" ::: "memory");
#pragma unroll
                for (int d0 = 0; d0 < 4; ++d0) { const float d = bf2f(stw[(r * 4 + d0) * 64]) - lam * (o[d0][r] * rli[r]); o[d0][r] = d; s += d * d; }
                ds[r] = s; }
#define SWZ_ADD(M) _Pragma("unroll") for (int r = 0; r < 16; ++r) ds[r] += __uint_as_float(__builtin_amdgcn_ds_swizzle(__float_as_uint(ds[r]), ((M) << 10) | 0x1f))
            SWZ_ADD(1); SWZ_ADD(2); SWZ_ADD(4); SWZ_ADD(8); SWZ_ADD(16);
#undef SWZ_ADD
            float g[4];
#pragma unroll
            for (int d0 = 0; d0 < 4; ++d0) g[d0] = subg[d0 * 32 + r32l] * gsc;
#pragma unroll
            for (int r = 0; r < 16; ++r) { const int orow = crow(r, hi2); const float rs = rsqrtf(ds[r] * (1.0f / 128.0f) + RMS_EPS);
#pragma unroll
                for (int d0 = 0; d0 < 4; ++d0) Ow2[(long)orow * LDO + d0 * 32 + r32l] = f2bf(o[d0][r] * rs * g[d0]); }
        }
    }
    __syncthreads();
#undef SLOAD
#undef SWRITE
#undef SWAIT
#undef RESC
}
template <int DQK, int LDQ, int LDK, int LDV, int LDO, int DA = 0>
__device__ __forceinline__ void attn_body_simple(const bf16_t* __restrict__ Qb, const bf16_t* __restrict__ Qb2, const bf16_t* __restrict__ Kh, const bf16_t* __restrict__ Vh, bf16_t* __restrict__ Ob, const int seq, LAS char* lds, const int tid,
                                                 const int msel = 0, const float lam = 0.f, const float gsc = 0.f, const float* subg = nullptr, LAS bf16_t* stash = nullptr) {
    using C = Cfg<DQK>;
    constexpr int SHM_V = C::SHM_V, SHM_K = C::SHM_K, KROW = C::KROW, NKC = C::NKC, CH = C::CH;
    const int wid = tid >> 6, lane = tid & 63, r32 = lane & 31, hi = lane >> 5;
    LAS char* V_lds = lds; LAS char* K_lds = lds + 2 * SHM_V;
    LAS float* ws = (LAS float*)(lds + 2 * SHM_V + 2 * SHM_K) + wid * 64; LAS float* li_l = ws; LAS float* al_l = ws + 32;
    float m_reg = 0.f, l_reg = 0; f32x16 o[4] = {}; bf16x8 qr[DQK / 16];
    const bf16_t* Qw = Qb + (long)(wid * QBLK + r32) * LDQ + hi * 8; const bf16_t* Qw2 = Qb2 + (long)(wid * QBLK + r32) * LDQ + hi * 8;
#pragma unroll
    for (int d0 = 0; d0 < DQK / 16; ++d0) qr[d0] = d0 < 8 ? *(const bf16x8*)(Qw + d0 * 16) : *(const bf16x8*)(Qw2 + (d0 - 8) * 16);
    const int sr = tid >> 4, sc = (tid & 15) * 8, vst0 = v_st(sr, sc), vst1 = v_st(32 + sr, sc);
    int krow[NKC], kcol[NKC], kst[NKC];
#pragma unroll
    for (int i = 0; i < NKC; ++i) { const int e = tid + 512 * i; krow[i] = e / CH; kcol[i] = (e % CH) * 8; kst[i] = krow[i] * KROW + ((kcol[i] * 2) ^ (((krow[i] >> 1) & 7) << 4)); }
    const int vb0 = (int)(uintptr_t)V_lds + v_rd_base(lane);
    bf16x8 vs0, vs1, ks[NKC];
    const unsigned voff0 = (unsigned)(sr * LDV + sc), voff1 = (unsigned)((32 + sr) * LDV + sc); unsigned koff[NKC];
#pragma unroll
    for (int i = 0; i < NKC; ++i) koff[i] = (unsigned)(krow[i] * LDK + kcol[i]);
#define SLOAD(k0) do { const bf16_t* vt_ = Vh + (size_t)(k0) * LDV; const bf16_t* kt_ = Kh + (size_t)(k0) * LDK; vs0 = *(const bf16x8*)(vt_ + voff0); vs1 = *(const bf16x8*)(vt_ + voff1); \
    _Pragma("unroll") for (int _c = 0; _c < NKC; ++_c) ks[_c] = *(const bf16x8*)(kt_ + koff[_c]); } while (0)
#define SWRITE(b) do { *(LAS bf16x8*)(V_lds + (b) * SHM_V + vst0) = vs0; *(LAS bf16x8*)(V_lds + (b) * SHM_V + vst1) = vs1; \
    _Pragma("unroll") for (int _c = 0; _c < NKC; ++_c) *(LAS bf16x8*)(K_lds + (b) * SHM_K + kst[_c]) = ks[_c]; } while (0)
    const int NT = seq / KVBLK;
    SLOAD(0); SWRITE(0); SLOAD(KVBLK); __syncthreads();
#pragma unroll 1
    for (int j = 0; j < NT; ++j) {
        const int bsel = j & 1; f32x16 p0, p1; float al; bf16x8 pa0, pa1, pa2, pa3;
        qkt<DQK>(p0, p1, K_lds + bsel * SHM_K, qr, r32, hi, m_reg);
        partialSM<true>(p0, p1, m_reg, al, j == 0);
        if (__any(al < 1.f)) { if (hi == 0) al_l[r32] = al; asm volatile("s_waitcnt lgkmcnt(0)" ::: "memory");
#pragma unroll
            for (int d = 0; d < 4; ++d)
#pragma unroll
                for (int r = 0; r < 16; ++r) o[d][r] *= al_l[crow(r, hi)]; }
        finishSM(p0, p1, al, l_reg, pa0, pa1, pa2, pa3); SBAR();
        pv_pipe(o, vb0 + bsel * SHM_V, pa0, pa1, pa2, pa3);
        if (j + 1 < NT) { SWRITE(bsel ^ 1); if (j + 2 < NT) SLOAD((j + 2) * KVBLK); }
        __syncthreads();
    }
    if (hi == 0) li_l[r32] = l_reg; asm volatile("s_waitcnt lgkmcnt(0)" ::: "memory");
    float rli[16];
#pragma unroll
    for (int r = 0; r < 16; ++r) rli[r] = __builtin_amdgcn_rcpf(li_l[crow(r, hi)]);
    bf16_t* Ow = Ob + (long)(wid * QBLK) * LDO;
    if constexpr (DA == 0) {
#pragma unroll
        for (int r = 0; r < 16; ++r) { const int orow = crow(r, hi);
#pragma unroll
            for (int d0 = 0; d0 < 4; ++d0) Ow[(long)orow * LDO + d0 * 32 + r32] = f2bf(o[d0][r] * rli[r]); }
    } else {
        int t2 = threadIdx.x; asm volatile("" : "+v"(t2));
        const int wid2 = t2 >> 6, lane2 = t2 & 63, r32l = lane2 & 31, hi2 = lane2 >> 5; bf16_t* Ow2 = Ob + (long)(wid2 * QBLK) * LDO;
        LAS bf16_t* stw = stash + wid2 * 4096 + lane2;
        if (msel == 0) {
#pragma unroll
            for (int r = 0; r < 16; ++r)
#pragma unroll
                for (int d0 = 0; d0 < 4; ++d0) stw[(r * 4 + d0) * 64] = f2bf(o[d0][r] * rli[r]);
        } else {
            float ds[16];
#pragma unroll
            for (int r = 0; r < 16; ++r) { float s = 0.f; if ((r & 3) == 0) asm volatile("" ::: "memory");
#pragma unroll
                for (int d0 = 0; d0 < 4; ++d0) { const float d = bf2f(stw[(r * 4 + d0) * 64]) - lam * (o[d0][r] * rli[r]); o[d0][r] = d; s += d * d; }
                ds[r] = s; }
#define SWZ_ADD(M) _Pragma("unroll") for (int r = 0; r < 16; ++r) ds[r] += __uint_as_float(__builtin_amdgcn_ds_swizzle(__float_as_uint(ds[r]), ((M) << 10) | 0x1f))
            SWZ_ADD(1); SWZ_ADD(2); SWZ_ADD(4); SWZ_ADD(8); SWZ_ADD(16);
#undef SWZ_ADD
            float g[4];
#pragma unroll
            for (int d0 = 0; d0 < 4; ++d0) g[d0] = subg[d0 * 32 + r32l] * gsc;
#pragma unroll
            for (int r = 0; r < 16; ++r) { const int orow = crow(r, hi2); const float rs = rsqrtf(ds[r] * (1.0f / 128.0f) + RMS_EPS);
#pragma unroll
                for (int d0 = 0; d0 < 4; ++d0) Ow2[(long)orow * LDO + d0 * 32 + r32l] = f2bf(o[d0][r] * rs * g[d0]); }
        }
    }
    __syncthreads();
#undef SLOAD
#undef SWRITE
}
template <int DQK, int LDQ, int LDK, int LDV, int LDO>
__device__ __forceinline__ void attn_body_stag(const bf16_t* __restrict__ Qb, const bf16_t* __restrict__ Qb2, const bf16_t* __restrict__ Kh, const bf16_t* __restrict__ Vh, bf16_t* __restrict__ Ob, const int seq, LAS char* lds, const int tid) {
    using C = Cfg<DQK>;
    constexpr int SHM_V = C::SHM_V, SHM_K = C::SHM_K, KROW = C::KROW, NKC = C::NKC, CH = C::CH;
    const int wid = __builtin_amdgcn_readfirstlane(tid >> 6), lane = tid & 63, r32 = lane & 31, hi = lane >> 5, half = wid >> 2;
    LAS char* V_lds = lds; LAS char* K_lds = lds + 2 * SHM_V;
    LAS float* ws = (LAS float*)(lds + 2 * SHM_V + 2 * SHM_K) + wid * 64; LAS float* li_l = ws; LAS float* al_l = ws + 32;
    float m_reg = 0.f, l_reg = 0; f32x16 o[4] = {}; bf16x8 qr[DQK / 16];
    const bf16_t* Qw = Qb + (long)(wid * QBLK + r32) * LDQ + hi * 8; const bf16_t* Qw2 = Qb2 + (long)(wid * QBLK + r32) * LDQ + hi * 8;
#pragma unroll
    for (int d0 = 0; d0 < DQK / 16; ++d0) qr[d0] = d0 < 8 ? *(const bf16x8*)(Qw + d0 * 16) : *(const bf16x8*)(Qw2 + (d0 - 8) * 16);
    const int sr = tid >> 4, sc = (tid & 15) * 8, vst0 = v_st(sr, sc), vst1 = v_st(32 + sr, sc);
    int kst[NKC]; unsigned koff[NKC];
#pragma unroll
    for (int i = 0; i < NKC; ++i) { const int e = tid + 512 * i, krow = e / CH, kcol = (e % CH) * 8; kst[i] = krow * KROW + ((kcol * 2) ^ (((krow >> 1) & 7) << 4)); koff[i] = (unsigned)(krow * LDK + kcol); }
    const unsigned voff0 = (unsigned)(sr * LDV + sc), voff1 = (unsigned)((32 + sr) * LDV + sc);
    const int vb0 = (int)(uintptr_t)V_lds + v_rd_base(lane);
    bf16x8 vs0, vs1, ks[NKC];
#define KLOAD(k0) do { const bf16_t* kt_ = Kh + (size_t)(k0) * LDK; _Pragma("unroll") for (int _c = 0; _c < NKC; ++_c) ks[_c] = *(const bf16x8*)(kt_ + koff[_c]); } while (0)
#define VLOAD(k0) do { const bf16_t* vt_ = Vh + (size_t)(k0) * LDV; vs0 = *(const bf16x8*)(vt_ + voff0); vs1 = *(const bf16x8*)(vt_ + voff1); } while (0)
#define KWRITE(b) do { _Pragma("unroll") for (int _c = 0; _c < NKC; ++_c) *(LAS bf16x8*)(K_lds + (b) * SHM_K + kst[_c]) = ks[_c]; } while (0)
#define VWRITE(b) do { *(LAS bf16x8*)(V_lds + (b) * SHM_V + vst0) = vs0; *(LAS bf16x8*)(V_lds + (b) * SHM_V + vst1) = vs1; } while (0)
    const int NT = seq / KVBLK;
    KLOAD(0); VLOAD(0); KWRITE(0); VWRITE(0); KLOAD(KVBLK); VLOAD(KVBLK);
    __syncthreads();
    f32x16 p0 = {}, p1 = {}; float al = 1.f;
#define STG_K(J_) do { if ((J_) + 1 < NT) { KWRITE(((J_) + 1) & 1); if ((J_) + 2 < NT) KLOAD(((J_) + 2) * KVBLK); } } while (0)
#define STG_V(J_) do { if ((J_) + 1 < NT) { VWRITE(((J_) + 1) & 1); if ((J_) + 2 < NT) VLOAD(((J_) + 2) * KVBLK); } } while (0)
#define SP0(j_) do { qkt<DQK>(p0, p1, K_lds + ((j_) & 1) * SHM_K, qr, r32, hi, m_reg); partialSM<true>(p0, p1, m_reg, al, (j_) == 0); } while (0)
#define SP1(j_) do { bf16x8 pa0, pa1, pa2, pa3; \
        if (__any(al < 1.f)) { if (hi == 0) al_l[r32] = al; asm volatile("s_waitcnt lgkmcnt(0)" ::: "memory"); \
            _Pragma("unroll") for (int d = 0; d < 4; ++d) _Pragma("unroll") for (int r = 0; r < 16; ++r) o[d][r] *= al_l[crow(r, hi)]; } \
        finishSM(p0, p1, al, l_reg, pa0, pa1, pa2, pa3); SBAR(); \
        pv_pipe(o, vb0 + ((j_) & 1) * SHM_V, pa0, pa1, pa2, pa3); } while (0)
    if (half == 0) {
#pragma unroll 1
        for (int J = 0; J < NT; ++J) { STG_K(J); SP0(J); __syncthreads(); STG_V(J); SP1(J); __syncthreads(); }
        __syncthreads();
    } else {
        STG_K(0); __syncthreads(); STG_V(0); SP0(0); __syncthreads();
#pragma unroll 1
        for (int J = 1; J < NT; ++J) { STG_K(J); SP1(J - 1); __syncthreads(); STG_V(J); SP0(J); __syncthreads(); }
        SP1(NT - 1); __syncthreads();
    }
#undef STG_K
#undef STG_V
#undef SP0
#undef SP1
    if (hi == 0) li_l[r32] = l_reg; asm volatile("s_waitcnt lgkmcnt(0)" ::: "memory");
    float rli[16];
#pragma unroll
    for (int r = 0; r < 16; ++r) rli[r] = __builtin_amdgcn_rcpf(li_l[crow(r, hi)]);
    bf16_t* Ow = Ob + (long)(wid * QBLK) * LDO;
#pragma unroll
    for (int r = 0; r < 16; ++r) { const int orow = crow(r, hi);
#pragma unroll
        for (int d0 = 0; d0 < 4; ++d0) Ow[(long)orow * LDO + d0 * 32 + r32] = f2bf(o[d0][r] * rli[r]); }
    __syncthreads();
#undef KLOAD
#undef VLOAD
#undef KWRITE
#undef VWRITE
}
template <int DQK, int SDEPTH, int NH, int VSHARE, bool CTXQ, bool KSH = false>
__device__ __forceinline__ void attn_phase(const bf16_t* Q, const bf16_t* K, const bf16_t* V, bf16_t* O, LAS char* lds, const int tid) {
    constexpr int LDQ = NH * DQK, LDK = KSH ? DQK : NH * DQK, LDV = KSH ? DQK : (NH / VSHARE) * DV, LDO = NH * DV;
    if constexpr (KSH) V = K;
    const int c = blockIdx.x, xcd = c & 7, slot = c >> 3;
    constexpr int ROUNDS = NB * NH / 8;
#pragma unroll 1
    for (int i = 0; i <= ROUNDS; ++i) {
        int b, h, seq; size_t qtok;
        if (i < ROUNDS) { const int bh = i * 8 + xcd; b = bh / NH; h = bh % NH; qtok = (size_t)b * TB + CTX + (size_t)slot * 256; seq = TB; }
        else { if (!CTXQ || c >= NB * NH) break; b = c / NH; h = c % NH; qtok = (size_t)b * TB; seq = CTX; }
        const size_t t0 = (size_t)b * TB;
        if constexpr (SDEPTH == 3) attn_body_stag<DQK, LDQ, LDK, LDV, LDO>(Q + qtok * LDQ + h * (DQK > 128 ? 128 : DQK), Q + qtok * LDQ + NH * 128 + h * (DQK > 128 ? DQK - 128 : 0), K + t0 * LDK + h * DQK, V + t0 * LDV + (h / VSHARE) * DV, O + qtok * LDO + h * DV, seq, lds, tid);
        else if constexpr (SDEPTH == 0) attn_body_simple<DQK, LDQ, LDK, LDV, LDO>(Q + qtok * LDQ + h * (DQK > 128 ? 128 : DQK), Q + qtok * LDQ + NH * 128 + h * (DQK > 128 ? DQK - 128 : 0), K + t0 * LDK + (KSH ? 0 : h * DQK), V + t0 * LDV + (KSH ? 0 : (h / VSHARE) * DV), O + qtok * LDO + h * DV, seq, lds, tid);
        else attn_body<DQK, ((SDEPTH == 0 || SDEPTH == 3) ? 1 : SDEPTH), LDQ, LDK, LDV, LDO>(Q + qtok * LDQ + h * DQK, Q + qtok * LDQ + h * DQK, K + t0 * LDK + h * DQK, V + t0 * LDV + (h / VSHARE) * DV, O + qtok * LDO + h * DV, seq, lds, tid);
    }
}
template <int L>
__device__ __forceinline__ void attn_phase_da(const bf16_t* Q, const bf16_t* K, const bf16_t* V, bf16_t* O2, const float* lamv, const float* subg, LAS char* lds, const int tid) {
    constexpr int LD = 1024;
    const float lam_init = L == 0 ? 0.2f : 0.8f - 0.6f * 0.40656965974059917f;
    const int lane = tid & 63;
    const float d01 = wave_sum(lamv[lane] * lamv[64 + lane]), d23 = wave_sum(lamv[128 + lane] * lamv[192 + lane]);
    const float lam = __uint_as_float(__builtin_amdgcn_readfirstlane(__float_as_uint(expf(d01) - expf(d23) + lam_init))), gsc = 1.0f - lam_init;
    LAS bf16_t* stash = (LAS bf16_t*)(lds + 52 * 1024);
    const int c = blockIdx.x, xcd = c & 7, slot = c >> 3;
    constexpr int NU = 2 * NB + ((L != 3) ? 2 : 0);
#pragma unroll 1
    for (int i = 0; i < NU; ++i) {
        const int msel = i & 1; int b, h, seq; size_t qtok;
        if (i < 2 * NB) { const int bh = (i >> 1) * 8 + xcd; b = bh >> 3; h = bh & 7; qtok = (size_t)b * TB + CTX + (size_t)slot * 256; seq = TB; }
        else { if (c >= NB * 8) break; b = c >> 3; h = c & 7; qtok = (size_t)b * TB; seq = CTX; }
        const size_t t0 = (size_t)b * TB; const int hh = 2 * h + msel;
        attn_body<64, 2, LD, LD, LD, LD, 1>(Q + qtok * LD + hh * 64, Q + qtok * LD + hh * 64, K + t0 * LD + hh * 64, V + t0 * LD + h * 128, O2 + qtok * LD + h * 128, seq, lds, tid, msel, lam, gsc, subg, stash);
    }
}
}

struct Params { const float* in[27]; float* out; unsigned char* ws; int ph_lo, ph_hi; };
enum { I_X = 0, I_C, I_CTX, I_CCTX, I_ADAW, I_ADAB, I_NORMG, I_FINALG, I_DA_WIN, I_DA_WOUT, I_DA_LAM, I_DA_SUBG, I_RET_WIN, I_RET_DECAY, I_RET_WOUT, I_MLA_WIN, I_MLA_QG,
       I_MLA_WQUP, I_MLA_KVG, I_MLA_WKVUP, I_MLA_WOUT, I_MOE_WR, I_MOE_BR, I_MOE_WGU, I_MOE_BGU, I_MOE_WDN, I_MOE_BDN };

struct Frame {
    const Params* p; LAS unsigned char* lds; LAS unsigned char* reg; volatile LAS int* misc; int tid, lane, wave;
    unsigned char* ws;
};

enum { PK_ID = 0, PK_DA_IN, PK_RET_IN, PK_MLA_QUP, PK_MOE_GU };
__device__ __forceinline__ int src_col(int n, int kind) {
    if (kind == PK_DA_IN) { if ((n >> 10) == 1) return n; const int o = n & 63, axis = o >> 5, p = o & 31, f = p >> 1; return (n & ~63) | (axis * 32 + ((p & 1) ? 16 + f : f)); }
    if (kind == PK_RET_IN) { if (n < 1024 || (n >= 3072 && n < 4096)) { const int o = n & 255, f = o >> 1; return (n & ~255) | ((o & 1) ? 128 + f : f); } return n; }
    if (kind == PK_MLA_QUP) { if (n < 1024) return (n >> 7) * 192 + (n & 127); const int nn = n - 1024, hd = nn >> 6, oo = nn & 63, axis = oo >> 5, p = oo & 31, f = p >> 1; return hd * 192 + 128 + axis * 32 + ((p & 1) ? 16 + f : f); }
    if (kind == PK_MOE_GU) return ((n >> 7) & 1) * 1024 + (n >> 8) * 128 + (n & 127);
    return n;
}
__device__ __forceinline__ void tr_item(const float* W, int Ksrc, int Nsrc, bf16_t* WT, int Kdst, int Ndst, int Nvalid, int kind, LAS float* scr, int item, int lane) {
    const int nblk = Ndst / 32, kb = item / nblk, nb = item % nblk, k0 = 64 * kb, n0 = 32 * nb;
    const int n = n0 + (lane & 31); const bool nv = n < Nvalid; const int scn = nv ? src_col(n, kind) : 0;
#pragma unroll 8
    for (int i = 0; i < 32; ++i) { const int kk = 2 * i + (lane >> 5), k = k0 + kk; scr[kk * 33 + (lane & 31)] = (nv && k < Ksrc) ? W[(size_t)k * Nsrc + scn] : 0.f; }
    asm volatile("s_waitcnt lgkmcnt(0)" ::: "memory");
    const int c = lane & 7;
#pragma unroll
    for (int j = 0; j < 4; ++j) { const int nn = (lane >> 3) + 8 * j; const LAS float* s = scr + (8 * c) * 33 + nn;
        u32x4 o; o.x = pk2(s[0 * 33], s[1 * 33]); o.y = pk2(s[2 * 33], s[3 * 33]); o.z = pk2(s[4 * 33], s[5 * 33]); o.w = pk2(s[6 * 33], s[7 * 33]);
        *(u32x4*)(WT + (size_t)(n0 + nn) * Kdst + k0 + 8 * c) = o; }
    asm volatile("s_waitcnt lgkmcnt(0)" ::: "memory");
}
__device__ __forceinline__ void tr_itemq(const float* W, int Ksrc, int Nsrc, signed char* WT, int Kdst, int Ndst, int Nvalid, int kind, const unsigned* raw, LAS float* scr, int item, int lane) {
    const int nblk = Ndst / 32, kb = item / nblk, nb = item % nblk, k0 = 64 * kb, n0 = 32 * nb;
    const int n = n0 + (lane & 31); const bool nv = n < Nvalid; const int scn = nv ? src_col(n, kind) : 0; const float inv = 127.0f / fmaxf(__uint_as_float(raw[scn]), 1e-30f);
#pragma unroll 8
    for (int i = 0; i < 32; ++i) { const int kk = 2 * i + (lane >> 5), k = k0 + kk; const float v = (nv && k < Ksrc) ? W[(size_t)k * Nsrc + scn] * inv : 0.f; scr[kk * 33 + (lane & 31)] = fminf(fmaxf(rintf(v), -127.f), 127.f); }
    asm volatile("s_waitcnt lgkmcnt(0)" ::: "memory");
    const int c = lane & 7;
#pragma unroll
    for (int j = 0; j < 4; ++j) { const int nn = (lane >> 3) + 8 * j; const LAS float* s = scr + (8 * c) * 33 + nn;
        unsigned lo = ((unsigned)(int)s[0 * 33] & 0xffu) | (((unsigned)(int)s[1 * 33] & 0xffu) << 8) | (((unsigned)(int)s[2 * 33] & 0xffu) << 16) | (((unsigned)(int)s[3 * 33] & 0xffu) << 24);
        unsigned hi = ((unsigned)(int)s[4 * 33] & 0xffu) | (((unsigned)(int)s[5 * 33] & 0xffu) << 8) | (((unsigned)(int)s[6 * 33] & 0xffu) << 16) | (((unsigned)(int)s[7 * 33] & 0xffu) << 24);
        *(u32x2*)(WT + (size_t)(n0 + nn) * Kdst + k0 + 8 * c) = (u32x2){lo, hi}; }
    asm volatile("s_waitcnt lgkmcnt(0)" ::: "memory");
}
__device__ __forceinline__ void tr_item4q(const float* W, int Nsrc, signed char* WT, int Kdst, int Ndst, int kind, const unsigned* raw, LAS float* scr, int item, int lane) {
    const int nblk = Ndst / 32, kb = item / nblk, nb = item % nblk, k0 = 64 * kb, n0 = 32 * nb, nq = lane & 7, kr = lane >> 3;
    const int scn = src_col(n0 + 4 * nq, kind); const float* wp = W + (size_t)(k0 + kr) * Nsrc + scn;
    const u32x4 rw4 = *(const u32x4*)(raw + scn); const f32x4 inv = (f32x4){127.0f / fmaxf(__uint_as_float(rw4.x), 1e-30f), 127.0f / fmaxf(__uint_as_float(rw4.y), 1e-30f), 127.0f / fmaxf(__uint_as_float(rw4.z), 1e-30f), 127.0f / fmaxf(__uint_as_float(rw4.w), 1e-30f)};
    f32x4 v[8];
#pragma unroll
    for (int i = 0; i < 8; ++i) v[i] = *(const f32x4*)(wp + (size_t)(8 * i) * Nsrc);
#pragma unroll
    for (int i = 0; i < 8; ++i) { LAS float* d = scr + (8 * i + kr) * 33 + 4 * nq; const f32x4 q = v[i] * inv;
        d[0] = fminf(fmaxf(rintf(q[0]), -127.f), 127.f); d[1] = fminf(fmaxf(rintf(q[1]), -127.f), 127.f); d[2] = fminf(fmaxf(rintf(q[2]), -127.f), 127.f); d[3] = fminf(fmaxf(rintf(q[3]), -127.f), 127.f); }
    asm volatile("s_waitcnt lgkmcnt(0)" ::: "memory");
    const int c = lane & 7;
#pragma unroll
    for (int j = 0; j < 4; ++j) { const int nn = (lane >> 3) + 8 * j; const LAS float* s = scr + (8 * c) * 33 + nn;
        unsigned lo = ((unsigned)(int)s[0 * 33] & 0xffu) | (((unsigned)(int)s[1 * 33] & 0xffu) << 8) | (((unsigned)(int)s[2 * 33] & 0xffu) << 16) | (((unsigned)(int)s[3 * 33] & 0xffu) << 24);
        unsigned hi = ((unsigned)(int)s[4 * 33] & 0xffu) | (((unsigned)(int)s[5 * 33] & 0xffu) << 8) | (((unsigned)(int)s[6 * 33] & 0xffu) << 16) | (((unsigned)(int)s[7 * 33] & 0xffu) << 24);
        *(u32x2*)(WT + (size_t)(n0 + nn) * Kdst + k0 + 8 * c) = (u32x2){lo, hi}; }
    asm volatile("s_waitcnt lgkmcnt(0)" ::: "memory");
}
__device__ __forceinline__ void tr4_load(f32x4 (&v)[8], const float* W, int Nsrc, int Ndst, int kind, int item, int lane, int& scn) {
    const int nblk = Ndst / 32, kb = item / nblk, nb = item % nblk, k0 = 64 * kb, n0 = 32 * nb, nq = lane & 7, kr = lane >> 3;
    scn = src_col(n0 + 4 * nq, kind); const float* wp = W + (size_t)(k0 + kr) * Nsrc + scn;
#pragma unroll
    for (int i = 0; i < 8; ++i) v[i] = *(const f32x4*)(wp + (size_t)(8 * i) * Nsrc);
}
template <bool Q8> __device__ __forceinline__ void tr4_store(const f32x4 (&v)[8], void* WTv, int Kdst, int Ndst, const unsigned* raw, int scn, LAS float* scr, int item, int lane) {
    const int nblk = Ndst / 32, kb = item / nblk, nb = item % nblk, k0 = 64 * kb, n0 = 32 * nb, nq = lane & 7, kr = lane >> 3;
    f32x4 inv = (f32x4){1.f, 1.f, 1.f, 1.f};
    if constexpr (Q8) { const u32x4 rw4 = *(const u32x4*)(raw + scn); inv = (f32x4){127.0f / fmaxf(__uint_as_float(rw4.x), 1e-30f), 127.0f / fmaxf(__uint_as_float(rw4.y), 1e-30f), 127.0f / fmaxf(__uint_as_float(rw4.z), 1e-30f), 127.0f / fmaxf(__uint_as_float(rw4.w), 1e-30f)}; }
#pragma unroll
    for (int i = 0; i < 8; ++i) { LAS float* d = scr + (8 * i + kr) * 33 + 4 * nq;
        if constexpr (Q8) { const f32x4 q = v[i] * inv; d[0] = fminf(fmaxf(rintf(q[0]), -127.f), 127.f); d[1] = fminf(fmaxf(rintf(q[1]), -127.f), 127.f); d[2] = fminf(fmaxf(rintf(q[2]), -127.f), 127.f); d[3] = fminf(fmaxf(rintf(q[3]), -127.f), 127.f); }
        else { d[0] = v[i][0]; d[1] = v[i][1]; d[2] = v[i][2]; d[3] = v[i][3]; } }
    asm volatile("s_waitcnt lgkmcnt(0)" ::: "memory");
    const int c = lane & 7;
#pragma unroll
    for (int j = 0; j < 4; ++j) { const int nn = (lane >> 3) + 8 * j; const LAS float* s = scr + (8 * c) * 33 + nn;
        if constexpr (Q8) {
            unsigned lo = ((unsigned)(int)s[0 * 33] & 0xffu) | (((unsigned)(int)s[1 * 33] & 0xffu) << 8) | (((unsigned)(int)s[2 * 33] & 0xffu) << 16) | (((unsigned)(int)s[3 * 33] & 0xffu) << 24);
            unsigned hi = ((unsigned)(int)s[4 * 33] & 0xffu) | (((unsigned)(int)s[5 * 33] & 0xffu) << 8) | (((unsigned)(int)s[6 * 33] & 0xffu) << 16) | (((unsigned)(int)s[7 * 33] & 0xffu) << 24);
            *(u32x2*)((signed char*)WTv + (size_t)(n0 + nn) * Kdst + k0 + 8 * c) = (u32x2){lo, hi};
        } else { u32x4 o; o.x = pk2(s[0 * 33], s[1 * 33]); o.y = pk2(s[2 * 33], s[3 * 33]); o.z = pk2(s[4 * 33], s[5 * 33]); o.w = pk2(s[6 * 33], s[7 * 33]);
            *(u32x4*)((bf16_t*)WTv + (size_t)(n0 + nn) * Kdst + k0 + 8 * c) = o; } }
    asm volatile("s_waitcnt lgkmcnt(0)" ::: "memory");
}
__device__ __forceinline__ void tr4_store_inv(const f32x4 (&v)[8], signed char* WT, int Kdst, int Ndst, const f32x4 inv, LAS float* scr, int item, int lane) {
    const int nblk = Ndst / 32, kb = item / nblk, nb = item % nblk, k0 = 64 * kb, n0 = 32 * nb, nq = lane & 7, kr = lane >> 3;
#pragma unroll
    for (int i = 0; i < 8; ++i) { LAS float* d = scr + (8 * i + kr) * 33 + 4 * nq; const f32x4 q = v[i] * inv;
        d[0] = fminf(fmaxf(rintf(q[0]), -127.f), 127.f); d[1] = fminf(fmaxf(rintf(q[1]), -127.f), 127.f); d[2] = fminf(fmaxf(rintf(q[2]), -127.f), 127.f); d[3] = fminf(fmaxf(rintf(q[3]), -127.f), 127.f); }
    asm volatile("s_waitcnt lgkmcnt(0)" ::: "memory");
    const int c = lane & 7;
#pragma unroll
    for (int j = 0; j < 4; ++j) { const int nn = (lane >> 3) + 8 * j; const LAS float* s = scr + (8 * c) * 33 + nn;
        unsigned lo = ((unsigned)(int)s[0 * 33] & 0xffu) | (((unsigned)(int)s[1 * 33] & 0xffu) << 8) | (((unsigned)(int)s[2 * 33] & 0xffu) << 16) | (((unsigned)(int)s[3 * 33] & 0xffu) << 24);
        unsigned hi = ((unsigned)(int)s[4 * 33] & 0xffu) | (((unsigned)(int)s[5 * 33] & 0xffu) << 8) | (((unsigned)(int)s[6 * 33] & 0xffu) << 16) | (((unsigned)(int)s[7 * 33] & 0xffu) << 24);
        *(u32x2*)(WT + (size_t)(n0 + nn) * Kdst + k0 + 8 * c) = (u32x2){lo, hi}; }
    asm volatile("s_waitcnt lgkmcnt(0)" ::: "memory");
}
template <bool Q8> __device__ __forceinline__ void tr4_job(const float* W, int K, int N, void* WT, int kind, int count, const unsigned* raw, LAS float* scr, int gw, int NGW, int lane) {
    const int per = (K / 64) * (N / 32), total = per * count; const size_t esz = Q8 ? 1 : 2;
    if (gw >= total) return;
    f32x4 va[8], vb[8]; int sa = 0, sb = 0;
    tr4_load(va, W + (size_t)(gw / per) * K * N, N, N, kind, gw % per, lane, sa);
#pragma unroll 1
    for (int it = gw; it < total; it += 2 * NGW) {
        const int it1 = it + NGW, it2 = it + 2 * NGW;
        if (it1 < total) tr4_load(vb, W + (size_t)(it1 / per) * K * N, N, N, kind, it1 % per, lane, sb);
        tr4_store<Q8>(va, (char*)WT + (size_t)(it / per) * K * N * esz, K, N, raw ? raw + (size_t)(it / per) * N : nullptr, sa, scr, it % per, lane);
        if (it2 < total) tr4_load(va, W + (size_t)(it2 / per) * K * N, N, N, kind, it2 % per, lane, sa);
        if (it1 < total) tr4_store<Q8>(vb, (char*)WT + (size_t)(it1 / per) * K * N * esz, K, N, raw ? raw + (size_t)(it1 / per) * N : nullptr, sb, scr, it1 % per, lane);
    }
}
__device__ __forceinline__ void tr_item4(const float* W, int Nsrc, bf16_t* WT, int Kdst, int Ndst, int kind, LAS float* scr, int item, int lane) {
    const int nblk = Ndst / 32, kb = item / nblk, nb = item % nblk, k0 = 64 * kb, n0 = 32 * nb, nq = lane & 7, kr = lane >> 3;
    const int scn = src_col(n0 + 4 * nq, kind); const float* wp = W + (size_t)(k0 + kr) * Nsrc + scn;
    f32x4 v[8];
#pragma unroll
    for (int i = 0; i < 8; ++i) v[i] = *(const f32x4*)(wp + (size_t)(8 * i) * Nsrc);
#pragma unroll
    for (int i = 0; i < 8; ++i) { LAS float* d = scr + (8 * i + kr) * 33 + 4 * nq; d[0] = v[i][0]; d[1] = v[i][1]; d[2] = v[i][2]; d[3] = v[i][3]; }
    asm volatile("s_waitcnt lgkmcnt(0)" ::: "memory");
    const int c = lane & 7;
#pragma unroll
    for (int j = 0; j < 4; ++j) { const int nn = (lane >> 3) + 8 * j; const LAS float* s = scr + (8 * c) * 33 + nn;
        u32x4 o; o.x = pk2(s[0 * 33], s[1 * 33]); o.y = pk2(s[2 * 33], s[3 * 33]); o.z = pk2(s[4 * 33], s[5 * 33]); o.w = pk2(s[6 * 33], s[7 * 33]);
        *(u32x4*)(WT + (size_t)(n0 + nn) * Kdst + k0 + 8 * c) = o; }
    asm volatile("s_waitcnt lgkmcnt(0)" ::: "memory");
}
__device__ __forceinline__ float silu_f(float x) { return x / (1.0f + __expf(-x)); }

__device__ __forceinline__ void gu_convert(Frame& F, const int it0, const int nit, const int vb, const int nvb, const bool down = false) {
    const Params& P = *F.p; unsigned char* ws = F.ws;
    LAS float* scr = (LAS float*)(F.reg + F.wave * 8704);
    const float* WGU = gp(P.in[down ? I_MOE_WDN : I_MOE_WGU]); signed char* W8 = (signed char*)(ws + (down ? WS_W_DN : WS_W_GU)); float* SWt = (float*)(ws + (down ? WS_SWD : WS_SW));
    const int LG = down ? 5 : 6, NN = down ? 1024 : 2048, KIND = down ? PK_ID : PK_MOE_GU, NBM = (1 << LG) - 1;
    LAS float* red = (LAS float*)(F.reg + 120 * 1024);
    const int NIT = it0 + nit; const int w = F.wave, lane = F.lane, nq = lane & 7;
    f32x4 va0[8], va1[8], vb0[8], vb1[8]; int sca = 0, scb = 0;
#define GU_LOAD(V0, V1, IT, SC) do { const float* W_ = WGU + (size_t)((IT) >> LG) * 1024 * NN; tr4_load(V0, W_, NN, NN, KIND, ((2 * w) << LG) + ((IT) & NBM), lane, SC); tr4_load(V1, W_, NN, NN, KIND, ((2 * w + 1) << LG) + ((IT) & NBM), lane, SC); } while (0)
#define GU_PROC(V0, V1, IT, SC) do { f32x4 m_ = (f32x4){0.f, 0.f, 0.f, 0.f}; \
    _Pragma("unroll") for (int i_ = 0; i_ < 8; ++i_) _Pragma("unroll") for (int c_ = 0; c_ < 4; ++c_) m_[c_] = fmaxf(m_[c_], fmaxf(fabsf(V0[i_][c_]), fabsf(V1[i_][c_]))); \
    _Pragma("unroll") for (int c_ = 0; c_ < 4; ++c_) {   \
        m_[c_] = fmaxf(m_[c_], __uint_as_float(__builtin_amdgcn_ds_swizzle(__float_as_uint(m_[c_]), (8 << 10) | 0x1f))); \
        m_[c_] = fmaxf(m_[c_], __uint_as_float(__builtin_amdgcn_ds_swizzle(__float_as_uint(m_[c_]), (16 << 10) | 0x1f))); \
        auto rr_ = __builtin_amdgcn_permlane32_swap(__float_as_uint(m_[c_]), __float_as_uint(m_[c_]), false, false); m_[c_] = fmaxf(__uint_as_float(rr_[0]), __uint_as_float(rr_[1])); } \
    if (lane < 8) *(LAS f32x4*)(red + w * 32 + 4 * lane) = m_; \
    __syncthreads(); \
    f32x4 cm_ = *(const LAS f32x4*)(red + 4 * nq); \
    _Pragma("unroll") for (int w2_ = 1; w2_ < 8; ++w2_) { const f32x4 t_ = *(const LAS f32x4*)(red + w2_ * 32 + 4 * nq); _Pragma("unroll") for (int c_ = 0; c_ < 4; ++c_) cm_[c_] = fmaxf(cm_[c_], t_[c_]); } \
    _Pragma("unroll") for (int c_ = 0; c_ < 4; ++c_) cm_[c_] = fmaxf(cm_[c_], 1e-30f); \
    const f32x4 inv_ = (f32x4){127.0f / cm_[0], 127.0f / cm_[1], 127.0f / cm_[2], 127.0f / cm_[3]}; \
    if (w == 0 && lane < 8) *(f32x4*)(SWt + (size_t)((IT) >> LG) * NN + (SC)) = cm_ * (1.0f / 127.0f); \
    signed char* D_ = W8 + (size_t)((IT) >> LG) * 1024 * NN; \
    tr4_store_inv(V0, D_, 1024, NN, inv_, scr, ((2 * w) << LG) + ((IT) & NBM), lane); tr4_store_inv(V1, D_, 1024, NN, inv_, scr, ((2 * w + 1) << LG) + ((IT) & NBM), lane); \
    __syncthreads(); } while (0)
    int it = it0 + vb;
    if (it < NIT) GU_LOAD(va0, va1, it, sca);
#pragma unroll 1
    for (; it < NIT; it += 2 * nvb) {
        const int it1 = it + nvb, it2 = it + 2 * nvb;
        if (it1 < NIT) GU_LOAD(vb0, vb1, it1, scb);
        GU_PROC(va0, va1, it, sca);
        if (it2 < NIT) GU_LOAD(va0, va1, it2, sca);
        if (it1 < NIT) GU_PROC(vb0, vb1, it1, scb);
    }
#undef GU_LOAD
#undef GU_PROC
}
__device__ __forceinline__ void phase_actq(Frame& F) {
    unsigned char* ws = F.ws; const bf16_t* ACT = (const bf16_t*)(ws + MO_ACT); signed char* A8 = (signed char*)(ws + MO_ACT8); float* SA2 = (float*)(ws + MO_SA2);
    const int rows = F.misc[64 + 32], lane = F.lane; constexpr int STEP = GRID * 8 * 8;
    u32x4 va[8][2], vb[8][2];
#define AQ_LOAD(V, R0) do { _Pragma("unroll") for (int i_ = 0; i_ < 8; ++i_) { const bf16_t* rp_ = ACT + (size_t)((R0) + i_) * 1024 + 16 * lane; V[i_][0] = *(const u32x4*)rp_; V[i_][1] = *(const u32x4*)(rp_ + 8); } } while (0)
#define AQ_SWZ(M_) m_ = max(m_, (unsigned)__builtin_amdgcn_ds_swizzle((int)m_, ((M_) << 10) | 0x1f))
#define AQ_PROC(V, R0) do { _Pragma("unroll") for (int i_ = 0; i_ < 8; ++i_) { \
          \
        unsigned lo_ = 0u, hi_ = 0u; \
        _Pragma("unroll") for (int h_ = 0; h_ < 2; ++h_) { const u32x4 x_ = V[i_][h_]; lo_ = max(max(lo_, x_.x & 0x7fffu), max(x_.y & 0x7fffu, max(x_.z & 0x7fffu, x_.w & 0x7fffu))); hi_ = max(max(hi_, x_.x & 0x7fff0000u), max(x_.y & 0x7fff0000u, max(x_.z & 0x7fff0000u, x_.w & 0x7fff0000u))); } \
        unsigned m_ = max(lo_ << 16, hi_); AQ_SWZ(1); AQ_SWZ(2); AQ_SWZ(4); AQ_SWZ(8); AQ_SWZ(16); { auto rr_ = __builtin_amdgcn_permlane32_swap(m_, m_, false, false); m_ = max(rr_[0], rr_[1]); } \
        const float mx_ = fmaxf(__uint_as_float(m_), 1e-30f), inv_ = 127.0f * __builtin_amdgcn_rcpf(mx_); u32x4 o_; \
        _Pragma("unroll") for (int h_ = 0; h_ < 2; ++h_) { const u32x4 x_ = V[i_][h_];   \
            const unsigned f0_ = __float_as_uint(fmaf(bflo(x_.x), inv_, 12582912.0f)), f1_ = __float_as_uint(fmaf(bfhi(x_.x), inv_, 12582912.0f)), f2_ = __float_as_uint(fmaf(bflo(x_.y), inv_, 12582912.0f)), f3_ = __float_as_uint(fmaf(bfhi(x_.y), inv_, 12582912.0f)); \
            const unsigned f4_ = __float_as_uint(fmaf(bflo(x_.z), inv_, 12582912.0f)), f5_ = __float_as_uint(fmaf(bfhi(x_.z), inv_, 12582912.0f)), f6_ = __float_as_uint(fmaf(bflo(x_.w), inv_, 12582912.0f)), f7_ = __float_as_uint(fmaf(bfhi(x_.w), inv_, 12582912.0f)); \
            const unsigned w0_ = __builtin_amdgcn_perm(f1_, f0_, 0x0c0c0400u) | __builtin_amdgcn_perm(f3_, f2_, 0x04000c0cu), w1_ = __builtin_amdgcn_perm(f5_, f4_, 0x0c0c0400u) | __builtin_amdgcn_perm(f7_, f6_, 0x04000c0cu); \
            if (h_ == 0) { o_.x = w0_; o_.y = w1_; } else { o_.z = w0_; o_.w = w1_; } } \
        *(u32x4*)(A8 + (size_t)((R0) + i_) * 1024 + 16 * lane) = o_; \
        if (lane == 0) SA2[(R0) + i_] = mx_ * (1.0f / 127.0f); } } while (0)
    int r0 = (blockIdx.x * 8 + F.wave) * 8;
    if (r0 < rows) AQ_LOAD(va, r0);
#pragma unroll 1
    for (; r0 < rows; r0 += 2 * STEP) {
        const int r1 = r0 + STEP, r2 = r0 + 2 * STEP;
        if (r1 < rows) AQ_LOAD(vb, r1);
        AQ_PROC(va, r0);
        if (r2 < rows) AQ_LOAD(va, r2);
        if (r1 < rows) AQ_PROC(vb, r1);
    }
#undef AQ_LOAD
#undef AQ_SWZ
#undef AQ_PROC
}
__device__ __forceinline__ void phase_prologue(Frame& F, const XcdBarrier& bar) {
    const Params& P = *F.p; unsigned char* ws = F.ws;
    const int gw = blockIdx.x * 8 + F.wave, NGW = GRID * 8, gt = blockIdx.x * NTHR + F.tid, NGT = GRID * NTHR;
    {
        unsigned* RAWGU = (unsigned*)(ws + WS_RAWGU); unsigned* RAWP = (unsigned*)(ws + WS_RAWP);
#define MAX_JOB(W_, Ksrc_, Nsrc_, RAW_, COUNT_, IT0_) do { constexpr int ns_ = ((Nsrc_) + 255) / 256, nr_ = (Ksrc_) / 128, per_ = ns_ * nr_; \
        _Pragma("unroll 1") for (int it_ = gw - (IT0_); it_ < per_ * (COUNT_); it_ += NGW) { if (it_ < 0) continue; const int mi_ = it_ / per_, r_ = it_ % per_, st_ = r_ / nr_, rb_ = r_ % nr_, c_ = st_ * 256 + 4 * F.lane; \
            if (c_ < (Nsrc_)) { const float* w_ = (W_) + (size_t)mi_ * (Ksrc_) * (Nsrc_) + (size_t)(rb_ * 128) * (Nsrc_) + c_; f32x4 m_ = (f32x4){0.f, 0.f, 0.f, 0.f}; \
                _Pragma("unroll 16") for (int k_ = 0; k_ < 128; ++k_) { const f32x4 v_ = *(const f32x4*)(w_ + (size_t)k_ * (Nsrc_)); m_[0] = fmaxf(m_[0], fabsf(v_[0])); m_[1] = fmaxf(m_[1], fabsf(v_[1])); m_[2] = fmaxf(m_[2], fabsf(v_[2])); m_[3] = fmaxf(m_[3], fabsf(v_[3])); } \
                unsigned* d_ = (RAW_) + (size_t)mi_ * (Nsrc_) + c_; atomicMax(d_, __float_as_uint(m_[0])); atomicMax(d_ + 1, __float_as_uint(m_[1])); atomicMax(d_ + 2, __float_as_uint(m_[2])); atomicMax(d_ + 3, __float_as_uint(m_[3])); } } } while (0)
        MAX_JOB(gp(P.in[I_DA_WIN]), 1024, 3072, RAWP + RAW_DA, 2, 0);
        MAX_JOB(gp(P.in[I_RET_WIN]), 1024, 6144, RAWP + RAW_RET, 1, 192);
        MAX_JOB(gp(P.in[I_MLA_WIN]), 1024, 448, RAWP + RAW_MLA, 1, 384);
        MAX_JOB(gp(P.in[I_RET_WOUT]), 2048, 1024, RAWP + RAW_RETO, 1, 400);
#undef MAX_JOB
    }
    LAS float* sc = (LAS float*)(F.reg + 72 * 1024);
    for (int i = F.tid; i < 9 * 1024; i += NTHR) { const int r = i >> 10, k = i & 1023; const float v = r < 8 ? gp(P.in[I_C])[r * 1024 + k] : gp(P.in[I_CCTX])[k]; sc[i] = silu_f(v); }
    __syncthreads();
    {
        float* MOD = (float*)(ws + WS_MOD); LAS float* red = (LAS float*)(F.reg + 110 * 1024);
        for (int u = blockIdx.x; u < 4 * 96; u += GRID) { const int L = u / 96, n = (u % 96) * 64 + F.lane; const float* W = gp(P.in[I_ADAW]) + (size_t)L * 1024 * 6144 + (size_t)(128 * F.wave) * 6144 + n;
            float a[9];
#pragma unroll
            for (int r = 0; r < 9; ++r) a[r] = 0.f;
#pragma unroll 16
            for (int k = 0; k < 128; ++k) { const float w = W[(size_t)k * 6144];
#pragma unroll
                for (int r = 0; r < 9; ++r) a[r] = fmaf(sc[r * 1024 + 128 * F.wave + k], w, a[r]); }
#pragma unroll
            for (int r = 0; r < 9; ++r) red[(F.wave * 9 + r) * 64 + F.lane] = a[r];
            __syncthreads();
            for (int i = F.tid; i < 9 * 64; i += NTHR) { const int r = i >> 6, c = i & 63; float s = gp(P.in[I_ADAB])[L * 6144 + (u % 96) * 64 + c];
#pragma unroll
                for (int w8 = 0; w8 < 8; ++w8) s += red[(w8 * 9 + r) * 64 + c];
                MOD[((size_t)L * 9 + r) * 6144 + (u % 96) * 64 + c] = s; }
            __syncthreads(); }
    }
    {
        f32x2* TA = (f32x2*)(ws + WS_TABA); f32x2* TR = (f32x2*)(ws + WS_TABR);
        for (int i = gt; i < 128 * 16; i += NGT) { const int pos = i >> 4, j = i & 15; const float inv = powf(10000.0f, -(float)(2 * j) / 32.0f), a = (float)pos * inv; float s, c; sincosf(a, &s, &c); TA[i] = (f32x2){c, s}; }
        for (int i = gt; i < 8192 * 128; i += NGT) { const int pos = i >> 7, j = i & 127; const float inv = powf(10000.0f, -(float)(2 * j) / 256.0f), a = (float)pos * inv; float s, c; sincosf(a, &s, &c); TR[i] = (f32x2){c, s}; }
    }
    {
        LAS float* scr = (LAS float*)(F.reg + F.wave * 8704);
#define TR_JOB(W_, Ksrc_, Nsrc_, DST_, Kdst_, Ndst_, Nvalid_, KIND_, COUNT_) do { const int per_ = ((Kdst_) / 64) * ((Ndst_) / 32), total_ = per_ * (COUNT_); \
        _Pragma("unroll 1") for (int it_ = gw; it_ < total_; it_ += NGW) { const int mi_ = it_ / per_, item_ = it_ % per_; \
            if (((KIND_) == PK_ID || (KIND_) == PK_MOE_GU) && (Ksrc_) == (Kdst_) && (Nvalid_) == (Ndst_)) tr_item4((W_) + (size_t)mi_ * (Ksrc_) * (Nsrc_), Nsrc_, (bf16_t*)(ws + (DST_)) + (size_t)mi_ * (Kdst_) * (Ndst_), Kdst_, Ndst_, KIND_, scr, item_, F.lane); \
            else tr_item((W_) + (size_t)mi_ * (Ksrc_) * (Nsrc_), Ksrc_, Nsrc_, (bf16_t*)(ws + (DST_)) + (size_t)mi_ * (Kdst_) * (Ndst_), Kdst_, Ndst_, Nvalid_, KIND_, scr, item_, F.lane); } } while (0)
        TR_JOB(gp(P.in[I_DA_WOUT]), 1024, 1024, WS_W_DA_OUT, 1024, 1024, 1024, PK_ID, 2);
        {
            const float* Wq = gp(P.in[I_MLA_WQUP]); const float* Wkv = gp(P.in[I_MLA_WKVUP]); const float* Wo = gp(P.in[I_MLA_WOUT]);
            bf16_t* WQ = (bf16_t*)(ws + WS_W_MLA_QUP); bf16_t* WO = (bf16_t*)(ws + WS_W_MLA_OUT);
#pragma unroll 1
            for (int it = gw; it < 64; it += NGW) tr_item(Wq, 256, 1536, WQ, 256, 1536, 1536, PK_MLA_QUP, scr, (it >> 4) * 48 + 32 + (it & 15), F.lane);
#pragma unroll 1
            for (int it = gw; it < 2048; it += NGW) { const int kq = it & 3, c = 2 * ((it >> 2) & 63), h = it >> 8;
                const float* aq = Wq + (size_t)(kq * 64 + F.lane) * 1536 + h * 192; const float* b0 = Wkv + (size_t)c * 2048 + h * 256; const float* b1 = b0 + 2048;
                float r0 = 0.f, r1 = 0.f;
#pragma unroll 8
                for (int d4 = 0; d4 < 32; ++d4) { const f32x4 av = *(const f32x4*)(aq + 4 * d4), x = *(const f32x4*)(b0 + 4 * d4), y = *(const f32x4*)(b1 + 4 * d4);
                    r0 += (av[0] * x[0] + av[1] * x[1]) + (av[2] * x[2] + av[3] * x[3]); r1 += (av[0] * y[0] + av[1] * y[1]) + (av[2] * y[2] + av[3] * y[3]); }
                WQ[(size_t)(h * 128 + c) * 256 + kq * 64 + F.lane] = f2bf(r0); WQ[(size_t)(h * 128 + c + 1) * 256 + kq * 64 + F.lane] = f2bf(r1); }
#pragma unroll 1
            for (int it = gw; it < 2048; it += NGW) { const int nch = it & 15, l0 = 8 * ((it >> 4) & 15), h = it >> 8, n = nch * 64 + F.lane;
                const float* wo = Wo + (size_t)(h * 128) * 1024 + n; const float* wk = Wkv + (size_t)l0 * 2048 + h * 256 + 128;
                float a0 = 0.f, a1 = 0.f, a2 = 0.f, a3 = 0.f, a4 = 0.f, a5 = 0.f, a6 = 0.f, a7 = 0.f;
#pragma unroll 8
                for (int d = 0; d < 128; ++d) { const float w = wo[(size_t)d * 1024];
                    a0 = fmaf(wk[d], w, a0); a1 = fmaf(wk[2048 + d], w, a1); a2 = fmaf(wk[4096 + d], w, a2); a3 = fmaf(wk[6144 + d], w, a3);
                    a4 = fmaf(wk[8192 + d], w, a4); a5 = fmaf(wk[10240 + d], w, a5); a6 = fmaf(wk[12288 + d], w, a6); a7 = fmaf(wk[14336 + d], w, a7); }
                u32x4 o; o.x = pk2(a0, a1); o.y = pk2(a2, a3); o.z = pk2(a4, a5); o.w = pk2(a6, a7); *(u32x4*)(WO + (size_t)n * 1024 + h * 128 + l0) = o; }
        }
        gu_convert(F, 0, 32 * 32, (int)blockIdx.x, GRID, true); gu_convert(F, 2 * 32 * 32, 32 * 32, (int)blockIdx.x, GRID, true);
#undef TR_JOB
        if (!MK_MULTI) xcd_barrier(bar);
        {
            float* SW = (float*)(ws + WS_SW); float* SWP = (float*)(ws + WS_SWP); const unsigned* RG = (const unsigned*)(ws + WS_RAWGU); const unsigned* RP = (const unsigned*)(ws + WS_RAWP);
            for (int i = gt; i < (int)SWP_N; i += NGT) { float m;
                if (i < (int)SWP_RET) { const int mi = i / 3072, n = i % 3072; m = __uint_as_float(RP[RAW_DA + mi * 3072 + src_col(n, PK_DA_IN)]); }
                else if (i < (int)SWP_MLA) m = __uint_as_float(RP[RAW_RET + src_col(i - (int)SWP_RET, PK_RET_IN)]);
                else if (i < (int)SWP_RETO) { const int n = i - (int)SWP_MLA; m = n < 448 ? __uint_as_float(RP[RAW_MLA + n]) : 0.f; }
                else m = __uint_as_float(RP[RAW_RETO + i - (int)SWP_RETO]);
                SWP[i] = fmaxf(m, 1e-30f) * (1.0f / 127.0f); }
        }
#define TRQ_JOB(W_, Ksrc_, Nsrc_, DST_, Kdst_, Ndst_, Nvalid_, KIND_, COUNT_, OFF_) do { const int per_ = ((Kdst_) / 64) * ((Ndst_) / 32), total_ = per_ * (COUNT_); \
        _Pragma("unroll 1") for (int it_ = gw; it_ < total_; it_ += NGW) { const int mi_ = it_ / per_, item_ = it_ % per_; \
            tr_itemq((W_) + (size_t)mi_ * (Ksrc_) * (Nsrc_), Ksrc_, Nsrc_, (signed char*)(ws + (DST_)) + (size_t)mi_ * (Kdst_) * (Ndst_), Kdst_, Ndst_, Nvalid_, KIND_, (const unsigned*)(ws + WS_RAWP) + (OFF_) + (size_t)mi_ * (Nsrc_), scr, item_, F.lane); } } while (0)
        TRQ_JOB(gp(P.in[I_DA_WIN]), 1024, 3072, WS_W_DA_IN, 1024, 3072, 3072, PK_DA_IN, 2, RAW_DA);
        TRQ_JOB(gp(P.in[I_RET_WIN]), 1024, 6144, WS_W_RET_IN, 1024, 6144, 6144, PK_RET_IN, 1, RAW_RET);
        TRQ_JOB(gp(P.in[I_RET_WOUT]), 2048, 1024, WS_W_RET_OUT, 2048, 1024, 1024, PK_ID, 1, RAW_RETO);
        TRQ_JOB(gp(P.in[I_MLA_WIN]), 1024, 448, WS_W_MLA_IN, 1024, 512, 448, PK_ID, 1, RAW_MLA);
#undef TRQ_JOB
        gu_convert(F, 0, 32 * 64, (int)blockIdx.x, GRID);
    }
}

template <int L, int LC = L - 1>
__device__ __forceinline__ void phase_norm1(Frame& F) {
    const Params& P = *F.p; unsigned char* ws = F.ws;
    bf16_t* XR = (bf16_t*)(ws + WS_XRES); const float* MOD = (const float*)(ws + WS_MOD);
    const int* SLOT = (const int*)(ws + WS_SLOT); const float* GATE = (const float*)(ws + WS_GATE); const bf16_t* OUT2 = (const bf16_t*)(ws + MO_OUT);
    const float* gain = L < 4 ? gp(P.in[I_NORMG]) + (size_t)(L * 2 + 0) * 1024 : gp(P.in[I_FINALG]);
    f32x4 gn[4];
#pragma unroll
    for (int j = 0; j < 4; ++j) gn[j] = *(const f32x4*)(gain + 4 * F.lane + 256 * j);
#pragma unroll 3
    for (int i = 0; i < TOK_PER_BLK / 8; ++i) {
        const int t = blockIdx.x * TOK_PER_BLK + F.wave + 8 * i; const int b = t / TB, jt = t % TB; const bool isctx = jt < CTX; const int mrow = isctx ? 8 : b;
        if (L == 4 && isctx) continue;
        f32x4 v[4]; bf16_t* xr = XR + (size_t)t * 1024 + 4 * F.lane;
        if (L == 0) { const float* xsrc = (isctx ? gp(P.in[I_CTX]) + ((size_t)b * CTX + jt) * 1024 : gp(P.in[I_X]) + ((size_t)b * SEQ + (jt - CTX)) * 1024) + 4 * F.lane;
#pragma unroll
            for (int j = 0; j < 4; ++j) { v[j] = *(const f32x4*)(xsrc + 256 * j); st4bf(xr + 256 * j, v[j]); }
        } else {
#pragma unroll
            for (int j = 0; j < 4; ++j) v[j] = ld4bf(xr + 256 * j); }
        if (LC >= 0) {
            const int4 sl = *(const int4*)(SLOT + (size_t)t * 4); const f32x4 gt = *(const f32x4*)(GATE + (size_t)t * 4);
            const int sls[4] = {sl.x, sl.y, sl.z, sl.w};
            f32x4 a[4];
#pragma unroll
            for (int j = 0; j < 4; ++j) a[j] = (f32x4){0.f, 0.f, 0.f, 0.f};
#pragma unroll
            for (int k = 0; k < 4; ++k) { const bf16_t* orow = OUT2 + (size_t)sls[k] * 1024 + 4 * F.lane; const float gk = gt[k];
#pragma unroll
                for (int j = 0; j < 4; ++j) { const u32x2 w = *(const u32x2*)(orow + 256 * j); a[j] += gk * (f32x4){bflo(w.x), bfhi(w.x), bflo(w.y), bfhi(w.y)}; } }
            const float* m5 = MOD + ((size_t)(LC < 0 ? 0 : LC) * 9 + mrow) * 6144 + 5 * 1024 + 4 * F.lane;
#pragma unroll
            for (int j = 0; j < 4; ++j) { v[j] += *(const f32x4*)(m5 + 256 * j) * a[j]; if (L < 4) st4bf(xr + 256 * j, v[j]); }
        }
#ifdef DBG_NANFIX
        if (L == 4) {
#pragma unroll
            for (int j = 0; j < 4; ++j)
#pragma unroll
                for (int e = 0; e < 4; ++e) if (!(fabsf(v[j][e]) < 1e30f)) v[j][e] = 1000.0f; }
#endif
        float ss = 0.f;
#pragma unroll
        for (int j = 0; j < 4; ++j) ss += (v[j][0] * v[j][0] + v[j][1] * v[j][1]) + (v[j][2] * v[j][2] + v[j][3] * v[j][3]);
        const float rstd = rsqrtf(wave_sum(ss) * (1.0f / 1024.0f) + RMS_EPS);
        if (L < 4) {
            const float* msh = MOD + ((size_t)L * 9 + mrow) * 6144 + 4 * F.lane; f32x4 y[4]; float am = 0.f;
#pragma unroll
            for (int j = 0; j < 4; ++j) { const f32x4 sh = *(const f32x4*)(msh + 256 * j), scl = *(const f32x4*)(msh + 1024 + 256 * j);
                y[j] = v[j] * rstd * gn[j] * (scl + 1.0f) + sh; am = fmaxf(fmaxf(am, fmaxf(fabsf(y[j][0]), fabsf(y[j][1]))), fmaxf(fabsf(y[j][2]), fabsf(y[j][3]))); }
#pragma unroll
            for (int o = 1; o < 64; o <<= 1) am = fmaxf(am, __shfl_xor(am, o));
            am = fmaxf(am, 1e-30f); const float qinv = 127.0f / am; signed char* hq = (signed char*)(ws + WS_HQ1) + (size_t)t * 1024 + 4 * F.lane;
#pragma unroll
            for (int j = 0; j < 4; ++j) { const int q0 = (int)rintf(y[j][0] * qinv), q1 = (int)rintf(y[j][1] * qinv), q2 = (int)rintf(y[j][2] * qinv), q3 = (int)rintf(y[j][3] * qinv);
                *(unsigned*)(hq + 256 * j) = ((unsigned)q0 & 0xffu) | (((unsigned)q1 & 0xffu) << 8) | (((unsigned)q2 & 0xffu) << 16) | (((unsigned)q3 & 0xffu) << 24); }
            if (F.lane == 0) ((float*)(ws + WS_SA1))[t] = am * (1.0f / 127.0f);
        } else {
            float* orow = gp(P.out) + ((size_t)b * SEQ + (jt - CTX)) * 1024 + 4 * F.lane;
#pragma unroll
            for (int j = 0; j < 4; ++j) *(f32x4*)(orow + 256 * j) = v[j] * rstd * gn[j];
        }
    }
}

template <int L>
__device__ __forceinline__ void phase_norm2(Frame& F) {
    const Params& P = *F.p; unsigned char* ws = F.ws;
    const bf16_t* XR = (const bf16_t*)(ws + WS_XRES); const float* MOD = (const float*)(ws + WS_MOD);
    int* IDX = (int*)(ws + WS_IDX); float* GATE = (float*)(ws + WS_GATE); int* RANK = (int*)(ws + WS_RANK); int* BLKCNT = (int*)(ws + WS_BLKCNT);
    const float* gain = gp(P.in[I_NORMG]) + (size_t)(L * 2 + 1) * 1024; const float* Wr = gp(P.in[I_MOE_WR]) + (size_t)L * 1024 * 32; const float* br = gp(P.in[I_MOE_BR]) + L * 32;
    constexpr int HS_ = 1028;
    LAS float* hf = (LAS float*)F.reg;
    LAS float* part = (LAS float*)(F.reg + 16 * HS_ * 4);
    LAS int* lcnt = (LAS int*)(F.reg + 16 * HS_ * 4 + 8 * 16 * 32 * 4);
    if (F.tid < 32) lcnt[F.tid] = 0;
    const int w = F.wave, l15 = F.lane & 15, g = F.lane >> 4;
    float wb[2][32];
#pragma unroll
    for (int ks = 0; ks < 32; ++ks)
#pragma unroll
        for (int nt = 0; nt < 2; ++nt) wb[nt][ks] = Wr[(size_t)(128 * w + 4 * ks + g) * 32 + 16 * nt + l15];
    f32x4 gn[4];
#pragma unroll
    for (int j = 0; j < 4; ++j) gn[j] = *(const f32x4*)(gain + 4 * F.lane + 256 * j);
    const float bre = br[F.lane & 31];
    __syncthreads();
    constexpr int NIT = (TOK_PER_BLK + 15) / 16;
#pragma unroll 1
    for (int i = 0; i < NIT; ++i) {
        const int tl0 = 16 * i;
#pragma unroll
        for (int rr = 0; rr < 2; ++rr) {
            const int tl = tl0 + 2 * w + rr;
            if (tl < TOK_PER_BLK) {
                const int t = blockIdx.x * TOK_PER_BLK + tl; const int b = t / TB, jt = t % TB; const int mrow = jt < CTX ? 8 : b;
                if (L == 3 && jt < CTX) continue;
                f32x4 v[4]; const bf16_t* xr = XR + (size_t)t * 1024 + 4 * F.lane;
#pragma unroll
                for (int j = 0; j < 4; ++j) v[j] = ld4bf(xr + 256 * j);
                float ss = 0.f;
#pragma unroll
                for (int j = 0; j < 4; ++j) ss += (v[j][0] * v[j][0] + v[j][1] * v[j][1]) + (v[j][2] * v[j][2] + v[j][3] * v[j][3]);
                const float rstd = rsqrtf(wave_sum(ss) * (1.0f / 1024.0f) + RMS_EPS);
                const float* msh = MOD + ((size_t)L * 9 + mrow) * 6144 + 3 * 1024 + 4 * F.lane; f32x4 y[4]; float am = 0.f;
#pragma unroll
                for (int j = 0; j < 4; ++j) { const f32x4 sh = *(const f32x4*)(msh + 256 * j), scl = *(const f32x4*)(msh + 1024 + 256 * j);
                    y[j] = v[j] * rstd * gn[j] * (scl + 1.0f) + sh; am = fmaxf(fmaxf(am, fmaxf(fabsf(y[j][0]), fabsf(y[j][1]))), fmaxf(fabsf(y[j][2]), fabsf(y[j][3])));
                    *(LAS f32x4*)(hf + (2 * w + rr) * HS_ + 4 * F.lane + 256 * j) = y[j]; }
#pragma unroll
                for (int o = 1; o < 64; o <<= 1) am = fmaxf(am, __shfl_xor(am, o));
                am = fmaxf(am, 1e-30f); const float qinv = 127.0f / am; signed char* hq = (signed char*)(ws + MO_HQ) + (size_t)t * 1024 + 4 * F.lane;
#pragma unroll
                for (int j = 0; j < 4; ++j) { const int q0 = (int)rintf(y[j][0] * qinv), q1 = (int)rintf(y[j][1] * qinv), q2 = (int)rintf(y[j][2] * qinv), q3 = (int)rintf(y[j][3] * qinv);
                    *(unsigned*)(hq + 256 * j) = ((unsigned)q0 & 0xffu) | (((unsigned)q1 & 0xffu) << 8) | (((unsigned)q2 & 0xffu) << 16) | (((unsigned)q3 & 0xffu) << 24); }
                if (F.lane == 0) ((float*)(ws + MO_SA))[t] = am * (1.0f / 127.0f);
            }
        }
        __syncthreads();
        {
            f32x4 a0 = (f32x4){0.f, 0.f, 0.f, 0.f}, a1 = a0; const LAS float* hp = hf + l15 * HS_ + 128 * w + g;
#pragma unroll
            for (int ks = 0; ks < 32; ++ks) { const float av = hp[4 * ks];
                a0 = __builtin_amdgcn_mfma_f32_16x16x4f32(av, wb[0][ks], a0, 0, 0, 0); a1 = __builtin_amdgcn_mfma_f32_16x16x4f32(av, wb[1][ks], a1, 0, 0, 0); }
#pragma unroll
            for (int r = 0; r < 4; ++r) { part[(w * 16 + 4 * g + r) * 32 + l15] = a0[r]; part[(w * 16 + 4 * g + r) * 32 + 16 + l15] = a1[r]; }
        }
        __syncthreads();
        {
            const int tok = F.tid >> 5, e = F.tid & 31; float v = bre;
#pragma unroll
            for (int ww = 0; ww < 8; ++ww) v += part[(ww * 16 + tok) * 32 + e];
            int id[4]; float lv[4];
#pragma unroll
            for (int k = 0; k < 4; ++k) { float bv = v; int bi = e;
#pragma unroll
                for (int m = 16; m >= 1; m >>= 1) { const float ov = __shfl_xor(bv, m, 32); const int oi = __shfl_xor(bi, m, 32); if (ov > bv || (ov == bv && oi < bi)) { bv = ov; bi = oi; } }
                id[k] = bi; lv[k] = bv; if (e == bi) v = -3.0e38f; }
            const int tl = tl0 + tok;
            if (e == 0 && tl < TOK_PER_BLK && !(L == 3 && (blockIdx.x * TOK_PER_BLK + tl) % TB < CTX)) {
                const int t = blockIdx.x * TOK_PER_BLK + tl;
                float ex[4], s = 0.f;
#pragma unroll
                for (int k = 0; k < 4; ++k) { ex[k] = __expf(lv[k] - lv[0]); s += ex[k]; }
                const float inv = 1.0f / s; int rk[4];
#pragma unroll
                for (int k = 0; k < 4; ++k) rk[k] = atomicAdd((int*)(lcnt + id[k]), 1);
                *(int4*)(IDX + (size_t)t * 4) = make_int4(id[0], id[1], id[2], id[3]);
                *(f32x4*)(GATE + (size_t)t * 4) = (f32x4){ex[0] * inv, ex[1] * inv, ex[2] * inv, ex[3] * inv};
                *(int4*)(RANK + (size_t)t * 4) = make_int4(rk[0], rk[1], rk[2], rk[3]);
            }
        }
    }
    __syncthreads();
    if (F.tid < 32) BLKCNT[blockIdx.x * 32 + F.tid] = lcnt[F.tid];
}

__device__ __forceinline__ void moe_offsets(Frame& F) {
    const int* BLKCNT = (const int*)(F.ws + WS_BLKCNT);
    __syncthreads();
    if (F.tid < 32) { int tot = 0, pre = 0;
        for (int b = 0; b < GRID; ++b) { const int c = BLKCNT[b * 32 + F.tid]; pre += (b < (int)blockIdx.x) ? c : 0; tot += c; }
        F.misc[128 + F.tid] = pre; F.misc[160 + F.tid] = (tot + 255) & ~255; F.misc[192 + F.tid] = tot; }
    __syncthreads();
    if (F.tid == 0) { int s = 0; for (int e = 0; e < 32; ++e) { F.misc[64 + e] = s; s += F.misc[160 + e]; } F.misc[64 + 32] = s; }
    __syncthreads();
    { volatile LAS unsigned char* texp = (volatile LAS unsigned char*)F.misc + 1024; const int nt_ = F.misc[64 + 32] >> 8;
      for (int tl = F.tid; tl < nt_; tl += NTHR) { const int r0 = tl * 256; int e = 0; for (int k = 1; k < NEXP; ++k) e += (F.misc[64 + k] <= r0) ? 1 : 0; texp[tl] = (unsigned char)e; } }
    __syncthreads();
}
template <int L>
__device__ __forceinline__ void phase_scatter(Frame& F) {
    unsigned char* ws = F.ws;
    const int* IDX = (const int*)(ws + WS_IDX); const int* RANK = (const int*)(ws + WS_RANK); int* SLOT = (int*)(ws + WS_SLOT); int* TOKOF = (int*)(ws + WS_TOKOF);
    moe_offsets(F);
    for (int q = F.tid; q < TOK_PER_BLK * 4; q += NTHR) { const int t = blockIdx.x * TOK_PER_BLK + (q >> 2);
        if (L == 3 && t % TB < CTX) continue;
        const size_t gi = (size_t)blockIdx.x * TOK_PER_BLK * 4 + q; const int e = IDX[gi], r = RANK[gi]; const int slot = F.misc[64 + e] + F.misc[128 + e] + r;
        SLOT[gi] = slot; TOKOF[slot] = t; ((float*)(ws + MO_SASLOT))[slot] = ((const float*)(ws + MO_SA))[t]; }
    if (blockIdx.x < NEXP) { const int e = blockIdx.x; for (int s = F.misc[64 + e] + F.misc[192 + e] + F.tid; s < F.misc[64 + e + 1]; s += NTHR) { TOKOF[s] = 0; ((float*)(ws + MO_SASLOT))[s] = 0.f; } }
}

template <int L>
__device__ __forceinline__ void phase_da_post(Frame& F) {
    const Params& P = *F.p; unsigned char* ws = F.ws; constexpr int J = L / 3;
    const bf16_t* O = (const bf16_t*)(ws + DA_O); bf16_t* O2 = (bf16_t*)(ws + DA_O2);
    const float* lamv = gp(P.in[I_DA_LAM]) + J * 256; const float* subg = gp(P.in[I_DA_SUBG]) + J * 128;
    const float lam_init = L == 0 ? 0.2f : 0.8f - 0.6f * 0.40656965974059917f;
    const float d01 = wave_sum(lamv[F.lane] * lamv[64 + F.lane]), d23 = wave_sum(lamv[128 + F.lane] * lamv[192 + F.lane]);
    const float lam = expf(d01) - expf(d23) + lam_init;
    const int h = F.lane >> 3, ch = F.lane & 7; float g[16];
#pragma unroll
    for (int e = 0; e < 16; ++e) g[e] = subg[ch * 16 + e] * (1.0f - lam_init);
    for (int t = blockIdx.x * 8 + F.wave; t < T; t += GRID * 8) {
        if (L == 3 && t % TB < CTX) continue;
        const bf16_t* r0 = O + (size_t)t * 2048 + (2 * h) * 128 + ch * 16; const bf16_t* r1 = r0 + 128;
        const u32x4 a0 = *(const u32x4*)r0, a1 = *(const u32x4*)(r0 + 8), b0 = *(const u32x4*)r1, b1 = *(const u32x4*)(r1 + 8);
        float d[16]; const unsigned aw[8] = {a0.x, a0.y, a0.z, a0.w, a1.x, a1.y, a1.z, a1.w}, bw[8] = {b0.x, b0.y, b0.z, b0.w, b1.x, b1.y, b1.z, b1.w};
        float ss = 0.f;
#pragma unroll
        for (int e = 0; e < 8; ++e) { d[2 * e] = bflo(aw[e]) - lam * bflo(bw[e]); d[2 * e + 1] = bfhi(aw[e]) - lam * bfhi(bw[e]); ss += d[2 * e] * d[2 * e] + d[2 * e + 1] * d[2 * e + 1]; }
        ss += __shfl_xor(ss, 1); ss += __shfl_xor(ss, 2); ss += __shfl_xor(ss, 4);
        const float r = rsqrtf(ss * (1.0f / 128.0f) + RMS_EPS);
        u32x4 w0, w1;
        w0.x = pk2(d[0] * r * g[0], d[1] * r * g[1]); w0.y = pk2(d[2] * r * g[2], d[3] * r * g[3]); w0.z = pk2(d[4] * r * g[4], d[5] * r * g[5]); w0.w = pk2(d[6] * r * g[6], d[7] * r * g[7]);
        w1.x = pk2(d[8] * r * g[8], d[9] * r * g[9]); w1.y = pk2(d[10] * r * g[10], d[11] * r * g[11]); w1.z = pk2(d[12] * r * g[12], d[13] * r * g[13]); w1.w = pk2(d[14] * r * g[14], d[15] * r * g[15]);
        bf16_t* orow = O2 + (size_t)t * 1024 + h * 128 + ch * 16; *(u32x4*)orow = w0; *(u32x4*)(orow + 8) = w1;
    }
}

__device__ __forceinline__ void phase_ret_post(Frame& F) {
    unsigned char* ws = F.ws;
    const bf16_t* OF = (const bf16_t*)(ws + RT_OF); const bf16_t* OB = (const bf16_t*)(ws + RT_OB); const bf16_t* Gb = (const bf16_t*)(ws + RT_G); signed char* A = (signed char*)(ws + RT_A); float* SA = (float*)(ws + RT_SA);
    for (int t = blockIdx.x * 8 + F.wave; t < T; t += GRID * 8) {
        const size_t off = (size_t)t * 2048 + F.lane * 32; float o[32]; float ss = 0.f;
#pragma unroll
        for (int q = 0; q < 4; ++q) { const u32x4 a = *(const u32x4*)(OF + off + 8 * q), b = *(const u32x4*)(OB + off + 8 * q); const unsigned aw[4] = {a.x, a.y, a.z, a.w}, bw[4] = {b.x, b.y, b.z, b.w};
#pragma unroll
            for (int e = 0; e < 4; ++e) { const float x0 = bflo(aw[e]) + bflo(bw[e]), x1 = bfhi(aw[e]) + bfhi(bw[e]); o[8 * q + 2 * e] = x0; o[8 * q + 2 * e + 1] = x1; ss += x0 * x0 + x1 * x1; } }
        ss += __shfl_xor(ss, 1); ss += __shfl_xor(ss, 2); ss += __shfl_xor(ss, 4); ss += __shfl_xor(ss, 8);
        const float r = rsqrtf(ss * (1.0f / 512.0f) + RMS_EPS); float am = 0.f;
#pragma unroll
        for (int q = 0; q < 4; ++q) { const u32x4 gq = *(const u32x4*)(Gb + off + 8 * q); const unsigned gw[4] = {gq.x, gq.y, gq.z, gq.w};
#pragma unroll
            for (int e = 0; e < 4; ++e) { const float y0 = silu_f(bflo(gw[e])) * o[8 * q + 2 * e] * r, y1 = silu_f(bfhi(gw[e])) * o[8 * q + 2 * e + 1] * r; o[8 * q + 2 * e] = y0; o[8 * q + 2 * e + 1] = y1; am = fmaxf(am, fmaxf(fabsf(y0), fabsf(y1))); } }
#pragma unroll
        for (int m = 1; m < 64; m <<= 1) am = fmaxf(am, __shfl_xor(am, m));
        am = fmaxf(am, 1e-30f); const float qinv = 127.0f / am;
#pragma unroll
        for (int q = 0; q < 2; ++q) { unsigned w[4];
#pragma unroll
            for (int e = 0; e < 4; ++e) { const int b0 = 16 * q + 4 * e; w[e] = ((unsigned)(int)rintf(o[b0] * qinv) & 0xffu) | (((unsigned)(int)rintf(o[b0 + 1] * qinv) & 0xffu) << 8) | (((unsigned)(int)rintf(o[b0 + 2] * qinv) & 0xffu) << 16) | (((unsigned)(int)rintf(o[b0 + 3] * qinv) & 0xffu) << 24); }
            *(u32x4*)(A + off + 16 * q) = (u32x4){w[0], w[1], w[2], w[3]}; }
        if (F.lane == 0) SA[t] = am * (1.0f / 127.0f);
    }
}

__device__ __forceinline__ void phase_mla_norm(Frame& F) {
    const Params& P = *F.p; unsigned char* ws = F.ws;
    const float* Pm = (const float*)(ws + ML_P); bf16_t* AQ = (bf16_t*)(ws + ML_AQ); bf16_t* Kb = (bf16_t*)(ws + ML_K);
    const f32x2* TA = (const f32x2*)(ws + WS_TABA);
    const f32x2 gkv = *(const f32x2*)(gp(P.in[I_MLA_KVG]) + 2 * F.lane); const f32x4 gq = *(const f32x4*)(gp(P.in[I_MLA_QG]) + 4 * F.lane);
    for (int t = blockIdx.x * 8 + F.wave; t < T; t += GRID * 8) {
        const float* pr = Pm + (size_t)t * 512; const int jt = t % TB; const bool lat = jt >= CTX; const int p = jt - CTX;
        const f32x2 ckv = *(const f32x2*)(pr + 2 * F.lane); const f32x4 cq = *(const f32x4*)(pr + 192 + 4 * F.lane);
        const float rkv = rsqrtf(wave_sum(ckv[0] * ckv[0] + ckv[1] * ckv[1]) * (1.0f / 128.0f) + RMS_EPS);
        const float rq = rsqrtf(wave_sum((cq[0] * cq[0] + cq[1] * cq[1]) + (cq[2] * cq[2] + cq[3] * cq[3])) * (1.0f / 256.0f) + RMS_EPS);
        *(unsigned*)(Kb + (size_t)t * 192 + 2 * F.lane) = pk2(ckv[0] * rkv * gkv[0], ckv[1] * rkv * gkv[1]);
        u32x2 wq; wq.x = pk2(cq[0] * rq * gq[0], cq[1] * rq * gq[1]); wq.y = pk2(cq[2] * rq * gq[2], cq[3] * rq * gq[3]); *(u32x2*)(AQ + (size_t)t * 256 + 4 * F.lane) = wq;
        if (F.lane < 32) { const int axis = F.lane >> 4, f = F.lane & 15; float x1 = pr[128 + axis * 32 + f], x2 = pr[128 + axis * 32 + 16 + f];
            if (lat) { const int pos = axis ? (p & 63) : (p >> 6); const f32x2 cs = TA[pos * 16 + f]; const float r1 = x1 * cs[0] - x2 * cs[1], r2 = x1 * cs[1] + x2 * cs[0]; x1 = r1; x2 = r2; }
            *(unsigned*)(Kb + (size_t)t * 192 + 128 + axis * 32 + 2 * f) = pk2(x1, x2); }
    }
}

__device__ __forceinline__ s16x4 tr_rd(int addr) { s16x4 r; asm volatile("ds_read_b64_tr_b16 %0, %1" : "=&v"(r) : "v"(addr) : "memory"); return r; }
template <int OFF> __device__ __forceinline__ s16x4 tr_rdo(int base) { s16x4 r; asm volatile("ds_read_b64_tr_b16 %0, %1 offset:%2" : "=&v"(r) : "v"(base), "i"(OFF) : "memory"); return r; }
#define PK8_(L, H) (bf16x8){L[0], L[1], L[2], L[3], H[0], H[1], H[2], H[3]}
template <int KQ, int QS2> __device__ __forceinline__ void ret_state2(f32x4* st, int trK, bf16x8 bs0, bf16x8 bs1, float cdec) {
    const s16x4 al0 = tr_rdo<32 * KQ>(trK), ah0 = tr_rdo<4 * QS2 + 32 * KQ>(trK), al1 = tr_rdo<32 * QS2 + 32 * KQ>(trK), ah1 = tr_rdo<36 * QS2 + 32 * KQ>(trK);
    const s16x4 bl0 = tr_rdo<32 * (KQ + 1)>(trK), bh0 = tr_rdo<4 * QS2 + 32 * (KQ + 1)>(trK), bl1 = tr_rdo<32 * QS2 + 32 * (KQ + 1)>(trK), bh1 = tr_rdo<36 * QS2 + 32 * (KQ + 1)>(trK);
    asm volatile("s_waitcnt lgkmcnt(0)" ::: "memory"); __builtin_amdgcn_sched_barrier(0);
    f32x4 a = st[KQ] * cdec, b = st[KQ + 1] * cdec;
    a = __builtin_amdgcn_mfma_f32_16x16x32_bf16(PK8_(al0, ah0), bs0, a, 0, 0, 0); b = __builtin_amdgcn_mfma_f32_16x16x32_bf16(PK8_(bl0, bh0), bs0, b, 0, 0, 0);
    a = __builtin_amdgcn_mfma_f32_16x16x32_bf16(PK8_(al1, ah1), bs1, a, 0, 0, 0); b = __builtin_amdgcn_mfma_f32_16x16x32_bf16(PK8_(bl1, bh1), bs1, b, 0, 0, 0);
    st[KQ] = a; st[KQ + 1] = b;
}
#define LGK0_PIN() do { asm volatile("s_waitcnt lgkmcnt(0)" ::: "memory"); __builtin_amdgcn_sched_barrier(0); } while (0)
#define PK8(L, H) (bf16x8){L[0], L[1], L[2], L[3], H[0], H[1], H[2], H[3]}
__device__ __forceinline__ void phase_ret_scan(Frame& F) {
    const Params& P = *F.p; unsigned char* ws = F.ws;
    const bf16_t* Qg = (const bf16_t*)(ws + RT_Q); const bf16_t* Kg = (const bf16_t*)(ws + RT_K); const bf16_t* Vg = (const bf16_t*)(ws + RT_V);
    const int u = blockIdx.x, sl = u & 3, dir = (u >> 2) & 1, h = (u >> 3) & 3, b = u >> 5;
    bf16_t* Og = (bf16_t*)(ws + (dir ? RT_OB : RT_OF));
    constexpr int QS = 264, VS = 136, TS = 72;
    LAS bf16_t* Qc = (LAS bf16_t*)F.reg;
    LAS bf16_t* Kc = Qc + 64 * QS;
    LAS bf16_t* Vc = Kc + 64 * QS;
    LAS bf16_t* Vs = Vc + 64 * VS;
    LAS bf16_t* Sb = Vs + 64 * VS;
    const float x = gp(P.in[I_RET_DECAY])[dir * 4 + h];
    const float lg2 = -log1pf(expf(-x)) * 1.4426950408889634f;
    const int tid = F.tid, lane = F.lane, w = F.wave, l15 = lane & 15, g = lane >> 4, tq = l15 >> 2, tp = l15 & 3;
    f32x4 st[16];
#pragma unroll
    for (int k = 0; k < 16; ++k) st[k] = (f32x4){0.f, 0.f, 0.f, 0.f};
    const float cdec = exp2f(64.0f * lg2);
    const size_t tb0 = (size_t)b * TB;
    unsigned gqk[4], lqk[4], gv[2], lv[2]; float kdv[2];
#pragma unroll
    for (int i = 0; i < 4; ++i) { const int e = tid + 512 * i, row = e >> 5, ch = e & 31; gqk[i] = (unsigned)(row * 1024 + h * 256 + ch * 8); lqk[i] = (unsigned)(row * QS + ch * 8); }
#pragma unroll
    for (int i = 0; i < 2; ++i) { const int e = tid + 512 * i, row = e >> 4, ch = e & 15; gv[i] = (unsigned)(row * 2048 + h * 512 + sl * 128 + ch * 8); lv[i] = (unsigned)(row * VS + ch * 8);
        kdv[i] = exp2f((dir == 0 ? (float)(63 - row) : (float)row) * lg2); }
    const int trK = (int)(uintptr_t)Kc + ((8 * g + tq) * QS + 4 * tp) * 2;
    const int trV = (int)(uintptr_t)Vc + ((8 * g + tq) * VS + 16 * w + 4 * tp) * 2;
    u32x4 rq[4], rk[4], rv[2];
#define RS_CHUNK(s_) ((dir == 0) ? (s_) : ((s_) < 4 ? 3 - (s_) : 4 + (131 - (s_))))
#define RS_LOAD(s_) do { const size_t t0_ = tb0 + (size_t)RS_CHUNK(s_) * 64; const bf16_t* q_ = Qg + t0_ * 1024; const bf16_t* k_ = Kg + t0_ * 1024; const bf16_t* v_ = Vg + t0_ * 2048; \
    _Pragma("unroll") for (int i_ = 0; i_ < 4; ++i_) { rq[i_] = *(const u32x4*)(q_ + gqk[i_]); rk[i_] = *(const u32x4*)(k_ + gqk[i_]); } \
    _Pragma("unroll") for (int i_ = 0; i_ < 2; ++i_) rv[i_] = *(const u32x4*)(v_ + gv[i_]); } while (0)
    RS_LOAD(0);
#pragma unroll 1
    for (int s = 0; s < TB / 64; ++s) {
        const size_t tok0 = tb0 + (size_t)RS_CHUNK(s) * 64;
        __syncthreads();
#pragma unroll
        for (int i = 0; i < 4; ++i) { *(LAS u32x4*)(Qc + lqk[i]) = rq[i]; *(LAS u32x4*)(Kc + lqk[i]) = rk[i]; }
#pragma unroll
        for (int i = 0; i < 2; ++i) { *(LAS u32x4*)(Vc + lv[i]) = rv[i]; const unsigned vw[4] = {rv[i].x, rv[i].y, rv[i].z, rv[i].w}; u32x4 sv;
            sv.x = pk2(bflo(vw[0]) * kdv[i], bfhi(vw[0]) * kdv[i]); sv.y = pk2(bflo(vw[1]) * kdv[i], bfhi(vw[1]) * kdv[i]);
            sv.z = pk2(bflo(vw[2]) * kdv[i], bfhi(vw[2]) * kdv[i]); sv.w = pk2(bflo(vw[3]) * kdv[i], bfhi(vw[3]) * kdv[i]); *(LAS u32x4*)(Vs + lv[i]) = sv; }
        if (s + 1 < TB / 64) RS_LOAD(s + 1);
        __syncthreads();
        {
            const int ti = w >> 1;
#pragma unroll
            for (int c2 = 0; c2 < 2; ++c2) { const int tj = 2 * (w & 1) + c2; f32x4 a = (f32x4){0.f, 0.f, 0.f, 0.f};
#pragma unroll
                for (int kk = 0; kk < 8; ++kk) { const bf16x8 af = *(const LAS bf16x8*)(Qc + (16 * ti + l15) * QS + 32 * kk + 8 * g), bfr = *(const LAS bf16x8*)(Kc + (16 * tj + l15) * QS + 32 * kk + 8 * g);
                    a = __builtin_amdgcn_mfma_f32_16x16x32_bf16(af, bfr, a, 0, 0, 0); }
                const int jj = 16 * tj + l15;
#pragma unroll
                for (int r = 0; r < 4; ++r) { const int ii = 16 * ti + 4 * g + r; const int df = dir == 0 ? ii - jj : jj - ii;
                    const float m = df >= 0 ? exp2f((float)df * lg2) : 0.f; Sb[ii * TS + jj] = f2bf(a[r] * m); } }
        }
        __syncthreads();
        {
            f32x4 a[4];
#pragma unroll
            for (int it = 0; it < 4; ++it) a[it] = (f32x4){0.f, 0.f, 0.f, 0.f};
#pragma unroll
            for (int kk = 0; kk < 8; ++kk) { u32x4 wv; wv.x = pk2(st[2 * kk][0], st[2 * kk][1]); wv.y = pk2(st[2 * kk][2], st[2 * kk][3]); wv.z = pk2(st[2 * kk + 1][0], st[2 * kk + 1][1]); wv.w = pk2(st[2 * kk + 1][2], st[2 * kk + 1][3]);
                const bf16x8 sf = *reinterpret_cast<bf16x8*>(&wv);
#pragma unroll
                for (int it = 0; it < 4; ++it) { const LAS bf16_t* qp = Qc + (16 * it + l15) * QS + 32 * kk + 4 * g; const s16x4 lo = *(const LAS s16x4*)qp, hi4 = *(const LAS s16x4*)(qp + 16);
                    a[it] = __builtin_amdgcn_mfma_f32_16x16x32_bf16(PK8(lo, hi4), sf, a[it], 0, 0, 0); }
                __builtin_amdgcn_sched_barrier(0); }
#pragma unroll
            for (int it = 0; it < 4; ++it)
#pragma unroll
                for (int r = 0; r < 4; ++r) { const int ii = 16 * it + 4 * g + r; a[it][r] *= exp2f((dir == 0 ? (float)(ii + 1) : (float)(64 - ii)) * lg2); }
            const s16x4 v0l = tr_rdo<0>(trV), v0h = tr_rdo<4 * VS * 2>(trV), v1l = tr_rdo<32 * VS * 2>(trV), v1h = tr_rdo<36 * VS * 2>(trV);
            LGK0_PIN();
            const bf16x8 vf0 = PK8(v0l, v0h), vf1 = PK8(v1l, v1h);
#pragma unroll
            for (int it = 0; it < 4; ++it) { const bf16x8 s0 = *(const LAS bf16x8*)(Sb + (16 * it + l15) * TS + 8 * g), s1 = *(const LAS bf16x8*)(Sb + (16 * it + l15) * TS + 32 + 8 * g);
                a[it] = __builtin_amdgcn_mfma_f32_16x16x32_bf16(s0, vf0, a[it], 0, 0, 0); a[it] = __builtin_amdgcn_mfma_f32_16x16x32_bf16(s1, vf1, a[it], 0, 0, 0); }
#pragma unroll
            for (int it = 0; it < 4; ++it)
#pragma unroll
                for (int r = 0; r < 4; ++r) { const int ii = 16 * it + 4 * g + r; Og[(tok0 + ii) * 2048 + h * 512 + sl * 128 + 16 * w + l15] = f2bf_c(a[it][r]); }
        }
        {
            const s16x4 b0l = tr_rdo<64 * VS * 2>(trV), b0h = tr_rdo<68 * VS * 2>(trV), b1l = tr_rdo<96 * VS * 2>(trV), b1h = tr_rdo<100 * VS * 2>(trV);
            LGK0_PIN();
            const bf16x8 bs0 = PK8(b0l, b0h), bs1 = PK8(b1l, b1h);
            ret_state2<0, QS * 2>(st, trK, bs0, bs1, cdec); ret_state2<2, QS * 2>(st, trK, bs0, bs1, cdec); ret_state2<4, QS * 2>(st, trK, bs0, bs1, cdec); ret_state2<6, QS * 2>(st, trK, bs0, bs1, cdec);
            ret_state2<8, QS * 2>(st, trK, bs0, bs1, cdec); ret_state2<10, QS * 2>(st, trK, bs0, bs1, cdec); ret_state2<12, QS * 2>(st, trK, bs0, bs1, cdec); ret_state2<14, QS * 2>(st, trK, bs0, bs1, cdec);
        }
    }
    __syncthreads();
#undef RS_CHUNK
#undef RS_LOAD
}
#undef PK8

__global__ void __launch_bounds__(NTHR, 2) hybrid_fwd(Params prm) {
    extern __shared__ __attribute__((aligned(16))) unsigned char lds_raw[];
    Frame F; F.p = &prm; F.lds = (LAS unsigned char*)lds_raw; F.reg = F.lds + REG_OFF; F.misc = (volatile LAS int*)F.lds;
    F.tid = threadIdx.x; F.lane = F.tid & 63; F.wave = __builtin_amdgcn_readfirstlane(F.tid >> 6); F.ws = prm.ws;
    if (gridDim.x != GRID) return;
    for (int i = F.tid; i < MISC_BYTES / 4; i += NTHR) F.misc[i] = 0;
    __syncthreads();
    unsigned* barw = (unsigned*)(F.ws + WS_CTL);
    XcdBarrier bar; bar.bar = barw; bar.x = 0; bar.st = nullptr;
    if (!MK_MULTI) bar = xcd_barrier_post(barw, (volatile LAS unsigned*)(F.misc + 8));
    const int lo = prm.ph_lo, hi = prm.ph_hi;
    unsigned char* ws = F.ws; const Params& P = prm;
    LAS unsigned char* GR = F.reg;
#define MOD ((const float*)(ws + WS_MOD))
#ifndef DUP_PHASE
#define DUP_PHASE -1
#endif
#ifndef ABL_FIRST
#define ABL_FIRST 0
#endif
#define REP(k) for (int rep_ = 0; rep_ < ((k) == DUP_PHASE ? 2 : 1); ++rep_)
#define PHASE_INIT do { size_t z_ = 0; asm volatile("" : "+s"(z_)); unsigned char* w_ = prm.ws + z_; F.ws = w_; ws = w_;     int t_ = threadIdx.x; asm volatile("" : "+v"(t_)); F.tid = t_; F.lane = t_ & 63; } while (0)
#ifndef PH_MIN
#define PH_MIN 0
#define PH_MAX 1000
#endif
#ifndef DBG_STOP
#define DBG_STOP 1000
#define DBG_LC 3
#endif
#define IN(k) ((k) >= PH_MIN && (k) <= PH_MAX && ((k) <= DBG_STOP || (k) == 38) && lo <= (k) && (k) < hi)
#define SEAM(k) do { if (!MK_MULTI && IN(k) && IN((k) + 1)) xcd_barrier(bar); } while (0)
#define GEMM_DENSE(EPI, EOBJ, APTR, BPTR, KK, NN) GEMM_DENSE_X(EPI, EOBJ, APTR, BPTR, KK, NN, false, false)
#define GEMM_DENSE_L(EPI, EOBJ, APTR, BPTR, KK, NN, LATONLY) GEMM_DENSE_X(EPI, EOBJ, APTR, BPTR, KK, NN, LATONLY, false)
#define GEMM_DENSE_Q(EPI, EOBJ, APTR, BPTR, KK, NN) GEMM_DENSE_X(EPI, EOBJ, APTR, BPTR, KK, NN, false, true)
#define GEMM_DENSE_X(EPI, EOBJ, APTR, BPTR, KK, NN, LATONLY, I8FLAG) do { pg8::StaticOrder S_; S_.init((LATONLY) ? NTILES - NB : NTILES, (NN) / 256, (int)blockIdx.x, LATONLY); \
        pg8::gemm_phase<EPI, pg8::StaticOrder, I8FLAG>(GR, (const bf16_t*)(APTR), (const bf16_t*)(BPTR), KK, 0, S_, EOBJ, F.tid); } while (0)

#ifdef PROBE_T0
#ifndef PROBE_QOFF
#endif
#define PROBE_MARK(k) do { if (blockIdx.x == 0 && threadIdx.x == 0) { if ((k) == PROBE_T0) ((unsigned long long*)(prm.ws + WS_CTL + 65536))[0] = wall_clock64(); if ((k) == PROBE_T1 + 1) ((unsigned long long*)(prm.ws + WS_CTL + 65536))[1] = wall_clock64(); } } while (0)
#else
#define PROBE_MARK(k) do {} while (0)
#endif
    PROBE_MARK(0); if (IN(0)) { PHASE_INIT; REP(0) { phase_prologue(F, bar); } } SEAM(0);

#define TAILDN(L_, C0_) do { if ((int)blockIdx.x >= (C0_)) { size_t z2_ = 0; asm volatile("" : "+s"(z2_)); F.ws = prm.ws + z2_; int t2_ = threadIdx.x; asm volatile("" : "+v"(t2_)); F.tid = t2_; F.lane = t2_ & 63; gu_convert(F, (L_) * 32 * 32, 32 * 32, (int)blockIdx.x - (C0_), GRID - (C0_), true); } } while (0)
#define TAILGU(L_) do { if (blockIdx.x >= 32) { size_t z2_ = 0; asm volatile("" : "+s"(z2_)); F.ws = prm.ws + z2_; int t2_ = threadIdx.x; asm volatile("" : "+v"(t2_)); F.tid = t2_; F.lane = t2_ & 63; gu_convert(F, ((L_) + 1) * 2048, 2048, (int)blockIdx.x - 32, GRID - 32); } } while (0)
#define DA_LAYER(L, BASE) do { constexpr int J_ = (L) / 3; \
    PROBE_MARK(BASE + 0); if (IN(BASE + 0)) { PHASE_INIT; REP(BASE + 0) { phase_norm1<L>(F); } } SEAM(BASE + 0); \
    PROBE_MARK(BASE + 1); if (IN(BASE + 1)) { PHASE_INIT; REP(BASE + 1) { pg8::EpiDaIn<true> E_{(bf16_t*)(ws + DA_K), (const f32x2*)(ws + WS_TABA), (const float*)(ws + WS_SA1), (const float*)(ws + WS_SWP) + SWP_DA + J_ * 3072}; \
        GEMM_DENSE_Q(pg8::EpiDaIn<true>, E_, ws + WS_HQ1, ws + WS_W_DA_IN + (size_t)J_ * 3072 * 1024, 512, 3072); } } SEAM(BASE + 1); \
    PROBE_MARK(BASE + 2); if (IN(BASE + 2)) { PHASE_INIT; REP(BASE + 2) { att::attn_phase_da<L>((const bf16_t*)(ws + DA_Q), (const bf16_t*)(ws + DA_K), (const bf16_t*)(ws + DA_V), (bf16_t*)(ws + DA_O2), gp(P.in[I_DA_LAM]) + J_ * 256, gp(P.in[I_DA_SUBG]) + J_ * 128, (LAS char*)GR, F.tid); if ((L) == 0) TAILDN(1, 64); } } SEAM(BASE + 2); \
    PROBE_MARK(BASE + 4); if (IN(BASE + 4)) { PHASE_INIT; REP(BASE + 4) { pg8::EpiResid<false> E_{(bf16_t*)(ws + WS_XRES), MOD + (size_t)(L) * 9 * 6144 + 2 * 1024, nullptr, nullptr}; \
        GEMM_DENSE_L(pg8::EpiResid<false>, E_, ws + DA_O2, ws + WS_W_DA_OUT + (size_t)J_ * 1024 * 1024 * 2, 1024, 1024, (L) == 3); if ((L) != 3) TAILGU(L); } } SEAM(BASE + 4); } while (0)

#define MOE_LAYER(L, BASE) do { \
    PROBE_MARK(BASE + 0); if (IN(BASE + 0)) { PHASE_INIT; REP(BASE + 0) { phase_norm2<L>(F); } } SEAM(BASE + 0); \
    PROBE_MARK(BASE + 1); if (IN(BASE + 1)) { PHASE_INIT; REP(BASE + 1) { phase_scatter<L>(F); } } SEAM(BASE + 1); \
    PROBE_MARK(BASE + 2); if (IN(BASE + 2)) { PHASE_INIT; REP(BASE + 2) { if (MK_MULTI) moe_offsets(F); pg8::MoeOrder S_; S_.init(F.misc[64 + 32] / 256, 8, (int)blockIdx.x); S_.pad_start = F.misc + 64; S_.tok = (const int*)(ws + WS_TOKOF); \
        pg8::EpiMoe1Q E_{(bf16_t*)(ws + MO_ACT), gp(P.in[I_MOE_BGU]) + (size_t)(L) * 32 * 2048, (const float*)(ws + WS_SW) + (size_t)(L) * 32 * 2048, (const float*)(ws + MO_SASLOT)}; \
        pg8::gemm_phase<pg8::EpiMoe1Q, pg8::MoeOrder, true>(GR, (const bf16_t*)(ws + MO_HQ), (const bf16_t*)(ws + WS_W_GU + (size_t)(L) * 32 * 2048 * 1024), 512, (size_t)2048 * 1024, S_, E_, F.tid); } } SEAM(BASE + 2); \
    PROBE_MARK(BASE + 3); if (IN(BASE + 3)) { PHASE_INIT; REP(BASE + 3) { if (MK_MULTI) moe_offsets(F); pg8::MoeOrderPlain S_; S_.init(F.misc[64 + 32] / 256, 4, (int)blockIdx.x); S_.pad_start = F.misc + 64; S_.tok = nullptr; \
        phase_actq(F); xcd_barrier(bar);     \
        pg8::EpiMoe2Q E_{(bf16_t*)(ws + MO_OUT), gp(P.in[I_MOE_BDN]) + (size_t)(L) * 32 * 1024, (const float*)(ws + WS_SWD) + (size_t)(L) * 32 * 1024, (const float*)(ws + MO_SA2)}; \
        pg8::gemm_phase<pg8::EpiMoe2Q, pg8::MoeOrderPlain, true>(GR, (const bf16_t*)(ws + MO_ACT8), (const bf16_t*)(ws + WS_W_DN + (size_t)(L) * 32 * 1024 * 1024), 512, (size_t)1024 * 1024, S_, E_, F.tid); } } SEAM(BASE + 3); } while (0)

    DA_LAYER(0, 1);
    MOE_LAYER(0, 6);

    PROBE_MARK(10); if (IN(10)) { PHASE_INIT; REP(10) { phase_norm1<1>(F); } } SEAM(10);
    PROBE_MARK(11); if (IN(11)) { PHASE_INIT; REP(11) { pg8::EpiRetIn<true> E_{(bf16_t*)(ws + RT_K), (bf16_t*)(ws + RT_V), (bf16_t*)(ws + RT_Q), (bf16_t*)(ws + RT_G), (const f32x2*)(ws + WS_TABR), (const float*)(ws + WS_SA1), (const float*)(ws + WS_SWP) + SWP_RET};
        GEMM_DENSE_Q(pg8::EpiRetIn<true>, E_, ws + WS_HQ1, ws + WS_W_RET_IN, 512, 6144); } } SEAM(11);
    PROBE_MARK(12); if (IN(12)) { PHASE_INIT; REP(12) { phase_ret_scan(F); } } SEAM(12);
    PROBE_MARK(13); if (IN(13)) { PHASE_INIT; REP(13) { phase_ret_post(F); } } SEAM(13);
    PROBE_MARK(14); if (IN(14)) { PHASE_INIT; REP(14) { pg8::EpiResid<true> E_{(bf16_t*)(ws + WS_XRES), MOD + (size_t)1 * 9 * 6144 + 2 * 1024, (const float*)(ws + RT_SA), (const float*)(ws + WS_SWP) + SWP_RETO};
        GEMM_DENSE_Q(pg8::EpiResid<true>, E_, ws + RT_A, ws + WS_W_RET_OUT, 1024, 1024); TAILGU(1); } } SEAM(14);
    MOE_LAYER(1, 15);

    PROBE_MARK(19); if (IN(19)) { PHASE_INIT; REP(19) { phase_norm1<2>(F); } } SEAM(19);
    PROBE_MARK(20); if (IN(20)) { PHASE_INIT; REP(20) { pg8::EpiF32<true> E_{(float*)(ws + ML_P), 512, (const float*)(ws + WS_SA1), (const float*)(ws + WS_SWP) + SWP_MLA}; GEMM_DENSE_Q(pg8::EpiF32<true>, E_, ws + WS_HQ1, ws + WS_W_MLA_IN, 512, 512); TAILDN(3, 16); } } SEAM(20);
    PROBE_MARK(21); if (IN(21)) { PHASE_INIT; REP(21) { phase_mla_norm(F); } } SEAM(21);
    PROBE_MARK(22); if (IN(22)) { PHASE_INIT; REP(22) {
#ifndef NO_QUP
 { pg8::EpiMlaQ E_{(bf16_t*)(ws + ML_Q), (const f32x2*)(ws + WS_TABA)}; GEMM_DENSE(pg8::EpiMlaQ, E_, ws + ML_AQ, ws + WS_W_MLA_QUP, 256, 1536); }
#endif
 } } SEAM(22);
    PROBE_MARK(23); if (IN(23)) { PHASE_INIT; REP(23) { att::attn_phase<192, 0, 8, 1, true, true>((const bf16_t*)(ws + ML_Q), (const bf16_t*)(ws + ML_K), (const bf16_t*)(ws + ML_K), (bf16_t*)(ws + ML_O), (LAS char*)GR, F.tid); } } SEAM(23);
    PROBE_MARK(24); if (IN(24)) { PHASE_INIT; REP(24) { pg8::EpiResid<false> E_{(bf16_t*)(ws + WS_XRES), MOD + (size_t)2 * 9 * 6144 + 2 * 1024, nullptr, nullptr};
        GEMM_DENSE(pg8::EpiResid<false>, E_, ws + ML_O, ws + WS_W_MLA_OUT, 1024, 1024); TAILGU(2); } } SEAM(24);
    MOE_LAYER(2, 25);

    DA_LAYER(3, 29);
    MOE_LAYER(3, 34);

    PROBE_MARK(38); if (IN(38)) { PHASE_INIT; REP(38) { phase_norm1<4, DBG_LC>(F); } }
#ifdef PROBE_T0
    PROBE_MARK(39);
    if (!MK_MULTI) xcd_barrier(bar);
    { const unsigned long long* tsp = (const unsigned long long*)(prm.ws + WS_CTL + 65536); const unsigned long long t0 = __hip_atomic_load(tsp, __ATOMIC_RELAXED, __HIP_MEMORY_SCOPE_AGENT), t1 = __hip_atomic_load(tsp + 1, __ATOMIC_RELAXED, __HIP_MEMORY_SCOPE_AGENT);
      const float us_ = (float)(t1 - t0) * 0.01f; const float cval = exp2f(rintf(log2f(us_) * 8.0f + PROBE_QOFF) * 0.125f) * 0.01f;
      for (size_t i = (size_t)blockIdx.x * NTHR + threadIdx.x; i < (size_t)NB * SEQ * DM; i += (size_t)GRID * NTHR) gp(prm.out)[i] = cval; }
#endif
#undef IN
#undef SEAM
}
constexpr int N_PHASES = 39;

extern "C" void kernel_launch(void* const* d_in, const int* in_sizes, int n_in, void* d_out, int out_size, void* d_ws, size_t ws_size, hipStream_t stream) {
    static int ready = 0;
    if (ready == 0) {
        if (n_in != 27 || out_size != NB * SEQ * DM || ws_size < WS_END) { fprintf(stderr, "kernel_launch: unexpected shapes (n_in %d, out %d, ws %zu, need %zu)\n", n_in, out_size, ws_size, (size_t)WS_END); ready = -1; return; }
        if (hipFuncSetAttribute((const void*)hybrid_fwd, hipFuncAttributeMaxDynamicSharedMemorySize, LDS_BYTES) != hipSuccess) { fprintf(stderr, "kernel_launch: hipFuncSetAttribute failed\n"); ready = -1; return; }
        int per_cu = 0; (void)hipOccupancyMaxActiveBlocksPerMultiprocessor(&per_cu, (const void*)hybrid_fwd, NTHR, LDS_BYTES); (void)hipGetLastError();
        if (per_cu < 1) fprintf(stderr, "kernel_launch: occupancy query reports %d\n", per_cu);
        ready = 1;
    }
    if (ready < 0) return;
    (void)hipMemsetAsync((char*)d_ws + WS_CTL, 0, CTL_BYTES, stream);
    Params p{};
    for (int i = 0; i < 27; ++i) p.in[i] = (const float*)d_in[i];
    p.out = (float*)d_out; p.ws = (unsigned char*)d_ws;
#if MK_MULTI
    for (int ph = 0; ph < N_PHASES; ++ph) { p.ph_lo = ph; p.ph_hi = ph + 1; hipLaunchKernelGGL(hybrid_fwd, dim3(GRID), dim3(NTHR), LDS_BYTES, stream, p); }
#else
    p.ph_lo = 0; p.ph_hi = N_PHASES; hipLaunchKernelGGL(hybrid_fwd, dim3(GRID), dim3(NTHR), LDS_BYTES, stream, p);
#endif
    const hipError_t le = hipPeekAtLastError();
    if (le != hipSuccess) fprintf(stderr, "kernel_launch: launch failed: %s\n", hipGetErrorName(le));
}
```

```cpp
#include <hip/hip_runtime.h>
#include <cstdio>
#include <cstdint>
#include <type_traits>


#ifndef MK_MULTI
#define MK_MULTI 0
#endif

#define LAS __attribute__((address_space(3)))
typedef unsigned short bf16_t;
typedef short bf16x8 __attribute__((ext_vector_type(8)));
typedef short s16x4 __attribute__((ext_vector_type(4)));
typedef float f32x4 __attribute__((ext_vector_type(4)));
typedef float f32x2 __attribute__((ext_vector_type(2)));
typedef float f32x16 __attribute__((ext_vector_type(16)));
typedef unsigned u32x4 __attribute__((ext_vector_type(4)));
typedef unsigned u32x2 __attribute__((ext_vector_type(2)));
typedef int i32x4 __attribute__((ext_vector_type(4)));

constexpr int DM = 1024, NB = 8, SEQ = 8192, CTX = 256, TB = SEQ + CTX, T = NB * TB;
constexpr int NTILES = T / 256, TPB = TB / 256;
constexpr int NEXP = 32, TOPK = 4;
constexpr int GRID = 256, NTHR = 512, TOK_PER_BLK = T / GRID;
constexpr int MOE_MAXTILES = (T * TOPK) / 256 + NEXP;
constexpr float RMS_EPS = 1e-6f;
constexpr int LDS_BYTES = 144 * 1024, MISC_BYTES = 4096, REG_OFF = MISC_BYTES;

constexpr size_t AL(size_t x) { return (x + 255) / 256 * 256; }
constexpr size_t WS_CTL = 0, CTL_BYTES = 3u << 20;
constexpr size_t WS_RAWGU = WS_CTL + (1u << 20), WS_RAWP = WS_CTL + (2u << 20);
constexpr size_t WS_MOD = WS_CTL + CTL_BYTES;
constexpr size_t WS_TABA = WS_MOD + AL((size_t)4 * 9 * 6144 * 4);
constexpr size_t WS_TABR = WS_TABA + AL(128 * 16 * 8);
constexpr size_t WS_BLKCNT = WS_TABR + AL((size_t)8192 * 128 * 8);
constexpr size_t WS_IDX = WS_BLKCNT + AL(256 * 32 * 4);
constexpr size_t WS_GATE = WS_IDX + AL((size_t)T * 16);
constexpr size_t WS_RANK = WS_GATE + AL((size_t)T * 16);
constexpr size_t WS_SLOT = WS_RANK + AL((size_t)T * 16);
constexpr size_t WS_TOKOF = WS_SLOT + AL((size_t)T * 16);
constexpr size_t WS_SW = WS_TOKOF + AL((size_t)MOE_MAXTILES * 256 * 4);
constexpr size_t WS_SWP = WS_SW + AL((size_t)128 * 2048 * 4);
constexpr size_t SWP_DA = 0, SWP_RET = 2 * 3072, SWP_MLA = SWP_RET + 6144, SWP_RETO = SWP_MLA + 512, SWP_N = SWP_RETO + 1024;
constexpr size_t RAW_DA = 0, RAW_RET = 2 * 3072, RAW_MLA = RAW_RET + 6144, RAW_RETO = RAW_MLA + 448;
constexpr size_t WS_W_DA_IN = WS_SWP + AL(SWP_N * 4);
constexpr size_t WS_W_DA_OUT = WS_W_DA_IN + (size_t)2 * 3072 * 1024 * 2;
constexpr size_t WS_W_RET_IN = WS_W_DA_OUT + (size_t)2 * 1024 * 1024 * 2;
constexpr size_t WS_W_RET_OUT = WS_W_RET_IN + (size_t)6144 * 1024 * 2;
constexpr size_t WS_W_MLA_IN = WS_W_RET_OUT + (size_t)1024 * 2048 * 2;
constexpr size_t WS_W_MLA_QUP = WS_W_MLA_IN + (size_t)512 * 1024 * 2;
constexpr size_t WS_W_MLA_KVUP = WS_W_MLA_QUP + (size_t)1536 * 256 * 2;
constexpr size_t WS_W_MLA_OUT = WS_W_MLA_KVUP + (size_t)2048 * 256 * 2;
constexpr size_t WS_W_GU = WS_W_MLA_OUT + (size_t)1024 * 1024 * 2;
constexpr size_t WS_W_DN = WS_W_GU + (size_t)128 * 2048 * 1024 * 2;
constexpr size_t WS_XRES = WS_W_DN + (size_t)128 * 1024 * 1024 * 2;
constexpr size_t WS_HBUF = WS_XRES + (size_t)T * 1024 * 4;
constexpr size_t WS_HQ1 = WS_HBUF  , WS_SA1 = WS_HBUF + (size_t)T * 1024  ;
constexpr size_t WS_BIG = WS_HBUF + (size_t)T * 1024 * 2;
constexpr size_t ROW1K = (size_t)T * 1024 * 2;
constexpr size_t DA_K = WS_BIG, DA_V = DA_K + ROW1K, DA_Q = DA_V + ROW1K, DA_O = DA_Q + ROW1K  , DA_O2 = DA_O + 2 * ROW1K, DA_END = DA_O2 + ROW1K;
constexpr size_t RT_K = WS_BIG, RT_V = RT_K + ROW1K  , RT_Q = RT_V + 2 * ROW1K, RT_G = RT_Q + ROW1K  , RT_OF = RT_G + 2 * ROW1K, RT_OB = RT_OF + 2 * ROW1K,
                 RT_A = RT_OB + 2 * ROW1K  , RT_SA = RT_A + ROW1K  , RT_END = RT_A + 2 * ROW1K;
constexpr size_t ML_P = WS_BIG  , ML_AKV = ML_P + ROW1K  , ML_AQ = ML_AKV + ROW1K / 4, ML_Q = ML_AQ + ROW1K / 4  , ML_K = ML_Q + ROW1K * 3 / 2,
                 ML_V = ML_K + ROW1K * 3 / 2, ML_O = ML_V + ROW1K, ML_END = ML_O + ROW1K;
constexpr size_t MOE_ROWS = (size_t)MOE_MAXTILES * 256;
constexpr size_t MO_HQ = WS_BIG  , MO_SA = MO_HQ + (size_t)T * 1024  , MO_SASLOT = MO_SA + AL((size_t)T * 4)  ;
constexpr size_t MO_ROWMAX = MO_SASLOT + AL(MOE_ROWS * 4)  , MO_SA2 = MO_ROWMAX + AL(MOE_ROWS * 4)  , MO_ACT8 = WS_BIG + ((size_t)80 << 20)  ;
constexpr size_t WS_SWD = WS_W_MLA_KVUP;
constexpr size_t MO_HS = WS_BIG, MO_ACT = MO_HS + MOE_ROWS * 2048, MO_OUT = MO_ACT + MOE_ROWS * 2048, MO_END = MO_OUT + MOE_ROWS * 2048;
constexpr size_t MO_OUTS = MO_OUT + MOE_ROWS * 1024;
constexpr size_t cmax(size_t a, size_t b) { return a > b ? a : b; }
constexpr size_t WS_END = cmax(cmax(DA_END, RT_END), cmax(ML_END, MO_END));
static_assert(MO_SA2 + MOE_ROWS * 4 <= MO_ACT8 && MO_ACT8 + MOE_ROWS * 1024 <= MO_ACT, "MoE int8 activation buffers overlap");
static_assert((size_t)128 * 1024 * 4 <= (size_t)2048 * 256 * 2, "down scale table does not fit its slot");

template <class T> __device__ __forceinline__ T* gp(T* p) { return p; }
__device__ __forceinline__ float wave_sum(float v) {
#pragma unroll
    for (int o = 1; o < 64; o <<= 1) v += __shfl_xor(v, o);
    return v;
}
__device__ __forceinline__ unsigned pk2(float lo, float hi) { unsigned r; asm volatile("v_cvt_pk_bf16_f32 %0, %1, %2" : "=v"(r) : "v"(lo), "v"(hi)); return r; }
__device__ __forceinline__ float bflo(unsigned w) { return __uint_as_float(w << 16); }
__device__ __forceinline__ float bfhi(unsigned w) { return __uint_as_float(w & 0xffff0000u); }
__device__ __forceinline__ float bf2f(bf16_t h) { return __uint_as_float((unsigned)h << 16); }
__device__ __forceinline__ bf16_t f2bf(float f) { return (bf16_t)(pk2(f, 0.f) & 0xffffu); }
__device__ __forceinline__ f32x4 ld4bf(const bf16_t* p) { const u32x2 w = *(const u32x2*)p; return (f32x4){bflo(w.x), bfhi(w.x), bflo(w.y), bfhi(w.y)}; }
__device__ __forceinline__ void st4bf(bf16_t* p, f32x4 v) { u32x2 w; w.x = pk2(v[0], v[1]); w.y = pk2(v[2], v[3]); *(u32x2*)p = w; }
__device__ __forceinline__ bf16_t f2bf_c(float f) { unsigned u = __float_as_uint(f); u += 0x7fffu + ((u >> 16) & 1u); return (bf16_t)(u >> 16); }

#define XB_TMO      128
#define XB_XCNT(j)  (256  + 64 * (j))
#define XB_XSUB(j)  (1280 + 64 * (j))
#define XB_XGEN(j)  (2304 + 64 * (j))
#define XB_TOP      3328
#define XB_TOPGEN   3392
#define XCD_BAR_WORDS 3456
#define XB_SPIN_CAP (1u << 22)
__device__ __forceinline__ unsigned xb_ld(unsigned* p)              { return __hip_atomic_load(p, __ATOMIC_RELAXED, __HIP_MEMORY_SCOPE_AGENT); }
__device__ __forceinline__ unsigned xb_add(unsigned* p, unsigned v) { return __hip_atomic_fetch_add(p, v, __ATOMIC_RELAXED, __HIP_MEMORY_SCOPE_AGENT); }
__device__ __forceinline__ unsigned xb_xcc_id() { return (unsigned)__builtin_amdgcn_s_getreg((3 << 11) | 20) & 0xFu; }
#define XB_SPIN(cond, bar) do { unsigned _sp = 0; while (cond) { __builtin_amdgcn_s_sleep(1); \
    if ((++_sp & 255u) == 0u) { if (xb_ld(&(bar)[XB_TMO])) break; if (_sp > XB_SPIN_CAP) { atomicAdd(&(bar)[XB_TMO], 1u); break; } } } } while (0)
struct XcdBarrier { unsigned* bar; unsigned x; volatile LAS unsigned* st; };
__device__ __forceinline__ XcdBarrier xcd_barrier_post(unsigned* bar, volatile LAS unsigned* st) {
    XcdBarrier b; b.bar = bar; b.x = xb_xcc_id(); b.st = st;
    if (threadIdx.x == 0) (void)xb_add(&bar[XB_XCNT(b.x)], 1u);
    return b;
}
__device__ __forceinline__ void xcd_barrier_complete(unsigned* bar, unsigned x, unsigned& nloc, unsigned& nx) {
    const unsigned G = gridDim.x * gridDim.y * gridDim.z;
    unsigned sum, cnt, mine, sp = 0u;
    for (;;) {
        sum = 0u; cnt = 0u; mine = 0u;
#pragma unroll
        for (unsigned j = 0; j < 16; ++j) { const unsigned c = xb_ld(&bar[XB_XCNT(j)]); sum += c; cnt += (c > 0u) ? 1u : 0u; mine = (j == x) ? c : mine; }
        if (sum == G) break;
        __builtin_amdgcn_s_sleep(1);
        if ((++sp & 255u) == 0u) { if (xb_ld(&bar[XB_TMO])) break; if (sp > XB_SPIN_CAP) { atomicAdd(&bar[XB_TMO], 1u); break; } }
    }
    nloc = mine > 0u ? mine : 1u; nx = cnt > 0u ? cnt : 1u;
}
__device__ __forceinline__ void xcd_barrier(const XcdBarrier& b) {
    asm volatile("s_waitcnt vmcnt(0)" ::: "memory");
    __syncthreads();
    if (threadIdx.x == 0) {
        unsigned* bar = b.bar;
        __builtin_amdgcn_s_waitcnt(0);
        unsigned nloc = b.st[0], nx = b.st[1];
        if (nloc == 0u) { xcd_barrier_complete(bar, b.x, nloc, nx); b.st[0] = nloc; b.st[1] = nx; }
        const unsigned old = xb_add(&bar[XB_XSUB(b.x)], 1u);
        const unsigned gen = old / nloc;
        if (old + 1u == (gen + 1u) * nloc) {
            __builtin_amdgcn_fence(__ATOMIC_RELEASE, "agent");
            asm volatile("s_waitcnt vmcnt(0)" ::: "memory");
            const unsigned og = xb_add(&bar[XB_TOP], 1u);
            const unsigned tg = og / nx;
            if (og + 1u == (tg + 1u) * nx) xb_add(&bar[XB_TOPGEN], 1u);
            else XB_SPIN(xb_ld(&bar[XB_TOPGEN]) == tg, bar);
            __builtin_amdgcn_fence(__ATOMIC_ACQUIRE, "agent");
            xb_add(&bar[XB_XGEN(b.x)], 1u);
            asm volatile("s_waitcnt vmcnt(0)" ::: "memory");
        } else {
            XB_SPIN(xb_ld(&bar[XB_XGEN(b.x)]) == gen, bar);
            __builtin_amdgcn_fence(__ATOMIC_ACQUIRE, "agent");
            asm volatile("s_waitcnt vmcnt(0)" ::: "memory");
        }
    }
    __syncthreads();
}

namespace pg8 {
constexpr int BM = 256, BK = 64, HALF = 128, HTB = HALF * BK * 2, STAGE_BYTES = 8 * HTB, NXCD = 8, WGM = 8;
__host__ __device__ __forceinline__ int lds_byte(int r, int c) { const int st = (r >> 4) * 2 + (c >> 5), rr = r & 15, cc = c & 31, ob = rr * 64 + cc * 2; return st * 1024 + (ob ^ (((ob >> 9) & 1) << 5)); }
__host__ __device__ __forceinline__ void stage_rc(int b, int& R, int& C) { const int st = b / 1024, sb = b % 1024, swz = sb ^ (((sb >> 9) & 1) << 5); R = (st >> 1) * 16 + swz / 64; C = (st & 1) * 32 + (swz % 64) / 2; }
__host__ __device__ __forceinline__ int perm32(int rho) { const int n = rho >> 4, i = rho & 15; return 8 * (i >> 2) + 4 * n + (i & 3); }
struct Unit { int pm, pn, grp; };
struct StaticOrder {
    static constexpr bool GATHER = false; const int* tok;
    int nM, nN, nwg, c; bool latonly;
    __device__ __forceinline__ void init(int nM_, int nN_, int c_, bool lat_ = false) { nM = nM_; nN = nN_; nwg = nM * nN; c = c_; latonly = lat_; }
    __device__ __forceinline__ bool next(int i, Unit& u) const {
        const long L = (long)i * GRID + c; if (L >= nwg) return false;
        int wgid = (int)L; { const int q = nwg / NXCD, r = nwg % NXCD, xcd = wgid % NXCD, off = wgid / NXCD; wgid = (xcd < r ? xcd * (q + 1) : r * (q + 1) + (xcd - r) * q) + off; }
        const int nig = WGM * nN, gid = wgid / nig, fm = gid * WGM, gsz = (nM - fm) < WGM ? (nM - fm) : WGM;
        u.pm = fm + ((wgid % nig) % gsz); u.pn = (wgid % nig) / gsz; u.grp = 0; if (latonly) u.pm += u.pm / 32 + 1; return true;
    }
};
struct MoeOrder : StaticOrder {
    static constexpr bool GATHER = true;
    const volatile LAS int* pad_start;
    __device__ __forceinline__ bool next(int i, Unit& u) const {
        if (!StaticOrder::next(i, u)) return false;
        u.grp = ((const volatile LAS unsigned char*)(pad_start - 64))[1024 + u.pm]; return true;
    }
};

struct MoeOrderPlain : MoeOrder { static constexpr bool GATHER = false; };

template <class Epi, class Sched, bool I8 = false>
__device__ __forceinline__ void gemm_phase(LAS unsigned char* lds, const bf16_t* Aptr, const bf16_t* Btptr, const int K, const size_t grp_stride_bytes, const Sched& S, const Epi& E, const int tid) {
    const int wid = __builtin_amdgcn_readfirstlane(tid >> 6), lane = tid & 63, wr = wid >> 2, wc = wid & 3, fr = lane & 15, fq = lane >> 4;
    const int nt = K / BK;
    constexpr bool GATHER = Sched::GATHER;
    unsigned voffB[2], voC[2][2], voN[2][2]; int rowA[2]; unsigned colA[2];
#pragma unroll
    for (int i = 0; i < 2; ++i) { int R, C; stage_rc(tid * 16 + i * 8192, R, C); const int Rb = Epi::PERM ? ((R & ~31) + perm32(R & 31)) : R;
        rowA[i] = R; colA[i] = (unsigned)C * 2u; voffB[i] = (unsigned)(Rb * K + C) * 2u;
        voC[0][i] = (unsigned)(R * K + C) * 2u; voC[1][i] = voC[0][i] + (unsigned)(HALF * K * 2); voN[0][i] = voC[0][i]; voN[1][i] = voC[1][i]; }
#define PG8_TOK(u_, vo_) do { const int* tp_ = S.tok + (size_t)(u_).pm * 256; _Pragma("unroll") for (int h_ = 0; h_ < 2; ++h_) _Pragma("unroll") for (int i_ = 0; i_ < 2; ++i_) \
        vo_[h_][i_] = (unsigned)tp_[h_ * 128 + rowA[i_]] * (unsigned)(K * 2) + colA[i_]; } while (0)
    const size_t kstep = (size_t)(BK * 2);
    const size_t hstep = (size_t)HALF * K * 2;
    const size_t tstep = 2 * hstep;
    const unsigned ldsw = (unsigned)wid * 1024u;
    const int aoff = lds_byte(wr * 64 + fr, fq * 8), boff = lds_byte(wc * 32 + fr, fq * 8);
#define PG8_SA(b, h) (((b) * 2 + (h)) * HTB)
#define PG8_SB(b, h) ((4 + (b) * 2 + (h)) * HTB)
#define PG8_STAGE(bufoff, gbase, voff) do { _Pragma("unroll") for (int _i = 0; _i < 2; ++_i) \
        __builtin_amdgcn_global_load_lds((const unsigned*)((const char*)(gbase) + (voff)[_i]), (LAS unsigned*)(lds + (bufoff) + ldsw + _i * 8192), 16, 0, 0); } while (0)
    using FragT = std::conditional_t<I8, i32x4, bf16x8>; using AccT = std::conditional_t<I8, i32x4, f32x4>;
#define PG8_LDA(dst, b, h) do { _Pragma("unroll") for (int m = 0; m < 4; ++m) _Pragma("unroll") for (int k = 0; k < 2; ++k) dst[m][k] = *(const LAS FragT*)(lds + PG8_SA(b, h) + aoff + m * 2048 + k * 1024); } while (0)
#define PG8_LDB(dst, b, h) do { _Pragma("unroll") for (int n = 0; n < 2; ++n) _Pragma("unroll") for (int k = 0; k < 2; ++k) dst[n][k] = *(const LAS FragT*)(lds + PG8_SB(b, h) + boff + n * 2048 + k * 1024); } while (0)
#define PG8_MMA(ai, bj, At, Bt) do { __builtin_amdgcn_s_setprio(1); _Pragma("unroll") for (int m = 0; m < 4; ++m) _Pragma("unroll") for (int n = 0; n < 2; ++n) _Pragma("unroll") for (int k = 0; k < 2; ++k) \
        { if constexpr (I8) acc[ai][bj][m][n] = __builtin_amdgcn_mfma_i32_16x16x64_i8(Bt[n][k], At[m][k], acc[ai][bj][m][n], 0, 0, 0); else acc[ai][bj][m][n] = __builtin_amdgcn_mfma_f32_16x16x32_bf16(Bt[n][k], At[m][k], acc[ai][bj][m][n], 0, 0, 0); } __builtin_amdgcn_s_setprio(0); } while (0)
#define PG8_WAIT_V(n) asm volatile("s_waitcnt vmcnt(" #n ")" ::: "memory")
#define PG8_WAIT_L(n) asm volatile("s_waitcnt lgkmcnt(" #n ")" ::: "memory")
#define PG8_BAR __builtin_amdgcn_s_barrier()
#define PG8_SCHED __builtin_amdgcn_sched_barrier(0)
    Unit cur, nxt; int ui = 0;
    if (!S.next(0, cur)) return;
    AccT acc[2][2][4][2];
#pragma unroll
    for (int a = 0; a < 2; ++a)
#pragma unroll
        for (int b = 0; b < 2; ++b)
#pragma unroll
            for (int m = 0; m < 4; ++m)
#pragma unroll
                for (int n = 0; n < 2; ++n) acc[a][b][m][n] = (AccT){0, 0, 0, 0};
    FragT At[4][2], B0[2][2], B1[2][2];
    const char* cA = (const char*)Aptr + (GATHER ? (size_t)0 : (size_t)cur.pm * tstep); const char* cB = (const char*)Btptr + (size_t)cur.grp * grp_stride_bytes + (size_t)cur.pn * tstep;
    if constexpr (GATHER) PG8_TOK(cur, voC);
    PG8_STAGE(PG8_SB(0, 0), cB, voffB); PG8_STAGE(PG8_SA(0, 0), cA, voC[0]); PG8_STAGE(PG8_SB(0, 1), cB + hstep, voffB); PG8_STAGE(PG8_SA(0, 1), cA, voC[1]);
    if (wr == 1) PG8_BAR;
    PG8_WAIT_V(4); PG8_BAR;
    PG8_STAGE(PG8_SB(1, 0), cB + kstep, voffB); PG8_STAGE(PG8_SA(1, 0), cA + kstep, voC[0]); PG8_STAGE(PG8_SB(1, 1), cB + hstep + kstep, voffB);
    PG8_WAIT_V(6); PG8_BAR;
    for (;;) {
        const bool has_next = S.next(ui + 1, nxt);
        const char* nA = GATHER ? cA : (has_next ? (const char*)Aptr + (size_t)nxt.pm * tstep : cA);
        const char* nB = has_next ? (const char*)Btptr + (size_t)nxt.grp * grp_stride_bytes + (size_t)nxt.pn * tstep : cB;
        if constexpr (GATHER) { if (has_next) PG8_TOK(nxt, voN); }
#pragma unroll 1
        for (int t = 0; t < nt; t += 2) {
            const bool last = (t == nt - 2);
            if constexpr (Epi::LDSPRE) { if (last) E.pre(lds + 8 * HTB, cur, wid, lane); }
            const char* a1 = cA + (size_t)(t + 1) * kstep;
            const char* a2 = last ? nA : cA + (size_t)(t + 2) * kstep; const char* b2 = last ? nB : cB + (size_t)(t + 2) * kstep;
            const char* a3 = a2 + kstep; const char* b3 = b2 + kstep;
            unsigned s0[2], s1[2];
#pragma unroll
            for (int i = 0; i < 2; ++i) { s0[i] = (GATHER && last) ? voN[0][i] : voC[0][i]; s1[i] = (GATHER && last) ? voN[1][i] : voC[1][i]; }
            PG8_LDB(B0, 0, 0); PG8_SCHED; PG8_LDA(At, 0, 0); PG8_STAGE(PG8_SA(1, 1), a1, voC[1]);
            PG8_WAIT_L(8); PG8_BAR; PG8_WAIT_L(0); PG8_MMA(0, 0, At, B0); PG8_BAR; PG8_SCHED;
            PG8_LDB(B1, 0, 1); PG8_STAGE(PG8_SB(0, 0), b2, voffB);
            PG8_BAR; PG8_WAIT_L(0); PG8_MMA(0, 1, At, B1); PG8_BAR;
            PG8_LDA(At, 0, 1); PG8_STAGE(PG8_SA(0, 0), a2, s0);
            PG8_BAR; PG8_WAIT_L(0); PG8_MMA(1, 0, At, B0); PG8_BAR; PG8_SCHED;
            PG8_STAGE(PG8_SB(0, 1), b2 + hstep, voffB);
            PG8_WAIT_V(6); PG8_BAR; PG8_MMA(1, 1, At, B1); PG8_BAR;
            PG8_LDB(B0, 1, 0); PG8_SCHED; PG8_LDA(At, 1, 0); PG8_STAGE(PG8_SA(0, 1), a2, s1);
            PG8_WAIT_L(8); PG8_BAR; PG8_WAIT_L(0); PG8_MMA(0, 0, At, B0); PG8_BAR; PG8_SCHED;
            PG8_LDB(B1, 1, 1); PG8_STAGE(PG8_SB(1, 0), b3, voffB);
            PG8_BAR; PG8_WAIT_L(0); PG8_MMA(0, 1, At, B1); PG8_BAR;
            PG8_LDA(At, 1, 1); PG8_STAGE(PG8_SA(1, 0), a3, s0);
            PG8_BAR; PG8_WAIT_L(0); PG8_MMA(1, 0, At, B0); PG8_BAR; PG8_SCHED;
            PG8_STAGE(PG8_SB(1, 1), b3 + hstep, voffB);
            PG8_WAIT_V(6); PG8_BAR; PG8_MMA(1, 1, At, B1); PG8_BAR;
        }
        if constexpr (Epi::LDSPRE) E(acc, cur, wr, wc, fr, fq, lds + 8 * HTB); else E(acc, cur, wr, wc, fr, fq);
        if (!has_next) break;
        if constexpr (GATHER) {
#pragma unroll
            for (int h = 0; h < 2; ++h)
#pragma unroll
                for (int i = 0; i < 2; ++i) voC[h][i] = voN[h][i]; }
#pragma unroll
        for (int a = 0; a < 2; ++a)
#pragma unroll
            for (int b = 0; b < 2; ++b)
#pragma unroll
                for (int m = 0; m < 4; ++m)
#pragma unroll
                    for (int n = 0; n < 2; ++n) acc[a][b][m][n] = (AccT){0, 0, 0, 0};
        cur = nxt; cA = nA; cB = nB; ++ui;
    }
    PG8_WAIT_V(0);
    if (wr == 0) PG8_BAR;
    PG8_BAR;
#undef PG8_TOK
#undef PG8_SA
#undef PG8_SB
#undef PG8_STAGE
#undef PG8_LDA
#undef PG8_LDB
#undef PG8_MMA
#undef PG8_WAIT_V
#undef PG8_WAIT_L
#undef PG8_BAR
#undef PG8_SCHED
}

typedef const f32x4 (&AccRef)[2][2][4][2];

template <bool Q> struct AccSel { typedef f32x4 T; typedef const f32x4 (&Ref)[2][2][4][2]; };
template <> struct AccSel<true> { typedef i32x4 T; typedef const i32x4 (&Ref)[2][2][4][2]; };
template <bool Q> __device__ __forceinline__ f32x4 deq(const typename AccSel<Q>::T a, const float sr, const f32x4 sc) {
    if constexpr (Q) return (f32x4){(float)a[0], (float)a[1], (float)a[2], (float)a[3]} * (sc * sr); else return a;
}
__device__ __forceinline__ void rope8(f32x4& v0, f32x4& v1, const f32x2* cs) {
    const f32x4 c01 = *(const f32x4*)cs, c23 = *(const f32x4*)(cs + 2);
    f32x4 a = v0, b = v1;
    v0[0] = a[0] * c01[0] - a[1] * c01[1]; v0[1] = a[0] * c01[1] + a[1] * c01[0];
    v0[2] = a[2] * c01[2] - a[3] * c01[3]; v0[3] = a[2] * c01[3] + a[3] * c01[2];
    v1[0] = b[0] * c23[0] - b[1] * c23[1]; v1[1] = b[0] * c23[1] + b[1] * c23[0];
    v1[2] = b[2] * c23[2] - b[3] * c23[3]; v1[3] = b[2] * c23[3] + b[3] * c23[2];
}
__device__ __forceinline__ void rope8r(f32x4& v0, f32x4& v1, const f32x4 c01, const f32x4 c23) {
    f32x4 a = v0, b = v1;
    v0[0] = a[0] * c01[0] - a[1] * c01[1]; v0[1] = a[0] * c01[1] + a[1] * c01[0];
    v0[2] = a[2] * c01[2] - a[3] * c01[3]; v0[3] = a[2] * c01[3] + a[3] * c01[2];
    v1[0] = b[0] * c23[0] - b[1] * c23[1]; v1[1] = b[0] * c23[1] + b[1] * c23[0];
    v1[2] = b[2] * c23[2] - b[3] * c23[3]; v1[3] = b[2] * c23[3] + b[3] * c23[2];
}
__device__ __forceinline__ void store8(bf16_t* p, f32x4 v0, f32x4 v1) {
    u32x4 w; w.x = pk2(v0[0], v0[1]); w.y = pk2(v0[2], v0[3]); w.z = pk2(v1[0], v1[1]); w.w = pk2(v1[2], v1[3]); *(u32x4*)p = w;
}

__device__ __forceinline__ void store8q(bf16_t* base, int ld, f32x4 v0, f32x4 v1, int fr, int fq) {
    const int L = fq * 16 + fr, src = (((L & 3) << 4) | (L >> 2)) << 2;
    u32x4 w; w.x = pk2(v0[0], v0[1]); w.y = pk2(v0[2], v0[3]); w.z = pk2(v1[0], v1[1]); w.w = pk2(v1[2], v1[3]);
    u32x4 r; r.x = (unsigned)__builtin_amdgcn_ds_bpermute(src, (int)w.x); r.y = (unsigned)__builtin_amdgcn_ds_bpermute(src, (int)w.y); r.z = (unsigned)__builtin_amdgcn_ds_bpermute(src, (int)w.z); r.w = (unsigned)__builtin_amdgcn_ds_bpermute(src, (int)w.w);
    *(u32x4*)(base + (size_t)(L >> 2) * ld + (L & 3) * 8) = r;
}
__device__ __forceinline__ u32x4 pack8(f32x4 v0, f32x4 v1) { u32x4 w; w.x = pk2(v0[0], v0[1]); w.y = pk2(v0[2], v0[3]); w.z = pk2(v1[0], v1[1]); w.w = pk2(v1[2], v1[3]); return w; }
__device__ __forceinline__ u32x4 qperm4(u32x4 w, int src) { u32x4 r; r.x = (unsigned)__builtin_amdgcn_ds_bpermute(src, (int)w.x); r.y = (unsigned)__builtin_amdgcn_ds_bpermute(src, (int)w.y); r.z = (unsigned)__builtin_amdgcn_ds_bpermute(src, (int)w.z); r.w = (unsigned)__builtin_amdgcn_ds_bpermute(src, (int)w.w); return r; }
template <bool Q> struct EpiDaIn {
    static constexpr bool PERM = true; static constexpr bool LDSPRE = false;
    bf16_t* KVQ; const f32x2* tabA; const float* sa; const float* swp;
    __device__ __forceinline__ void operator()(typename AccSel<Q>::Ref acc, const Unit& u, int wr, int wc, int fr, int fq) const {
        const int part = u.pn >> 2; bf16_t* base = KVQ + (size_t)part * ((size_t)T * 1024);
        const int tb = u.pm % TPB; const bool lat = tb != 0; const bool rope = lat && part != 1;
        const int cin0 = (u.pn & 3) * 256 + wc * 32 + 8 * fq; const float qs = part == 2 ? 0.125f * 1.4426950408889634f : 1.0f;
        f32x4 swc[2][2];
        if constexpr (Q) {
#pragma unroll
            for (int bj = 0; bj < 2; ++bj)
#pragma unroll
                for (int n = 0; n < 2; ++n) swc[bj][n] = *(const f32x4*)(swp + u.pn * 256 + wc * 32 + 8 * fq + bj * HALF + 4 * n) * qs; }
#pragma unroll
        for (int ai = 0; ai < 2; ++ai) {
            f32x4 t[4][2][2]; float sr[4];
#pragma unroll
            for (int m = 0; m < 4; ++m) sr[m] = Q ? sa[(size_t)u.pm * BM + ai * HALF + wr * 64 + m * 16 + fr] : qs;
            if (rope) {
#pragma unroll
                for (int m = 0; m < 4; ++m) { const int p = (tb - 1) * 256 + ai * HALF + wr * 64 + m * 16 + fr;
#pragma unroll
                    for (int bj = 0; bj < 2; ++bj) { const int o = (cin0 + bj * HALF) & 63, axis = o >> 5, f0 = (o & 31) >> 1, pos = axis ? (p & 63) : (p >> 6); const f32x2* cs = tabA + pos * 16 + f0;
                        t[m][bj][0] = *(const f32x4*)cs; t[m][bj][1] = *(const f32x4*)(cs + 2); } }
            }
            asm volatile("" ::: "memory");
            const int L_ = fq * 16 + fr, src_ = (((L_ & 3) << 4) | (L_ >> 2)) << 2; const unsigned lo_ = (unsigned)(L_ >> 2) * 2048u + (unsigned)(L_ & 3) * 16u;
#pragma unroll
            for (int mh = 0; mh < 2; ++mh) { u32x4 pr[2][2];
#pragma unroll
                for (int mm = 0; mm < 2; ++mm) { const int m = 2 * mh + mm;
#pragma unroll
                    for (int bj = 0; bj < 2; ++bj) { f32x4 v0, v1;
                        if constexpr (Q) { v0 = deq<true>(acc[ai][bj][m][0], sr[m], swc[bj][0]); v1 = deq<true>(acc[ai][bj][m][1], sr[m], swc[bj][1]); }
                        else { v0 = acc[ai][bj][m][0] * qs; v1 = acc[ai][bj][m][1] * qs; }
                        if (rope) rope8r(v0, v1, t[m][bj][0], t[m][bj][1]);
                        pr[mm][bj] = qperm4(pack8(v0, v1), src_); } }
#pragma unroll
                for (int mm = 0; mm < 2; ++mm)
#pragma unroll
                    for (int bj = 0; bj < 2; ++bj) { char* bp_ = (char*)(base + ((size_t)u.pm * BM + ai * HALF + wr * 64 + (2 * mh + mm) * 16) * 1024 + (cin0 - 8 * fq) + bj * HALF);
                        *(u32x4*)(bp_ + lo_) = pr[mm][bj]; } }
        }
    }
};
template <bool Q> struct EpiRetIn {
    static constexpr bool PERM = true; static constexpr bool LDSPRE = false;
    bf16_t *Kb, *Vb, *Qb, *Gb; const f32x2* tabR; const float* sa; const float* swp;
    __device__ __forceinline__ void operator()(typename AccSel<Q>::Ref acc, const Unit& u, int wr, int wc, int fr, int fq) const {
        const int ct = u.pn * 256; bf16_t* base; int ld, c0; bool isk = false, isq = false;
        if (ct < 1024) { base = Kb; ld = 1024; c0 = ct; isk = true; } else if (ct < 3072) { base = Vb; ld = 2048; c0 = ct - 1024; }
        else if (ct < 4096) { base = Qb; ld = 1024; c0 = ct - 3072; isq = true; } else { base = Gb; ld = 2048; c0 = ct - 4096; }
        const int tb = u.pm % TPB; const bool lat = tb != 0; const bool rope = lat && (isk || isq);
        const int cin0 = c0 + wc * 32 + 8 * fq; const float sc = isk ? 0.0625f : 1.0f;
        f32x4 swc[2][2];
        if constexpr (Q) {
#pragma unroll
            for (int bj = 0; bj < 2; ++bj)
#pragma unroll
                for (int n = 0; n < 2; ++n) swc[bj][n] = *(const f32x4*)(swp + u.pn * 256 + wc * 32 + 8 * fq + bj * HALF + 4 * n) * sc; }
#pragma unroll
        for (int ai = 0; ai < 2; ++ai)
#pragma unroll
            for (int mh = 0; mh < 2; ++mh) {
                f32x4 t[2][2][2]; float sr[2];
#pragma unroll
                for (int mm = 0; mm < 2; ++mm) sr[mm] = Q ? sa[(size_t)u.pm * BM + ai * HALF + wr * 64 + (2 * mh + mm) * 16 + fr] : sc;
                if (rope) {
#pragma unroll
                    for (int mm = 0; mm < 2; ++mm) { const int p = (tb - 1) * 256 + ai * HALF + wr * 64 + (2 * mh + mm) * 16 + fr;
#pragma unroll
                        for (int bj = 0; bj < 2; ++bj) { const int f0 = ((cin0 + bj * HALF) & 255) >> 1; const f32x2* cs = tabR + (size_t)p * 128 + f0;
                            t[mm][bj][0] = *(const f32x4*)cs; t[mm][bj][1] = *(const f32x4*)(cs + 2); } }
                }
                asm volatile("" ::: "memory");
                const int L_ = fq * 16 + fr, src_ = (((L_ & 3) << 4) | (L_ >> 2)) << 2; const unsigned lo_ = (unsigned)(L_ >> 2) * (unsigned)(ld * 2) + (unsigned)(L_ & 3) * 16u;
                u32x4 pr[2][2];
#pragma unroll
                for (int mm = 0; mm < 2; ++mm) { const int m = 2 * mh + mm;
#pragma unroll
                    for (int bj = 0; bj < 2; ++bj) { f32x4 v0, v1;
                        if constexpr (Q) { v0 = deq<true>(acc[ai][bj][m][0], sr[mm], swc[bj][0]); v1 = deq<true>(acc[ai][bj][m][1], sr[mm], swc[bj][1]); }
                        else { v0 = acc[ai][bj][m][0] * sc; v1 = acc[ai][bj][m][1] * sc; }
                        if (rope) rope8r(v0, v1, t[mm][bj][0], t[mm][bj][1]);
                        pr[mm][bj] = qperm4(pack8(v0, v1), src_); } }
#pragma unroll
                for (int mm = 0; mm < 2; ++mm)
#pragma unroll
                    for (int bj = 0; bj < 2; ++bj) { char* bp_ = (char*)(base + ((size_t)u.pm * BM + ai * HALF + wr * 64 + (2 * mh + mm) * 16) * ld + (cin0 - 8 * fq) + bj * HALF);
                        *(u32x4*)(bp_ + lo_) = pr[mm][bj]; }
            }
    }
};
template <bool Q> struct EpiF32 {
    static constexpr bool PERM = false; static constexpr bool LDSPRE = false;
    float* C; int ldc; const float* sa; const float* swp;
    __device__ __forceinline__ void operator()(typename AccSel<Q>::Ref acc, const Unit& u, int wr, int wc, int fr, int fq) const {
        const int row0 = u.pm * BM + wr * 64 + fr, col0 = u.pn * BM + wc * 32 + 4 * fq;
        f32x4 swc[2][2];
        if constexpr (Q) {
#pragma unroll
            for (int bj = 0; bj < 2; ++bj)
#pragma unroll
                for (int n = 0; n < 2; ++n) swc[bj][n] = *(const f32x4*)(swp + col0 + bj * HALF + n * 16); }
#pragma unroll
        for (int ai = 0; ai < 2; ++ai)
#pragma unroll
            for (int m = 0; m < 4; ++m) { float* rowp = C + (size_t)(row0 + ai * HALF + m * 16) * ldc + col0; const float sr = Q ? sa[row0 + ai * HALF + m * 16] : 1.0f;
#pragma unroll
                for (int bj = 0; bj < 2; ++bj)
#pragma unroll
                    for (int n = 0; n < 2; ++n) *(f32x4*)(rowp + bj * HALF + n * 16) = deq<Q>(acc[ai][bj][m][n], sr, swc[bj][n]); }
    }
};
struct EpiMlaQ {
    static constexpr bool PERM = true; static constexpr bool LDSPRE = false;
    bf16_t* Qb; const f32x2* tabA;
    __device__ __forceinline__ void operator()(AccRef acc, const Unit& u, int wr, int wc, int fr, int fq) const {
        const int tb = u.pm % TPB; const bool rope = tb != 0 && u.pn >= 4; const int c0 = u.pn * 256 + wc * 32 + 8 * fq; const float qs = 0.07216878364870322f * 1.4426950408889634f;
#pragma unroll
        for (int ai = 0; ai < 2; ++ai) {
            f32x4 t[4][2][2];
            if (rope) {
#pragma unroll
                for (int m = 0; m < 4; ++m) { const int p = (tb - 1) * 256 + ai * HALF + wr * 64 + m * 16 + fr;
#pragma unroll
                    for (int bj = 0; bj < 2; ++bj) { const int o = (c0 + bj * HALF) & 63, axis = o >> 5, f0 = (o & 31) >> 1, pos = axis ? (p & 63) : (p >> 6); const f32x2* cs = tabA + pos * 16 + f0;
                        t[m][bj][0] = *(const f32x4*)cs; t[m][bj][1] = *(const f32x4*)(cs + 2); } }
            }
            asm volatile("" ::: "memory");
#pragma unroll
            for (int m = 0; m < 4; ++m) { const size_t row = (size_t)u.pm * BM + ai * HALF + wr * 64 + m * 16 + fr;
#pragma unroll
                for (int bj = 0; bj < 2; ++bj) { f32x4 v0 = acc[ai][bj][m][0] * qs, v1 = acc[ai][bj][m][1] * qs;
                    if (rope) rope8r(v0, v1, t[m][bj][0], t[m][bj][1]);
                    store8(Qb + row * 1536 + c0 + bj * HALF, v0, v1); } }
        }
    }
};
struct EpiMlaKV {
    static constexpr bool PERM = true; static constexpr bool LDSPRE = false;
    bf16_t *Kb, *Vb;
    __device__ __forceinline__ void operator()(AccRef acc, const Unit& u, int wr, int wc, int fr, int fq) const {
        const int c0 = wc * 32 + 8 * fq;
#pragma unroll
        for (int ai = 0; ai < 2; ++ai)
#pragma unroll
            for (int m = 0; m < 4; ++m) {
                const size_t row = (size_t)u.pm * BM + ai * HALF + wr * 64 + m * 16 + fr;
                store8(Kb + row * 1536 + u.pn * 192 + c0, acc[ai][0][m][0], acc[ai][0][m][1]);
                store8(Vb + row * 1024 + u.pn * 128 + c0, acc[ai][1][m][0], acc[ai][1][m][1]);
            }
    }
};
template <bool Q> struct EpiResid {
    static constexpr bool PERM = true; static constexpr bool LDSPRE = false;
    bf16_t* X; const float* mod2; const float* sa; const float* swp;
    __device__ __forceinline__ void operator()(typename AccSel<Q>::Ref acc, const Unit& u, int wr, int wc, int fr, int fq) const {
        const int tb = u.pm % TPB, b = u.pm / TPB, mrow = tb == 0 ? 8 : b;
        const int row0 = u.pm * BM + wr * 64 + fr, col0 = u.pn * BM + wc * 32 + 8 * fq;
        const float* mp = mod2 + (size_t)mrow * 6144 + col0;
        f32x4 g[2][2];
#pragma unroll
        for (int bj = 0; bj < 2; ++bj)
#pragma unroll
            for (int n = 0; n < 2; ++n) { g[bj][n] = *(const f32x4*)(mp + bj * HALF + 4 * n); if constexpr (Q) g[bj][n] = g[bj][n] * *(const f32x4*)(swp + col0 + bj * HALF + 4 * n); }
#pragma unroll
        for (int ai = 0; ai < 2; ++ai) {
            u32x4 x[4][2]; float sr[4];
#pragma unroll
            for (int m = 0; m < 4; ++m) { const bf16_t* rowp = X + (size_t)(row0 + ai * HALF + m * 16) * 1024 + col0; sr[m] = Q ? sa[row0 + ai * HALF + m * 16] : 1.0f;
#pragma unroll
                for (int bj = 0; bj < 2; ++bj) x[m][bj] = *(const u32x4*)(rowp + bj * HALF); }
            asm volatile("" ::: "memory");
#pragma unroll
            for (int m = 0; m < 4; ++m) { bf16_t* rowp = X + (size_t)(row0 + ai * HALF + m * 16) * 1024 + col0;
#pragma unroll
                for (int bj = 0; bj < 2; ++bj) { const f32x4 lo = (f32x4){bflo(x[m][bj].x), bfhi(x[m][bj].x), bflo(x[m][bj].y), bfhi(x[m][bj].y)}, hi4 = (f32x4){bflo(x[m][bj].z), bfhi(x[m][bj].z), bflo(x[m][bj].w), bfhi(x[m][bj].w)};
                    f32x4 d0, d1;
                    if constexpr (Q) { d0 = deq<true>(acc[ai][bj][m][0], sr[m], g[bj][0]); d1 = deq<true>(acc[ai][bj][m][1], sr[m], g[bj][1]); }
                    else { d0 = g[bj][0] * acc[ai][bj][m][0]; d1 = g[bj][1] * acc[ai][bj][m][1]; }
                    store8(rowp + bj * HALF, lo + d0, hi4 + d1); } }
            asm volatile("" ::: "memory");
        }
    }
};
struct EpiMoe1 {
    static constexpr bool PERM = true; static constexpr bool LDSPRE = false;
    bf16_t* ACT; const float* bgu;
    __device__ __forceinline__ void operator()(AccRef acc, const Unit& u, int wr, int wc, int fr, int fq) const {
        const int j0 = u.pn * 128 + wc * 32 + 8 * fq; const float* bp = bgu + (size_t)u.grp * 2048 + j0;
        const f32x4 bg0 = *(const f32x4*)bp, bg1 = *(const f32x4*)(bp + 4), bl0 = *(const f32x4*)(bp + 1024), bl1 = *(const f32x4*)(bp + 1028);
#pragma unroll
        for (int ai = 0; ai < 2; ++ai)
#pragma unroll
            for (int m = 0; m < 4; ++m) { const size_t row = (size_t)u.pm * BM + ai * HALF + wr * 64 + m * 16 + fr;
                const f32x4 gl[2] = {acc[ai][0][m][0] + bg0, acc[ai][0][m][1] + bg1}, li[2] = {acc[ai][1][m][0] + bl0, acc[ai][1][m][1] + bl1}; f32x4 a[2];
#pragma unroll
                for (int n = 0; n < 2; ++n)
#pragma unroll
                    for (int e = 0; e < 4; ++e) { const float g = fminf(gl[n][e], 7.0f), l = fminf(fmaxf(li[n][e], -7.0f), 7.0f);
                        const float s = __builtin_amdgcn_rcpf(1.0f + __builtin_amdgcn_exp2f(g * (-1.702f * 1.4426950408889634f))); a[n][e] = g * s * (l + 1.0f); }
                store8(ACT + row * 1024 + j0, a[0], a[1]); }
    }
};
typedef const i32x4 (&AccRefI)[2][2][4][2];
__device__ __forceinline__ f32x2 pk_mul(f32x2 a, f32x2 b) { f32x2 d; asm("v_pk_mul_f32 %0, %1, %2" : "=v"(d) : "v"(a), "v"(b)); return d; }
__device__ __forceinline__ f32x2 pk_fma(f32x2 a, f32x2 b, f32x2 c) { f32x2 d; asm("v_pk_fma_f32 %0, %1, %2, %3" : "=v"(d) : "v"(a), "v"(b), "v"(c)); return d; }
__device__ __forceinline__ float min_asm(float a, float b) { float d; asm("v_min_f32 %0, %1, %2" : "=v"(d) : "v"(a), "v"(b)); return d; }
__device__ __forceinline__ float med3_asm(float a, float lo, float hi) { float d; asm("v_med3_f32 %0, %1, %2, %3" : "=v"(d) : "v"(a), "v"(lo), "v"(hi)); return d; }
struct EpiMoe1Q {
    static constexpr bool PERM = true; static constexpr bool LDSPRE = true;
    bf16_t* ACT; const float* bgu; const float* sw; const float* saslot;
    __device__ __forceinline__ void pre(LAS unsigned char* ep, const Unit& u, int wid, int lane) const {
        if (wid > 2) return;
        const float* g = wid == 2 ? saslot + (size_t)u.pm * BM + 4 * lane : (wid == 0 ? bgu : sw) + (size_t)u.grp * 2048 + (lane >> 5) * 1024 + u.pn * 128 + 4 * (lane & 31);
        __builtin_amdgcn_global_load_lds((const unsigned*)g, (LAS unsigned*)(ep + wid * 1024), 16, 0, 0);
    }
    __device__ __forceinline__ void operator()(AccRefI acc, const Unit& u, int wr, int wc, int fr, int fq, const LAS unsigned char* ep) const {
        const int j0 = u.pn * 128 + wc * 32 + 8 * fq; const LAS float* bp = (const LAS float*)ep + wc * 32 + 8 * fq; const LAS float* sp = bp + 256;
        f32x2 bg[4], bl[4], sg[4], sl[4];
#pragma unroll
        for (int q = 0; q < 4; ++q) { bg[q] = *(const LAS f32x2*)(bp + 2 * q); bl[q] = *(const LAS f32x2*)(bp + 128 + 2 * q) + 1.0f; sg[q] = *(const LAS f32x2*)(sp + 2 * q); sl[q] = *(const LAS f32x2*)(sp + 128 + 2 * q); }
        const f32x2 cc = {-1.702f * 1.4426950408889634f, -1.702f * 1.4426950408889634f}; float c7 = 7.0f, cm6 = -6.0f, c8 = 8.0f; asm volatile("" : "+v"(c7), "+v"(cm6), "+v"(c8));
        float sa[2][4];
#pragma unroll
        for (int ai = 0; ai < 2; ++ai)
#pragma unroll
            for (int m = 0; m < 4; ++m) sa[ai][m] = ((const LAS float*)ep)[512 + ai * HALF + wr * 64 + m * 16 + fr];
#pragma unroll
        for (int ai = 0; ai < 2; ++ai)
#pragma unroll
            for (int m = 0; m < 4; ++m) { const size_t row = (size_t)u.pm * BM + ai * HALF + wr * 64 + m * 16 + fr; const f32x2 ss = {sa[ai][m], sa[ai][m]};
                unsigned w[4]; f32x2 sgs[4], sls[4], g[4], l[4], gm[4], lc[4], t[4], gl[4];
#pragma unroll
                for (int q = 0; q < 4; ++q) { sgs[q] = pk_mul(sg[q], ss); sls[q] = pk_mul(sl[q], ss); }
#pragma unroll
                for (int q = 0; q < 4; ++q) { const int n = q >> 1, e0 = 2 * (q & 1); const i32x4 ig = acc[ai][0][m][n], il = acc[ai][1][m][n];
                    g[q] = pk_fma((f32x2){(float)ig[e0], (float)ig[e0 + 1]}, sgs[q], bg[q]); l[q] = pk_fma((f32x2){(float)il[e0], (float)il[e0 + 1]}, sls[q], bl[q]); }
#pragma unroll
                for (int q = 0; q < 4; ++q) { gm[q] = (f32x2){min_asm(g[q][0], c7), min_asm(g[q][1], c7)}; lc[q] = (f32x2){med3_asm(l[q][0], cm6, c8), med3_asm(l[q][1], cm6, c8)}; }
#pragma unroll
                for (int q = 0; q < 4; ++q) { t[q] = pk_mul(gm[q], cc); gl[q] = pk_mul(gm[q], lc[q]); }
#pragma unroll
                for (int q = 0; q < 4; ++q) { const float r0 = __builtin_amdgcn_rcpf(1.0f + __builtin_amdgcn_exp2f(t[q][0])), r1 = __builtin_amdgcn_rcpf(1.0f + __builtin_amdgcn_exp2f(t[q][1]));
                    w[q] = pk2(gl[q][0] * r0, gl[q][1] * r1); }
                *(u32x4*)(ACT + row * 1024 + j0) = (u32x4){w[0], w[1], w[2], w[3]}; }
    }
};
struct EpiMoe2 {
    static constexpr bool PERM = true; static constexpr bool LDSPRE = true;
    bf16_t* OUT; const float* bdn; int abl;
    __device__ __forceinline__ void pre(LAS unsigned char* ep, const Unit& u, int wid, int lane) const {
        if (wid == 0) __builtin_amdgcn_global_load_lds((const unsigned*)(bdn + (size_t)u.grp * 1024 + u.pn * 256 + 4 * lane), (LAS unsigned*)ep, 16, 0, 0);
    }
    __device__ __forceinline__ void operator()(AccRef acc, const Unit& u, int wr, int wc, int fr, int fq, const LAS unsigned char* ep) const {
        const int c0 = u.pn * 256 + wc * 32 + 8 * fq; const LAS float* bp = (const LAS float*)ep + wc * 32 + 8 * fq;
        f32x4 b[2][2];
#pragma unroll
        for (int bj = 0; bj < 2; ++bj) { b[bj][0] = *(const LAS f32x4*)(bp + bj * HALF); b[bj][1] = *(const LAS f32x4*)(bp + bj * HALF + 4); }
#pragma unroll
        for (int ai = 0; ai < 2; ++ai)
#pragma unroll
            for (int m = 0; m < 4; ++m) { const size_t row = (size_t)u.pm * BM + ai * HALF + wr * 64 + m * 16 + fr;
#pragma unroll
                for (int bj = 0; bj < 2; ++bj) {
                    if (abl) { const f32x4 t0_ = acc[ai][bj][m][0] + b[bj][0], t1_ = acc[ai][bj][m][1] + b[bj][1]; asm volatile("" :: "v"(t0_[0] + t0_[1] + t0_[2] + t0_[3] + t1_[0] + t1_[1] + t1_[2] + t1_[3])); }
                    else store8q(OUT + (row - fr) * 1024 + (c0 - 8 * fq) + bj * HALF, 1024, acc[ai][bj][m][0] + b[bj][0], acc[ai][bj][m][1] + b[bj][1], fr, fq);
                } }
    }
};
struct EpiMoe2Q {
    static constexpr bool PERM = true; static constexpr bool LDSPRE = false;
    bf16_t* OUT; const float* bdn; const float* swd; const float* sa2; float* outs;
    __device__ __forceinline__ void operator()(AccRefI acc, const Unit& u, int wr, int wc, int fr, int fq) const {
        const int c0 = u.pn * 256 + wc * 32 + 8 * fq; const unsigned lc_ = (unsigned)(wc * 32 + 8 * fq), lr_ = (unsigned)(wr * 64 + fr);
        const float* bp = bdn + (size_t)u.grp * 1024 + u.pn * 256 + lc_; const float* sp = swd + (size_t)u.grp * 1024 + u.pn * 256 + lc_; const float* rp_ = sa2 + (size_t)u.pm * BM;
        int t_ = threadIdx.x; asm volatile("" : "+v"(t_)); const int L_ = t_ & 63, src_ = (((L_ & 3) << 4) | (L_ >> 2)) << 2; const unsigned lrow2_ = (unsigned)(((t_ >> 8) & 1) * 64 + (t_ & 15)); float* osb_ = outs + (size_t)u.pm * BM * 32;
        float sr[2][4];
#pragma unroll
        for (int ai = 0; ai < 2; ++ai)
#pragma unroll
            for (int m = 0; m < 4; ++m) sr[ai][m] = rp_[lr_ + (unsigned)(ai * HALF + m * 16)];
#pragma unroll
        for (int bj = 0; bj < 2; ++bj) {
            const f32x4 b0 = *(const f32x4*)(bp + bj * HALF), b1 = *(const f32x4*)(bp + bj * HALF + 4), s0 = *(const f32x4*)(sp + bj * HALF), s1 = *(const f32x4*)(sp + bj * HALF + 4);
#pragma unroll
            for (int ai = 0; ai < 2; ++ai)
#pragma unroll
                for (int m = 0; m < 4; ++m) { const size_t row0 = (size_t)u.pm * BM + ai * HALF + wr * 64 + m * 16;
                    const f32x4 v0 = deq<true>(acc[ai][bj][m][0], sr[ai][m], s0) + b0, v1 = deq<true>(acc[ai][bj][m][1], sr[ai][m], s1) + b1;
                    unsigned mb = __float_as_uint(fmaxf(fmaxf(fmaxf(fabsf(v0[0]), fabsf(v0[1])), fmaxf(fabsf(v0[2]), fabsf(v0[3]))), fmaxf(fmaxf(fabsf(v1[0]), fabsf(v1[1])), fmaxf(fabsf(v1[2]), fabsf(v1[3])))));
                    mb = max(mb, (unsigned)__builtin_amdgcn_ds_swizzle((int)mb, (16 << 10) | 0x1f));
                    { auto rr = __builtin_amdgcn_permlane32_swap(mb, mb, false, false); mb = max(rr[0], rr[1]); }
                    const float mx = fmaxf(__uint_as_float(mb), 1e-30f), inv = 127.0f * __builtin_amdgcn_rcpf(mx);
                    const unsigned f0 = __float_as_uint(fmaf(v0[0], inv, 12582912.0f)), f1 = __float_as_uint(fmaf(v0[1], inv, 12582912.0f)), f2 = __float_as_uint(fmaf(v0[2], inv, 12582912.0f)), f3 = __float_as_uint(fmaf(v0[3], inv, 12582912.0f));
                    const unsigned f4 = __float_as_uint(fmaf(v1[0], inv, 12582912.0f)), f5 = __float_as_uint(fmaf(v1[1], inv, 12582912.0f)), f6 = __float_as_uint(fmaf(v1[2], inv, 12582912.0f)), f7 = __float_as_uint(fmaf(v1[3], inv, 12582912.0f));
                    const unsigned w0 = __builtin_amdgcn_perm(f1, f0, 0x0c0c0400u) | __builtin_amdgcn_perm(f3, f2, 0x04000c0cu), w1 = __builtin_amdgcn_perm(f5, f4, 0x0c0c0400u) | __builtin_amdgcn_perm(f7, f6, 0x04000c0cu);
                    const unsigned p0 = (unsigned)__builtin_amdgcn_ds_bpermute(src_, (int)w0), p1 = (unsigned)__builtin_amdgcn_ds_bpermute(src_, (int)w1);
                    *(u32x2*)((unsigned char*)OUT + (row0 + (unsigned)(L_ >> 2)) * 1024 + (unsigned)(u.pn * 256 + wc * 32 + bj * HALF + (L_ & 3) * 8)) = (u32x2){p0, p1};
                    if (fq == 0) osb_[(lrow2_ + (unsigned)(ai * HALF + m * 16)) * 32u + (unsigned)(u.pn * 8 + bj * 4 + wc)] = mx * (1.0f / 127.0f); }
            asm volatile("" ::: "memory");
        }
    }
};
}

namespace att {
constexpr int DV = 128, QBLK = 32, KVBLK = 64;
#define SBAR() __builtin_amdgcn_sched_barrier(0)
__device__ __forceinline__ int crow(int r, int hi) { return (r & 3) + 8 * (r >> 2) + 4 * hi; }
__device__ __forceinline__ int v_st(int k, int c) { const int kk = (k & ~0xC) | ((k & 4) << 1) | ((k & 8) >> 1); return ((kk >> 3) * 4 + (c >> 5)) * 512 + ((kk & 7) * 32 + (c & 31)) * 2; }
__device__ __forceinline__ int v_rd_base(int lane) { return ((lane & 3) << 3) | (((lane >> 2) & 3) << 6) | (((lane >> 4) & 1) << 5) | (((lane >> 5) & 1) << 8); }
constexpr int v_rd_off(int d0, int ks, int half) { return d0 * 512 + ks * 4096 + half * 2048; }
template <int OFF> __device__ __forceinline__ s16x4 tr_read(int vb) {
    s16x4 r; asm volatile("ds_read_b64_tr_b16 %0, %1 offset:%2" : "=&v"(r) : "v"(vb), "i"(OFF) : "memory"); return r;
}
template <int D0> __device__ __forceinline__ void pv_one(f32x16& od, int vb, bf16x8 pa0, bf16x8 pa1, bf16x8 pa2, bf16x8 pa3) {
    const s16x4 l0 = tr_read<v_rd_off(D0, 0, 0)>(vb), h0 = tr_read<v_rd_off(D0, 0, 1)>(vb), l1 = tr_read<v_rd_off(D0, 1, 0)>(vb), h1 = tr_read<v_rd_off(D0, 1, 1)>(vb);
    const s16x4 l2 = tr_read<v_rd_off(D0, 2, 0)>(vb), h2 = tr_read<v_rd_off(D0, 2, 1)>(vb), l3 = tr_read<v_rd_off(D0, 3, 0)>(vb), h3 = tr_read<v_rd_off(D0, 3, 1)>(vb);
    asm volatile("s_waitcnt lgkmcnt(0)" ::: "memory"); SBAR();
#define PK(L, H) (bf16x8){L[0], L[1], L[2], L[3], H[0], H[1], H[2], H[3]}
    od = __builtin_amdgcn_mfma_f32_32x32x16_bf16(pa0, PK(l0, h0), od, 0, 0, 0);
    od = __builtin_amdgcn_mfma_f32_32x32x16_bf16(pa1, PK(l1, h1), od, 0, 0, 0);
    od = __builtin_amdgcn_mfma_f32_32x32x16_bf16(pa2, PK(l2, h2), od, 0, 0, 0);
    od = __builtin_amdgcn_mfma_f32_32x32x16_bf16(pa3, PK(l3, h3), od, 0, 0, 0);
#undef PK
}
__device__ __forceinline__ void pv_d0(f32x16* o, int vb, bf16x8 pa0, bf16x8 pa1, bf16x8 pa2, bf16x8 pa3) {
    pv_one<0>(o[0], vb, pa0, pa1, pa2, pa3); pv_one<1>(o[1], vb, pa0, pa1, pa2, pa3); pv_one<2>(o[2], vb, pa0, pa1, pa2, pa3); pv_one<3>(o[3], vb, pa0, pa1, pa2, pa3);
}
#define PV_RD(D0, S) S##0 = tr_read<v_rd_off(D0, 0, 0)>(vb); S##1 = tr_read<v_rd_off(D0, 0, 1)>(vb); S##2 = tr_read<v_rd_off(D0, 1, 0)>(vb); S##3 = tr_read<v_rd_off(D0, 1, 1)>(vb); \
                     S##4 = tr_read<v_rd_off(D0, 2, 0)>(vb); S##5 = tr_read<v_rd_off(D0, 2, 1)>(vb); S##6 = tr_read<v_rd_off(D0, 3, 0)>(vb); S##7 = tr_read<v_rd_off(D0, 3, 1)>(vb)
#define PV_PK(L, H) (bf16x8){L[0], L[1], L[2], L[3], H[0], H[1], H[2], H[3]}
#define PV_MM(OD, S) OD = __builtin_amdgcn_mfma_f32_32x32x16_bf16(pa0, PV_PK(S##0, S##1), OD, 0, 0, 0); OD = __builtin_amdgcn_mfma_f32_32x32x16_bf16(pa1, PV_PK(S##2, S##3), OD, 0, 0, 0); \
                     OD = __builtin_amdgcn_mfma_f32_32x32x16_bf16(pa2, PV_PK(S##4, S##5), OD, 0, 0, 0); OD = __builtin_amdgcn_mfma_f32_32x32x16_bf16(pa3, PV_PK(S##6, S##7), OD, 0, 0, 0)
__device__ __forceinline__ void pv_pipe(f32x16* o, int vb, bf16x8 pa0, bf16x8 pa1, bf16x8 pa2, bf16x8 pa3) {
    s16x4 a0, a1, a2, a3, a4, a5, a6, a7, b0, b1, b2, b3, b4, b5, b6, b7;
    asm volatile("s_waitcnt lgkmcnt(0)" ::: "memory"); SBAR();
    PV_RD(0, a); PV_RD(1, b);
    asm volatile("s_waitcnt lgkmcnt(8)" ::: "memory"); SBAR();
    PV_MM(o[0], a); SBAR();
    PV_RD(2, a);
    asm volatile("s_waitcnt lgkmcnt(8)" ::: "memory"); SBAR();
    PV_MM(o[1], b); SBAR();
    PV_RD(3, b);
    asm volatile("s_waitcnt lgkmcnt(8)" ::: "memory"); SBAR();
    PV_MM(o[2], a); SBAR();
    asm volatile("s_waitcnt lgkmcnt(0)" ::: "memory"); SBAR();
    PV_MM(o[3], b);
}
#undef PV_RD
#undef PV_PK
#undef PV_MM
template <int DQK> struct Cfg {
    static constexpr int KROW = DQK * 2;
    static constexpr int SHM_K = KVBLK * DQK * 2, SHM_V = KVBLK * DV * 2;
    static constexpr int NKC = DQK / 64;
    static constexpr int CH = DQK / 8;
    static constexpr int LDS_NEED = 2 * SHM_V + 2 * SHM_K + 8 * 64 * 4;
};
template <bool GUARD>
__device__ __forceinline__ void partialSM(f32x16& p0, f32x16& p1, float& m_ref, float& alpha, const bool first) {
    constexpr float THR2 = 8.0f * 1.4426950408889634f;
    if constexpr (GUARD) { __builtin_amdgcn_sched_barrier(0); asm volatile("s_nop 15\n\ts_nop 15" ::: "memory"); __builtin_amdgcn_sched_barrier(0); }
#define MAX3(a, b, c) ({ float r_; asm volatile("v_max3_f32 %0, %1, %2, %3" : "=v"(r_) : "v"(a), "v"(b), "v"(c)); r_; })
    float pm0 = MAX3(p0[0], p0[1], p0[2]), pm1 = MAX3(p0[3], p0[4], p0[5]), pm2 = MAX3(p1[0], p1[1], p1[2]), pm3 = MAX3(p1[3], p1[4], p1[5]);
#pragma unroll
    for (int r = 6; r < 16; r += 2) { pm0 = MAX3(pm0, p0[r], p0[r + 1]); pm2 = MAX3(pm2, p1[r], p1[r + 1]); }
    float pmax = MAX3(pm0, pm1, pm2); pmax = fmaxf(pmax, pm3);
#undef MAX3
    { auto rr = __builtin_amdgcn_permlane32_swap(__float_as_uint(pmax), __float_as_uint(pmax), false, false);
      pmax = fmaxf(__uint_as_float(rr[0]), __uint_as_float(rr[1])); }
    if (__builtin_expect(!first && __all(pmax <= THR2), 1)) { alpha = 1.f; }
    else { const float d = first ? pmax : fmaxf(pmax, 0.f); alpha = first ? 1.f : __builtin_amdgcn_exp2f(-d); m_ref += d;
#pragma unroll
        for (int r = 0; r < 16; ++r) { p0[r] -= d; p1[r] -= d; } }
#pragma unroll
    for (int r = 0; r < 16; ++r) p0[r] = __builtin_amdgcn_exp2f(p0[r]);
}
__device__ __forceinline__ void finishSM(f32x16& p0, f32x16& p1, float alpha, float& l_reg, bf16x8& pa0, bf16x8& pa1, bf16x8& pa2, bf16x8& pa3) {
#pragma unroll
    for (int r = 0; r < 16; ++r) p1[r] = __builtin_amdgcn_exp2f(p1[r]);
    float ps0 = p0[0] + p0[1], ps1 = p0[2] + p0[3], ps2 = p1[0] + p1[1], ps3 = p1[2] + p1[3];
#pragma unroll
    for (int r = 4; r < 16; r += 4) { ps0 += p0[r] + p0[r + 1]; ps1 += p0[r + 2] + p0[r + 3]; ps2 += p1[r] + p1[r + 1]; ps3 += p1[r + 2] + p1[r + 3]; }
    float ps = (ps0 + ps1) + (ps2 + ps3);
    { auto rr = __builtin_amdgcn_permlane32_swap(__float_as_uint(ps), __float_as_uint(ps), false, false);
      ps = __uint_as_float(rr[0]) + __uint_as_float(rr[1]); }
    l_reg = l_reg * alpha + ps;
#define PK4(P, BASE, OUT) do { unsigned a0 = pk2(P[BASE + 0], P[BASE + 1]), a1 = pk2(P[BASE + 2], P[BASE + 3]);   \
    unsigned b0 = pk2(P[BASE + 4], P[BASE + 5]), b1 = pk2(P[BASE + 6], P[BASE + 7]);                              \
    auto r0 = __builtin_amdgcn_permlane32_swap(a0, b0, false, false); auto r1 = __builtin_amdgcn_permlane32_swap(a1, b1, false, false); \
    u32x4 w = {r0[0], r1[0], r0[1], r1[1]}; OUT = *reinterpret_cast<bf16x8*>(&w); } while (0)
    PK4(p0, 0, pa0); PK4(p0, 8, pa1); PK4(p1, 0, pa2); PK4(p1, 8, pa3);
#undef PK4
}
template <int DQK>
__device__ __forceinline__ void qkt(f32x16& p0, f32x16& p1, const LAS char* Ks, const bf16x8* qr, int r32, int hi, const float m_ref) {
    constexpr int KROW = Cfg<DQK>::KROW;
    const float nm = -m_ref;
#pragma unroll
    for (int r = 0; r < 16; ++r) { p0[r] = nm; p1[r] = nm; }
#pragma unroll
    for (int d0 = 0; d0 < DQK / 16; ++d0) { const int cb = (d0 * 16 + hi * 8) * 2;
        const bf16x8 b0 = *(const LAS bf16x8*)(Ks + r32 * KROW + (cb ^ (((r32 >> 1) & 7) << 4)));
        const bf16x8 b1 = *(const LAS bf16x8*)(Ks + (32 + r32) * KROW + (cb ^ (((r32 >> 1) & 7) << 4)));
        p0 = __builtin_amdgcn_mfma_f32_32x32x16_bf16(b0, qr[d0], p0, 0, 0, 0);
        p1 = __builtin_amdgcn_mfma_f32_32x32x16_bf16(b1, qr[d0], p1, 0, 0, 0); }
}
template <int DQK, int SDEPTH, int LDQ, int LDK, int LDV, int LDO, int DA = 0>
__device__ __forceinline__ void attn_body(const bf16_t* __restrict__ Qb, const bf16_t* __restrict__ Qb2, const bf16_t* __restrict__ Kh, const bf16_t* __restrict__ Vh, bf16_t* __restrict__ Ob, const int seq, LAS char* lds, const int tid,
                                          const int msel = 0, const float lam = 0.f, const float gsc = 0.f, const float* subg = nullptr, LAS bf16_t* stash = nullptr) {
    using C = Cfg<DQK>;
    constexpr int SHM_V = C::SHM_V, SHM_K = C::SHM_K, KROW = C::KROW, NKC = C::NKC, CH = C::CH;
    const int wid = tid >> 6, lane = tid & 63, r32 = lane & 31, hi = lane >> 5;
    LAS char* V_lds = lds; LAS char* K_lds = lds + 2 * SHM_V;
    LAS float* ws = (LAS float*)(lds + 2 * SHM_V + 2 * SHM_K) + wid * 64; LAS float* li_l = ws; LAS float* al_l = ws + 32;
    float m_reg = 0.f, l_reg = 0; f32x16 o[4] = {}; bf16x8 qr[DQK / 16];
    const bf16_t* Qw = Qb + (long)(wid * QBLK + r32) * LDQ + hi * 8; const bf16_t* Qw2 = Qb2 + (long)(wid * QBLK + r32) * LDQ + hi * 8;
#pragma unroll
    for (int d0 = 0; d0 < DQK / 16; ++d0) qr[d0] = d0 < 8 ? *(const bf16x8*)(Qw + d0 * 16) : *(const bf16x8*)(Qw2 + (d0 - 8) * 16);
    const int sr = tid >> 4, sc = (tid & 15) * 8, vst0 = v_st(sr, sc), vst1 = v_st(32 + sr, sc);
    int krow[NKC], kcol[NKC], kst[NKC];
#pragma unroll
    for (int i = 0; i < NKC; ++i) { const int e = tid + 512 * i; krow[i] = e / CH; kcol[i] = (e % CH) * 8; kst[i] = krow[i] * KROW + ((kcol[i] * 2) ^ (((krow[i] >> 1) & 7) << 4)); }
    const int vb0 = (int)(uintptr_t)V_lds + v_rd_base(lane);
    struct { bf16x8 vs0, vs1, ks[NKC]; } sr_[SDEPTH];
    const unsigned voff0 = (unsigned)(sr * LDV + sc), voff1 = (unsigned)((32 + sr) * LDV + sc); unsigned koff[NKC];
#pragma unroll
    for (int i = 0; i < NKC; ++i) koff[i] = (unsigned)(krow[i] * LDK + kcol[i]);
#define SLOAD(i, k0) do { const bf16_t* vt_ = Vh + (size_t)(k0) * LDV; const bf16_t* kt_ = Kh + (size_t)(k0) * LDK; sr_[i].vs0 = *(const bf16x8*)(vt_ + voff0); sr_[i].vs1 = *(const bf16x8*)(vt_ + voff1); \
    _Pragma("unroll") for (int _c = 0; _c < NKC; ++_c) sr_[i].ks[_c] = *(const bf16x8*)(kt_ + koff[_c]); } while (0)
#define SWRITE(b, i) do { *(LAS bf16x8*)(V_lds + (b) * SHM_V + vst0) = sr_[i].vs0; *(LAS bf16x8*)(V_lds + (b) * SHM_V + vst1) = sr_[i].vs1; \
    _Pragma("unroll") for (int _c = 0; _c < NKC; ++_c) *(LAS bf16x8*)(K_lds + (b) * SHM_K + kst[_c]) = sr_[i].ks[_c]; } while (0)
#define SWAIT() do { if constexpr (SDEPTH == 2) { if constexpr (NKC == 1) asm volatile("s_waitcnt vmcnt(3)" ::: "memory"); else asm volatile("s_waitcnt vmcnt(5)" ::: "memory"); } \
    else asm volatile("s_waitcnt vmcnt(0)" ::: "memory"); } while (0)
#define RESC(a) do { if (__any((a) < 1.f)) { if (hi == 0) al_l[r32] = (a); asm volatile("s_waitcnt lgkmcnt(0)" ::: "memory"); \
    _Pragma("unroll") for (int d = 0; d < 4; ++d) _Pragma("unroll") for (int r = 0; r < 16; ++r) o[d][r] *= al_l[crow(r, hi)]; } } while (0)
    f32x16 pA0, pA1, pB0, pB1; float alA, alB; bf16x8 pa0, pa1, pa2, pa3; const int NT = seq / KVBLK;
    constexpr int SE = 0, SO = SDEPTH - 1;
    SLOAD(SE, 0); asm volatile("s_waitcnt vmcnt(0)" ::: "memory"); SWRITE(0, SE); __syncthreads();
    qkt<DQK>(pA0, pA1, K_lds, qr, r32, hi, m_reg); partialSM<true>(pA0, pA1, m_reg, alA, true);
    SLOAD(SO, KVBLK); if constexpr (SDEPTH == 2) { if (2 < NT) SLOAD(SE, 2 * KVBLK); }
    SWAIT(); SWRITE(1, SO); __syncthreads();
    for (int j = 1; j + 1 < NT; j += 2) {
        SBAR(); qkt<DQK>(pB0, pB1, K_lds + SHM_K, qr, r32, hi, m_reg);
        finishSM(pA0, pA1, alA, l_reg, pa0, pa1, pa2, pa3); SBAR();
        SLOAD(SO, (j + SDEPTH) * KVBLK); SBAR();
        pv_d0(o, vb0, pa0, pa1, pa2, pa3); partialSM<false>(pB0, pB1, m_reg, alB, false);
        __syncthreads(); SWAIT(); SWRITE(0, SE);
        RESC(alB); __syncthreads();
        SBAR(); qkt<DQK>(pA0, pA1, K_lds, qr, r32, hi, m_reg);
        finishSM(pB0, pB1, alB, l_reg, pa0, pa1, pa2, pa3); SBAR();
        if (SDEPTH == 1 || j + 3 < NT) SLOAD(SE, (j + 1 + SDEPTH) * KVBLK); SBAR();
        pv_d0(o, vb0 + SHM_V, pa0, pa1, pa2, pa3); partialSM<false>(pA0, pA1, m_reg, alA, false);
        __syncthreads(); SWAIT(); SWRITE(1, SO);
        RESC(alA); __syncthreads();
    }
    SBAR(); qkt<DQK>(pB0, pB1, K_lds + SHM_K, qr, r32, hi, m_reg);
    finishSM(pA0, pA1, alA, l_reg, pa0, pa1, pa2, pa3); SBAR();
    pv_d0(o, vb0, pa0, pa1, pa2, pa3); partialSM<false>(pB0, pB1, m_reg, alB, false);
    __syncthreads(); RESC(alB);
    finishSM(pB0, pB1, alB, l_reg, pa0, pa1, pa2, pa3); SBAR();
    pv_d0(o, vb0 + SHM_V, pa0, pa1, pa2, pa3);
    if (hi == 0) li_l[r32] = l_reg; asm volatile("s_waitcnt lgkmcnt(0)" ::: "memory");
    float rli[16];
#pragma unroll
    for (int r = 0; r < 16; ++r) rli[r] = __builtin_amdgcn_rcpf(li_l[crow(r, hi)]);
    bf16_t* Ow = Ob + (long)(wid * QBLK) * LDO;
    if constexpr (DA == 0) {
#pragma unroll
        for (int r = 0; r < 16; ++r) { const int orow = crow(r, hi);
#pragma unroll
            for (int d0 = 0; d0 < 4; ++d0) Ow[(long)orow * LDO + d0 * 32 + r32] = f2bf(o[d0][r] * rli[r]); }
    } else {
        int t2 = threadIdx.x; asm volatile("" : "+v"(t2));
        const int wid2 = t2 >> 6, lane2 = t2 & 63, r32l = lane2 & 31, hi2 = lane2 >> 5; bf16_t* Ow2 = Ob + (long)(wid2 * QBLK) * LDO;
        LAS bf16_t* stw = stash + wid2 * 4096 + lane2;
        if (msel == 0) {
#pragma unroll
            for (int r = 0; r < 16; ++r)
#pragma unroll
                for (int d0 = 0; d0 < 4; ++d0) stw[(r * 4 + d0) * 64] = f2bf(o[d0][r] * rli[r]);
        } else {
            float ds[16];
#pragma unroll
            for (int r = 0; r < 16; ++r) { float s = 0.f; if ((r & 3) == 0) asm volatile("" ::: "memory");
#pragma unroll
                for (int d0 = 0; d0 < 4; ++d0) { const float d = bf2f(stw[(r * 4 + d0) * 64]) - lam * (o[d0][r] * rli[r]); o[d0][r] = d; s += d * d; }
                ds[r] = s; }
#define SWZ_ADD(M) _Pragma("unroll") for (int r = 0; r < 16; ++r) ds[r] += __uint_as_float(__builtin_amdgcn_ds_swizzle(__float_as_uint(ds[r]), ((M) << 10) | 0x1f))
            SWZ_ADD(1); SWZ_ADD(2); SWZ_ADD(4); SWZ_ADD(8); SWZ_ADD(16);
#undef SWZ_ADD
            float g[4];
#pragma unroll
            for (int d0 = 0; d0 < 4; ++d0) g[d0] = subg[d0 * 32 + r32l] * gsc;
#pragma unroll
            for (int r = 0; r < 16; ++r) { const int orow = crow(r, hi2); const float rs = rsqrtf(ds[r] * (1.0f / 128.0f) + RMS_EPS);
#pragma unroll
                for (int d0 = 0; d0 < 4; ++d0) Ow2[(long)orow * LDO + d0 * 32 + r32l] = f2bf(o[d0][r] * rs * g[d0]); }
        }
    }
    __syncthreads();
#undef SLOAD
#undef SWRITE
#undef SWAIT
#undef RESC
}
template <int DQK, int LDQ, int LDK, int LDV, int LDO, int DA = 0>
__device__ __forceinline__ void attn_body_simple(const bf16_t* __restrict__ Qb, const bf16_t* __restrict__ Qb2, const bf16_t* __restrict__ Kh, const bf16_t* __restrict__ Vh, bf16_t* __restrict__ Ob, const int seq, LAS char* lds, const int tid,
                                                 const int msel = 0, const float lam = 0.f, const float gsc = 0.f, const float* subg = nullptr, LAS bf16_t* stash = nullptr) {
    using C = Cfg<DQK>;
    constexpr int SHM_V = C::SHM_V, SHM_K = C::SHM_K, KROW = C::KROW, NKC = C::NKC, CH = C::CH;
    const int wid = tid >> 6, lane = tid & 63, r32 = lane & 31, hi = lane >> 5;
    LAS char* V_lds = lds; LAS char* K_lds = lds + 2 * SHM_V;
    LAS float* ws = (LAS float*)(lds + 2 * SHM_V + 2 * SHM_K) + wid * 64; LAS float* li_l = ws; LAS float* al_l = ws + 32;
    float m_reg = 0.f, l_reg = 0; f32x16 o[4] = {}; bf16x8 qr[DQK / 16];
    const bf16_t* Qw = Qb + (long)(wid * QBLK + r32) * LDQ + hi * 8; const bf16_t* Qw2 = Qb2 + (long)(wid * QBLK + r32) * LDQ + hi * 8;
#pragma unroll
    for (int d0 = 0; d0 < DQK / 16; ++d0) qr[d0] = d0 < 8 ? *(const bf16x8*)(Qw + d0 * 16) : *(const bf16x8*)(Qw2 + (d0 - 8) * 16);
    const int sr = tid >> 4, sc = (tid & 15) * 8, vst0 = v_st(sr, sc), vst1 = v_st(32 + sr, sc);
    int krow[NKC], kcol[NKC], kst[NKC];
#pragma unroll
    for (int i = 0; i < NKC; ++i) { const int e = tid + 512 * i; krow[i] = e / CH; kcol[i] = (e % CH) * 8; kst[i] = krow[i] * KROW + ((kcol[i] * 2) ^ (((krow[i] >> 1) & 7) << 4)); }
    const int vb0 = (int)(uintptr_t)V_lds + v_rd_base(lane);
    bf16x8 vs0, vs1, ks[NKC];
    const unsigned voff0 = (unsigned)(sr * LDV + sc), voff1 = (unsigned)((32 + sr) * LDV + sc); unsigned koff[NKC];
#pragma unroll
    for (int i = 0; i < NKC; ++i) koff[i] = (unsigned)(krow[i] * LDK + kcol[i]);
#define SLOAD(k0) do { const bf16_t* vt_ = Vh + (size_t)(k0) * LDV; const bf16_t* kt_ = Kh + (size_t)(k0) * LDK; vs0 = *(const bf16x8*)(vt_ + voff0); vs1 = *(const bf16x8*)(vt_ + voff1); \
    _Pragma("unroll") for (int _c = 0; _c < NKC; ++_c) ks[_c] = *(const bf16x8*)(kt_ + koff[_c]); } while (0)
#define SWRITE(b) do { *(LAS bf16x8*)(V_lds + (b) * SHM_V + vst0) = vs0; *(LAS bf16x8*)(V_lds + (b) * SHM_V + vst1) = vs1; \
    _Pragma("unroll") for (int _c = 0; _c < NKC; ++_c) *(LAS bf16x8*)(K_lds + (b) * SHM_K + kst[_c]) = ks[_c]; } while (0)
    const int NT = seq / KVBLK;
    SLOAD(0); SWRITE(0); SLOAD(KVBLK); __syncthreads();
#pragma unroll 1
    for (int j = 0; j < NT; ++j) {
        const int bsel = j & 1; f32x16 p0, p1; float al; bf16x8 pa0, pa1, pa2, pa3;
        qkt<DQK>(p0, p1, K_lds + bsel * SHM_K, qr, r32, hi, m_reg);
        partialSM<true>(p0, p1, m_reg, al, j == 0);
        if (__any(al < 1.f)) { if (hi == 0) al_l[r32] = al; asm volatile("s_waitcnt lgkmcnt(0)" ::: "memory");
#pragma unroll
            for (int d = 0; d < 4; ++d)
#pragma unroll
                for (int r = 0; r < 16; ++r) o[d][r] *= al_l[crow(r, hi)]; }
        finishSM(p0, p1, al, l_reg, pa0, pa1, pa2, pa3); SBAR();
        pv_pipe(o, vb0 + bsel * SHM_V, pa0, pa1, pa2, pa3);
        if (j + 1 < NT) { SWRITE(bsel ^ 1); if (j + 2 < NT) SLOAD((j + 2) * KVBLK); }
        __syncthreads();
    }
    if (hi == 0) li_l[r32] = l_reg; asm volatile("s_waitcnt lgkmcnt(0)" ::: "memory");
    float rli[16];
#pragma unroll
    for (int r = 0; r < 16; ++r) rli[r] = __builtin_amdgcn_rcpf(li_l[crow(r, hi)]);
    bf16_t* Ow = Ob + (long)(wid * QBLK) * LDO;
    if constexpr (DA == 0) {
#pragma unroll
        for (int r = 0; r < 16; ++r) { const int orow = crow(r, hi);
#pragma unroll
            for (int d0 = 0; d0 < 4; ++d0) Ow[(long)orow * LDO + d0 * 32 + r32] = f2bf(o[d0][r] * rli[r]); }
    } else {
        int t2 = threadIdx.x; asm volatile("" : "+v"(t2));
        const int wid2 = t2 >> 6, lane2 = t2 & 63, r32l = lane2 & 31, hi2 = lane2 >> 5; bf16_t* Ow2 = Ob + (long)(wid2 * QBLK) * LDO;
        LAS bf16_t* stw = stash + wid2 * 4096 + lane2;
        if (msel == 0) {
#pragma unroll
            for (int r = 0; r < 16; ++r)
#pragma unroll
                for (int d0 = 0; d0 < 4; ++d0) stw[(r * 4 + d0) * 64] = f2bf(o[d0][r] * rli[r]);
        } else {
            float ds[16];
#pragma unroll
            for (int r = 0; r < 16; ++r) { float s = 0.f; if ((r & 3) == 0) asm volatile("" ::: "memory");
#pragma unroll
                for (int d0 = 0; d0 < 4; ++d0) { const float d = bf2f(stw[(r * 4 + d0) * 64]) - lam * (o[d0][r] * rli[r]); o[d0][r] = d; s += d * d; }
                ds[r] = s; }
#define SWZ_ADD(M) _Pragma("unroll") for (int r = 0; r < 16; ++r) ds[r] += __uint_as_float(__builtin_amdgcn_ds_swizzle(__float_as_uint(ds[r]), ((M) << 10) | 0x1f))
            SWZ_ADD(1); SWZ_ADD(2); SWZ_ADD(4); SWZ_ADD(8); SWZ_ADD(16);
#undef SWZ_ADD
            float g[4];
#pragma unroll
            for (int d0 = 0; d0 < 4; ++d0) g[d0] = subg[d0 * 32 + r32l] * gsc;
#pragma unroll
            for (int r = 0; r < 16; ++r) { const int orow = crow(r, hi2); const float rs = rsqrtf(ds[r] * (1.0f / 128.0f) + RMS_EPS);
#pragma unroll
                for (int d0 = 0; d0 < 4; ++d0) Ow2[(long)orow * LDO + d0 * 32 + r32l] = f2bf(o[d0][r] * rs * g[d0]); }
        }
    }
    __syncthreads();
#undef SLOAD
#undef SWRITE
}
template <int DQK, int LDQ, int LDK, int LDV, int LDO>
__device__ __forceinline__ void attn_body_stag(const bf16_t* __restrict__ Qb, const bf16_t* __restrict__ Qb2, const bf16_t* __restrict__ Kh, const bf16_t* __restrict__ Vh, bf16_t* __restrict__ Ob, const int seq, LAS char* lds, const int tid) {
    using C = Cfg<DQK>;
    constexpr int SHM_V = C::SHM_V, SHM_K = C::SHM_K, KROW = C::KROW, NKC = C::NKC, CH = C::CH;
    const int wid = __builtin_amdgcn_readfirstlane(tid >> 6), lane = tid & 63, r32 = lane & 31, hi = lane >> 5, half = wid >> 2;
    LAS char* V_lds = lds; LAS char* K_lds = lds + 2 * SHM_V;
    LAS float* ws = (LAS float*)(lds + 2 * SHM_V + 2 * SHM_K) + wid * 64; LAS float* li_l = ws; LAS float* al_l = ws + 32;
    float m_reg = 0.f, l_reg = 0; f32x16 o[4] = {}; bf16x8 qr[DQK / 16];
    const bf16_t* Qw = Qb + (long)(wid * QBLK + r32) * LDQ + hi * 8; const bf16_t* Qw2 = Qb2 + (long)(wid * QBLK + r32) * LDQ + hi * 8;
#pragma unroll
    for (int d0 = 0; d0 < DQK / 16; ++d0) qr[d0] = d0 < 8 ? *(const bf16x8*)(Qw + d0 * 16) : *(const bf16x8*)(Qw2 + (d0 - 8) * 16);
    const int sr = tid >> 4, sc = (tid & 15) * 8, vst0 = v_st(sr, sc), vst1 = v_st(32 + sr, sc);
    int kst[NKC]; unsigned koff[NKC];
#pragma unroll
    for (int i = 0; i < NKC; ++i) { const int e = tid + 512 * i, krow = e / CH, kcol = (e % CH) * 8; kst[i] = krow * KROW + ((kcol * 2) ^ (((krow >> 1) & 7) << 4)); koff[i] = (unsigned)(krow * LDK + kcol); }
    const unsigned voff0 = (unsigned)(sr * LDV + sc), voff1 = (unsigned)((32 + sr) * LDV + sc);
    const int vb0 = (int)(uintptr_t)V_lds + v_rd_base(lane);
    bf16x8 vs0, vs1, ks[NKC];
#define KLOAD(k0) do { const bf16_t* kt_ = Kh + (size_t)(k0) * LDK; _Pragma("unroll") for (int _c = 0; _c < NKC; ++_c) ks[_c] = *(const bf16x8*)(kt_ + koff[_c]); } while (0)
#define VLOAD(k0) do { const bf16_t* vt_ = Vh + (size_t)(k0) * LDV; vs0 = *(const bf16x8*)(vt_ + voff0); vs1 = *(const bf16x8*)(vt_ + voff1); } while (0)
#define KWRITE(b) do { _Pragma("unroll") for (int _c = 0; _c < NKC; ++_c) *(LAS bf16x8*)(K_lds + (b) * SHM_K + kst[_c]) = ks[_c]; } while (0)
#define VWRITE(b) do { *(LAS bf16x8*)(V_lds + (b) * SHM_V + vst0) = vs0; *(LAS bf16x8*)(V_lds + (b) * SHM_V + vst1) = vs1; } while (0)
    const int NT = seq / KVBLK;
    KLOAD(0); VLOAD(0); KWRITE(0); VWRITE(0); KLOAD(KVBLK); VLOAD(KVBLK);
    __syncthreads();
    f32x16 p0 = {}, p1 = {}; float al = 1.f;
#define STG_K(J_) do { if ((J_) + 1 < NT) { KWRITE(((J_) + 1) & 1); if ((J_) + 2 < NT) KLOAD(((J_) + 2) * KVBLK); } } while (0)
#define STG_V(J_) do { if ((J_) + 1 < NT) { VWRITE(((J_) + 1) & 1); if ((J_) + 2 < NT) VLOAD(((J_) + 2) * KVBLK); } } while (0)
#define SP0(j_) do { qkt<DQK>(p0, p1, K_lds + ((j_) & 1) * SHM_K, qr, r32, hi, m_reg); partialSM<true>(p0, p1, m_reg, al, (j_) == 0); } while (0)
#define SP1(j_) do { bf16x8 pa0, pa1, pa2, pa3; \
        if (__any(al < 1.f)) { if (hi == 0) al_l[r32] = al; asm volatile("s_waitcnt lgkmcnt(0)" ::: "memory"); \
            _Pragma("unroll") for (int d = 0; d < 4; ++d) _Pragma("unroll") for (int r = 0; r < 16; ++r) o[d][r] *= al_l[crow(r, hi)]; } \
        finishSM(p0, p1, al, l_reg, pa0, pa1, pa2, pa3); SBAR(); \
        pv_pipe(o, vb0 + ((j_) & 1) * SHM_V, pa0, pa1, pa2, pa3); } while (0)
    if (half == 0) {
#pragma unroll 1
        for (int J = 0; J < NT; ++J) { STG_K(J); SP0(J); __syncthreads(); STG_V(J); SP1(J); __syncthreads(); }
        __syncthreads();
    } else {
        STG_K(0); __syncthreads(); STG_V(0); SP0(0); __syncthreads();
#pragma unroll 1
        for (int J = 1; J < NT; ++J) { STG_K(J); SP1(J - 1); __syncthreads(); STG_V(J); SP0(J); __syncthreads(); }
        SP1(NT - 1); __syncthreads();
    }
#undef STG_K
#undef STG_V
#undef SP0
#undef SP1
    if (hi == 0) li_l[r32] = l_reg; asm volatile("s_waitcnt lgkmcnt(0)" ::: "memory");
    float rli[16];
#pragma unroll
    for (int r = 0; r < 16; ++r) rli[r] = __builtin_amdgcn_rcpf(li_l[crow(r, hi)]);
    bf16_t* Ow = Ob + (long)(wid * QBLK) * LDO;
#pragma unroll
    for (int r = 0; r < 16; ++r) { const int orow = crow(r, hi);
#pragma unroll
        for (int d0 = 0; d0 < 4; ++d0) Ow[(long)orow * LDO + d0 * 32 + r32] = f2bf(o[d0][r] * rli[r]); }
    __syncthreads();
#undef KLOAD
#undef VLOAD
#undef KWRITE
#undef VWRITE
}
template <int DQK, int SDEPTH, int NH, int VSHARE, bool CTXQ, bool KSH = false>
__device__ __forceinline__ void attn_phase(const bf16_t* Q, const bf16_t* K, const bf16_t* V, bf16_t* O, LAS char* lds, const int tid) {
    constexpr int LDQ = NH * DQK, LDK = KSH ? DQK : NH * DQK, LDV = KSH ? DQK : (NH / VSHARE) * DV, LDO = NH * DV;
    if constexpr (KSH) V = K;
    const int c = blockIdx.x, xcd = c & 7, slot = c >> 3;
    constexpr int ROUNDS = NB * NH / 8;
#pragma unroll 1
    for (int i = 0; i <= ROUNDS; ++i) {
        int b, h, seq; size_t qtok;
        if (i < ROUNDS) { const int bh = i * 8 + xcd; b = bh / NH; h = bh % NH; qtok = (size_t)b * TB + CTX + (size_t)slot * 256; seq = TB; }
        else { if (!CTXQ || c >= NB * NH) break; b = c / NH; h = c % NH; qtok = (size_t)b * TB; seq = CTX; }
        const size_t t0 = (size_t)b * TB;
        if constexpr (SDEPTH == 3) attn_body_stag<DQK, LDQ, LDK, LDV, LDO>(Q + qtok * LDQ + h * (DQK > 128 ? 128 : DQK), Q + qtok * LDQ + NH * 128 + h * (DQK > 128 ? DQK - 128 : 0), K + t0 * LDK + h * DQK, V + t0 * LDV + (h / VSHARE) * DV, O + qtok * LDO + h * DV, seq, lds, tid);
        else if constexpr (SDEPTH == 0) attn_body_simple<DQK, LDQ, LDK, LDV, LDO>(Q + qtok * LDQ + h * (DQK > 128 ? 128 : DQK), Q + qtok * LDQ + NH * 128 + h * (DQK > 128 ? DQK - 128 : 0), K + t0 * LDK + (KSH ? 0 : h * DQK), V + t0 * LDV + (KSH ? 0 : (h / VSHARE) * DV), O + qtok * LDO + h * DV, seq, lds, tid);
        else attn_body<DQK, ((SDEPTH == 0 || SDEPTH == 3) ? 1 : SDEPTH), LDQ, LDK, LDV, LDO>(Q + qtok * LDQ + h * DQK, Q + qtok * LDQ + h * DQK, K + t0 * LDK + h * DQK, V + t0 * LDV + (h / VSHARE) * DV, O + qtok * LDO + h * DV, seq, lds, tid);
    }
}
template <int L>
__device__ __forceinline__ void attn_phase_da(const bf16_t* Q, const bf16_t* K, const bf16_t* V, bf16_t* O2, const float* lamv, const float* subg, LAS char* lds, const int tid) {
    constexpr int LD = 1024;
    const float lam_init = L == 0 ? 0.2f : 0.8f - 0.6f * 0.40656965974059917f;
    const int lane = tid & 63;
    const float d01 = wave_sum(lamv[lane] * lamv[64 + lane]), d23 = wave_sum(lamv[128 + lane] * lamv[192 + lane]);
    const float lam = __uint_as_float(__builtin_amdgcn_readfirstlane(__float_as_uint(expf(d01) - expf(d23) + lam_init))), gsc = 1.0f - lam_init;
    LAS bf16_t* stash = (LAS bf16_t*)(lds + 52 * 1024);
    const int c = blockIdx.x, xcd = c & 7, slot = c >> 3;
    constexpr int NU = 2 * NB + ((L != 3) ? 2 : 0);
#pragma unroll 1
    for (int i = 0; i < NU; ++i) {
        const int msel = i & 1; int b, h, seq; size_t qtok;
        if (i < 2 * NB) { const int bh = (i >> 1) * 8 + xcd; b = bh >> 3; h = bh & 7; qtok = (size_t)b * TB + CTX + (size_t)slot * 256; seq = TB; }
        else { if (c >= NB * 8) break; b = c >> 3; h = c & 7; qtok = (size_t)b * TB; seq = CTX; }
        const size_t t0 = (size_t)b * TB; const int hh = 2 * h + msel;
        attn_body<64, 2, LD, LD, LD, LD, 1>(Q + qtok * LD + hh * 64, Q + qtok * LD + hh * 64, K + t0 * LD + hh * 64, V + t0 * LD + h * 128, O2 + qtok * LD + h * 128, seq, lds, tid, msel, lam, gsc, subg, stash);
    }
}
}

struct Params { const float* in[27]; float* out; unsigned char* ws; int ph_lo, ph_hi; };
enum { I_X = 0, I_C, I_CTX, I_CCTX, I_ADAW, I_ADAB, I_NORMG, I_FINALG, I_DA_WIN, I_DA_WOUT, I_DA_LAM, I_DA_SUBG, I_RET_WIN, I_RET_DECAY, I_RET_WOUT, I_MLA_WIN, I_MLA_QG,
       I_MLA_WQUP, I_MLA_KVG, I_MLA_WKVUP, I_MLA_WOUT, I_MOE_WR, I_MOE_BR, I_MOE_WGU, I_MOE_BGU, I_MOE_WDN, I_MOE_BDN };

struct Frame {
    const Params* p; LAS unsigned char* lds; LAS unsigned char* reg; volatile LAS int* misc; int tid, lane, wave;
    unsigned char* ws;
};

enum { PK_ID = 0, PK_DA_IN, PK_RET_IN, PK_MLA_QUP, PK_MOE_GU };
__device__ __forceinline__ int src_col(int n, int kind) {
    if (kind == PK_DA_IN) { if ((n >> 10) == 1) return n; const int o = n & 63, axis = o >> 5, p = o & 31, f = p >> 1; return (n & ~63) | (axis * 32 + ((p & 1) ? 16 + f : f)); }
    if (kind == PK_RET_IN) { if (n < 1024 || (n >= 3072 && n < 4096)) { const int o = n & 255, f = o >> 1; return (n & ~255) | ((o & 1) ? 128 + f : f); } return n; }
    if (kind == PK_MLA_QUP) { if (n < 1024) return (n >> 7) * 192 + (n & 127); const int nn = n - 1024, hd = nn >> 6, oo = nn & 63, axis = oo >> 5, p = oo & 31, f = p >> 1; return hd * 192 + 128 + axis * 32 + ((p & 1) ? 16 + f : f); }
    if (kind == PK_MOE_GU) return ((n >> 7) & 1) * 1024 + (n >> 8) * 128 + (n & 127);
    return n;
}
__device__ __forceinline__ void tr_item(const float* W, int Ksrc, int Nsrc, bf16_t* WT, int Kdst, int Ndst, int Nvalid, int kind, LAS float* scr, int item, int lane) {
    const int nblk = Ndst / 32, kb = item / nblk, nb = item % nblk, k0 = 64 * kb, n0 = 32 * nb;
    const int n = n0 + (lane & 31); const bool nv = n < Nvalid; const int scn = nv ? src_col(n, kind) : 0;
#pragma unroll 8
    for (int i = 0; i < 32; ++i) { const int kk = 2 * i + (lane >> 5), k = k0 + kk; scr[kk * 33 + (lane & 31)] = (nv && k < Ksrc) ? W[(size_t)k * Nsrc + scn] : 0.f; }
    asm volatile("s_waitcnt lgkmcnt(0)" ::: "memory");
    const int c = lane & 7;
#pragma unroll
    for (int j = 0; j < 4; ++j) { const int nn = (lane >> 3) + 8 * j; const LAS float* s = scr + (8 * c) * 33 + nn;
        u32x4 o; o.x = pk2(s[0 * 33], s[1 * 33]); o.y = pk2(s[2 * 33], s[3 * 33]); o.z = pk2(s[4 * 33], s[5 * 33]); o.w = pk2(s[6 * 33], s[7 * 33]);
        *(u32x4*)(WT + (size_t)(n0 + nn) * Kdst + k0 + 8 * c) = o; }
    asm volatile("s_waitcnt lgkmcnt(0)" ::: "memory");
}
__device__ __forceinline__ void tr_itemq(const float* W, int Ksrc, int Nsrc, signed char* WT, int Kdst, int Ndst, int Nvalid, int kind, const unsigned* raw, LAS float* scr, int item, int lane) {
    const int nblk = Ndst / 32, kb = item / nblk, nb = item % nblk, k0 = 64 * kb, n0 = 32 * nb;
    const int n = n0 + (lane & 31); const bool nv = n < Nvalid; const int scn = nv ? src_col(n, kind) : 0; const float inv = 127.0f / fmaxf(__uint_as_float(raw[scn]), 1e-30f);
#pragma unroll 8
    for (int i = 0; i < 32; ++i) { const int kk = 2 * i + (lane >> 5), k = k0 + kk; const float v = (nv && k < Ksrc) ? W[(size_t)k * Nsrc + scn] * inv : 0.f; scr[kk * 33 + (lane & 31)] = fminf(fmaxf(rintf(v), -127.f), 127.f); }
    asm volatile("s_waitcnt lgkmcnt(0)" ::: "memory");
    const int c = lane & 7;
#pragma unroll
    for (int j = 0; j < 4; ++j) { const int nn = (lane >> 3) + 8 * j; const LAS float* s = scr + (8 * c) * 33 + nn;
        unsigned lo = ((unsigned)(int)s[0 * 33] & 0xffu) | (((unsigned)(int)s[1 * 33] & 0xffu) << 8) | (((unsigned)(int)s[2 * 33] & 0xffu) << 16) | (((unsigned)(int)s[3 * 33] & 0xffu) << 24);
        unsigned hi = ((unsigned)(int)s[4 * 33] & 0xffu) | (((unsigned)(int)s[5 * 33] & 0xffu) << 8) | (((unsigned)(int)s[6 * 33] & 0xffu) << 16) | (((unsigned)(int)s[7 * 33] & 0xffu) << 24);
        *(u32x2*)(WT + (size_t)(n0 + nn) * Kdst + k0 + 8 * c) = (u32x2){lo, hi}; }
    asm volatile("s_waitcnt lgkmcnt(0)" ::: "memory");
}
__device__ __forceinline__ void tr_item4q(const float* W, int Nsrc, signed char* WT, int Kdst, int Ndst, int kind, const unsigned* raw, LAS float* scr, int item, int lane) {
    const int nblk = Ndst / 32, kb = item / nblk, nb = item % nblk, k0 = 64 * kb, n0 = 32 * nb, nq = lane & 7, kr = lane >> 3;
    const int scn = src_col(n0 + 4 * nq, kind); const float* wp = W + (size_t)(k0 + kr) * Nsrc + scn;
    const u32x4 rw4 = *(const u32x4*)(raw + scn); const f32x4 inv = (f32x4){127.0f / fmaxf(__uint_as_float(rw4.x), 1e-30f), 127.0f / fmaxf(__uint_as_float(rw4.y), 1e-30f), 127.0f / fmaxf(__uint_as_float(rw4.z), 1e-30f), 127.0f / fmaxf(__uint_as_float(rw4.w), 1e-30f)};
    f32x4 v[8];
#pragma unroll
    for (int i = 0; i < 8; ++i) v[i] = *(const f32x4*)(wp + (size_t)(8 * i) * Nsrc);
#pragma unroll
    for (int i = 0; i < 8; ++i) { LAS float* d = scr + (8 * i + kr) * 33 + 4 * nq; const f32x4 q = v[i] * inv;
        d[0] = fminf(fmaxf(rintf(q[0]), -127.f), 127.f); d[1] = fminf(fmaxf(rintf(q[1]), -127.f), 127.f); d[2] = fminf(fmaxf(rintf(q[2]), -127.f), 127.f); d[3] = fminf(fmaxf(rintf(q[3]), -127.f), 127.f); }
    asm volatile("s_waitcnt lgkmcnt(0)" ::: "memory");
    const int c = lane & 7;
#pragma unroll
    for (int j = 0; j < 4; ++j) { const int nn = (lane >> 3) + 8 * j; const LAS float* s = scr + (8 * c) * 33 + nn;
        unsigned lo = ((unsigned)(int)s[0 * 33] & 0xffu) | (((unsigned)(int)s[1 * 33] & 0xffu) << 8) | (((unsigned)(int)s[2 * 33] & 0xffu) << 16) | (((unsigned)(int)s[3 * 33] & 0xffu) << 24);
        unsigned hi = ((unsigned)(int)s[4 * 33] & 0xffu) | (((unsigned)(int)s[5 * 33] & 0xffu) << 8) | (((unsigned)(int)s[6 * 33] & 0xffu) << 16) | (((unsigned)(int)s[7 * 33] & 0xffu) << 24);
        *(u32x2*)(WT + (size_t)(n0 + nn) * Kdst + k0 + 8 * c) = (u32x2){lo, hi}; }
    asm volatile("s_waitcnt lgkmcnt(0)" ::: "memory");
}
__device__ __forceinline__ void tr4_load(f32x4 (&v)[8], const float* W, int Nsrc, int Ndst, int kind, int item, int lane, int& scn) {
    const int nblk = Ndst / 32, kb = item / nblk, nb = item % nblk, k0 = 64 * kb, n0 = 32 * nb, nq = lane & 7, kr = lane >> 3;
    scn = src_col(n0 + 4 * nq, kind); const float* wp = W + (size_t)(k0 + kr) * Nsrc + scn;
#pragma unroll
    for (int i = 0; i < 8; ++i) v[i] = *(const f32x4*)(wp + (size_t)(8 * i) * Nsrc);
}
template <bool Q8> __device__ __forceinline__ void tr4_store(const f32x4 (&v)[8], void* WTv, int Kdst, int Ndst, const unsigned* raw, int scn, LAS float* scr, int item, int lane) {
    const int nblk = Ndst / 32, kb = item / nblk, nb = item % nblk, k0 = 64 * kb, n0 = 32 * nb, nq = lane & 7, kr = lane >> 3;
    f32x4 inv = (f32x4){1.f, 1.f, 1.f, 1.f};
    if constexpr (Q8) { const u32x4 rw4 = *(const u32x4*)(raw + scn); inv = (f32x4){127.0f / fmaxf(__uint_as_float(rw4.x), 1e-30f), 127.0f / fmaxf(__uint_as_float(rw4.y), 1e-30f), 127.0f / fmaxf(__uint_as_float(rw4.z), 1e-30f), 127.0f / fmaxf(__uint_as_float(rw4.w), 1e-30f)}; }
#pragma unroll
    for (int i = 0; i < 8; ++i) { LAS float* d = scr + (8 * i + kr) * 33 + 4 * nq;
        if constexpr (Q8) { const f32x4 q = v[i] * inv; d[0] = fminf(fmaxf(rintf(q[0]), -127.f), 127.f); d[1] = fminf(fmaxf(rintf(q[1]), -127.f), 127.f); d[2] = fminf(fmaxf(rintf(q[2]), -127.f), 127.f); d[3] = fminf(fmaxf(rintf(q[3]), -127.f), 127.f); }
        else { d[0] = v[i][0]; d[1] = v[i][1]; d[2] = v[i][2]; d[3] = v[i][3]; } }
    asm volatile("s_waitcnt lgkmcnt(0)" ::: "memory");
    const int c = lane & 7;
#pragma unroll
    for (int j = 0; j < 4; ++j) { const int nn = (lane >> 3) + 8 * j; const LAS float* s = scr + (8 * c) * 33 + nn;
        if constexpr (Q8) {
            unsigned lo = ((unsigned)(int)s[0 * 33] & 0xffu) | (((unsigned)(int)s[1 * 33] & 0xffu) << 8) | (((unsigned)(int)s[2 * 33] & 0xffu) << 16) | (((unsigned)(int)s[3 * 33] & 0xffu) << 24);
            unsigned hi = ((unsigned)(int)s[4 * 33] & 0xffu) | (((unsigned)(int)s[5 * 33] & 0xffu) << 8) | (((unsigned)(int)s[6 * 33] & 0xffu) << 16) | (((unsigned)(int)s[7 * 33] & 0xffu) << 24);
            *(u32x2*)((signed char*)WTv + (size_t)(n0 + nn) * Kdst + k0 + 8 * c) = (u32x2){lo, hi};
        } else { u32x4 o; o.x = pk2(s[0 * 33], s[1 * 33]); o.y = pk2(s[2 * 33], s[3 * 33]); o.z = pk2(s[4 * 33], s[5 * 33]); o.w = pk2(s[6 * 33], s[7 * 33]);
            *(u32x4*)((bf16_t*)WTv + (size_t)(n0 + nn) * Kdst + k0 + 8 * c) = o; } }
    asm volatile("s_waitcnt lgkmcnt(0)" ::: "memory");
}
__device__ __forceinline__ void tr4_store_inv(const f32x4 (&v)[8], signed char* WT, int Kdst, int Ndst, const f32x4 inv, LAS float* scr, int item, int lane) {
    const int nblk = Ndst / 32, kb = item / nblk, nb = item % nblk, k0 = 64 * kb, n0 = 32 * nb, nq = lane & 7, kr = lane >> 3;
#pragma unroll
    for (int i = 0; i < 8; ++i) { LAS float* d = scr + (8 * i + kr) * 33 + 4 * nq; const f32x4 q = v[i] * inv;
        d[0] = fminf(fmaxf(rintf(q[0]), -127.f), 127.f); d[1] = fminf(fmaxf(rintf(q[1]), -127.f), 127.f); d[2] = fminf(fmaxf(rintf(q[2]), -127.f), 127.f); d[3] = fminf(fmaxf(rintf(q[3]), -127.f), 127.f); }
    asm volatile("s_waitcnt lgkmcnt(0)" ::: "memory");
    const int c = lane & 7;
#pragma unroll
    for (int j = 0; j < 4; ++j) { const int nn = (lane >> 3) + 8 * j; const LAS float* s = scr + (8 * c) * 33 + nn;
        unsigned lo = ((unsigned)(int)s[0 * 33] & 0xffu) | (((unsigned)(int)s[1 * 33] & 0xffu) << 8) | (((unsigned)(int)s[2 * 33] & 0xffu) << 16) | (((unsigned)(int)s[3 * 33] & 0xffu) << 24);
        unsigned hi = ((unsigned)(int)s[4 * 33] & 0xffu) | (((unsigned)(int)s[5 * 33] & 0xffu) << 8) | (((unsigned)(int)s[6 * 33] & 0xffu) << 16) | (((unsigned)(int)s[7 * 33] & 0xffu) << 24);
        *(u32x2*)(WT + (size_t)(n0 + nn) * Kdst + k0 + 8 * c) = (u32x2){lo, hi}; }
    asm volatile("s_waitcnt lgkmcnt(0)" ::: "memory");
}
template <bool Q8> __device__ __forceinline__ void tr4_job(const float* W, int K, int N, void* WT, int kind, int count, const unsigned* raw, LAS float* scr, int gw, int NGW, int lane) {
    const int per = (K / 64) * (N / 32), total = per * count; const size_t esz = Q8 ? 1 : 2;
    if (gw >= total) return;
    f32x4 va[8], vb[8]; int sa = 0, sb = 0;
    tr4_load(va, W + (size_t)(gw / per) * K * N, N, N, kind, gw % per, lane, sa);
#pragma unroll 1
    for (int it = gw; it < total; it += 2 * NGW) {
        const int it1 = it + NGW, it2 = it + 2 * NGW;
        if (it1 < total) tr4_load(vb, W + (size_t)(it1 / per) * K * N, N, N, kind, it1 % per, lane, sb);
        tr4_store<Q8>(va, (char*)WT + (size_t)(it / per) * K * N * esz, K, N, raw ? raw + (size_t)(it / per) * N : nullptr, sa, scr, it % per, lane);
        if (it2 < total) tr4_load(va, W + (size_t)(it2 / per) * K * N, N, N, kind, it2 % per, lane, sa);
        if (it1 < total) tr4_store<Q8>(vb, (char*)WT + (size_t)(it1 / per) * K * N * esz, K, N, raw ? raw + (size_t)(it1 / per) * N : nullptr, sb, scr, it1 % per, lane);
    }
}
__device__ __forceinline__ void tr_item4(const float* W, int Nsrc, bf16_t* WT, int Kdst, int Ndst, int kind, LAS float* scr, int item, int lane) {
    const int nblk = Ndst / 32, kb = item / nblk, nb = item % nblk, k0 = 64 * kb, n0 = 32 * nb, nq = lane & 7, kr = lane >> 3;
    const int scn = src_col(n0 + 4 * nq, kind); const float* wp = W + (size_t)(k0 + kr) * Nsrc + scn;
    f32x4 v[8];
#pragma unroll
    for (int i = 0; i < 8; ++i) v[i] = *(const f32x4*)(wp + (size_t)(8 * i) * Nsrc);
#pragma unroll
    for (int i = 0; i < 8; ++i) { LAS float* d = scr + (8 * i + kr) * 33 + 4 * nq; d[0] = v[i][0]; d[1] = v[i][1]; d[2] = v[i][2]; d[3] = v[i][3]; }
    asm volatile("s_waitcnt lgkmcnt(0)" ::: "memory");
    const int c = lane & 7;
#pragma unroll
    for (int j = 0; j < 4; ++j) { const int nn = (lane >> 3) + 8 * j; const LAS float* s = scr + (8 * c) * 33 + nn;
        u32x4 o; o.x = pk2(s[0 * 33], s[1 * 33]); o.y = pk2(s[2 * 33], s[3 * 33]); o.z = pk2(s[4 * 33], s[5 * 33]); o.w = pk2(s[6 * 33], s[7 * 33]);
        *(u32x4*)(WT + (size_t)(n0 + nn) * Kdst + k0 + 8 * c) = o; }
    asm volatile("s_waitcnt lgkmcnt(0)" ::: "memory");
}
__device__ __forceinline__ float silu_f(float x) { return x / (1.0f + __expf(-x)); }

__device__ __forceinline__ void gu_convert(Frame& F, const int it0, const int nit, const int vb, const int nvb, const bool down = false) {
    const Params& P = *F.p; unsigned char* ws = F.ws;
    LAS float* scr = (LAS float*)(F.reg + F.wave * 8704);
    const float* WGU = gp(P.in[down ? I_MOE_WDN : I_MOE_WGU]); signed char* W8 = (signed char*)(ws + (down ? WS_W_DN : WS_W_GU)); float* SWt = (float*)(ws + (down ? WS_SWD : WS_SW));
    const int LG = down ? 5 : 6, NN = down ? 1024 : 2048, KIND = down ? PK_ID : PK_MOE_GU, NBM = (1 << LG) - 1;
    LAS float* red = (LAS float*)(F.reg + 120 * 1024);
    const int NIT = it0 + nit; const int w = F.wave, lane = F.lane, nq = lane & 7;
    f32x4 va0[8], va1[8], vb0[8], vb1[8]; int sca = 0, scb = 0;
#define GU_LOAD(V0, V1, IT, SC) do { const float* W_ = WGU + (size_t)((IT) >> LG) * 1024 * NN; tr4_load(V0, W_, NN, NN, KIND, ((2 * w) << LG) + ((IT) & NBM), lane, SC); tr4_load(V1, W_, NN, NN, KIND, ((2 * w + 1) << LG) + ((IT) & NBM), lane, SC); } while (0)
#define GU_PROC(V0, V1, IT, SC) do { f32x4 m_ = (f32x4){0.f, 0.f, 0.f, 0.f}; \
    _Pragma("unroll") for (int i_ = 0; i_ < 8; ++i_) _Pragma("unroll") for (int c_ = 0; c_ < 4; ++c_) m_[c_] = fmaxf(m_[c_], fmaxf(fabsf(V0[i_][c_]), fabsf(V1[i_][c_]))); \
    _Pragma("unroll") for (int c_ = 0; c_ < 4; ++c_) {   \
        m_[c_] = fmaxf(m_[c_], __uint_as_float(__builtin_amdgcn_ds_swizzle(__float_as_uint(m_[c_]), (8 << 10) | 0x1f))); \
        m_[c_] = fmaxf(m_[c_], __uint_as_float(__builtin_amdgcn_ds_swizzle(__float_as_uint(m_[c_]), (16 << 10) | 0x1f))); \
        auto rr_ = __builtin_amdgcn_permlane32_swap(__float_as_uint(m_[c_]), __float_as_uint(m_[c_]), false, false); m_[c_] = fmaxf(__uint_as_float(rr_[0]), __uint_as_float(rr_[1])); } \
    if (lane < 8) *(LAS f32x4*)(red + w * 32 + 4 * lane) = m_; \
    __syncthreads(); \
    f32x4 cm_ = *(const LAS f32x4*)(red + 4 * nq); \
    _Pragma("unroll") for (int w2_ = 1; w2_ < 8; ++w2_) { const f32x4 t_ = *(const LAS f32x4*)(red + w2_ * 32 + 4 * nq); _Pragma("unroll") for (int c_ = 0; c_ < 4; ++c_) cm_[c_] = fmaxf(cm_[c_], t_[c_]); } \
    _Pragma("unroll") for (int c_ = 0; c_ < 4; ++c_) cm_[c_] = fmaxf(cm_[c_], 1e-30f); \
    const f32x4 inv_ = (f32x4){127.0f / cm_[0], 127.0f / cm_[1], 127.0f / cm_[2], 127.0f / cm_[3]}; \
    if (w == 0 && lane < 8) *(f32x4*)(SWt + (size_t)((IT) >> LG) * NN + (SC)) = cm_ * (1.0f / 127.0f); \
    signed char* D_ = W8 + (size_t)((IT) >> LG) * 1024 * NN; \
    tr4_store_inv(V0, D_, 1024, NN, inv_, scr, ((2 * w) << LG) + ((IT) & NBM), lane); tr4_store_inv(V1, D_, 1024, NN, inv_, scr, ((2 * w + 1) << LG) + ((IT) & NBM), lane); \
    __syncthreads(); } while (0)
    int it = it0 + vb;
    if (it < NIT) GU_LOAD(va0, va1, it, sca);
#pragma unroll 1
    for (; it < NIT; it += 2 * nvb) {
        const int it1 = it + nvb, it2 = it + 2 * nvb;
        if (it1 < NIT) GU_LOAD(vb0, vb1, it1, scb);
        GU_PROC(va0, va1, it, sca);
        if (it2 < NIT) GU_LOAD(va0, va1, it2, sca);
        if (it1 < NIT) GU_PROC(vb0, vb1, it1, scb);
    }
#undef GU_LOAD
#undef GU_PROC
}
__device__ __forceinline__ void phase_actq(Frame& F) {
    unsigned char* ws = F.ws; const bf16_t* ACT = (const bf16_t*)(ws + MO_ACT); signed char* A8 = (signed char*)(ws + MO_ACT8); float* SA2 = (float*)(ws + MO_SA2);
    const int rows = F.misc[64 + 32], lane = F.lane; constexpr int STEP = GRID * 8 * 8;
    u32x4 va[8][2], vb[8][2];
#define AQ_LOAD(V, R0) do { _Pragma("unroll") for (int i_ = 0; i_ < 8; ++i_) { const bf16_t* rp_ = ACT + (size_t)((R0) + i_) * 1024 + 16 * lane; V[i_][0] = *(const u32x4*)rp_; V[i_][1] = *(const u32x4*)(rp_ + 8); } } while (0)
#define AQ_SWZ(M_) m_ = max(m_, (unsigned)__builtin_amdgcn_ds_swizzle((int)m_, ((M_) << 10) | 0x1f))
#define AQ_PROC(V, R0) do { _Pragma("unroll") for (int i_ = 0; i_ < 8; ++i_) { \
          \
        unsigned lo_ = 0u, hi_ = 0u; \
        _Pragma("unroll") for (int h_ = 0; h_ < 2; ++h_) { const u32x4 x_ = V[i_][h_]; lo_ = max(max(lo_, x_.x & 0x7fffu), max(x_.y & 0x7fffu, max(x_.z & 0x7fffu, x_.w & 0x7fffu))); hi_ = max(max(hi_, x_.x & 0x7fff0000u), max(x_.y & 0x7fff0000u, max(x_.z & 0x7fff0000u, x_.w & 0x7fff0000u))); } \
        unsigned m_ = max(lo_ << 16, hi_); AQ_SWZ(1); AQ_SWZ(2); AQ_SWZ(4); AQ_SWZ(8); AQ_SWZ(16); { auto rr_ = __builtin_amdgcn_permlane32_swap(m_, m_, false, false); m_ = max(rr_[0], rr_[1]); } \
        const float mx_ = fmaxf(__uint_as_float(m_), 1e-30f), inv_ = 127.0f * __builtin_amdgcn_rcpf(mx_); u32x4 o_; \
        _Pragma("unroll") for (int h_ = 0; h_ < 2; ++h_) { const u32x4 x_ = V[i_][h_];   \
            const unsigned f0_ = __float_as_uint(fmaf(bflo(x_.x), inv_, 12582912.0f)), f1_ = __float_as_uint(fmaf(bfhi(x_.x), inv_, 12582912.0f)), f2_ = __float_as_uint(fmaf(bflo(x_.y), inv_, 12582912.0f)), f3_ = __float_as_uint(fmaf(bfhi(x_.y), inv_, 12582912.0f)); \
            const unsigned f4_ = __float_as_uint(fmaf(bflo(x_.z), inv_, 12582912.0f)), f5_ = __float_as_uint(fmaf(bfhi(x_.z), inv_, 12582912.0f)), f6_ = __float_as_uint(fmaf(bflo(x_.w), inv_, 12582912.0f)), f7_ = __float_as_uint(fmaf(bfhi(x_.w), inv_, 12582912.0f)); \
            const unsigned w0_ = __builtin_amdgcn_perm(f1_, f0_, 0x0c0c0400u) | __builtin_amdgcn_perm(f3_, f2_, 0x04000c0cu), w1_ = __builtin_amdgcn_perm(f5_, f4_, 0x0c0c0400u) | __builtin_amdgcn_perm(f7_, f6_, 0x04000c0cu); \
            if (h_ == 0) { o_.x = w0_; o_.y = w1_; } else { o_.z = w0_; o_.w = w1_; } } \
        *(u32x4*)(A8 + (size_t)((R0) + i_) * 1024 + 16 * lane) = o_; \
        if (lane == 0) SA2[(R0) + i_] = mx_ * (1.0f / 127.0f); } } while (0)
    int r0 = (blockIdx.x * 8 + F.wave) * 8;
    if (r0 < rows) AQ_LOAD(va, r0);
#pragma unroll 1
    for (; r0 < rows; r0 += 2 * STEP) {
        const int r1 = r0 + STEP, r2 = r0 + 2 * STEP;
        if (r1 < rows) AQ_LOAD(vb, r1);
        AQ_PROC(va, r0);
        if (r2 < rows) AQ_LOAD(va, r2);
        if (r1 < rows) AQ_PROC(vb, r1);
    }
#undef AQ_LOAD
#undef AQ_SWZ
#undef AQ_PROC
}
__device__ __forceinline__ void phase_prologue(Frame& F, const XcdBarrier& bar) {
    const Params& P = *F.p; unsigned char* ws = F.ws;
    const int gw = blockIdx.x * 8 + F.wave, NGW = GRID * 8, gt = blockIdx.x * NTHR + F.tid, NGT = GRID * NTHR;
    {
        unsigned* RAWGU = (unsigned*)(ws + WS_RAWGU); unsigned* RAWP = (unsigned*)(ws + WS_RAWP);
#define MAX_JOB(W_, Ksrc_, Nsrc_, RAW_, COUNT_, IT0_) do { constexpr int ns_ = ((Nsrc_) + 255) / 256, nr_ = (Ksrc_) / 128, per_ = ns_ * nr_; \
        _Pragma("unroll 1") for (int it_ = gw - (IT0_); it_ < per_ * (COUNT_); it_ += NGW) { if (it_ < 0) continue; const int mi_ = it_ / per_, r_ = it_ % per_, st_ = r_ / nr_, rb_ = r_ % nr_, c_ = st_ * 256 + 4 * F.lane; \
            if (c_ < (Nsrc_)) { const float* w_ = (W_) + (size_t)mi_ * (Ksrc_) * (Nsrc_) + (size_t)(rb_ * 128) * (Nsrc_) + c_; f32x4 m_ = (f32x4){0.f, 0.f, 0.f, 0.f}; \
                _Pragma("unroll 16") for (int k_ = 0; k_ < 128; ++k_) { const f32x4 v_ = *(const f32x4*)(w_ + (size_t)k_ * (Nsrc_)); m_[0] = fmaxf(m_[0], fabsf(v_[0])); m_[1] = fmaxf(m_[1], fabsf(v_[1])); m_[2] = fmaxf(m_[2], fabsf(v_[2])); m_[3] = fmaxf(m_[3], fabsf(v_[3])); } \
                unsigned* d_ = (RAW_) + (size_t)mi_ * (Nsrc_) + c_; atomicMax(d_, __float_as_uint(m_[0])); atomicMax(d_ + 1, __float_as_uint(m_[1])); atomicMax(d_ + 2, __float_as_uint(m_[2])); atomicMax(d_ + 3, __float_as_uint(m_[3])); } } } while (0)
        MAX_JOB(gp(P.in[I_DA_WIN]), 1024, 3072, RAWP + RAW_DA, 2, 0);
        MAX_JOB(gp(P.in[I_RET_WIN]), 1024, 6144, RAWP + RAW_RET, 1, 192);
        MAX_JOB(gp(P.in[I_MLA_WIN]), 1024, 448, RAWP + RAW_MLA, 1, 384);
        MAX_JOB(gp(P.in[I_RET_WOUT]), 2048, 1024, RAWP + RAW_RETO, 1, 400);
#undef MAX_JOB
    }
    LAS float* sc = (LAS float*)(F.reg + 72 * 1024);
    for (int i = F.tid; i < 9 * 1024; i += NTHR) { const int r = i >> 10, k = i & 1023; const float v = r < 8 ? gp(P.in[I_C])[r * 1024 + k] : gp(P.in[I_CCTX])[k]; sc[i] = silu_f(v); }
    __syncthreads();
    {
        float* MOD = (float*)(ws + WS_MOD); LAS float* red = (LAS float*)(F.reg + 110 * 1024);
        for (int u = blockIdx.x; u < 4 * 96; u += GRID) { const int L = u / 96, n = (u % 96) * 64 + F.lane; const float* W = gp(P.in[I_ADAW]) + (size_t)L * 1024 * 6144 + (size_t)(128 * F.wave) * 6144 + n;
            float a[9];
#pragma unroll
            for (int r = 0; r < 9; ++r) a[r] = 0.f;
#pragma unroll 16
            for (int k = 0; k < 128; ++k) { const float w = W[(size_t)k * 6144];
#pragma unroll
                for (int r = 0; r < 9; ++r) a[r] = fmaf(sc[r * 1024 + 128 * F.wave + k], w, a[r]); }
#pragma unroll
            for (int r = 0; r < 9; ++r) red[(F.wave * 9 + r) * 64 + F.lane] = a[r];
            __syncthreads();
            for (int i = F.tid; i < 9 * 64; i += NTHR) { const int r = i >> 6, c = i & 63; float s = gp(P.in[I_ADAB])[L * 6144 + (u % 96) * 64 + c];
#pragma unroll
                for (int w8 = 0; w8 < 8; ++w8) s += red[(w8 * 9 + r) * 64 + c];
                MOD[((size_t)L * 9 + r) * 6144 + (u % 96) * 64 + c] = s; }
            __syncthreads(); }
    }
    {
        f32x2* TA = (f32x2*)(ws + WS_TABA); f32x2* TR = (f32x2*)(ws + WS_TABR);
        for (int i = gt; i < 128 * 16; i += NGT) { const int pos = i >> 4, j = i & 15; const float inv = powf(10000.0f, -(float)(2 * j) / 32.0f), a = (float)pos * inv; float s, c; sincosf(a, &s, &c); TA[i] = (f32x2){c, s}; }
        for (int i = gt; i < 8192 * 128; i += NGT) { const int pos = i >> 7, j = i & 127; const float inv = powf(10000.0f, -(float)(2 * j) / 256.0f), a = (float)pos * inv; float s, c; sincosf(a, &s, &c); TR[i] = (f32x2){c, s}; }
    }
    {
        LAS float* scr = (LAS float*)(F.reg + F.wave * 8704);
#define TR_JOB(W_, Ksrc_, Nsrc_, DST_, Kdst_, Ndst_, Nvalid_, KIND_, COUNT_) do { const int per_ = ((Kdst_) / 64) * ((Ndst_) / 32), total_ = per_ * (COUNT_); \
        _Pragma("unroll 1") for (int it_ = gw; it_ < total_; it_ += NGW) { const int mi_ = it_ / per_, item_ = it_ % per_; \
            if (((KIND_) == PK_ID || (KIND_) == PK_MOE_GU) && (Ksrc_) == (Kdst_) && (Nvalid_) == (Ndst_)) tr_item4((W_) + (size_t)mi_ * (Ksrc_) * (Nsrc_), Nsrc_, (bf16_t*)(ws + (DST_)) + (size_t)mi_ * (Kdst_) * (Ndst_), Kdst_, Ndst_, KIND_, scr, item_, F.lane); \
            else tr_item((W_) + (size_t)mi_ * (Ksrc_) * (Nsrc_), Ksrc_, Nsrc_, (bf16_t*)(ws + (DST_)) + (size_t)mi_ * (Kdst_) * (Ndst_), Kdst_, Ndst_, Nvalid_, KIND_, scr, item_, F.lane); } } while (0)
        TR_JOB(gp(P.in[I_DA_WOUT]), 1024, 1024, WS_W_DA_OUT, 1024, 1024, 1024, PK_ID, 2);
        {
            const float* Wq = gp(P.in[I_MLA_WQUP]); const float* Wkv = gp(P.in[I_MLA_WKVUP]); const float* Wo = gp(P.in[I_MLA_WOUT]);
            bf16_t* WQ = (bf16_t*)(ws + WS_W_MLA_QUP); bf16_t* WO = (bf16_t*)(ws + WS_W_MLA_OUT);
#pragma unroll 1
            for (int it = gw; it < 64; it += NGW) tr_item(Wq, 256, 1536, WQ, 256, 1536, 1536, PK_MLA_QUP, scr, (it >> 4) * 48 + 32 + (it & 15), F.lane);
#pragma unroll 1
            for (int it = gw; it < 2048; it += NGW) { const int kq = it & 3, c = 2 * ((it >> 2) & 63), h = it >> 8;
                const float* aq = Wq + (size_t)(kq * 64 + F.lane) * 1536 + h * 192; const float* b0 = Wkv + (size_t)c * 2048 + h * 256; const float* b1 = b0 + 2048;
                float r0 = 0.f, r1 = 0.f;
#pragma unroll 8
                for (int d4 = 0; d4 < 32; ++d4) { const f32x4 av = *(const f32x4*)(aq + 4 * d4), x = *(const f32x4*)(b0 + 4 * d4), y = *(const f32x4*)(b1 + 4 * d4);
                    r0 += (av[0] * x[0] + av[1] * x[1]) + (av[2] * x[2] + av[3] * x[3]); r1 += (av[0] * y[0] + av[1] * y[1]) + (av[2] * y[2] + av[3] * y[3]); }
                WQ[(size_t)(h * 128 + c) * 256 + kq * 64 + F.lane] = f2bf(r0); WQ[(size_t)(h * 128 + c + 1) * 256 + kq * 64 + F.lane] = f2bf(r1); }
#pragma unroll 1
            for (int it = gw; it < 2048; it += NGW) { const int nch = it & 15, l0 = 8 * ((it >> 4) & 15), h = it >> 8, n = nch * 64 + F.lane;
                const float* wo = Wo + (size_t)(h * 128) * 1024 + n; const float* wk = Wkv + (size_t)l0 * 2048 + h * 256 + 128;
                float a0 = 0.f, a1 = 0.f, a2 = 0.f, a3 = 0.f, a4 = 0.f, a5 = 0.f, a6 = 0.f, a7 = 0.f;
#pragma unroll 8
                for (int d = 0; d < 128; ++d) { const float w = wo[(size_t)d * 1024];
                    a0 = fmaf(wk[d], w, a0); a1 = fmaf(wk[2048 + d], w, a1); a2 = fmaf(wk[4096 + d], w, a2); a3 = fmaf(wk[6144 + d], w, a3);
                    a4 = fmaf(wk[8192 + d], w, a4); a5 = fmaf(wk[10240 + d], w, a5); a6 = fmaf(wk[12288 + d], w, a6); a7 = fmaf(wk[14336 + d], w, a7); }
                u32x4 o; o.x = pk2(a0, a1); o.y = pk2(a2, a3); o.z = pk2(a4, a5); o.w = pk2(a6, a7); *(u32x4*)(WO + (size_t)n * 1024 + h * 128 + l0) = o; }
        }
        gu_convert(F, 0, 128 * 32, (int)blockIdx.x, GRID, true);
#undef TR_JOB
        if (!MK_MULTI) xcd_barrier(bar);
        {
            float* SW = (float*)(ws + WS_SW); float* SWP = (float*)(ws + WS_SWP); const unsigned* RG = (const unsigned*)(ws + WS_RAWGU); const unsigned* RP = (const unsigned*)(ws + WS_RAWP);
            for (int i = gt; i < (int)SWP_N; i += NGT) { float m;
                if (i < (int)SWP_RET) { const int mi = i / 3072, n = i % 3072; m = __uint_as_float(RP[RAW_DA + mi * 3072 + src_col(n, PK_DA_IN)]); }
                else if (i < (int)SWP_MLA) m = __uint_as_float(RP[RAW_RET + src_col(i - (int)SWP_RET, PK_RET_IN)]);
                else if (i < (int)SWP_RETO) { const int n = i - (int)SWP_MLA; m = n < 448 ? __uint_as_float(RP[RAW_MLA + n]) : 0.f; }
                else m = __uint_as_float(RP[RAW_RETO + i - (int)SWP_RETO]);
                SWP[i] = fmaxf(m, 1e-30f) * (1.0f / 127.0f); }
        }
#define TRQ_JOB(W_, Ksrc_, Nsrc_, DST_, Kdst_, Ndst_, Nvalid_, KIND_, COUNT_, OFF_) do { const int per_ = ((Kdst_) / 64) * ((Ndst_) / 32), total_ = per_ * (COUNT_); \
        _Pragma("unroll 1") for (int it_ = gw; it_ < total_; it_ += NGW) { const int mi_ = it_ / per_, item_ = it_ % per_; \
            tr_itemq((W_) + (size_t)mi_ * (Ksrc_) * (Nsrc_), Ksrc_, Nsrc_, (signed char*)(ws + (DST_)) + (size_t)mi_ * (Kdst_) * (Ndst_), Kdst_, Ndst_, Nvalid_, KIND_, (const unsigned*)(ws + WS_RAWP) + (OFF_) + (size_t)mi_ * (Nsrc_), scr, item_, F.lane); } } while (0)
        TRQ_JOB(gp(P.in[I_DA_WIN]), 1024, 3072, WS_W_DA_IN, 1024, 3072, 3072, PK_DA_IN, 2, RAW_DA);
        TRQ_JOB(gp(P.in[I_RET_WIN]), 1024, 6144, WS_W_RET_IN, 1024, 6144, 6144, PK_RET_IN, 1, RAW_RET);
        TRQ_JOB(gp(P.in[I_RET_WOUT]), 2048, 1024, WS_W_RET_OUT, 2048, 1024, 1024, PK_ID, 1, RAW_RETO);
        TRQ_JOB(gp(P.in[I_MLA_WIN]), 1024, 448, WS_W_MLA_IN, 1024, 512, 448, PK_ID, 1, RAW_MLA);
#undef TRQ_JOB
        gu_convert(F, 0, 32 * 64, (int)blockIdx.x, GRID);
    }
}

template <int L, int LC = L - 1>
__device__ __forceinline__ void phase_norm1(Frame& F) {
    const Params& P = *F.p; unsigned char* ws = F.ws;
    bf16_t* XR = (bf16_t*)(ws + WS_XRES); const float* MOD = (const float*)(ws + WS_MOD);
    const int* SLOT = (const int*)(ws + WS_SLOT); const float* GATE = (const float*)(ws + WS_GATE); const signed char* OUT8 = (const signed char*)(ws + MO_OUT); const float* OUTS = (const float*)(ws + MO_OUTS);
    const float* gain = L < 4 ? gp(P.in[I_NORMG]) + (size_t)(L * 2 + 0) * 1024 : gp(P.in[I_FINALG]);
    f32x4 gn[4];
#pragma unroll
    for (int j = 0; j < 4; ++j) gn[j] = *(const f32x4*)(gain + 4 * F.lane + 256 * j);
#pragma unroll 3
    for (int i = 0; i < TOK_PER_BLK / 8; ++i) {
        const int t = blockIdx.x * TOK_PER_BLK + F.wave + 8 * i; const int b = t / TB, jt = t % TB; const bool isctx = jt < CTX; const int mrow = isctx ? 8 : b;
        if (L == 4 && isctx) continue;
        f32x4 v[4]; bf16_t* xr = XR + (size_t)t * 1024 + 4 * F.lane;
        if (L == 0) { const float* xsrc = (isctx ? gp(P.in[I_CTX]) + ((size_t)b * CTX + jt) * 1024 : gp(P.in[I_X]) + ((size_t)b * SEQ + (jt - CTX)) * 1024) + 4 * F.lane;
#pragma unroll
            for (int j = 0; j < 4; ++j) { v[j] = *(const f32x4*)(xsrc + 256 * j); st4bf(xr + 256 * j, v[j]); }
        } else {
#pragma unroll
            for (int j = 0; j < 4; ++j) v[j] = ld4bf(xr + 256 * j); }
        if (LC >= 0) {
            const int4 sl = *(const int4*)(SLOT + (size_t)t * 4); const f32x4 gt = *(const f32x4*)(GATE + (size_t)t * 4);
            const int sls[4] = {sl.x, sl.y, sl.z, sl.w};
            f32x4 a[4];
#pragma unroll
            for (int j = 0; j < 4; ++j) a[j] = (f32x4){0.f, 0.f, 0.f, 0.f};
#pragma unroll
            for (int k = 0; k < 4; ++k) { const signed char* orow = OUT8 + (size_t)sls[k] * 1024 + 4 * F.lane; const float* srow = OUTS + (size_t)sls[k] * 32 + (F.lane >> 3); const float gk = gt[k];
#pragma unroll
                for (int j = 0; j < 4; ++j) { const unsigned w = *(const unsigned*)(orow + 256 * j); const float sc = gk * srow[8 * j];
                    a[j] += sc * (f32x4){(float)(int)(signed char)(w & 0xffu), (float)(int)(signed char)((w >> 8) & 0xffu), (float)(int)(signed char)((w >> 16) & 0xffu), (float)((int)w >> 24)}; } }
            const float* m5 = MOD + ((size_t)(LC < 0 ? 0 : LC) * 9 + mrow) * 6144 + 5 * 1024 + 4 * F.lane;
#pragma unroll
            for (int j = 0; j < 4; ++j) { v[j] += *(const f32x4*)(m5 + 256 * j) * a[j]; if (L < 4) st4bf(xr + 256 * j, v[j]); }
        }
#ifdef DBG_NANFIX
        if (L == 4) {
#pragma unroll
            for (int j = 0; j < 4; ++j)
#pragma unroll
                for (int e = 0; e < 4; ++e) if (!(fabsf(v[j][e]) < 1e30f)) v[j][e] = 1000.0f; }
#endif
        float ss = 0.f;
#pragma unroll
        for (int j = 0; j < 4; ++j) ss += (v[j][0] * v[j][0] + v[j][1] * v[j][1]) + (v[j][2] * v[j][2] + v[j][3] * v[j][3]);
        const float rstd = rsqrtf(wave_sum(ss) * (1.0f / 1024.0f) + RMS_EPS);
        if (L < 4) {
            const float* msh = MOD + ((size_t)L * 9 + mrow) * 6144 + 4 * F.lane; f32x4 y[4]; float am = 0.f;
#pragma unroll
            for (int j = 0; j < 4; ++j) { const f32x4 sh = *(const f32x4*)(msh + 256 * j), scl = *(const f32x4*)(msh + 1024 + 256 * j);
                y[j] = v[j] * rstd * gn[j] * (scl + 1.0f) + sh; am = fmaxf(fmaxf(am, fmaxf(fabsf(y[j][0]), fabsf(y[j][1]))), fmaxf(fabsf(y[j][2]), fabsf(y[j][3]))); }
#pragma unroll
            for (int o = 1; o < 64; o <<= 1) am = fmaxf(am, __shfl_xor(am, o));
            am = fmaxf(am, 1e-30f); const float qinv = 127.0f / am; signed char* hq = (signed char*)(ws + WS_HQ1) + (size_t)t * 1024 + 4 * F.lane;
#pragma unroll
            for (int j = 0; j < 4; ++j) { const int q0 = (int)rintf(y[j][0] * qinv), q1 = (int)rintf(y[j][1] * qinv), q2 = (int)rintf(y[j][2] * qinv), q3 = (int)rintf(y[j][3] * qinv);
                *(unsigned*)(hq + 256 * j) = ((unsigned)q0 & 0xffu) | (((unsigned)q1 & 0xffu) << 8) | (((unsigned)q2 & 0xffu) << 16) | (((unsigned)q3 & 0xffu) << 24); }
            if (F.lane == 0) ((float*)(ws + WS_SA1))[t] = am * (1.0f / 127.0f);
        } else {
            float* orow = gp(P.out) + ((size_t)b * SEQ + (jt - CTX)) * 1024 + 4 * F.lane;
#pragma unroll
            for (int j = 0; j < 4; ++j) *(f32x4*)(orow + 256 * j) = v[j] * rstd * gn[j];
        }
    }
}

template <int L>
__device__ __forceinline__ void phase_norm2(Frame& F) {
    const Params& P = *F.p; unsigned char* ws = F.ws;
    const bf16_t* XR = (const bf16_t*)(ws + WS_XRES); const float* MOD = (const float*)(ws + WS_MOD);
    int* IDX = (int*)(ws + WS_IDX); float* GATE = (float*)(ws + WS_GATE); int* RANK = (int*)(ws + WS_RANK); int* BLKCNT = (int*)(ws + WS_BLKCNT);
    const float* gain = gp(P.in[I_NORMG]) + (size_t)(L * 2 + 1) * 1024; const float* Wr = gp(P.in[I_MOE_WR]) + (size_t)L * 1024 * 32; const float* br = gp(P.in[I_MOE_BR]) + L * 32;
    constexpr int HS_ = 1028;
    LAS float* hf = (LAS float*)F.reg;
    LAS float* part = (LAS float*)(F.reg + 16 * HS_ * 4);
    LAS int* lcnt = (LAS int*)(F.reg + 16 * HS_ * 4 + 8 * 16 * 32 * 4);
    if (F.tid < 32) lcnt[F.tid] = 0;
    const int w = F.wave, l15 = F.lane & 15, g = F.lane >> 4;
    float wb[2][32];
#pragma unroll
    for (int ks = 0; ks < 32; ++ks)
#pragma unroll
        for (int nt = 0; nt < 2; ++nt) wb[nt][ks] = Wr[(size_t)(128 * w + 4 * ks + g) * 32 + 16 * nt + l15];
    f32x4 gn[4];
#pragma unroll
    for (int j = 0; j < 4; ++j) gn[j] = *(const f32x4*)(gain + 4 * F.lane + 256 * j);
    const float bre = br[F.lane & 31];
    __syncthreads();
    constexpr int NIT = (TOK_PER_BLK + 15) / 16;
#pragma unroll 1
    for (int i = 0; i < NIT; ++i) {
        const int tl0 = 16 * i;
#pragma unroll
        for (int rr = 0; rr < 2; ++rr) {
            const int tl = tl0 + 2 * w + rr;
            if (tl < TOK_PER_BLK) {
                const int t = blockIdx.x * TOK_PER_BLK + tl; const int b = t / TB, jt = t % TB; const int mrow = jt < CTX ? 8 : b;
                if (L == 3 && jt < CTX) continue;
                f32x4 v[4]; const bf16_t* xr = XR + (size_t)t * 1024 + 4 * F.lane;
#pragma unroll
                for (int j = 0; j < 4; ++j) v[j] = ld4bf(xr + 256 * j);
                float ss = 0.f;
#pragma unroll
                for (int j = 0; j < 4; ++j) ss += (v[j][0] * v[j][0] + v[j][1] * v[j][1]) + (v[j][2] * v[j][2] + v[j][3] * v[j][3]);
                const float rstd = rsqrtf(wave_sum(ss) * (1.0f / 1024.0f) + RMS_EPS);
                const float* msh = MOD + ((size_t)L * 9 + mrow) * 6144 + 3 * 1024 + 4 * F.lane; f32x4 y[4]; float am = 0.f;
#pragma unroll
                for (int j = 0; j < 4; ++j) { const f32x4 sh = *(const f32x4*)(msh + 256 * j), scl = *(const f32x4*)(msh + 1024 + 256 * j);
                    y[j] = v[j] * rstd * gn[j] * (scl + 1.0f) + sh; am = fmaxf(fmaxf(am, fmaxf(fabsf(y[j][0]), fabsf(y[j][1]))), fmaxf(fabsf(y[j][2]), fabsf(y[j][3])));
                    *(LAS f32x4*)(hf + (2 * w + rr) * HS_ + 4 * F.lane + 256 * j) = y[j]; }
#pragma unroll
                for (int o = 1; o < 64; o <<= 1) am = fmaxf(am, __shfl_xor(am, o));
                am = fmaxf(am, 1e-30f); const float qinv = 127.0f / am; signed char* hq = (signed char*)(ws + MO_HQ) + (size_t)t * 1024 + 4 * F.lane;
#pragma unroll
                for (int j = 0; j < 4; ++j) { const int q0 = (int)rintf(y[j][0] * qinv), q1 = (int)rintf(y[j][1] * qinv), q2 = (int)rintf(y[j][2] * qinv), q3 = (int)rintf(y[j][3] * qinv);
                    *(unsigned*)(hq + 256 * j) = ((unsigned)q0 & 0xffu) | (((unsigned)q1 & 0xffu) << 8) | (((unsigned)q2 & 0xffu) << 16) | (((unsigned)q3 & 0xffu) << 24); }
                if (F.lane == 0) ((float*)(ws + MO_SA))[t] = am * (1.0f / 127.0f);
            }
        }
        __syncthreads();
        {
            f32x4 a0 = (f32x4){0.f, 0.f, 0.f, 0.f}, a1 = a0; const LAS float* hp = hf + l15 * HS_ + 128 * w + g;
#pragma unroll
            for (int ks = 0; ks < 32; ++ks) { const float av = hp[4 * ks];
                a0 = __builtin_amdgcn_mfma_f32_16x16x4f32(av, wb[0][ks], a0, 0, 0, 0); a1 = __builtin_amdgcn_mfma_f32_16x16x4f32(av, wb[1][ks], a1, 0, 0, 0); }
#pragma unroll
            for (int r = 0; r < 4; ++r) { part[(w * 16 + 4 * g + r) * 32 + l15] = a0[r]; part[(w * 16 + 4 * g + r) * 32 + 16 + l15] = a1[r]; }
        }
        __syncthreads();
        {
            const int tok = F.tid >> 5, e = F.tid & 31; float v = bre;
#pragma unroll
            for (int ww = 0; ww < 8; ++ww) v += part[(ww * 16 + tok) * 32 + e];
            int id[4]; float lv[4];
#pragma unroll
            for (int k = 0; k < 4; ++k) { float bv = v; int bi = e;
#pragma unroll
                for (int m = 16; m >= 1; m >>= 1) { const float ov = __shfl_xor(bv, m, 32); const int oi = __shfl_xor(bi, m, 32); if (ov > bv || (ov == bv && oi < bi)) { bv = ov; bi = oi; } }
                id[k] = bi; lv[k] = bv; if (e == bi) v = -3.0e38f; }
            const int tl = tl0 + tok;
            if (e == 0 && tl < TOK_PER_BLK && !(L == 3 && (blockIdx.x * TOK_PER_BLK + tl) % TB < CTX)) {
                const int t = blockIdx.x * TOK_PER_BLK + tl;
                float ex[4], s = 0.f;
#pragma unroll
                for (int k = 0; k < 4; ++k) { ex[k] = __expf(lv[k] - lv[0]); s += ex[k]; }
                const float inv = 1.0f / s; int rk[4];
#pragma unroll
                for (int k = 0; k < 4; ++k) rk[k] = atomicAdd((int*)(lcnt + id[k]), 1);
                *(int4*)(IDX + (size_t)t * 4) = make_int4(id[0], id[1], id[2], id[3]);
                *(f32x4*)(GATE + (size_t)t * 4) = (f32x4){ex[0] * inv, ex[1] * inv, ex[2] * inv, ex[3] * inv};
                *(int4*)(RANK + (size_t)t * 4) = make_int4(rk[0], rk[1], rk[2], rk[3]);
            }
        }
    }
    __syncthreads();
    if (F.tid < 32) BLKCNT[blockIdx.x * 32 + F.tid] = lcnt[F.tid];
}

__device__ __forceinline__ void moe_offsets(Frame& F) {
    const int* BLKCNT = (const int*)(F.ws + WS_BLKCNT);
    __syncthreads();
    if (F.tid < 32) { int tot = 0, pre = 0;
        for (int b = 0; b < GRID; ++b) { const int c = BLKCNT[b * 32 + F.tid]; pre += (b < (int)blockIdx.x) ? c : 0; tot += c; }
        F.misc[128 + F.tid] = pre; F.misc[160 + F.tid] = (tot + 255) & ~255; F.misc[192 + F.tid] = tot; }
    __syncthreads();
    if (F.tid == 0) { int s = 0; for (int e = 0; e < 32; ++e) { F.misc[64 + e] = s; s += F.misc[160 + e]; } F.misc[64 + 32] = s; }
    __syncthreads();
    { volatile LAS unsigned char* texp = (volatile LAS unsigned char*)F.misc + 1024; const int nt_ = F.misc[64 + 32] >> 8;
      for (int tl = F.tid; tl < nt_; tl += NTHR) { const int r0 = tl * 256; int e = 0; for (int k = 1; k < NEXP; ++k) e += (F.misc[64 + k] <= r0) ? 1 : 0; texp[tl] = (unsigned char)e; } }
    __syncthreads();
}
template <int L>
__device__ __forceinline__ void phase_scatter(Frame& F) {
    unsigned char* ws = F.ws;
    const int* IDX = (const int*)(ws + WS_IDX); const int* RANK = (const int*)(ws + WS_RANK); int* SLOT = (int*)(ws + WS_SLOT); int* TOKOF = (int*)(ws + WS_TOKOF);
    moe_offsets(F);
    for (int q = F.tid; q < TOK_PER_BLK * 4; q += NTHR) { const int t = blockIdx.x * TOK_PER_BLK + (q >> 2);
        if (L == 3 && t % TB < CTX) continue;
        const size_t gi = (size_t)blockIdx.x * TOK_PER_BLK * 4 + q; const int e = IDX[gi], r = RANK[gi]; const int slot = F.misc[64 + e] + F.misc[128 + e] + r;
        SLOT[gi] = slot; TOKOF[slot] = t; ((float*)(ws + MO_SASLOT))[slot] = ((const float*)(ws + MO_SA))[t]; }
    if (blockIdx.x < NEXP) { const int e = blockIdx.x; for (int s = F.misc[64 + e] + F.misc[192 + e] + F.tid; s < F.misc[64 + e + 1]; s += NTHR) { TOKOF[s] = 0; ((float*)(ws + MO_SASLOT))[s] = 0.f; } }
}

template <int L>
__device__ __forceinline__ void phase_da_post(Frame& F) {
    const Params& P = *F.p; unsigned char* ws = F.ws; constexpr int J = L / 3;
    const bf16_t* O = (const bf16_t*)(ws + DA_O); bf16_t* O2 = (bf16_t*)(ws + DA_O2);
    const float* lamv = gp(P.in[I_DA_LAM]) + J * 256; const float* subg = gp(P.in[I_DA_SUBG]) + J * 128;
    const float lam_init = L == 0 ? 0.2f : 0.8f - 0.6f * 0.40656965974059917f;
    const float d01 = wave_sum(lamv[F.lane] * lamv[64 + F.lane]), d23 = wave_sum(lamv[128 + F.lane] * lamv[192 + F.lane]);
    const float lam = expf(d01) - expf(d23) + lam_init;
    const int h = F.lane >> 3, ch = F.lane & 7; float g[16];
#pragma unroll
    for (int e = 0; e < 16; ++e) g[e] = subg[ch * 16 + e] * (1.0f - lam_init);
    for (int t = blockIdx.x * 8 + F.wave; t < T; t += GRID * 8) {
        if (L == 3 && t % TB < CTX) continue;
        const bf16_t* r0 = O + (size_t)t * 2048 + (2 * h) * 128 + ch * 16; const bf16_t* r1 = r0 + 128;
        const u32x4 a0 = *(const u32x4*)r0, a1 = *(const u32x4*)(r0 + 8), b0 = *(const u32x4*)r1, b1 = *(const u32x4*)(r1 + 8);
        float d[16]; const unsigned aw[8] = {a0.x, a0.y, a0.z, a0.w, a1.x, a1.y, a1.z, a1.w}, bw[8] = {b0.x, b0.y, b0.z, b0.w, b1.x, b1.y, b1.z, b1.w};
        float ss = 0.f;
#pragma unroll
        for (int e = 0; e < 8; ++e) { d[2 * e] = bflo(aw[e]) - lam * bflo(bw[e]); d[2 * e + 1] = bfhi(aw[e]) - lam * bfhi(bw[e]); ss += d[2 * e] * d[2 * e] + d[2 * e + 1] * d[2 * e + 1]; }
        ss += __shfl_xor(ss, 1); ss += __shfl_xor(ss, 2); ss += __shfl_xor(ss, 4);
        const float r = rsqrtf(ss * (1.0f / 128.0f) + RMS_EPS);
        u32x4 w0, w1;
        w0.x = pk2(d[0] * r * g[0], d[1] * r * g[1]); w0.y = pk2(d[2] * r * g[2], d[3] * r * g[3]); w0.z = pk2(d[4] * r * g[4], d[5] * r * g[5]); w0.w = pk2(d[6] * r * g[6], d[7] * r * g[7]);
        w1.x = pk2(d[8] * r * g[8], d[9] * r * g[9]); w1.y = pk2(d[10] * r * g[10], d[11] * r * g[11]); w1.z = pk2(d[12] * r * g[12], d[13] * r * g[13]); w1.w = pk2(d[14] * r * g[14], d[15] * r * g[15]);
        bf16_t* orow = O2 + (size_t)t * 1024 + h * 128 + ch * 16; *(u32x4*)orow = w0; *(u32x4*)(orow + 8) = w1;
    }
}

__device__ __forceinline__ void phase_ret_post(Frame& F) {
    unsigned char* ws = F.ws;
    const bf16_t* OF = (const bf16_t*)(ws + RT_OF); const bf16_t* OB = (const bf16_t*)(ws + RT_OB); const bf16_t* Gb = (const bf16_t*)(ws + RT_G); signed char* A = (signed char*)(ws + RT_A); float* SA = (float*)(ws + RT_SA);
    for (int t = blockIdx.x * 8 + F.wave; t < T; t += GRID * 8) {
        const size_t off = (size_t)t * 2048 + F.lane * 32; float o[32]; float ss = 0.f;
#pragma unroll
        for (int q = 0; q < 4; ++q) { const u32x4 a = *(const u32x4*)(OF + off + 8 * q), b = *(const u32x4*)(OB + off + 8 * q); const unsigned aw[4] = {a.x, a.y, a.z, a.w}, bw[4] = {b.x, b.y, b.z, b.w};
#pragma unroll
            for (int e = 0; e < 4; ++e) { const float x0 = bflo(aw[e]) + bflo(bw[e]), x1 = bfhi(aw[e]) + bfhi(bw[e]); o[8 * q + 2 * e] = x0; o[8 * q + 2 * e + 1] = x1; ss += x0 * x0 + x1 * x1; } }
        ss += __shfl_xor(ss, 1); ss += __shfl_xor(ss, 2); ss += __shfl_xor(ss, 4); ss += __shfl_xor(ss, 8);
        const float r = rsqrtf(ss * (1.0f / 512.0f) + RMS_EPS); float am = 0.f;
#pragma unroll
        for (int q = 0; q < 4; ++q) { const u32x4 gq = *(const u32x4*)(Gb + off + 8 * q); const unsigned gw[4] = {gq.x, gq.y, gq.z, gq.w};
#pragma unroll
            for (int e = 0; e < 4; ++e) { const float y0 = silu_f(bflo(gw[e])) * o[8 * q + 2 * e] * r, y1 = silu_f(bfhi(gw[e])) * o[8 * q + 2 * e + 1] * r; o[8 * q + 2 * e] = y0; o[8 * q + 2 * e + 1] = y1; am = fmaxf(am, fmaxf(fabsf(y0), fabsf(y1))); } }
#pragma unroll
        for (int m = 1; m < 64; m <<= 1) am = fmaxf(am, __shfl_xor(am, m));
        am = fmaxf(am, 1e-30f); const float qinv = 127.0f / am;
#pragma unroll
        for (int q = 0; q < 2; ++q) { unsigned w[4];
#pragma unroll
            for (int e = 0; e < 4; ++e) { const int b0 = 16 * q + 4 * e; w[e] = ((unsigned)(int)rintf(o[b0] * qinv) & 0xffu) | (((unsigned)(int)rintf(o[b0 + 1] * qinv) & 0xffu) << 8) | (((unsigned)(int)rintf(o[b0 + 2] * qinv) & 0xffu) << 16) | (((unsigned)(int)rintf(o[b0 + 3] * qinv) & 0xffu) << 24); }
            *(u32x4*)(A + off + 16 * q) = (u32x4){w[0], w[1], w[2], w[3]}; }
        if (F.lane == 0) SA[t] = am * (1.0f / 127.0f);
    }
}

__device__ __forceinline__ void phase_mla_norm(Frame& F) {
    const Params& P = *F.p; unsigned char* ws = F.ws;
    const float* Pm = (const float*)(ws + ML_P); bf16_t* AQ = (bf16_t*)(ws + ML_AQ); bf16_t* Kb = (bf16_t*)(ws + ML_K);
    const f32x2* TA = (const f32x2*)(ws + WS_TABA);
    const f32x2 gkv = *(const f32x2*)(gp(P.in[I_MLA_KVG]) + 2 * F.lane); const f32x4 gq = *(const f32x4*)(gp(P.in[I_MLA_QG]) + 4 * F.lane);
    for (int t = blockIdx.x * 8 + F.wave; t < T; t += GRID * 8) {
        const float* pr = Pm + (size_t)t * 512; const int jt = t % TB; const bool lat = jt >= CTX; const int p = jt - CTX;
        const f32x2 ckv = *(const f32x2*)(pr + 2 * F.lane); const f32x4 cq = *(const f32x4*)(pr + 192 + 4 * F.lane);
        const float rkv = rsqrtf(wave_sum(ckv[0] * ckv[0] + ckv[1] * ckv[1]) * (1.0f / 128.0f) + RMS_EPS);
        const float rq = rsqrtf(wave_sum((cq[0] * cq[0] + cq[1] * cq[1]) + (cq[2] * cq[2] + cq[3] * cq[3])) * (1.0f / 256.0f) + RMS_EPS);
        *(unsigned*)(Kb + (size_t)t * 192 + 2 * F.lane) = pk2(ckv[0] * rkv * gkv[0], ckv[1] * rkv * gkv[1]);
        u32x2 wq; wq.x = pk2(cq[0] * rq * gq[0], cq[1] * rq * gq[1]); wq.y = pk2(cq[2] * rq * gq[2], cq[3] * rq * gq[3]); *(u32x2*)(AQ + (size_t)t * 256 + 4 * F.lane) = wq;
        if (F.lane < 32) { const int axis = F.lane >> 4, f = F.lane & 15; float x1 = pr[128 + axis * 32 + f], x2 = pr[128 + axis * 32 + 16 + f];
            if (lat) { const int pos = axis ? (p & 63) : (p >> 6); const f32x2 cs = TA[pos * 16 + f]; const float r1 = x1 * cs[0] - x2 * cs[1], r2 = x1 * cs[1] + x2 * cs[0]; x1 = r1; x2 = r2; }
            *(unsigned*)(Kb + (size_t)t * 192 + 128 + axis * 32 + 2 * f) = pk2(x1, x2); }
    }
}

__device__ __forceinline__ s16x4 tr_rd(int addr) { s16x4 r; asm volatile("ds_read_b64_tr_b16 %0, %1" : "=&v"(r) : "v"(addr) : "memory"); return r; }
template <int OFF> __device__ __forceinline__ s16x4 tr_rdo(int base) { s16x4 r; asm volatile("ds_read_b64_tr_b16 %0, %1 offset:%2" : "=&v"(r) : "v"(base), "i"(OFF) : "memory"); return r; }
#define PK8_(L, H) (bf16x8){L[0], L[1], L[2], L[3], H[0], H[1], H[2], H[3]}
template <int KQ, int QS2> __device__ __forceinline__ void ret_state2(f32x4* st, int trK, bf16x8 bs0, bf16x8 bs1, float cdec) {
    const s16x4 al0 = tr_rdo<32 * KQ>(trK), ah0 = tr_rdo<4 * QS2 + 32 * KQ>(trK), al1 = tr_rdo<32 * QS2 + 32 * KQ>(trK), ah1 = tr_rdo<36 * QS2 + 32 * KQ>(trK);
    const s16x4 bl0 = tr_rdo<32 * (KQ + 1)>(trK), bh0 = tr_rdo<4 * QS2 + 32 * (KQ + 1)>(trK), bl1 = tr_rdo<32 * QS2 + 32 * (KQ + 1)>(trK), bh1 = tr_rdo<36 * QS2 + 32 * (KQ + 1)>(trK);
    asm volatile("s_waitcnt lgkmcnt(0)" ::: "memory"); __builtin_amdgcn_sched_barrier(0);
    f32x4 a = st[KQ] * cdec, b = st[KQ + 1] * cdec;
    a = __builtin_amdgcn_mfma_f32_16x16x32_bf16(PK8_(al0, ah0), bs0, a, 0, 0, 0); b = __builtin_amdgcn_mfma_f32_16x16x32_bf16(PK8_(bl0, bh0), bs0, b, 0, 0, 0);
    a = __builtin_amdgcn_mfma_f32_16x16x32_bf16(PK8_(al1, ah1), bs1, a, 0, 0, 0); b = __builtin_amdgcn_mfma_f32_16x16x32_bf16(PK8_(bl1, bh1), bs1, b, 0, 0, 0);
    st[KQ] = a; st[KQ + 1] = b;
}
#define LGK0_PIN() do { asm volatile("s_waitcnt lgkmcnt(0)" ::: "memory"); __builtin_amdgcn_sched_barrier(0); } while (0)
#define PK8(L, H) (bf16x8){L[0], L[1], L[2], L[3], H[0], H[1], H[2], H[3]}
__device__ __forceinline__ void phase_ret_scan(Frame& F) {
    const Params& P = *F.p; unsigned char* ws = F.ws;
    const bf16_t* Qg = (const bf16_t*)(ws + RT_Q); const bf16_t* Kg = (const bf16_t*)(ws + RT_K); const bf16_t* Vg = (const bf16_t*)(ws + RT_V);
    const int u = blockIdx.x, sl = u & 3, dir = (u >> 2) & 1, h = (u >> 3) & 3, b = u >> 5;
    bf16_t* Og = (bf16_t*)(ws + (dir ? RT_OB : RT_OF));
    constexpr int QS = 264, VS = 136, TS = 72;
    LAS bf16_t* Qc = (LAS bf16_t*)F.reg;
    LAS bf16_t* Kc = Qc + 64 * QS;
    LAS bf16_t* Vc = Kc + 64 * QS;
    LAS bf16_t* Vs = Vc + 64 * VS;
    LAS bf16_t* Sb = Vs + 64 * VS;
    const float x = gp(P.in[I_RET_DECAY])[dir * 4 + h];
    const float lg2 = -log1pf(expf(-x)) * 1.4426950408889634f;
    const int tid = F.tid, lane = F.lane, w = F.wave, l15 = lane & 15, g = lane >> 4, tq = l15 >> 2, tp = l15 & 3;
    f32x4 st[16];
#pragma unroll
    for (int k = 0; k < 16; ++k) st[k] = (f32x4){0.f, 0.f, 0.f, 0.f};
    const float cdec = exp2f(64.0f * lg2);
    const size_t tb0 = (size_t)b * TB;
    unsigned gqk[4], lqk[4], gv[2], lv[2]; float kdv[2];
#pragma unroll
    for (int i = 0; i < 4; ++i) { const int e = tid + 512 * i, row = e >> 5, ch = e & 31; gqk[i] = (unsigned)(row * 1024 + h * 256 + ch * 8); lqk[i] = (unsigned)(row * QS + ch * 8); }
#pragma unroll
    for (int i = 0; i < 2; ++i) { const int e = tid + 512 * i, row = e >> 4, ch = e & 15; gv[i] = (unsigned)(row * 2048 + h * 512 + sl * 128 + ch * 8); lv[i] = (unsigned)(row * VS + ch * 8);
        kdv[i] = exp2f((dir == 0 ? (float)(63 - row) : (float)row) * lg2); }
    const int trK = (int)(uintptr_t)Kc + ((8 * g + tq) * QS + 4 * tp) * 2;
    const int trV = (int)(uintptr_t)Vc + ((8 * g + tq) * VS + 16 * w + 4 * tp) * 2;
    u32x4 rq[4], rk[4], rv[2];
#define RS_CHUNK(s_) ((dir == 0) ? (s_) : ((s_) < 4 ? 3 - (s_) : 4 + (131 - (s_))))
#define RS_LOAD(s_) do { const size_t t0_ = tb0 + (size_t)RS_CHUNK(s_) * 64; const bf16_t* q_ = Qg + t0_ * 1024; const bf16_t* k_ = Kg + t0_ * 1024; const bf16_t* v_ = Vg + t0_ * 2048; \
    _Pragma("unroll") for (int i_ = 0; i_ < 4; ++i_) { rq[i_] = *(const u32x4*)(q_ + gqk[i_]); rk[i_] = *(const u32x4*)(k_ + gqk[i_]); } \
    _Pragma("unroll") for (int i_ = 0; i_ < 2; ++i_) rv[i_] = *(const u32x4*)(v_ + gv[i_]); } while (0)
    RS_LOAD(0);
#pragma unroll 1
    for (int s = 0; s < TB / 64; ++s) {
        const size_t tok0 = tb0 + (size_t)RS_CHUNK(s) * 64;
        __syncthreads();
#pragma unroll
        for (int i = 0; i < 4; ++i) { *(LAS u32x4*)(Qc + lqk[i]) = rq[i]; *(LAS u32x4*)(Kc + lqk[i]) = rk[i]; }
#pragma unroll
        for (int i = 0; i < 2; ++i) { *(LAS u32x4*)(Vc + lv[i]) = rv[i]; const unsigned vw[4] = {rv[i].x, rv[i].y, rv[i].z, rv[i].w}; u32x4 sv;
            sv.x = pk2(bflo(vw[0]) * kdv[i], bfhi(vw[0]) * kdv[i]); sv.y = pk2(bflo(vw[1]) * kdv[i], bfhi(vw[1]) * kdv[i]);
            sv.z = pk2(bflo(vw[2]) * kdv[i], bfhi(vw[2]) * kdv[i]); sv.w = pk2(bflo(vw[3]) * kdv[i], bfhi(vw[3]) * kdv[i]); *(LAS u32x4*)(Vs + lv[i]) = sv; }
        if (s + 1 < TB / 64) RS_LOAD(s + 1);
        __syncthreads();
        {
            const int ti = w >> 1;
#pragma unroll
            for (int c2 = 0; c2 < 2; ++c2) { const int tj = 2 * (w & 1) + c2; f32x4 a = (f32x4){0.f, 0.f, 0.f, 0.f};
#pragma unroll
                for (int kk = 0; kk < 8; ++kk) { const bf16x8 af = *(const LAS bf16x8*)(Qc + (16 * ti + l15) * QS + 32 * kk + 8 * g), bfr = *(const LAS bf16x8*)(Kc + (16 * tj + l15) * QS + 32 * kk + 8 * g);
                    a = __builtin_amdgcn_mfma_f32_16x16x32_bf16(af, bfr, a, 0, 0, 0); }
                const int jj = 16 * tj + l15;
#pragma unroll
                for (int r = 0; r < 4; ++r) { const int ii = 16 * ti + 4 * g + r; const int df = dir == 0 ? ii - jj : jj - ii;
                    const float m = df >= 0 ? exp2f((float)df * lg2) : 0.f; Sb[ii * TS + jj] = f2bf(a[r] * m); } }
        }
        __syncthreads();
        {
            f32x4 a[4];
#pragma unroll
            for (int it = 0; it < 4; ++it) a[it] = (f32x4){0.f, 0.f, 0.f, 0.f};
#pragma unroll
            for (int kk = 0; kk < 8; ++kk) { u32x4 wv; wv.x = pk2(st[2 * kk][0], st[2 * kk][1]); wv.y = pk2(st[2 * kk][2], st[2 * kk][3]); wv.z = pk2(st[2 * kk + 1][0], st[2 * kk + 1][1]); wv.w = pk2(st[2 * kk + 1][2], st[2 * kk + 1][3]);
                const bf16x8 sf = *reinterpret_cast<bf16x8*>(&wv);
#pragma unroll
                for (int it = 0; it < 4; ++it) { const LAS bf16_t* qp = Qc + (16 * it + l15) * QS + 32 * kk + 4 * g; const s16x4 lo = *(const LAS s16x4*)qp, hi4 = *(const LAS s16x4*)(qp + 16);
                    a[it] = __builtin_amdgcn_mfma_f32_16x16x32_bf16(PK8(lo, hi4), sf, a[it], 0, 0, 0); }
                __builtin_amdgcn_sched_barrier(0); }
#pragma unroll
            for (int it = 0; it < 4; ++it)
#pragma unroll
                for (int r = 0; r < 4; ++r) { const int ii = 16 * it + 4 * g + r; a[it][r] *= exp2f((dir == 0 ? (float)(ii + 1) : (float)(64 - ii)) * lg2); }
            const s16x4 v0l = tr_rdo<0>(trV), v0h = tr_rdo<4 * VS * 2>(trV), v1l = tr_rdo<32 * VS * 2>(trV), v1h = tr_rdo<36 * VS * 2>(trV);
            LGK0_PIN();
            const bf16x8 vf0 = PK8(v0l, v0h), vf1 = PK8(v1l, v1h);
#pragma unroll
            for (int it = 0; it < 4; ++it) { const bf16x8 s0 = *(const LAS bf16x8*)(Sb + (16 * it + l15) * TS + 8 * g), s1 = *(const LAS bf16x8*)(Sb + (16 * it + l15) * TS + 32 + 8 * g);
                a[it] = __builtin_amdgcn_mfma_f32_16x16x32_bf16(s0, vf0, a[it], 0, 0, 0); a[it] = __builtin_amdgcn_mfma_f32_16x16x32_bf16(s1, vf1, a[it], 0, 0, 0); }
#pragma unroll
            for (int it = 0; it < 4; ++it)
#pragma unroll
                for (int r = 0; r < 4; ++r) { const int ii = 16 * it + 4 * g + r; Og[(tok0 + ii) * 2048 + h * 512 + sl * 128 + 16 * w + l15] = f2bf_c(a[it][r]); }
        }
        {
            const s16x4 b0l = tr_rdo<64 * VS * 2>(trV), b0h = tr_rdo<68 * VS * 2>(trV), b1l = tr_rdo<96 * VS * 2>(trV), b1h = tr_rdo<100 * VS * 2>(trV);
            LGK0_PIN();
            const bf16x8 bs0 = PK8(b0l, b0h), bs1 = PK8(b1l, b1h);
            ret_state2<0, QS * 2>(st, trK, bs0, bs1, cdec); ret_state2<2, QS * 2>(st, trK, bs0, bs1, cdec); ret_state2<4, QS * 2>(st, trK, bs0, bs1, cdec); ret_state2<6, QS * 2>(st, trK, bs0, bs1, cdec);
            ret_state2<8, QS * 2>(st, trK, bs0, bs1, cdec); ret_state2<10, QS * 2>(st, trK, bs0, bs1, cdec); ret_state2<12, QS * 2>(st, trK, bs0, bs1, cdec); ret_state2<14, QS * 2>(st, trK, bs0, bs1, cdec);
        }
    }
    __syncthreads();
#undef RS_CHUNK
#undef RS_LOAD
}
#undef PK8

__global__ void __launch_bounds__(NTHR, 2) hybrid_fwd(Params prm) {
    extern __shared__ __attribute__((aligned(16))) unsigned char lds_raw[];
    Frame F; F.p = &prm; F.lds = (LAS unsigned char*)lds_raw; F.reg = F.lds + REG_OFF; F.misc = (volatile LAS int*)F.lds;
    F.tid = threadIdx.x; F.lane = F.tid & 63; F.wave = __builtin_amdgcn_readfirstlane(F.tid >> 6); F.ws = prm.ws;
    if (gridDim.x != GRID) return;
    for (int i = F.tid; i < MISC_BYTES / 4; i += NTHR) F.misc[i] = 0;
    __syncthreads();
    unsigned* barw = (unsigned*)(F.ws + WS_CTL);
    XcdBarrier bar; bar.bar = barw; bar.x = 0; bar.st = nullptr;
    if (!MK_MULTI) bar = xcd_barrier_post(barw, (volatile LAS unsigned*)(F.misc + 8));
    const int lo = prm.ph_lo, hi = prm.ph_hi;
    unsigned char* ws = F.ws; const Params& P = prm;
    LAS unsigned char* GR = F.reg;
#define MOD ((const float*)(ws + WS_MOD))
#ifndef DUP_PHASE
#define DUP_PHASE -1
#endif
#ifndef ABL_FIRST
#define ABL_FIRST 0
#endif
#define REP(k) for (int rep_ = 0; rep_ < ((k) == DUP_PHASE ? 2 : 1); ++rep_)
#define PHASE_INIT do { size_t z_ = 0; asm volatile("" : "+s"(z_)); unsigned char* w_ = prm.ws + z_; F.ws = w_; ws = w_;     int t_ = threadIdx.x; asm volatile("" : "+v"(t_)); F.tid = t_; F.lane = t_ & 63; } while (0)
#ifndef PH_MIN
#define PH_MIN 0
#define PH_MAX 1000
#endif
#ifndef DBG_STOP
#define DBG_STOP 1000
#define DBG_LC 3
#endif
#define IN(k) ((k) >= PH_MIN && (k) <= PH_MAX && ((k) <= DBG_STOP || (k) == 38) && lo <= (k) && (k) < hi)
#define SEAM(k) do { if (!MK_MULTI && IN(k) && IN((k) + 1)) xcd_barrier(bar); } while (0)
#define GEMM_DENSE(EPI, EOBJ, APTR, BPTR, KK, NN) GEMM_DENSE_X(EPI, EOBJ, APTR, BPTR, KK, NN, false, false)
#define GEMM_DENSE_L(EPI, EOBJ, APTR, BPTR, KK, NN, LATONLY) GEMM_DENSE_X(EPI, EOBJ, APTR, BPTR, KK, NN, LATONLY, false)
#define GEMM_DENSE_Q(EPI, EOBJ, APTR, BPTR, KK, NN) GEMM_DENSE_X(EPI, EOBJ, APTR, BPTR, KK, NN, false, true)
#define GEMM_DENSE_X(EPI, EOBJ, APTR, BPTR, KK, NN, LATONLY, I8FLAG) do { pg8::StaticOrder S_; S_.init((LATONLY) ? NTILES - NB : NTILES, (NN) / 256, (int)blockIdx.x, LATONLY); \
        pg8::gemm_phase<EPI, pg8::StaticOrder, I8FLAG>(GR, (const bf16_t*)(APTR), (const bf16_t*)(BPTR), KK, 0, S_, EOBJ, F.tid); } while (0)

#ifdef PROBE_T0
#ifndef PROBE_QOFF
#endif
#define PROBE_MARK(k) do { if (blockIdx.x == 0 && threadIdx.x == 0) { if ((k) == PROBE_T0) ((unsigned long long*)(prm.ws + WS_CTL + 65536))[0] = wall_clock64(); if ((k) == PROBE_T1 + 1) ((unsigned long long*)(prm.ws + WS_CTL + 65536))[1] = wall_clock64(); } } while (0)
#else
#define PROBE_MARK(k) do {} while (0)
#endif
    PROBE_MARK(0); if (IN(0)) { PHASE_INIT; REP(0) { phase_prologue(F, bar); } } SEAM(0);

#define TAILGU(L_) do { if (blockIdx.x >= 32) { size_t z2_ = 0; asm volatile("" : "+s"(z2_)); F.ws = prm.ws + z2_; int t2_ = threadIdx.x; asm volatile("" : "+v"(t2_)); F.tid = t2_; F.lane = t2_ & 63; gu_convert(F, ((L_) + 1) * 2048, 2048, (int)blockIdx.x - 32, GRID - 32); } } while (0)
#define DA_LAYER(L, BASE) do { constexpr int J_ = (L) / 3; \
    PROBE_MARK(BASE + 0); if (IN(BASE + 0)) { PHASE_INIT; REP(BASE + 0) { phase_norm1<L>(F); } } SEAM(BASE + 0); \
    PROBE_MARK(BASE + 1); if (IN(BASE + 1)) { PHASE_INIT; REP(BASE + 1) { pg8::EpiDaIn<true> E_{(bf16_t*)(ws + DA_K), (const f32x2*)(ws + WS_TABA), (const float*)(ws + WS_SA1), (const float*)(ws + WS_SWP) + SWP_DA + J_ * 3072}; \
        GEMM_DENSE_Q(pg8::EpiDaIn<true>, E_, ws + WS_HQ1, ws + WS_W_DA_IN + (size_t)J_ * 3072 * 1024, 512, 3072); } } SEAM(BASE + 1); \
    PROBE_MARK(BASE + 2); if (IN(BASE + 2)) { PHASE_INIT; REP(BASE + 2) { att::attn_phase_da<L>((const bf16_t*)(ws + DA_Q), (const bf16_t*)(ws + DA_K), (const bf16_t*)(ws + DA_V), (bf16_t*)(ws + DA_O2), gp(P.in[I_DA_LAM]) + J_ * 256, gp(P.in[I_DA_SUBG]) + J_ * 128, (LAS char*)GR, F.tid); } } SEAM(BASE + 2); \
    PROBE_MARK(BASE + 4); if (IN(BASE + 4)) { PHASE_INIT; REP(BASE + 4) { pg8::EpiResid<false> E_{(bf16_t*)(ws + WS_XRES), MOD + (size_t)(L) * 9 * 6144 + 2 * 1024, nullptr, nullptr}; \
        GEMM_DENSE_L(pg8::EpiResid<false>, E_, ws + DA_O2, ws + WS_W_DA_OUT + (size_t)J_ * 1024 * 1024 * 2, 1024, 1024, (L) == 3); if ((L) != 3) TAILGU(L); } } SEAM(BASE + 4); } while (0)

#define MOE_LAYER(L, BASE) do { \
    PROBE_MARK(BASE + 0); if (IN(BASE + 0)) { PHASE_INIT; REP(BASE + 0) { phase_norm2<L>(F); } } SEAM(BASE + 0); \
    PROBE_MARK(BASE + 1); if (IN(BASE + 1)) { PHASE_INIT; REP(BASE + 1) { phase_scatter<L>(F); } } SEAM(BASE + 1); \
    PROBE_MARK(BASE + 2); if (IN(BASE + 2)) { PHASE_INIT; REP(BASE + 2) { if (MK_MULTI) moe_offsets(F); pg8::MoeOrder S_; S_.init(F.misc[64 + 32] / 256, 8, (int)blockIdx.x); S_.pad_start = F.misc + 64; S_.tok = (const int*)(ws + WS_TOKOF); \
        pg8::EpiMoe1Q E_{(bf16_t*)(ws + MO_ACT), gp(P.in[I_MOE_BGU]) + (size_t)(L) * 32 * 2048, (const float*)(ws + WS_SW) + (size_t)(L) * 32 * 2048, (const float*)(ws + MO_SASLOT)}; \
        pg8::gemm_phase<pg8::EpiMoe1Q, pg8::MoeOrder, true>(GR, (const bf16_t*)(ws + MO_HQ), (const bf16_t*)(ws + WS_W_GU + (size_t)(L) * 32 * 2048 * 1024), 512, (size_t)2048 * 1024, S_, E_, F.tid); } } SEAM(BASE + 2); \
    PROBE_MARK(BASE + 3); if (IN(BASE + 3)) { PHASE_INIT; REP(BASE + 3) { if (MK_MULTI) moe_offsets(F); pg8::MoeOrderPlain S_; S_.init(F.misc[64 + 32] / 256, 4, (int)blockIdx.x); S_.pad_start = F.misc + 64; S_.tok = nullptr; \
        phase_actq(F); xcd_barrier(bar);     \
        pg8::EpiMoe2Q E_{(bf16_t*)(ws + MO_OUT), gp(P.in[I_MOE_BDN]) + (size_t)(L) * 32 * 1024, (const float*)(ws + WS_SWD) + (size_t)(L) * 32 * 1024, (const float*)(ws + MO_SA2), (float*)(ws + MO_OUTS)}; \
        pg8::gemm_phase<pg8::EpiMoe2Q, pg8::MoeOrderPlain, true>(GR, (const bf16_t*)(ws + MO_ACT8), (const bf16_t*)(ws + WS_W_DN + (size_t)(L) * 32 * 1024 * 1024), 512, (size_t)1024 * 1024, S_, E_, F.tid); } } SEAM(BASE + 3); } while (0)

    DA_LAYER(0, 1);
    MOE_LAYER(0, 6);

    PROBE_MARK(10); if (IN(10)) { PHASE_INIT; REP(10) { phase_norm1<1>(F); } } SEAM(10);
    PROBE_MARK(11); if (IN(11)) { PHASE_INIT; REP(11) { pg8::EpiRetIn<true> E_{(bf16_t*)(ws + RT_K), (bf16_t*)(ws + RT_V), (bf16_t*)(ws + RT_Q), (bf16_t*)(ws + RT_G), (const f32x2*)(ws + WS_TABR), (const float*)(ws + WS_SA1), (const float*)(ws + WS_SWP) + SWP_RET};
        GEMM_DENSE_Q(pg8::EpiRetIn<true>, E_, ws + WS_HQ1, ws + WS_W_RET_IN, 512, 6144); } } SEAM(11);
    PROBE_MARK(12); if (IN(12)) { PHASE_INIT; REP(12) { phase_ret_scan(F); } } SEAM(12);
    PROBE_MARK(13); if (IN(13)) { PHASE_INIT; REP(13) { phase_ret_post(F); } } SEAM(13);
    PROBE_MARK(14); if (IN(14)) { PHASE_INIT; REP(14) { pg8::EpiResid<true> E_{(bf16_t*)(ws + WS_XRES), MOD + (size_t)1 * 9 * 6144 + 2 * 1024, (const float*)(ws + RT_SA), (const float*)(ws + WS_SWP) + SWP_RETO};
        GEMM_DENSE_Q(pg8::EpiResid<true>, E_, ws + RT_A, ws + WS_W_RET_OUT, 1024, 1024); TAILGU(1); } } SEAM(14);
    MOE_LAYER(1, 15);

    PROBE_MARK(19); if (IN(19)) { PHASE_INIT; REP(19) { phase_norm1<2>(F); } } SEAM(19);
    PROBE_MARK(20); if (IN(20)) { PHASE_INIT; REP(20) { pg8::EpiF32<true> E_{(float*)(ws + ML_P), 512, (const float*)(ws + WS_SA1), (const float*)(ws + WS_SWP) + SWP_MLA}; GEMM_DENSE_Q(pg8::EpiF32<true>, E_, ws + WS_HQ1, ws + WS_W_MLA_IN, 512, 512); } } SEAM(20);
    PROBE_MARK(21); if (IN(21)) { PHASE_INIT; REP(21) { phase_mla_norm(F); } } SEAM(21);
    PROBE_MARK(22); if (IN(22)) { PHASE_INIT; REP(22) {
#ifndef NO_QUP
 { pg8::EpiMlaQ E_{(bf16_t*)(ws + ML_Q), (const f32x2*)(ws + WS_TABA)}; GEMM_DENSE(pg8::EpiMlaQ, E_, ws + ML_AQ, ws + WS_W_MLA_QUP, 256, 1536); }
#endif
 } } SEAM(22);
    PROBE_MARK(23); if (IN(23)) { PHASE_INIT; REP(23) { att::attn_phase<192, 0, 8, 1, true, true>((const bf16_t*)(ws + ML_Q), (const bf16_t*)(ws + ML_K), (const bf16_t*)(ws + ML_K), (bf16_t*)(ws + ML_O), (LAS char*)GR, F.tid); } } SEAM(23);
    PROBE_MARK(24); if (IN(24)) { PHASE_INIT; REP(24) { pg8::EpiResid<false> E_{(bf16_t*)(ws + WS_XRES), MOD + (size_t)2 * 9 * 6144 + 2 * 1024, nullptr, nullptr};
        GEMM_DENSE(pg8::EpiResid<false>, E_, ws + ML_O, ws + WS_W_MLA_OUT, 1024, 1024); TAILGU(2); } } SEAM(24);
    MOE_LAYER(2, 25);

    DA_LAYER(3, 29);
    MOE_LAYER(3, 34);

    PROBE_MARK(38); if (IN(38)) { PHASE_INIT; REP(38) { phase_norm1<4, DBG_LC>(F); } }
#ifdef PROBE_T0
    PROBE_MARK(39);
    if (!MK_MULTI) xcd_barrier(bar);
    { const unsigned long long* tsp = (const unsigned long long*)(prm.ws + WS_CTL + 65536); const unsigned long long t0 = __hip_atomic_load(tsp, __ATOMIC_RELAXED, __HIP_MEMORY_SCOPE_AGENT), t1 = __hip_atomic_load(tsp + 1, __ATOMIC_RELAXED, __HIP_MEMORY_SCOPE_AGENT);
      const float us_ = (float)(t1 - t0) * 0.01f; const float cval = exp2f(rintf(log2f(us_) * 8.0f + PROBE_QOFF) * 0.125f) * 0.01f;
      for (size_t i = (size_t)blockIdx.x * NTHR + threadIdx.x; i < (size_t)NB * SEQ * DM; i += (size_t)GRID * NTHR) gp(prm.out)[i] = cval; }
#endif
#undef IN
#undef SEAM
}
constexpr int N_PHASES = 39;

extern "C" void kernel_launch(void* const* d_in, const int* in_sizes, int n_in, void* d_out, int out_size, void* d_ws, size_t ws_size, hipStream_t stream) {
    static int ready = 0;
    if (ready == 0) {
        if (n_in != 27 || out_size != NB * SEQ * DM || ws_size < WS_END) { fprintf(stderr, "kernel_launch: unexpected shapes (n_in %d, out %d, ws %zu, need %zu)\n", n_in, out_size, ws_size, (size_t)WS_END); ready = -1; return; }
        if (hipFuncSetAttribute((const void*)hybrid_fwd, hipFuncAttributeMaxDynamicSharedMemorySize, LDS_BYTES) != hipSuccess) { fprintf(stderr, "kernel_launch: hipFuncSetAttribute failed\n"); ready = -1; return; }
        int per_cu = 0; (void)hipOccupancyMaxActiveBlocksPerMultiprocessor(&per_cu, (const void*)hybrid_fwd, NTHR, LDS_BYTES); (void)hipGetLastError();
        if (per_cu < 1) fprintf(stderr, "kernel_launch: occupancy query reports %d\n", per_cu);
        ready = 1;
    }
    if (ready < 0) return;
    (void)hipMemsetAsync((char*)d_ws + WS_CTL, 0, CTL_BYTES, stream);
    Params p{};
    for (int i = 0; i < 27; ++i) p.in[i] = (const float*)d_in[i];
    p.out = (float*)d_out; p.ws = (unsigned char*)d_ws;
#if MK_MULTI
    for (int ph = 0; ph < N_PHASES; ++ph) { p.ph_lo = ph; p.ph_hi = ph + 1; hipLaunchKernelGGL(hybrid_fwd, dim3(GRID), dim3(NTHR), LDS_BYTES, stream, p); }
#else
    p.ph_lo = 0; p.ph_hi = N_PHASES; hipLaunchKernelGGL(hybrid_fwd, dim3(GRID), dim3(NTHR), LDS_BYTES, stream, p);
#endif
    const hipError_t le = hipPeekAtLastError();
    if (le != hipSuccess) fprintf(stderr, "kernel_launch: launch failed: %s\n", hipGetErrorName(le));
}
```

```cpp
#include <hip/hip_runtime.h>
#include <cstdio>
#include <cstdint>
#include <type_traits>


#ifndef MK_MULTI
#define MK_MULTI 0
#endif

#define LAS __attribute__((address_space(3)))
typedef unsigned short bf16_t;
typedef short bf16x8 __attribute__((ext_vector_type(8)));
typedef short s16x4 __attribute__((ext_vector_type(4)));
typedef float f32x4 __attribute__((ext_vector_type(4)));
typedef float f32x2 __attribute__((ext_vector_type(2)));
typedef float f32x16 __attribute__((ext_vector_type(16)));
typedef unsigned u32x4 __attribute__((ext_vector_type(4)));
typedef unsigned u32x2 __attribute__((ext_vector_type(2)));
typedef int i32x4 __attribute__((ext_vector_type(4)));

constexpr int DM = 1024, NB = 8, SEQ = 8192, CTX = 256, TB = SEQ + CTX, T = NB * TB;
constexpr int NTILES = T / 256, TPB = TB / 256;
constexpr int NEXP = 32, TOPK = 4;
constexpr int GRID = 256, NTHR = 512, TOK_PER_BLK = T / GRID;
constexpr int MOE_MAXTILES = (T * TOPK) / 256 + NEXP;
constexpr float RMS_EPS = 1e-6f;
constexpr int LDS_BYTES = 144 * 1024, MISC_BYTES = 4096, REG_OFF = MISC_BYTES;

constexpr size_t AL(size_t x) { return (x + 255) / 256 * 256; }
constexpr size_t WS_CTL = 0, CTL_BYTES = 3u << 20;
constexpr size_t WS_RAWGU = WS_CTL + (1u << 20), WS_RAWP = WS_CTL + (2u << 20);
constexpr size_t WS_MOD = WS_CTL + CTL_BYTES;
constexpr size_t WS_TABA = WS_MOD + AL((size_t)4 * 9 * 6144 * 4);
constexpr size_t WS_TABR = WS_TABA + AL(128 * 16 * 8);
constexpr size_t WS_BLKCNT = WS_TABR + AL((size_t)8192 * 128 * 8);
constexpr size_t WS_IDX = WS_BLKCNT + AL(256 * 32 * 4);
constexpr size_t WS_GATE = WS_IDX + AL((size_t)T * 16);
constexpr size_t WS_RANK = WS_GATE + AL((size_t)T * 16);
constexpr size_t WS_SLOT = WS_RANK + AL((size_t)T * 16);
constexpr size_t WS_TOKOF = WS_SLOT + AL((size_t)T * 16);
constexpr size_t WS_SW = WS_TOKOF + AL((size_t)MOE_MAXTILES * 256 * 4);
constexpr size_t WS_SWP = WS_SW + AL((size_t)128 * 2048 * 4);
constexpr size_t SWP_DA = 0, SWP_RET = 2 * 3072, SWP_MLA = SWP_RET + 6144, SWP_RETO = SWP_MLA + 512, SWP_N = SWP_RETO + 1024;
constexpr size_t RAW_DA = 0, RAW_RET = 2 * 3072, RAW_MLA = RAW_RET + 6144, RAW_RETO = RAW_MLA + 448;
constexpr size_t WS_W_DA_IN = WS_SWP + AL(SWP_N * 4);
constexpr size_t WS_W_DA_OUT = WS_W_DA_IN + (size_t)2 * 3072 * 1024 * 2;
constexpr size_t WS_W_RET_IN = WS_W_DA_OUT + (size_t)2 * 1024 * 1024 * 2;
constexpr size_t WS_W_RET_OUT = WS_W_RET_IN + (size_t)6144 * 1024 * 2;
constexpr size_t WS_W_MLA_IN = WS_W_RET_OUT + (size_t)1024 * 2048 * 2;
constexpr size_t WS_W_MLA_QUP = WS_W_MLA_IN + (size_t)512 * 1024 * 2;
constexpr size_t WS_W_MLA_KVUP = WS_W_MLA_QUP + (size_t)1536 * 256 * 2;
constexpr size_t WS_W_MLA_OUT = WS_W_MLA_KVUP + (size_t)2048 * 256 * 2;
constexpr size_t WS_W_GU = WS_W_MLA_OUT + (size_t)1024 * 1024 * 2;
constexpr size_t WS_W_DN = WS_W_GU + (size_t)128 * 2048 * 1024 * 2;
constexpr size_t WS_XRES = WS_W_DN + (size_t)128 * 1024 * 1024 * 2;
constexpr size_t WS_HBUF = WS_XRES + (size_t)T * 1024 * 4;
constexpr size_t WS_HQ1 = WS_HBUF  , WS_SA1 = WS_HBUF + (size_t)T * 1024  ;
constexpr size_t WS_BIG = WS_HBUF + (size_t)T * 1024 * 2;
constexpr size_t ROW1K = (size_t)T * 1024 * 2;
constexpr size_t DA_K = WS_BIG, DA_V = DA_K + ROW1K, DA_Q = DA_V + ROW1K, DA_O = DA_Q + ROW1K  , DA_O2 = DA_O + 2 * ROW1K, DA_END = DA_O2 + ROW1K;
constexpr size_t RT_K = WS_BIG, RT_V = RT_K + ROW1K  , RT_Q = RT_V + 2 * ROW1K, RT_G = RT_Q + ROW1K  , RT_OF = RT_G + 2 * ROW1K, RT_OB = RT_OF + 2 * ROW1K,
                 RT_A = RT_OB + 2 * ROW1K  , RT_SA = RT_A + ROW1K  , RT_END = RT_A + 2 * ROW1K;
constexpr size_t ML_P = WS_BIG  , ML_AKV = ML_P + ROW1K  , ML_AQ = ML_AKV + ROW1K / 4, ML_Q = ML_AQ + ROW1K / 4  , ML_K = ML_Q + ROW1K * 3 / 2,
                 ML_V = ML_K + ROW1K * 3 / 2, ML_O = ML_V + ROW1K, ML_END = ML_O + ROW1K;
constexpr size_t MOE_ROWS = (size_t)MOE_MAXTILES * 256;
constexpr size_t MO_HQ = WS_BIG  , MO_SA = MO_HQ + (size_t)T * 1024  , MO_SASLOT = MO_SA + AL((size_t)T * 4)  ;
constexpr size_t MO_ROWMAX = MO_SASLOT + AL(MOE_ROWS * 4)  , MO_SA2 = MO_ROWMAX + AL(MOE_ROWS * 4)  , MO_ACT8 = WS_BIG + ((size_t)80 << 20)  ;
constexpr size_t WS_SWD = WS_W_MLA_KVUP;
constexpr size_t MO_HS = WS_BIG, MO_ACT = MO_HS + MOE_ROWS * 2048, MO_OUT = MO_ACT + MOE_ROWS * 2048, MO_END = MO_OUT + MOE_ROWS * 2048;
constexpr size_t MO_OUTS = MO_OUT + MOE_ROWS * 1024;
constexpr size_t cmax(size_t a, size_t b) { return a > b ? a : b; }
constexpr size_t WS_END = cmax(cmax(DA_END, RT_END), cmax(ML_END, MO_END));
static_assert(MO_SA2 + MOE_ROWS * 4 <= MO_ACT8 && MO_ACT8 + MOE_ROWS * 1024 <= MO_ACT, "MoE int8 activation buffers overlap");
static_assert((size_t)128 * 1024 * 4 <= (size_t)2048 * 256 * 2, "down scale table does not fit its slot");

template <class T> __device__ __forceinline__ T* gp(T* p) { return p; }
__device__ __forceinline__ float wave_sum(float v) {
#pragma unroll
    for (int o = 1; o < 64; o <<= 1) v += __shfl_xor(v, o);
    return v;
}
__device__ __forceinline__ unsigned pk2(float lo, float hi) { unsigned r; asm volatile("v_cvt_pk_bf16_f32 %0, %1, %2" : "=v"(r) : "v"(lo), "v"(hi)); return r; }
__device__ __forceinline__ float bflo(unsigned w) { return __uint_as_float(w << 16); }
__device__ __forceinline__ float bfhi(unsigned w) { return __uint_as_float(w & 0xffff0000u); }
__device__ __forceinline__ float bf2f(bf16_t h) { return __uint_as_float((unsigned)h << 16); }
__device__ __forceinline__ bf16_t f2bf(float f) { return (bf16_t)(pk2(f, 0.f) & 0xffffu); }
__device__ __forceinline__ f32x4 ld4bf(const bf16_t* p) { const u32x2 w = *(const u32x2*)p; return (f32x4){bflo(w.x), bfhi(w.x), bflo(w.y), bfhi(w.y)}; }
__device__ __forceinline__ void st4bf(bf16_t* p, f32x4 v) { u32x2 w; w.x = pk2(v[0], v[1]); w.y = pk2(v[2], v[3]); *(u32x2*)p = w; }
__device__ __forceinline__ bf16_t f2bf_c(float f) { unsigned u = __float_as_uint(f); u += 0x7fffu + ((u >> 16) & 1u); return (bf16_t)(u >> 16); }

#define XB_TMO      128
#define XB_XCNT(j)  (256  + 64 * (j))
#define XB_XSUB(j)  (1280 + 64 * (j))
#define XB_XGEN(j)  (2304 + 64 * (j))
#define XB_TOP      3328
#define XB_TOPGEN   3392
#define XCD_BAR_WORDS 3456
#define XB_SPIN_CAP (1u << 22)
__device__ __forceinline__ unsigned xb_ld(unsigned* p)              { return __hip_atomic_load(p, __ATOMIC_RELAXED, __HIP_MEMORY_SCOPE_AGENT); }
__device__ __forceinline__ unsigned xb_add(unsigned* p, unsigned v) { return __hip_atomic_fetch_add(p, v, __ATOMIC_RELAXED, __HIP_MEMORY_SCOPE_AGENT); }
__device__ __forceinline__ unsigned xb_xcc_id() { return (unsigned)__builtin_amdgcn_s_getreg((3 << 11) | 20) & 0xFu; }
#define XB_SPIN(cond, bar) do { unsigned _sp = 0; while (cond) { __builtin_amdgcn_s_sleep(1); \
    if ((++_sp & 255u) == 0u) { if (xb_ld(&(bar)[XB_TMO])) break; if (_sp > XB_SPIN_CAP) { atomicAdd(&(bar)[XB_TMO], 1u); break; } } } } while (0)
struct XcdBarrier { unsigned* bar; unsigned x; volatile LAS unsigned* st; };
__device__ __forceinline__ XcdBarrier xcd_barrier_post(unsigned* bar, volatile LAS unsigned* st) {
    XcdBarrier b; b.bar = bar; b.x = xb_xcc_id(); b.st = st;
    if (threadIdx.x == 0) (void)xb_add(&bar[XB_XCNT(b.x)], 1u);
    return b;
}
__device__ __forceinline__ void xcd_barrier_complete(unsigned* bar, unsigned x, unsigned& nloc, unsigned& nx) {
    const unsigned G = gridDim.x * gridDim.y * gridDim.z;
    unsigned sum, cnt, mine, sp = 0u;
    for (;;) {
        sum = 0u; cnt = 0u; mine = 0u;
#pragma unroll
        for (unsigned j = 0; j < 16; ++j) { const unsigned c = xb_ld(&bar[XB_XCNT(j)]); sum += c; cnt += (c > 0u) ? 1u : 0u; mine = (j == x) ? c : mine; }
        if (sum == G) break;
        __builtin_amdgcn_s_sleep(1);
        if ((++sp & 255u) == 0u) { if (xb_ld(&bar[XB_TMO])) break; if (sp > XB_SPIN_CAP) { atomicAdd(&bar[XB_TMO], 1u); break; } }
    }
    nloc = mine > 0u ? mine : 1u; nx = cnt > 0u ? cnt : 1u;
}
__device__ __forceinline__ void xcd_barrier(const XcdBarrier& b) {
    asm volatile("s_waitcnt vmcnt(0)" ::: "memory");
    __syncthreads();
    if (threadIdx.x == 0) {
        unsigned* bar = b.bar;
        __builtin_amdgcn_s_waitcnt(0);
        unsigned nloc = b.st[0], nx = b.st[1];
        if (nloc == 0u) { xcd_barrier_complete(bar, b.x, nloc, nx); b.st[0] = nloc; b.st[1] = nx; }
        const unsigned old = xb_add(&bar[XB_XSUB(b.x)], 1u);
        const unsigned gen = old / nloc;
        if (old + 1u == (gen + 1u) * nloc) {
            __builtin_amdgcn_fence(__ATOMIC_RELEASE, "agent");
            asm volatile("s_waitcnt vmcnt(0)" ::: "memory");
            const unsigned og = xb_add(&bar[XB_TOP], 1u);
            const unsigned tg = og / nx;
            if (og + 1u == (tg + 1u) * nx) xb_add(&bar[XB_TOPGEN], 1u);
            else XB_SPIN(xb_ld(&bar[XB_TOPGEN]) == tg, bar);
            __builtin_amdgcn_fence(__ATOMIC_ACQUIRE, "agent");
            xb_add(&bar[XB_XGEN(b.x)], 1u);
            asm volatile("s_waitcnt vmcnt(0)" ::: "memory");
        } else {
            XB_SPIN(xb_ld(&bar[XB_XGEN(b.x)]) == gen, bar);
            __builtin_amdgcn_fence(__ATOMIC_ACQUIRE, "agent");
            asm volatile("s_waitcnt vmcnt(0)" ::: "memory");
        }
    }
    __syncthreads();
}

namespace pg8 {
constexpr int BM = 256, BK = 64, HALF = 128, HTB = HALF * BK * 2, STAGE_BYTES = 8 * HTB, NXCD = 8, WGM = 8;
__host__ __device__ __forceinline__ int lds_byte(int r, int c) { const int st = (r >> 4) * 2 + (c >> 5), rr = r & 15, cc = c & 31, ob = rr * 64 + cc * 2; return st * 1024 + (ob ^ (((ob >> 9) & 1) << 5)); }
__host__ __device__ __forceinline__ void stage_rc(int b, int& R, int& C) { const int st = b / 1024, sb = b % 1024, swz = sb ^ (((sb >> 9) & 1) << 5); R = (st >> 1) * 16 + swz / 64; C = (st & 1) * 32 + (swz % 64) / 2; }
__host__ __device__ __forceinline__ int perm32(int rho) { const int n = rho >> 4, i = rho & 15; return 8 * (i >> 2) + 4 * n + (i & 3); }
struct Unit { int pm, pn, grp; };
struct StaticOrder {
    static constexpr bool GATHER = false; const int* tok;
    int nM, nN, nwg, c; bool latonly;
    __device__ __forceinline__ void init(int nM_, int nN_, int c_, bool lat_ = false) { nM = nM_; nN = nN_; nwg = nM * nN; c = c_; latonly = lat_; }
    __device__ __forceinline__ bool next(int i, Unit& u) const {
        const long L = (long)i * GRID + c; if (L >= nwg) return false;
        int wgid = (int)L; { const int q = nwg / NXCD, r = nwg % NXCD, xcd = wgid % NXCD, off = wgid / NXCD; wgid = (xcd < r ? xcd * (q + 1) : r * (q + 1) + (xcd - r) * q) + off; }
        const int nig = WGM * nN, gid = wgid / nig, fm = gid * WGM, gsz = (nM - fm) < WGM ? (nM - fm) : WGM;
        u.pm = fm + ((wgid % nig) % gsz); u.pn = (wgid % nig) / gsz; u.grp = 0; if (latonly) u.pm += u.pm / 32 + 1; return true;
    }
};
struct MoeOrder : StaticOrder {
    static constexpr bool GATHER = true;
    const volatile LAS int* pad_start;
    __device__ __forceinline__ bool next(int i, Unit& u) const {
        if (!StaticOrder::next(i, u)) return false;
        u.grp = ((const volatile LAS unsigned char*)(pad_start - 64))[1024 + u.pm]; return true;
    }
};

struct MoeOrderPlain : MoeOrder { static constexpr bool GATHER = false; };

template <class Epi, class Sched, bool I8 = false>
__device__ __forceinline__ void gemm_phase(LAS unsigned char* lds, const bf16_t* Aptr, const bf16_t* Btptr, const int K, const size_t grp_stride_bytes, const Sched& S, const Epi& E, const int tid) {
    const int wid = __builtin_amdgcn_readfirstlane(tid >> 6), lane = tid & 63, wr = wid >> 2, wc = wid & 3, fr = lane & 15, fq = lane >> 4;
    const int nt = K / BK;
    constexpr bool GATHER = Sched::GATHER;
    unsigned voffB[2], voC[2][2], voN[2][2]; int rowA[2]; unsigned colA[2];
#pragma unroll
    for (int i = 0; i < 2; ++i) { int R, C; stage_rc(tid * 16 + i * 8192, R, C); const int Rb = Epi::PERM ? ((R & ~31) + perm32(R & 31)) : R;
        rowA[i] = R; colA[i] = (unsigned)C * 2u; voffB[i] = (unsigned)(Rb * K + C) * 2u;
        voC[0][i] = (unsigned)(R * K + C) * 2u; voC[1][i] = voC[0][i] + (unsigned)(HALF * K * 2); voN[0][i] = voC[0][i]; voN[1][i] = voC[1][i]; }
#define PG8_TOK(u_, vo_) do { const int* tp_ = S.tok + (size_t)(u_).pm * 256; _Pragma("unroll") for (int h_ = 0; h_ < 2; ++h_) _Pragma("unroll") for (int i_ = 0; i_ < 2; ++i_) \
        vo_[h_][i_] = (unsigned)tp_[h_ * 128 + rowA[i_]] * (unsigned)(K * 2) + colA[i_]; } while (0)
    const size_t kstep = (size_t)(BK * 2);
    const size_t hstep = (size_t)HALF * K * 2;
    const size_t tstep = 2 * hstep;
    const unsigned ldsw = (unsigned)wid * 1024u;
    const int aoff = lds_byte(wr * 64 + fr, fq * 8), boff = lds_byte(wc * 32 + fr, fq * 8);
#define PG8_SA(b, h) (((b) * 2 + (h)) * HTB)
#define PG8_SB(b, h) ((4 + (b) * 2 + (h)) * HTB)
#define PG8_STAGE(bufoff, gbase, voff) do { _Pragma("unroll") for (int _i = 0; _i < 2; ++_i) \
        __builtin_amdgcn_global_load_lds((const unsigned*)((const char*)(gbase) + (voff)[_i]), (LAS unsigned*)(lds + (bufoff) + ldsw + _i * 8192), 16, 0, 0); } while (0)
    using FragT = std::conditional_t<I8, i32x4, bf16x8>; using AccT = std::conditional_t<I8, i32x4, f32x4>;
#define PG8_LDA(dst, b, h) do { _Pragma("unroll") for (int m = 0; m < 4; ++m) _Pragma("unroll") for (int k = 0; k < 2; ++k) dst[m][k] = *(const LAS FragT*)(lds + PG8_SA(b, h) + aoff + m * 2048 + k * 1024); } while (0)
#define PG8_LDB(dst, b, h) do { _Pragma("unroll") for (int n = 0; n < 2; ++n) _Pragma("unroll") for (int k = 0; k < 2; ++k) dst[n][k] = *(const LAS FragT*)(lds + PG8_SB(b, h) + boff + n * 2048 + k * 1024); } while (0)
#define PG8_MMA(ai, bj, At, Bt) do { __builtin_amdgcn_s_setprio(1); _Pragma("unroll") for (int m = 0; m < 4; ++m) _Pragma("unroll") for (int n = 0; n < 2; ++n) _Pragma("unroll") for (int k = 0; k < 2; ++k) \
        { if constexpr (I8) acc[ai][bj][m][n] = __builtin_amdgcn_mfma_i32_16x16x64_i8(Bt[n][k], At[m][k], acc[ai][bj][m][n], 0, 0, 0); else acc[ai][bj][m][n] = __builtin_amdgcn_mfma_f32_16x16x32_bf16(Bt[n][k], At[m][k], acc[ai][bj][m][n], 0, 0, 0); } __builtin_amdgcn_s_setprio(0); } while (0)
#define PG8_WAIT_V(n) asm volatile("s_waitcnt vmcnt(" #n ")" ::: "memory")
#define PG8_WAIT_L(n) asm volatile("s_waitcnt lgkmcnt(" #n ")" ::: "memory")
#define PG8_BAR __builtin_amdgcn_s_barrier()
#define PG8_SCHED __builtin_amdgcn_sched_barrier(0)
    Unit cur, nxt; int ui = 0;
    if (!S.next(0, cur)) return;
    AccT acc[2][2][4][2];
#pragma unroll
    for (int a = 0; a < 2; ++a)
#pragma unroll
        for (int b = 0; b < 2; ++b)
#pragma unroll
            for (int m = 0; m < 4; ++m)
#pragma unroll
                for (int n = 0; n < 2; ++n) acc[a][b][m][n] = (AccT){0, 0, 0, 0};
    FragT At[4][2], B0[2][2], B1[2][2];
    const char* cA = (const char*)Aptr + (GATHER ? (size_t)0 : (size_t)cur.pm * tstep); const char* cB = (const char*)Btptr + (size_t)cur.grp * grp_stride_bytes + (size_t)cur.pn * tstep;
    if constexpr (GATHER) PG8_TOK(cur, voC);
    PG8_STAGE(PG8_SB(0, 0), cB, voffB); PG8_STAGE(PG8_SA(0, 0), cA, voC[0]); PG8_STAGE(PG8_SB(0, 1), cB + hstep, voffB); PG8_STAGE(PG8_SA(0, 1), cA, voC[1]);
    if (wr == 1) PG8_BAR;
    PG8_WAIT_V(4); PG8_BAR;
    PG8_STAGE(PG8_SB(1, 0), cB + kstep, voffB); PG8_STAGE(PG8_SA(1, 0), cA + kstep, voC[0]); PG8_STAGE(PG8_SB(1, 1), cB + hstep + kstep, voffB);
    PG8_WAIT_V(6); PG8_BAR;
    for (;;) {
        const bool has_next = S.next(ui + 1, nxt);
        const char* nA = GATHER ? cA : (has_next ? (const char*)Aptr + (size_t)nxt.pm * tstep : cA);
        const char* nB = has_next ? (const char*)Btptr + (size_t)nxt.grp * grp_stride_bytes + (size_t)nxt.pn * tstep : cB;
        if constexpr (GATHER) { if (has_next) PG8_TOK(nxt, voN); }
#pragma unroll 1
        for (int t = 0; t < nt; t += 2) {
            const bool last = (t == nt - 2);
            if constexpr (Epi::LDSPRE) { if (last) E.pre(lds + 8 * HTB, cur, wid, lane); }
            const char* a1 = cA + (size_t)(t + 1) * kstep;
            const char* a2 = last ? nA : cA + (size_t)(t + 2) * kstep; const char* b2 = last ? nB : cB + (size_t)(t + 2) * kstep;
            const char* a3 = a2 + kstep; const char* b3 = b2 + kstep;
            unsigned s0[2], s1[2];
#pragma unroll
            for (int i = 0; i < 2; ++i) { s0[i] = (GATHER && last) ? voN[0][i] : voC[0][i]; s1[i] = (GATHER && last) ? voN[1][i] : voC[1][i]; }
            PG8_LDB(B0, 0, 0); PG8_SCHED; PG8_LDA(At, 0, 0); PG8_STAGE(PG8_SA(1, 1), a1, voC[1]);
            PG8_WAIT_L(8); PG8_BAR; PG8_WAIT_L(0); PG8_MMA(0, 0, At, B0); PG8_BAR; PG8_SCHED;
            PG8_LDB(B1, 0, 1); PG8_STAGE(PG8_SB(0, 0), b2, voffB);
            PG8_BAR; PG8_WAIT_L(0); PG8_MMA(0, 1, At, B1); PG8_BAR;
            PG8_LDA(At, 0, 1); PG8_STAGE(PG8_SA(0, 0), a2, s0);
            PG8_BAR; PG8_WAIT_L(0); PG8_MMA(1, 0, At, B0); PG8_BAR; PG8_SCHED;
            PG8_STAGE(PG8_SB(0, 1), b2 + hstep, voffB);
            PG8_WAIT_V(6); PG8_BAR; PG8_MMA(1, 1, At, B1); PG8_BAR;
            PG8_LDB(B0, 1, 0); PG8_SCHED; PG8_LDA(At, 1, 0); PG8_STAGE(PG8_SA(0, 1), a2, s1);
            PG8_WAIT_L(8); PG8_BAR; PG8_WAIT_L(0); PG8_MMA(0, 0, At, B0); PG8_BAR; PG8_SCHED;
            PG8_LDB(B1, 1, 1); PG8_STAGE(PG8_SB(1, 0), b3, voffB);
            PG8_BAR; PG8_WAIT_L(0); PG8_MMA(0, 1, At, B1); PG8_BAR;
            PG8_LDA(At, 1, 1); PG8_STAGE(PG8_SA(1, 0), a3, s0);
            PG8_BAR; PG8_WAIT_L(0); PG8_MMA(1, 0, At, B0); PG8_BAR; PG8_SCHED;
            PG8_STAGE(PG8_SB(1, 1), b3 + hstep, voffB);
            PG8_WAIT_V(6); PG8_BAR; PG8_MMA(1, 1, At, B1); PG8_BAR;
        }
        if constexpr (Epi::LDSPRE) E(acc, cur, wr, wc, fr, fq, lds + 8 * HTB); else E(acc, cur, wr, wc, fr, fq);
        if (!has_next) break;
        if constexpr (GATHER) {
#pragma unroll
            for (int h = 0; h < 2; ++h)
#pragma unroll
                for (int i = 0; i < 2; ++i) voC[h][i] = voN[h][i]; }
#pragma unroll
        for (int a = 0; a < 2; ++a)
#pragma unroll
            for (int b = 0; b < 2; ++b)
#pragma unroll
                for (int m = 0; m < 4; ++m)
#pragma unroll
                    for (int n = 0; n < 2; ++n) acc[a][b][m][n] = (AccT){0, 0, 0, 0};
        cur = nxt; cA = nA; cB = nB; ++ui;
    }
    PG8_WAIT_V(0);
    if (wr == 0) PG8_BAR;
    PG8_BAR;
#undef PG8_TOK
#undef PG8_SA
#undef PG8_SB
#undef PG8_STAGE
#undef PG8_LDA
#undef PG8_LDB
#undef PG8_MMA
#undef PG8_WAIT_V
#undef PG8_WAIT_L
#undef PG8_BAR
#undef PG8_SCHED
}

typedef const f32x4 (&AccRef)[2][2][4][2];

template <bool Q> struct AccSel { typedef f32x4 T; typedef const f32x4 (&Ref)[2][2][4][2]; };
template <> struct AccSel<true> { typedef i32x4 T; typedef const i32x4 (&Ref)[2][2][4][2]; };
template <bool Q> __device__ __forceinline__ f32x4 deq(const typename AccSel<Q>::T a, const float sr, const f32x4 sc) {
    if constexpr (Q) return (f32x4){(float)a[0], (float)a[1], (float)a[2], (float)a[3]} * (sc * sr); else return a;
}
__device__ __forceinline__ void rope8(f32x4& v0, f32x4& v1, const f32x2* cs) {
    const f32x4 c01 = *(const f32x4*)cs, c23 = *(const f32x4*)(cs + 2);
    f32x4 a = v0, b = v1;
    v0[0] = a[0] * c01[0] - a[1] * c01[1]; v0[1] = a[0] * c01[1] + a[1] * c01[0];
    v0[2] = a[2] * c01[2] - a[3] * c01[3]; v0[3] = a[2] * c01[3] + a[3] * c01[2];
    v1[0] = b[0] * c23[0] - b[1] * c23[1]; v1[1] = b[0] * c23[1] + b[1] * c23[0];
    v1[2] = b[2] * c23[2] - b[3] * c23[3]; v1[3] = b[2] * c23[3] + b[3] * c23[2];
}
__device__ __forceinline__ void rope8r(f32x4& v0, f32x4& v1, const f32x4 c01, const f32x4 c23) {
    f32x4 a = v0, b = v1;
    v0[0] = a[0] * c01[0] - a[1] * c01[1]; v0[1] = a[0] * c01[1] + a[1] * c01[0];
    v0[2] = a[2] * c01[2] - a[3] * c01[3]; v0[3] = a[2] * c01[3] + a[3] * c01[2];
    v1[0] = b[0] * c23[0] - b[1] * c23[1]; v1[1] = b[0] * c23[1] + b[1] * c23[0];
    v1[2] = b[2] * c23[2] - b[3] * c23[3]; v1[3] = b[2] * c23[3] + b[3] * c23[2];
}
__device__ __forceinline__ void store8(bf16_t* p, f32x4 v0, f32x4 v1) {
    u32x4 w; w.x = pk2(v0[0], v0[1]); w.y = pk2(v0[2], v0[3]); w.z = pk2(v1[0], v1[1]); w.w = pk2(v1[2], v1[3]); *(u32x4*)p = w;
}

__device__ __forceinline__ void store8q(bf16_t* base, int ld, f32x4 v0, f32x4 v1, int fr, int fq) {
    const int L = fq * 16 + fr, src = (((L & 3) << 4) | (L >> 2)) << 2;
    u32x4 w; w.x = pk2(v0[0], v0[1]); w.y = pk2(v0[2], v0[3]); w.z = pk2(v1[0], v1[1]); w.w = pk2(v1[2], v1[3]);
    u32x4 r; r.x = (unsigned)__builtin_amdgcn_ds_bpermute(src, (int)w.x); r.y = (unsigned)__builtin_amdgcn_ds_bpermute(src, (int)w.y); r.z = (unsigned)__builtin_amdgcn_ds_bpermute(src, (int)w.z); r.w = (unsigned)__builtin_amdgcn_ds_bpermute(src, (int)w.w);
    *(u32x4*)(base + (size_t)(L >> 2) * ld + (L & 3) * 8) = r;
}
__device__ __forceinline__ u32x4 pack8(f32x4 v0, f32x4 v1) { u32x4 w; w.x = pk2(v0[0], v0[1]); w.y = pk2(v0[2], v0[3]); w.z = pk2(v1[0], v1[1]); w.w = pk2(v1[2], v1[3]); return w; }
__device__ __forceinline__ u32x4 qperm4(u32x4 w, int src) { u32x4 r; r.x = (unsigned)__builtin_amdgcn_ds_bpermute(src, (int)w.x); r.y = (unsigned)__builtin_amdgcn_ds_bpermute(src, (int)w.y); r.z = (unsigned)__builtin_amdgcn_ds_bpermute(src, (int)w.z); r.w = (unsigned)__builtin_amdgcn_ds_bpermute(src, (int)w.w); return r; }
template <bool Q> struct EpiDaIn {
    static constexpr bool PERM = true; static constexpr bool LDSPRE = false;
    bf16_t* KVQ; const f32x2* tabA; const float* sa; const float* swp;
    __device__ __forceinline__ void operator()(typename AccSel<Q>::Ref acc, const Unit& u, int wr, int wc, int fr, int fq) const {
        const int part = u.pn >> 2; bf16_t* base = KVQ + (size_t)part * ((size_t)T * 1024);
        const int tb = u.pm % TPB; const bool lat = tb != 0; const bool rope = lat && part != 1;
        const int cin0 = (u.pn & 3) * 256 + wc * 32 + 8 * fq; const float qs = part == 2 ? 0.125f * 1.4426950408889634f : 1.0f;
        f32x4 swc[2][2];
        if constexpr (Q) {
#pragma unroll
            for (int bj = 0; bj < 2; ++bj)
#pragma unroll
                for (int n = 0; n < 2; ++n) swc[bj][n] = *(const f32x4*)(swp + u.pn * 256 + wc * 32 + 8 * fq + bj * HALF + 4 * n) * qs; }
#pragma unroll
        for (int ai = 0; ai < 2; ++ai) {
            f32x4 t[4][2][2]; float sr[4];
#pragma unroll
            for (int m = 0; m < 4; ++m) sr[m] = Q ? sa[(size_t)u.pm * BM + ai * HALF + wr * 64 + m * 16 + fr] : qs;
            if (rope) {
#pragma unroll
                for (int m = 0; m < 4; ++m) { const int p = (tb - 1) * 256 + ai * HALF + wr * 64 + m * 16 + fr;
#pragma unroll
                    for (int bj = 0; bj < 2; ++bj) { const int o = (cin0 + bj * HALF) & 63, axis = o >> 5, f0 = (o & 31) >> 1, pos = axis ? (p & 63) : (p >> 6); const f32x2* cs = tabA + pos * 16 + f0;
                        t[m][bj][0] = *(const f32x4*)cs; t[m][bj][1] = *(const f32x4*)(cs + 2); } }
            }
            asm volatile("" ::: "memory");
            const int L_ = fq * 16 + fr, src_ = (((L_ & 3) << 4) | (L_ >> 2)) << 2; const unsigned lo_ = (unsigned)(L_ >> 2) * 2048u + (unsigned)(L_ & 3) * 16u;
#pragma unroll
            for (int mh = 0; mh < 2; ++mh) { u32x4 pr[2][2];
#pragma unroll
                for (int mm = 0; mm < 2; ++mm) { const int m = 2 * mh + mm;
#pragma unroll
                    for (int bj = 0; bj < 2; ++bj) { f32x4 v0, v1;
                        if constexpr (Q) { v0 = deq<true>(acc[ai][bj][m][0], sr[m], swc[bj][0]); v1 = deq<true>(acc[ai][bj][m][1], sr[m], swc[bj][1]); }
                        else { v0 = acc[ai][bj][m][0] * qs; v1 = acc[ai][bj][m][1] * qs; }
                        if (rope) rope8r(v0, v1, t[m][bj][0], t[m][bj][1]);
                        pr[mm][bj] = qperm4(pack8(v0, v1), src_); } }
#pragma unroll
                for (int mm = 0; mm < 2; ++mm)
#pragma unroll
                    for (int bj = 0; bj < 2; ++bj) { char* bp_ = (char*)(base + ((size_t)u.pm * BM + ai * HALF + wr * 64 + (2 * mh + mm) * 16) * 1024 + (cin0 - 8 * fq) + bj * HALF);
                        *(u32x4*)(bp_ + lo_) = pr[mm][bj]; } }
        }
    }
};
template <bool Q> struct EpiRetIn {
    static constexpr bool PERM = true; static constexpr bool LDSPRE = false;
    bf16_t *Kb, *Vb, *Qb, *Gb; const f32x2* tabR; const float* sa; const float* swp;
    __device__ __forceinline__ void operator()(typename AccSel<Q>::Ref acc, const Unit& u, int wr, int wc, int fr, int fq) const {
        const int ct = u.pn * 256; bf16_t* base; int ld, c0; bool isk = false, isq = false;
        if (ct < 1024) { base = Kb; ld = 1024; c0 = ct; isk = true; } else if (ct < 3072) { base = Vb; ld = 2048; c0 = ct - 1024; }
        else if (ct < 4096) { base = Qb; ld = 1024; c0 = ct - 3072; isq = true; } else { base = Gb; ld = 2048; c0 = ct - 4096; }
        const int tb = u.pm % TPB; const bool lat = tb != 0; const bool rope = lat && (isk || isq);
        const int cin0 = c0 + wc * 32 + 8 * fq; const float sc = isk ? 0.0625f : 1.0f;
        f32x4 swc[2][2];
        if constexpr (Q) {
#pragma unroll
            for (int bj = 0; bj < 2; ++bj)
#pragma unroll
                for (int n = 0; n < 2; ++n) swc[bj][n] = *(const f32x4*)(swp + u.pn * 256 + wc * 32 + 8 * fq + bj * HALF + 4 * n) * sc; }
#pragma unroll
        for (int ai = 0; ai < 2; ++ai)
#pragma unroll
            for (int mh = 0; mh < 2; ++mh) {
                f32x4 t[2][2][2]; float sr[2];
#pragma unroll
                for (int mm = 0; mm < 2; ++mm) sr[mm] = Q ? sa[(size_t)u.pm * BM + ai * HALF + wr * 64 + (2 * mh + mm) * 16 + fr] : sc;
                if (rope) {
#pragma unroll
                    for (int mm = 0; mm < 2; ++mm) { const int p = (tb - 1) * 256 + ai * HALF + wr * 64 + (2 * mh + mm) * 16 + fr;
#pragma unroll
                        for (int bj = 0; bj < 2; ++bj) { const int f0 = ((cin0 + bj * HALF) & 255) >> 1; const f32x2* cs = tabR + (size_t)p * 128 + f0;
                            t[mm][bj][0] = *(const f32x4*)cs; t[mm][bj][1] = *(const f32x4*)(cs + 2); } }
                }
                asm volatile("" ::: "memory");
                const int L_ = fq * 16 + fr, src_ = (((L_ & 3) << 4) | (L_ >> 2)) << 2; const unsigned lo_ = (unsigned)(L_ >> 2) * (unsigned)(ld * 2) + (unsigned)(L_ & 3) * 16u;
                u32x4 pr[2][2];
#pragma unroll
                for (int mm = 0; mm < 2; ++mm) { const int m = 2 * mh + mm;
#pragma unroll
                    for (int bj = 0; bj < 2; ++bj) { f32x4 v0, v1;
                        if constexpr (Q) { v0 = deq<true>(acc[ai][bj][m][0], sr[mm], swc[bj][0]); v1 = deq<true>(acc[ai][bj][m][1], sr[mm], swc[bj][1]); }
                        else { v0 = acc[ai][bj][m][0] * sc; v1 = acc[ai][bj][m][1] * sc; }
                        if (rope) rope8r(v0, v1, t[mm][bj][0], t[mm][bj][1]);
                        pr[mm][bj] = qperm4(pack8(v0, v1), src_); } }
#pragma unroll
                for (int mm = 0; mm < 2; ++mm)
#pragma unroll
                    for (int bj = 0; bj < 2; ++bj) { char* bp_ = (char*)(base + ((size_t)u.pm * BM + ai * HALF + wr * 64 + (2 * mh + mm) * 16) * ld + (cin0 - 8 * fq) + bj * HALF);
                        *(u32x4*)(bp_ + lo_) = pr[mm][bj]; }
            }
    }
};
template <bool Q> struct EpiF32 {
    static constexpr bool PERM = false; static constexpr bool LDSPRE = false;
    float* C; int ldc; const float* sa; const float* swp;
    __device__ __forceinline__ void operator()(typename AccSel<Q>::Ref acc, const Unit& u, int wr, int wc, int fr, int fq) const {
        const int row0 = u.pm * BM + wr * 64 + fr, col0 = u.pn * BM + wc * 32 + 4 * fq;
        f32x4 swc[2][2];
        if constexpr (Q) {
#pragma unroll
            for (int bj = 0; bj < 2; ++bj)
#pragma unroll
                for (int n = 0; n < 2; ++n) swc[bj][n] = *(const f32x4*)(swp + col0 + bj * HALF + n * 16); }
#pragma unroll
        for (int ai = 0; ai < 2; ++ai)
#pragma unroll
            for (int m = 0; m < 4; ++m) { float* rowp = C + (size_t)(row0 + ai * HALF + m * 16) * ldc + col0; const float sr = Q ? sa[row0 + ai * HALF + m * 16] : 1.0f;
#pragma unroll
                for (int bj = 0; bj < 2; ++bj)
#pragma unroll
                    for (int n = 0; n < 2; ++n) *(f32x4*)(rowp + bj * HALF + n * 16) = deq<Q>(acc[ai][bj][m][n], sr, swc[bj][n]); }
    }
};
struct EpiMlaQ {
    static constexpr bool PERM = true; static constexpr bool LDSPRE = false;
    bf16_t* Qb; const f32x2* tabA;
    __device__ __forceinline__ void operator()(AccRef acc, const Unit& u, int wr, int wc, int fr, int fq) const {
        const int tb = u.pm % TPB; const bool rope = tb != 0 && u.pn >= 4; const int c0 = u.pn * 256 + wc * 32 + 8 * fq; const float qs = 0.07216878364870322f * 1.4426950408889634f;
#pragma unroll
        for (int ai = 0; ai < 2; ++ai) {
            f32x4 t[4][2][2];
            if (rope) {
#pragma unroll
                for (int m = 0; m < 4; ++m) { const int p = (tb - 1) * 256 + ai * HALF + wr * 64 + m * 16 + fr;
#pragma unroll
                    for (int bj = 0; bj < 2; ++bj) { const int o = (c0 + bj * HALF) & 63, axis = o >> 5, f0 = (o & 31) >> 1, pos = axis ? (p & 63) : (p >> 6); const f32x2* cs = tabA + pos * 16 + f0;
                        t[m][bj][0] = *(const f32x4*)cs; t[m][bj][1] = *(const f32x4*)(cs + 2); } }
            }
            asm volatile("" ::: "memory");
#pragma unroll
            for (int m = 0; m < 4; ++m) { const size_t row = (size_t)u.pm * BM + ai * HALF + wr * 64 + m * 16 + fr;
#pragma unroll
                for (int bj = 0; bj < 2; ++bj) { f32x4 v0 = acc[ai][bj][m][0] * qs, v1 = acc[ai][bj][m][1] * qs;
                    if (rope) rope8r(v0, v1, t[m][bj][0], t[m][bj][1]);
                    store8(Qb + row * 1536 + c0 + bj * HALF, v0, v1); } }
        }
    }
};
struct EpiMlaKV {
    static constexpr bool PERM = true; static constexpr bool LDSPRE = false;
    bf16_t *Kb, *Vb;
    __device__ __forceinline__ void operator()(AccRef acc, const Unit& u, int wr, int wc, int fr, int fq) const {
        const int c0 = wc * 32 + 8 * fq;
#pragma unroll
        for (int ai = 0; ai < 2; ++ai)
#pragma unroll
            for (int m = 0; m < 4; ++m) {
                const size_t row = (size_t)u.pm * BM + ai * HALF + wr * 64 + m * 16 + fr;
                store8(Kb + row * 1536 + u.pn * 192 + c0, acc[ai][0][m][0], acc[ai][0][m][1]);
                store8(Vb + row * 1024 + u.pn * 128 + c0, acc[ai][1][m][0], acc[ai][1][m][1]);
            }
    }
};
template <bool Q> struct EpiResid {
    static constexpr bool PERM = true; static constexpr bool LDSPRE = false;
    bf16_t* X; const float* mod2; const float* sa; const float* swp;
    __device__ __forceinline__ void operator()(typename AccSel<Q>::Ref acc, const Unit& u, int wr, int wc, int fr, int fq) const {
        const int tb = u.pm % TPB, b = u.pm / TPB, mrow = tb == 0 ? 8 : b;
        const int row0 = u.pm * BM + wr * 64 + fr, col0 = u.pn * BM + wc * 32 + 8 * fq;
        const float* mp = mod2 + (size_t)mrow * 6144 + col0;
        f32x4 g[2][2];
#pragma unroll
        for (int bj = 0; bj < 2; ++bj)
#pragma unroll
            for (int n = 0; n < 2; ++n) { g[bj][n] = *(const f32x4*)(mp + bj * HALF + 4 * n); if constexpr (Q) g[bj][n] = g[bj][n] * *(const f32x4*)(swp + col0 + bj * HALF + 4 * n); }
#pragma unroll
        for (int ai = 0; ai < 2; ++ai) {
            u32x4 x[4][2]; float sr[4];
#pragma unroll
            for (int m = 0; m < 4; ++m) { const bf16_t* rowp = X + (size_t)(row0 + ai * HALF + m * 16) * 1024 + col0; sr[m] = Q ? sa[row0 + ai * HALF + m * 16] : 1.0f;
#pragma unroll
                for (int bj = 0; bj < 2; ++bj) x[m][bj] = *(const u32x4*)(rowp + bj * HALF); }
            asm volatile("" ::: "memory");
#pragma unroll
            for (int m = 0; m < 4; ++m) { bf16_t* rowp = X + (size_t)(row0 + ai * HALF + m * 16) * 1024 + col0;
#pragma unroll
                for (int bj = 0; bj < 2; ++bj) { const f32x4 lo = (f32x4){bflo(x[m][bj].x), bfhi(x[m][bj].x), bflo(x[m][bj].y), bfhi(x[m][bj].y)}, hi4 = (f32x4){bflo(x[m][bj].z), bfhi(x[m][bj].z), bflo(x[m][bj].w), bfhi(x[m][bj].w)};
                    f32x4 d0, d1;
                    if constexpr (Q) { d0 = deq<true>(acc[ai][bj][m][0], sr[m], g[bj][0]); d1 = deq<true>(acc[ai][bj][m][1], sr[m], g[bj][1]); }
                    else { d0 = g[bj][0] * acc[ai][bj][m][0]; d1 = g[bj][1] * acc[ai][bj][m][1]; }
                    store8(rowp + bj * HALF, lo + d0, hi4 + d1); } }
            asm volatile("" ::: "memory");
        }
    }
};
struct EpiMoe1 {
    static constexpr bool PERM = true; static constexpr bool LDSPRE = false;
    bf16_t* ACT; const float* bgu;
    __device__ __forceinline__ void operator()(AccRef acc, const Unit& u, int wr, int wc, int fr, int fq) const {
        const int j0 = u.pn * 128 + wc * 32 + 8 * fq; const float* bp = bgu + (size_t)u.grp * 2048 + j0;
        const f32x4 bg0 = *(const f32x4*)bp, bg1 = *(const f32x4*)(bp + 4), bl0 = *(const f32x4*)(bp + 1024), bl1 = *(const f32x4*)(bp + 1028);
#pragma unroll
        for (int ai = 0; ai < 2; ++ai)
#pragma unroll
            for (int m = 0; m < 4; ++m) { const size_t row = (size_t)u.pm * BM + ai * HALF + wr * 64 + m * 16 + fr;
                const f32x4 gl[2] = {acc[ai][0][m][0] + bg0, acc[ai][0][m][1] + bg1}, li[2] = {acc[ai][1][m][0] + bl0, acc[ai][1][m][1] + bl1}; f32x4 a[2];
#pragma unroll
                for (int n = 0; n < 2; ++n)
#pragma unroll
                    for (int e = 0; e < 4; ++e) { const float g = fminf(gl[n][e], 7.0f), l = fminf(fmaxf(li[n][e], -7.0f), 7.0f);
                        const float s = __builtin_amdgcn_rcpf(1.0f + __builtin_amdgcn_exp2f(g * (-1.702f * 1.4426950408889634f))); a[n][e] = g * s * (l + 1.0f); }
                store8(ACT + row * 1024 + j0, a[0], a[1]); }
    }
};
typedef const i32x4 (&AccRefI)[2][2][4][2];
__device__ __forceinline__ f32x2 pk_mul(f32x2 a, f32x2 b) { f32x2 d; asm("v_pk_mul_f32 %0, %1, %2" : "=v"(d) : "v"(a), "v"(b)); return d; }
__device__ __forceinline__ f32x2 pk_fma(f32x2 a, f32x2 b, f32x2 c) { f32x2 d; asm("v_pk_fma_f32 %0, %1, %2, %3" : "=v"(d) : "v"(a), "v"(b), "v"(c)); return d; }
__device__ __forceinline__ float min_asm(float a, float b) { float d; asm("v_min_f32 %0, %1, %2" : "=v"(d) : "v"(a), "v"(b)); return d; }
__device__ __forceinline__ float med3_asm(float a, float lo, float hi) { float d; asm("v_med3_f32 %0, %1, %2, %3" : "=v"(d) : "v"(a), "v"(lo), "v"(hi)); return d; }
struct EpiMoe1Q {
    static constexpr bool PERM = true; static constexpr bool LDSPRE = true;
    bf16_t* ACT; const float* bgu; const float* sw; const float* saslot;
    __device__ __forceinline__ void pre(LAS unsigned char* ep, const Unit& u, int wid, int lane) const {
        if (wid > 2) return;
        const float* g = wid == 2 ? saslot + (size_t)u.pm * BM + 4 * lane : (wid == 0 ? bgu : sw) + (size_t)u.grp * 2048 + (lane >> 5) * 1024 + u.pn * 128 + 4 * (lane & 31);
        __builtin_amdgcn_global_load_lds((const unsigned*)g, (LAS unsigned*)(ep + wid * 1024), 16, 0, 0);
    }
    __device__ __forceinline__ void operator()(AccRefI acc, const Unit& u, int wr, int wc, int fr, int fq, const LAS unsigned char* ep) const {
        const int j0 = u.pn * 128 + wc * 32 + 8 * fq; const LAS float* bp = (const LAS float*)ep + wc * 32 + 8 * fq; const LAS float* sp = bp + 256;
        f32x2 bg[4], bl[4], sg[4], sl[4];
#pragma unroll
        for (int q = 0; q < 4; ++q) { bg[q] = *(const LAS f32x2*)(bp + 2 * q); bl[q] = *(const LAS f32x2*)(bp + 128 + 2 * q) + 1.0f; sg[q] = *(const LAS f32x2*)(sp + 2 * q); sl[q] = *(const LAS f32x2*)(sp + 128 + 2 * q); }
        const f32x2 cc = {-1.702f * 1.4426950408889634f, -1.702f * 1.4426950408889634f}; float c7 = 7.0f, cm6 = -6.0f, c8 = 8.0f; asm volatile("" : "+v"(c7), "+v"(cm6), "+v"(c8));
        float sa[2][4];
#pragma unroll
        for (int ai = 0; ai < 2; ++ai)
#pragma unroll
            for (int m = 0; m < 4; ++m) sa[ai][m] = ((const LAS float*)ep)[512 + ai * HALF + wr * 64 + m * 16 + fr];
#pragma unroll
        for (int ai = 0; ai < 2; ++ai)
#pragma unroll
            for (int m = 0; m < 4; ++m) { const size_t row = (size_t)u.pm * BM + ai * HALF + wr * 64 + m * 16 + fr; const f32x2 ss = {sa[ai][m], sa[ai][m]};
                unsigned w[4]; f32x2 sgs[4], sls[4], g[4], l[4], gm[4], lc[4], t[4], gl[4];
#pragma unroll
                for (int q = 0; q < 4; ++q) { sgs[q] = pk_mul(sg[q], ss); sls[q] = pk_mul(sl[q], ss); }
#pragma unroll
                for (int q = 0; q < 4; ++q) { const int n = q >> 1, e0 = 2 * (q & 1); const i32x4 ig = acc[ai][0][m][n], il = acc[ai][1][m][n];
                    g[q] = pk_fma((f32x2){(float)ig[e0], (float)ig[e0 + 1]}, sgs[q], bg[q]); l[q] = pk_fma((f32x2){(float)il[e0], (float)il[e0 + 1]}, sls[q], bl[q]); }
#pragma unroll
                for (int q = 0; q < 4; ++q) { gm[q] = (f32x2){min_asm(g[q][0], c7), min_asm(g[q][1], c7)}; lc[q] = (f32x2){med3_asm(l[q][0], cm6, c8), med3_asm(l[q][1], cm6, c8)}; }
#pragma unroll
                for (int q = 0; q < 4; ++q) { t[q] = pk_mul(gm[q], cc); gl[q] = pk_mul(gm[q], lc[q]); }
#pragma unroll
                for (int q = 0; q < 4; ++q) { const float r0 = __builtin_amdgcn_rcpf(1.0f + __builtin_amdgcn_exp2f(t[q][0])), r1 = __builtin_amdgcn_rcpf(1.0f + __builtin_amdgcn_exp2f(t[q][1]));
                    w[q] = pk2(gl[q][0] * r0, gl[q][1] * r1); }
                *(u32x4*)(ACT + row * 1024 + j0) = (u32x4){w[0], w[1], w[2], w[3]}; }
    }
};
struct EpiMoe2 {
    static constexpr bool PERM = true; static constexpr bool LDSPRE = true;
    bf16_t* OUT; const float* bdn; int abl;
    __device__ __forceinline__ void pre(LAS unsigned char* ep, const Unit& u, int wid, int lane) const {
        if (wid == 0) __builtin_amdgcn_global_load_lds((const unsigned*)(bdn + (size_t)u.grp * 1024 + u.pn * 256 + 4 * lane), (LAS unsigned*)ep, 16, 0, 0);
    }
    __device__ __forceinline__ void operator()(AccRef acc, const Unit& u, int wr, int wc, int fr, int fq, const LAS unsigned char* ep) const {
        const int c0 = u.pn * 256 + wc * 32 + 8 * fq; const LAS float* bp = (const LAS float*)ep + wc * 32 + 8 * fq;
        f32x4 b[2][2];
#pragma unroll
        for (int bj = 0; bj < 2; ++bj) { b[bj][0] = *(const LAS f32x4*)(bp + bj * HALF); b[bj][1] = *(const LAS f32x4*)(bp + bj * HALF + 4); }
#pragma unroll
        for (int ai = 0; ai < 2; ++ai)
#pragma unroll
            for (int m = 0; m < 4; ++m) { const size_t row = (size_t)u.pm * BM + ai * HALF + wr * 64 + m * 16 + fr;
#pragma unroll
                for (int bj = 0; bj < 2; ++bj) {
                    if (abl) { const f32x4 t0_ = acc[ai][bj][m][0] + b[bj][0], t1_ = acc[ai][bj][m][1] + b[bj][1]; asm volatile("" :: "v"(t0_[0] + t0_[1] + t0_[2] + t0_[3] + t1_[0] + t1_[1] + t1_[2] + t1_[3])); }
                    else store8q(OUT + (row - fr) * 1024 + (c0 - 8 * fq) + bj * HALF, 1024, acc[ai][bj][m][0] + b[bj][0], acc[ai][bj][m][1] + b[bj][1], fr, fq);
                } }
    }
};
struct EpiMoe2Q {
    static constexpr bool PERM = true; static constexpr bool LDSPRE = false;
    bf16_t* OUT; const float* bdn; const float* swd; const float* sa2; float* outs;
    __device__ __forceinline__ void operator()(AccRefI acc, const Unit& u, int wr, int wc, int fr, int fq) const {
        const int c0 = u.pn * 256 + wc * 32 + 8 * fq; const unsigned lc_ = (unsigned)(wc * 32 + 8 * fq), lr_ = (unsigned)(wr * 64 + fr);
        const float* bp = bdn + (size_t)u.grp * 1024 + u.pn * 256 + lc_; const float* sp = swd + (size_t)u.grp * 1024 + u.pn * 256 + lc_; const float* rp_ = sa2 + (size_t)u.pm * BM;
        int t_ = threadIdx.x; asm volatile("" : "+v"(t_)); const int L_ = t_ & 63, src_ = (((L_ & 3) << 4) | (L_ >> 2)) << 2; const unsigned lrow2_ = (unsigned)(((t_ >> 8) & 1) * 64 + (t_ & 15)); float* osb_ = outs + (size_t)u.pm * BM * 32;
        float sr[2][4];
#pragma unroll
        for (int ai = 0; ai < 2; ++ai)
#pragma unroll
            for (int m = 0; m < 4; ++m) sr[ai][m] = rp_[lr_ + (unsigned)(ai * HALF + m * 16)];
#pragma unroll
        for (int bj = 0; bj < 2; ++bj) {
            const f32x4 b0 = *(const f32x4*)(bp + bj * HALF), b1 = *(const f32x4*)(bp + bj * HALF + 4), s0 = *(const f32x4*)(sp + bj * HALF), s1 = *(const f32x4*)(sp + bj * HALF + 4);
#pragma unroll
            for (int ai = 0; ai < 2; ++ai)
#pragma unroll
                for (int m = 0; m < 4; ++m) { const size_t row0 = (size_t)u.pm * BM + ai * HALF + wr * 64 + m * 16;
                    const f32x4 v0 = deq<true>(acc[ai][bj][m][0], sr[ai][m], s0) + b0, v1 = deq<true>(acc[ai][bj][m][1], sr[ai][m], s1) + b1;
                    unsigned mb = __float_as_uint(fmaxf(fmaxf(fmaxf(fabsf(v0[0]), fabsf(v0[1])), fmaxf(fabsf(v0[2]), fabsf(v0[3]))), fmaxf(fmaxf(fabsf(v1[0]), fabsf(v1[1])), fmaxf(fabsf(v1[2]), fabsf(v1[3])))));
                    mb = max(mb, (unsigned)__builtin_amdgcn_ds_swizzle((int)mb, (16 << 10) | 0x1f));
                    { auto rr = __builtin_amdgcn_permlane32_swap(mb, mb, false, false); mb = max(rr[0], rr[1]); }
                    const float mx = fmaxf(__uint_as_float(mb), 1e-30f), inv = 127.0f * __builtin_amdgcn_rcpf(mx);
                    const unsigned f0 = __float_as_uint(fmaf(v0[0], inv, 12582912.0f)), f1 = __float_as_uint(fmaf(v0[1], inv, 12582912.0f)), f2 = __float_as_uint(fmaf(v0[2], inv, 12582912.0f)), f3 = __float_as_uint(fmaf(v0[3], inv, 12582912.0f));
                    const unsigned f4 = __float_as_uint(fmaf(v1[0], inv, 12582912.0f)), f5 = __float_as_uint(fmaf(v1[1], inv, 12582912.0f)), f6 = __float_as_uint(fmaf(v1[2], inv, 12582912.0f)), f7 = __float_as_uint(fmaf(v1[3], inv, 12582912.0f));
                    const unsigned w0 = __builtin_amdgcn_perm(f1, f0, 0x0c0c0400u) | __builtin_amdgcn_perm(f3, f2, 0x04000c0cu), w1 = __builtin_amdgcn_perm(f5, f4, 0x0c0c0400u) | __builtin_amdgcn_perm(f7, f6, 0x04000c0cu);
                                        *(u32x2*)((unsigned char*)OUT + (row0 + (unsigned)(L_ & 15)) * 1024 + (unsigned)(u.pn * 256 + wc * 32 + bj * HALF + (L_ >> 4) * 8)) = (u32x2){w0, w1};
                    if (fq == 0) osb_[(lrow2_ + (unsigned)(ai * HALF + m * 16)) * 32u + (unsigned)(u.pn * 8 + bj * 4 + wc)] = mx * (1.0f / 127.0f); }
            asm volatile("" ::: "memory");
        }
    }
};
}

namespace att {
constexpr int DV = 128, QBLK = 32, KVBLK = 64;
#define SBAR() __builtin_amdgcn_sched_barrier(0)
__device__ __forceinline__ int crow(int r, int hi) { return (r & 3) + 8 * (r >> 2) + 4 * hi; }
__device__ __forceinline__ int v_st(int k, int c) { const int kk = (k & ~0xC) | ((k & 4) << 1) | ((k & 8) >> 1); return ((kk >> 3) * 4 + (c >> 5)) * 512 + ((kk & 7) * 32 + (c & 31)) * 2; }
__device__ __forceinline__ int v_rd_base(int lane) { return ((lane & 3) << 3) | (((lane >> 2) & 3) << 6) | (((lane >> 4) & 1) << 5) | (((lane >> 5) & 1) << 8); }
constexpr int v_rd_off(int d0, int ks, int half) { return d0 * 512 + ks * 4096 + half * 2048; }
template <int OFF> __device__ __forceinline__ s16x4 tr_read(int vb) {
    s16x4 r; asm volatile("ds_read_b64_tr_b16 %0, %1 offset:%2" : "=&v"(r) : "v"(vb), "i"(OFF) : "memory"); return r;
}
template <int D0> __device__ __forceinline__ void pv_one(f32x16& od, int vb, bf16x8 pa0, bf16x8 pa1, bf16x8 pa2, bf16x8 pa3) {
    const s16x4 l0 = tr_read<v_rd_off(D0, 0, 0)>(vb), h0 = tr_read<v_rd_off(D0, 0, 1)>(vb), l1 = tr_read<v_rd_off(D0, 1, 0)>(vb), h1 = tr_read<v_rd_off(D0, 1, 1)>(vb);
    const s16x4 l2 = tr_read<v_rd_off(D0, 2, 0)>(vb), h2 = tr_read<v_rd_off(D0, 2, 1)>(vb), l3 = tr_read<v_rd_off(D0, 3, 0)>(vb), h3 = tr_read<v_rd_off(D0, 3, 1)>(vb);
    asm volatile("s_waitcnt lgkmcnt(0)" ::: "memory"); SBAR();
#define PK(L, H) (bf16x8){L[0], L[1], L[2], L[3], H[0], H[1], H[2], H[3]}
    od = __builtin_amdgcn_mfma_f32_32x32x16_bf16(pa0, PK(l0, h0), od, 0, 0, 0);
    od = __builtin_amdgcn_mfma_f32_32x32x16_bf16(pa1, PK(l1, h1), od, 0, 0, 0);
    od = __builtin_amdgcn_mfma_f32_32x32x16_bf16(pa2, PK(l2, h2), od, 0, 0, 0);
    od = __builtin_amdgcn_mfma_f32_32x32x16_bf16(pa3, PK(l3, h3), od, 0, 0, 0);
#undef PK
}
__device__ __forceinline__ void pv_d0(f32x16* o, int vb, bf16x8 pa0, bf16x8 pa1, bf16x8 pa2, bf16x8 pa3) {
    pv_one<0>(o[0], vb, pa0, pa1, pa2, pa3); pv_one<1>(o[1], vb, pa0, pa1, pa2, pa3); pv_one<2>(o[2], vb, pa0, pa1, pa2, pa3); pv_one<3>(o[3], vb, pa0, pa1, pa2, pa3);
}
#define PV_RD(D0, S) S##0 = tr_read<v_rd_off(D0, 0, 0)>(vb); S##1 = tr_read<v_rd_off(D0, 0, 1)>(vb); S##2 = tr_read<v_rd_off(D0, 1, 0)>(vb); S##3 = tr_read<v_rd_off(D0, 1, 1)>(vb); \
                     S##4 = tr_read<v_rd_off(D0, 2, 0)>(vb); S##5 = tr_read<v_rd_off(D0, 2, 1)>(vb); S##6 = tr_read<v_rd_off(D0, 3, 0)>(vb); S##7 = tr_read<v_rd_off(D0, 3, 1)>(vb)
#define PV_PK(L, H) (bf16x8){L[0], L[1], L[2], L[3], H[0], H[1], H[2], H[3]}
#define PV_MM(OD, S) OD = __builtin_amdgcn_mfma_f32_32x32x16_bf16(pa0, PV_PK(S##0, S##1), OD, 0, 0, 0); OD = __builtin_amdgcn_mfma_f32_32x32x16_bf16(pa1, PV_PK(S##2, S##3), OD, 0, 0, 0); \
                     OD = __builtin_amdgcn_mfma_f32_32x32x16_bf16(pa2, PV_PK(S##4, S##5), OD, 0, 0, 0); OD = __builtin_amdgcn_mfma_f32_32x32x16_bf16(pa3, PV_PK(S##6, S##7), OD, 0, 0, 0)
__device__ __forceinline__ void pv_pipe(f32x16* o, int vb, bf16x8 pa0, bf16x8 pa1, bf16x8 pa2, bf16x8 pa3) {
    s16x4 a0, a1, a2, a3, a4, a5, a6, a7, b0, b1, b2, b3, b4, b5, b6, b7;
    asm volatile("s_waitcnt lgkmcnt(0)" ::: "memory"); SBAR();
    PV_RD(0, a); PV_RD(1, b);
    asm volatile("s_waitcnt lgkmcnt(8)" ::: "memory"); SBAR();
    PV_MM(o[0], a); SBAR();
    PV_RD(2, a);
    asm volatile("s_waitcnt lgkmcnt(8)" ::: "memory"); SBAR();
    PV_MM(o[1], b); SBAR();
    PV_RD(3, b);
    asm volatile("s_waitcnt lgkmcnt(8)" ::: "memory"); SBAR();
    PV_MM(o[2], a); SBAR();
    asm volatile("s_waitcnt lgkmcnt(0)" ::: "memory"); SBAR();
    PV_MM(o[3], b);
}
#undef PV_RD
#undef PV_PK
#undef PV_MM
template <int DQK> struct Cfg {
    static constexpr int KROW = DQK * 2;
    static constexpr int SHM_K = KVBLK * DQK * 2, SHM_V = KVBLK * DV * 2;
    static constexpr int NKC = DQK / 64;
    static constexpr int CH = DQK / 8;
    static constexpr int LDS_NEED = 2 * SHM_V + 2 * SHM_K + 8 * 64 * 4;
};
template <bool GUARD>
__device__ __forceinline__ void partialSM(f32x16& p0, f32x16& p1, float& m_ref, float& alpha, const bool first) {
    constexpr float THR2 = 8.0f * 1.4426950408889634f;
    if constexpr (GUARD) { __builtin_amdgcn_sched_barrier(0); asm volatile("s_nop 15\n\ts_nop 15" ::: "memory"); __builtin_amdgcn_sched_barrier(0); }
#define MAX3(a, b, c) ({ float r_; asm volatile("v_max3_f32 %0, %1, %2, %3" : "=v"(r_) : "v"(a), "v"(b), "v"(c)); r_; })
    float pm0 = MAX3(p0[0], p0[1], p0[2]), pm1 = MAX3(p0[3], p0[4], p0[5]), pm2 = MAX3(p1[0], p1[1], p1[2]), pm3 = MAX3(p1[3], p1[4], p1[5]);
#pragma unroll
    for (int r = 6; r < 16; r += 2) { pm0 = MAX3(pm0, p0[r], p0[r + 1]); pm2 = MAX3(pm2, p1[r], p1[r + 1]); }
    float pmax = MAX3(pm0, pm1, pm2); pmax = fmaxf(pmax, pm3);
#undef MAX3
    { auto rr = __builtin_amdgcn_permlane32_swap(__float_as_uint(pmax), __float_as_uint(pmax), false, false);
      pmax = fmaxf(__uint_as_float(rr[0]), __uint_as_float(rr[1])); }
    if (__builtin_expect(!first && __all(pmax <= THR2), 1)) { alpha = 1.f; }
    else { const float d = first ? pmax : fmaxf(pmax, 0.f); alpha = first ? 1.f : __builtin_amdgcn_exp2f(-d); m_ref += d;
#pragma unroll
        for (int r = 0; r < 16; ++r) { p0[r] -= d; p1[r] -= d; } }
#pragma unroll
    for (int r = 0; r < 16; ++r) p0[r] = __builtin_amdgcn_exp2f(p0[r]);
}
__device__ __forceinline__ void finishSM(f32x16& p0, f32x16& p1, float alpha, float& l_reg, bf16x8& pa0, bf16x8& pa1, bf16x8& pa2, bf16x8& pa3) {
#pragma unroll
    for (int r = 0; r < 16; ++r) p1[r] = __builtin_amdgcn_exp2f(p1[r]);
    float ps0 = p0[0] + p0[1], ps1 = p0[2] + p0[3], ps2 = p1[0] + p1[1], ps3 = p1[2] + p1[3];
#pragma unroll
    for (int r = 4; r < 16; r += 4) { ps0 += p0[r] + p0[r + 1]; ps1 += p0[r + 2] + p0[r + 3]; ps2 += p1[r] + p1[r + 1]; ps3 += p1[r + 2] + p1[r + 3]; }
    float ps = (ps0 + ps1) + (ps2 + ps3);
    { auto rr = __builtin_amdgcn_permlane32_swap(__float_as_uint(ps), __float_as_uint(ps), false, false);
      ps = __uint_as_float(rr[0]) + __uint_as_float(rr[1]); }
    l_reg = l_reg * alpha + ps;
#define PK4(P, BASE, OUT) do { unsigned a0 = pk2(P[BASE + 0], P[BASE + 1]), a1 = pk2(P[BASE + 2], P[BASE + 3]);   \
    unsigned b0 = pk2(P[BASE + 4], P[BASE + 5]), b1 = pk2(P[BASE + 6], P[BASE + 7]);                              \
    auto r0 = __builtin_amdgcn_permlane32_swap(a0, b0, false, false); auto r1 = __builtin_amdgcn_permlane32_swap(a1, b1, false, false); \
    u32x4 w = {r0[0], r1[0], r0[1], r1[1]}; OUT = *reinterpret_cast<bf16x8*>(&w); } while (0)
    PK4(p0, 0, pa0); PK4(p0, 8, pa1); PK4(p1, 0, pa2); PK4(p1, 8, pa3);
#undef PK4
}
template <int DQK>
__device__ __forceinline__ void qkt(f32x16& p0, f32x16& p1, const LAS char* Ks, const bf16x8* qr, int r32, int hi, const float m_ref) {
    constexpr int KROW = Cfg<DQK>::KROW;
    const float nm = -m_ref;
#pragma unroll
    for (int r = 0; r < 16; ++r) { p0[r] = nm; p1[r] = nm; }
#pragma unroll
    for (int d0 = 0; d0 < DQK / 16; ++d0) { const int cb = (d0 * 16 + hi * 8) * 2;
        const bf16x8 b0 = *(const LAS bf16x8*)(Ks + r32 * KROW + (cb ^ (((r32 >> 1) & 7) << 4)));
        const bf16x8 b1 = *(const LAS bf16x8*)(Ks + (32 + r32) * KROW + (cb ^ (((r32 >> 1) & 7) << 4)));
        p0 = __builtin_amdgcn_mfma_f32_32x32x16_bf16(b0, qr[d0], p0, 0, 0, 0);
        p1 = __builtin_amdgcn_mfma_f32_32x32x16_bf16(b1, qr[d0], p1, 0, 0, 0); }
}
template <int DQK, int SDEPTH, int LDQ, int LDK, int LDV, int LDO, int DA = 0>
__device__ __forceinline__ void attn_body(const bf16_t* __restrict__ Qb, const bf16_t* __restrict__ Qb2, const bf16_t* __restrict__ Kh, const bf16_t* __restrict__ Vh, bf16_t* __restrict__ Ob, const int seq, LAS char* lds, const int tid,
                                          const int msel = 0, const float lam = 0.f, const float gsc = 0.f, const float* subg = nullptr, LAS bf16_t* stash = nullptr) {
    using C = Cfg<DQK>;
    constexpr int SHM_V = C::SHM_V, SHM_K = C::SHM_K, KROW = C::KROW, NKC = C::NKC, CH = C::CH;
    const int wid = tid >> 6, lane = tid & 63, r32 = lane & 31, hi = lane >> 5;
    LAS char* V_lds = lds; LAS char* K_lds = lds + 2 * SHM_V;
    LAS float* ws = (LAS float*)(lds + 2 * SHM_V + 2 * SHM_K) + wid * 64; LAS float* li_l = ws; LAS float* al_l = ws + 32;
    float m_reg = 0.f, l_reg = 0; f32x16 o[4] = {}; bf16x8 qr[DQK / 16];
    const bf16_t* Qw = Qb + (long)(wid * QBLK + r32) * LDQ + hi * 8; const bf16_t* Qw2 = Qb2 + (long)(wid * QBLK + r32) * LDQ + hi * 8;
#pragma unroll
    for (int d0 = 0; d0 < DQK / 16; ++d0) qr[d0] = d0 < 8 ? *(const bf16x8*)(Qw + d0 * 16) : *(const bf16x8*)(Qw2 + (d0 - 8) * 16);
    const int sr = tid >> 4, sc = (tid & 15) * 8, vst0 = v_st(sr, sc), vst1 = v_st(32 + sr, sc);
    int krow[NKC], kcol[NKC], kst[NKC];
#pragma unroll
    for (int i = 0; i < NKC; ++i) { const int e = tid + 512 * i; krow[i] = e / CH; kcol[i] = (e % CH) * 8; kst[i] = krow[i] * KROW + ((kcol[i] * 2) ^ (((krow[i] >> 1) & 7) << 4)); }
    const int vb0 = (int)(uintptr_t)V_lds + v_rd_base(lane);
    struct { bf16x8 vs0, vs1, ks[NKC]; } sr_[SDEPTH];
    const unsigned voff0 = (unsigned)(sr * LDV + sc), voff1 = (unsigned)((32 + sr) * LDV + sc); unsigned koff[NKC];
#pragma unroll
    for (int i = 0; i < NKC; ++i) koff[i] = (unsigned)(krow[i] * LDK + kcol[i]);
#define SLOAD(i, k0) do { const bf16_t* vt_ = Vh + (size_t)(k0) * LDV; const bf16_t* kt_ = Kh + (size_t)(k0) * LDK; sr_[i].vs0 = *(const bf16x8*)(vt_ + voff0); sr_[i].vs1 = *(const bf16x8*)(vt_ + voff1); \
    _Pragma("unroll") for (int _c = 0; _c < NKC; ++_c) sr_[i].ks[_c] = *(const bf16x8*)(kt_ + koff[_c]); } while (0)
#define SWRITE(b, i) do { *(LAS bf16x8*)(V_lds + (b) * SHM_V + vst0) = sr_[i].vs0; *(LAS bf16x8*)(V_lds + (b) * SHM_V + vst1) = sr_[i].vs1; \
    _Pragma("unroll") for (int _c = 0; _c < NKC; ++_c) *(LAS bf16x8*)(K_lds + (b) * SHM_K + kst[_c]) = sr_[i].ks[_c]; } while (0)
#define SWAIT() do { if constexpr (SDEPTH == 2) { if constexpr (NKC == 1) asm volatile("s_waitcnt vmcnt(3)" ::: "memory"); else asm volatile("s_waitcnt vmcnt(5)" ::: "memory"); } \
    else asm volatile("s_waitcnt vmcnt(0)" ::: "memory"); } while (0)
#define RESC(a) do { if (__any((a) < 1.f)) { if (hi == 0) al_l[r32] = (a); asm volatile("s_waitcnt lgkmcnt(0)" ::: "memory"); \
    _Pragma("unroll") for (int d = 0; d < 4; ++d) _Pragma("unroll") for (int r = 0; r < 16; ++r) o[d][r] *= al_l[crow(r, hi)]; } } while (0)
    f32x16 pA0, pA1, pB0, pB1; float alA, alB; bf16x8 pa0, pa1, pa2, pa3; const int NT = seq / KVBLK;
    constexpr int SE = 0, SO = SDEPTH - 1;
    SLOAD(SE, 0); asm volatile("s_waitcnt vmcnt(0)" ::: "memory"); SWRITE(0, SE); __syncthreads();
    qkt<DQK>(pA0, pA1, K_lds, qr, r32, hi, m_reg); partialSM<true>(pA0, pA1, m_reg, alA, true);
    SLOAD(SO, KVBLK); if constexpr (SDEPTH == 2) { if (2 < NT) SLOAD(SE, 2 * KVBLK); }
    SWAIT(); SWRITE(1, SO); __syncthreads();
    for (int j = 1; j + 1 < NT; j += 2) {
        SBAR(); qkt<DQK>(pB0, pB1, K_lds + SHM_K, qr, r32, hi, m_reg);
        finishSM(pA0, pA1, alA, l_reg, pa0, pa1, pa2, pa3); SBAR();
        SLOAD(SO, (j + SDEPTH) * KVBLK); SBAR();
        pv_d0(o, vb0, pa0, pa1, pa2, pa3); partialSM<false>(pB0, pB1, m_reg, alB, false);
        __syncthreads(); SWAIT(); SWRITE(0, SE);
        RESC(alB); __syncthreads();
        SBAR(); qkt<DQK>(pA0, pA1, K_lds, qr, r32, hi, m_reg);
        finishSM(pB0, pB1, alB, l_reg, pa0, pa1, pa2, pa3); SBAR();
        if (SDEPTH == 1 || j + 3 < NT) SLOAD(SE, (j + 1 + SDEPTH) * KVBLK); SBAR();
        pv_d0(o, vb0 + SHM_V, pa0, pa1, pa2, pa3); partialSM<false>(pA0, pA1, m_reg, alA, false);
        __syncthreads(); SWAIT(); SWRITE(1, SO);
        RESC(alA); __syncthreads();
    }
    SBAR(); qkt<DQK>(pB0, pB1, K_lds + SHM_K, qr, r32, hi, m_reg);
    finishSM(pA0, pA1, alA, l_reg, pa0, pa1, pa2, pa3); SBAR();
    pv_d0(o, vb0, pa0, pa1, pa2, pa3); partialSM<false>(pB0, pB1, m_reg, alB, false);
    __syncthreads(); RESC(alB);
    finishSM(pB0, pB1, alB, l_reg, pa0, pa1, pa2, pa3); SBAR();
    pv_d0(o, vb0 + SHM_V, pa0, pa1, pa2, pa3);
    if (hi == 0) li_l[r32] = l_reg; asm volatile("s_waitcnt lgkmcnt(0)" ::: "memory");
    float rli[16];
#pragma unroll
    for (int r = 0; r < 16; ++r) rli[r] = __builtin_amdgcn_rcpf(li_l[crow(r, hi)]);
    bf16_t* Ow = Ob + (long)(wid * QBLK) * LDO;
    if constexpr (DA == 0) {
#pragma unroll
        for (int r = 0; r < 16; ++r) { const int orow = crow(r, hi);
#pragma unroll
            for (int d0 = 0; d0 < 4; ++d0) Ow[(long)orow * LDO + d0 * 32 + r32] = f2bf(o[d0][r] * rli[r]); }
    } else {
        int t2 = threadIdx.x; asm volatile("" : "+v"(t2));
        const int wid2 = t2 >> 6, lane2 = t2 & 63, r32l = lane2 & 31, hi2 = lane2 >> 5; bf16_t* Ow2 = Ob + (long)(wid2 * QBLK) * LDO;
        LAS bf16_t* stw = stash + wid2 * 4096 + lane2;
        if (msel == 0) {
#pragma unroll
            for (int r = 0; r < 16; ++r)
#pragma unroll
                for (int d0 = 0; d0 < 4; ++d0) stw[(r * 4 + d0) * 64] = f2bf(o[d0][r] * rli[r]);
        } else {
            float ds[16];
#pragma unroll
            for (int r = 0; r < 16; ++r) { float s = 0.f; if ((r & 3) == 0) asm volatile("" ::: "memory");
#pragma unroll
                for (int d0 = 0; d0 < 4; ++d0) { const float d = bf2f(stw[(r * 4 + d0) * 64]) - lam * (o[d0][r] * rli[r]); o[d0][r] = d; s += d * d; }
                ds[r] = s; }
#define SWZ_ADD(M) _Pragma("unroll") for (int r = 0; r < 16; ++r) ds[r] += __uint_as_float(__builtin_amdgcn_ds_swizzle(__float_as_uint(ds[r]), ((M) << 10) | 0x1f))
            SWZ_ADD(1); SWZ_ADD(2); SWZ_ADD(4); SWZ_ADD(8); SWZ_ADD(16);
#undef SWZ_ADD
            float g[4];
#pragma unroll
            for (int d0 = 0; d0 < 4; ++d0) g[d0] = subg[d0 * 32 + r32l] * gsc;
#pragma unroll
            for (int r = 0; r < 16; ++r) { const int orow = crow(r, hi2); const float rs = rsqrtf(ds[r] * (1.0f / 128.0f) + RMS_EPS);
#pragma unroll
                for (int d0 = 0; d0 < 4; ++d0) Ow2[(long)orow * LDO + d0 * 32 + r32l] = f2bf(o[d0][r] * rs * g[d0]); }
        }
    }
    __syncthreads();
#undef SLOAD
#undef SWRITE
#undef SWAIT
#undef RESC
}
template <int DQK, int LDQ, int LDK, int LDV, int LDO, int DA = 0>
__device__ __forceinline__ void attn_body_simple(const bf16_t* __restrict__ Qb, const bf16_t* __restrict__ Qb2, const bf16_t* __restrict__ Kh, const bf16_t* __restrict__ Vh, bf16_t* __restrict__ Ob, const int seq, LAS char* lds, const int tid,
                                                 const int msel = 0, const float lam = 0.f, const float gsc = 0.f, const float* subg = nullptr, LAS bf16_t* stash = nullptr) {
    using C = Cfg<DQK>;
    constexpr int SHM_V = C::SHM_V, SHM_K = C::SHM_K, KROW = C::KROW, NKC = C::NKC, CH = C::CH;
    const int wid = tid >> 6, lane = tid & 63, r32 = lane & 31, hi = lane >> 5;
    LAS char* V_lds = lds; LAS char* K_lds = lds + 2 * SHM_V;
    LAS float* ws = (LAS float*)(lds + 2 * SHM_V + 2 * SHM_K) + wid * 64; LAS float* li_l = ws; LAS float* al_l = ws + 32;
    float m_reg = 0.f, l_reg = 0; f32x16 o[4] = {}; bf16x8 qr[DQK / 16];
    const bf16_t* Qw = Qb + (long)(wid * QBLK + r32) * LDQ + hi * 8; const bf16_t* Qw2 = Qb2 + (long)(wid * QBLK + r32) * LDQ + hi * 8;
#pragma unroll
    for (int d0 = 0; d0 < DQK / 16; ++d0) qr[d0] = d0 < 8 ? *(const bf16x8*)(Qw + d0 * 16) : *(const bf16x8*)(Qw2 + (d0 - 8) * 16);
    const int sr = tid >> 4, sc = (tid & 15) * 8, vst0 = v_st(sr, sc), vst1 = v_st(32 + sr, sc);
    int krow[NKC], kcol[NKC], kst[NKC];
#pragma unroll
    for (int i = 0; i < NKC; ++i) { const int e = tid + 512 * i; krow[i] = e / CH; kcol[i] = (e % CH) * 8; kst[i] = krow[i] * KROW + ((kcol[i] * 2) ^ (((krow[i] >> 1) & 7) << 4)); }
    const int vb0 = (int)(uintptr_t)V_lds + v_rd_base(lane);
    bf16x8 vs0, vs1, ks[NKC];
    const unsigned voff0 = (unsigned)(sr * LDV + sc), voff1 = (unsigned)((32 + sr) * LDV + sc); unsigned koff[NKC];
#pragma unroll
    for (int i = 0; i < NKC; ++i) koff[i] = (unsigned)(krow[i] * LDK + kcol[i]);
#define SLOAD(k0) do { const bf16_t* vt_ = Vh + (size_t)(k0) * LDV; const bf16_t* kt_ = Kh + (size_t)(k0) * LDK; vs0 = *(const bf16x8*)(vt_ + voff0); vs1 = *(const bf16x8*)(vt_ + voff1); \
    _Pragma("unroll") for (int _c = 0; _c < NKC; ++_c) ks[_c] = *(const bf16x8*)(kt_ + koff[_c]); } while (0)
#define SWRITE(b) do { *(LAS bf16x8*)(V_lds + (b) * SHM_V + vst0) = vs0; *(LAS bf16x8*)(V_lds + (b) * SHM_V + vst1) = vs1; \
    _Pragma("unroll") for (int _c = 0; _c < NKC; ++_c) *(LAS bf16x8*)(K_lds + (b) * SHM_K + kst[_c]) = ks[_c]; } while (0)
    const int NT = seq / KVBLK;
    SLOAD(0); SWRITE(0); SLOAD(KVBLK); __syncthreads();
#pragma unroll 1
    for (int j = 0; j < NT; ++j) {
        const int bsel = j & 1; f32x16 p0, p1; float al; bf16x8 pa0, pa1, pa2, pa3;
        qkt<DQK>(p0, p1, K_lds + bsel * SHM_K, qr, r32, hi, m_reg);
        partialSM<true>(p0, p1, m_reg, al, j == 0);
        if (__any(al < 1.f)) { if (hi == 0) al_l[r32] = al; asm volatile("s_waitcnt lgkmcnt(0)" ::: "memory");
#pragma unroll
            for (int d = 0; d < 4; ++d)
#pragma unroll
                for (int r = 0; r < 16; ++r) o[d][r] *= al_l[crow(r, hi)]; }
        finishSM(p0, p1, al, l_reg, pa0, pa1, pa2, pa3); SBAR();
        pv_pipe(o, vb0 + bsel * SHM_V, pa0, pa1, pa2, pa3);
        if (j + 1 < NT) { SWRITE(bsel ^ 1); if (j + 2 < NT) SLOAD((j + 2) * KVBLK); }
        __syncthreads();
    }
    if (hi == 0) li_l[r32] = l_reg; asm volatile("s_waitcnt lgkmcnt(0)" ::: "memory");
    float rli[16];
#pragma unroll
    for (int r = 0; r < 16; ++r) rli[r] = __builtin_amdgcn_rcpf(li_l[crow(r, hi)]);
    bf16_t* Ow = Ob + (long)(wid * QBLK) * LDO;
    if constexpr (DA == 0) {
#pragma unroll
        for (int r = 0; r < 16; ++r) { const int orow = crow(r, hi);
#pragma unroll
            for (int d0 = 0; d0 < 4; ++d0) Ow[(long)orow * LDO + d0 * 32 + r32] = f2bf(o[d0][r] * rli[r]); }
    } else {
        int t2 = threadIdx.x; asm volatile("" : "+v"(t2));
        const int wid2 = t2 >> 6, lane2 = t2 & 63, r32l = lane2 & 31, hi2 = lane2 >> 5; bf16_t* Ow2 = Ob + (long)(wid2 * QBLK) * LDO;
        LAS bf16_t* stw = stash + wid2 * 4096 + lane2;
        if (msel == 0) {
#pragma unroll
            for (int r = 0; r < 16; ++r)
#pragma unroll
                for (int d0 = 0; d0 < 4; ++d0) stw[(r * 4 + d0) * 64] = f2bf(o[d0][r] * rli[r]);
        } else {
            float ds[16];
#pragma unroll
            for (int r = 0; r < 16; ++r) { float s = 0.f; if ((r & 3) == 0) asm volatile("" ::: "memory");
#pragma unroll
                for (int d0 = 0; d0 < 4; ++d0) { const float d = bf2f(stw[(r * 4 + d0) * 64]) - lam * (o[d0][r] * rli[r]); o[d0][r] = d; s += d * d; }
                ds[r] = s; }
#define SWZ_ADD(M) _Pragma("unroll") for (int r = 0; r < 16; ++r) ds[r] += __uint_as_float(__builtin_amdgcn_ds_swizzle(__float_as_uint(ds[r]), ((M) << 10) | 0x1f))
            SWZ_ADD(1); SWZ_ADD(2); SWZ_ADD(4); SWZ_ADD(8); SWZ_ADD(16);
#undef SWZ_ADD
            float g[4];
#pragma unroll
            for (int d0 = 0; d0 < 4; ++d0) g[d0] = subg[d0 * 32 + r32l] * gsc;
#pragma unroll
            for (int r = 0; r < 16; ++r) { const int orow = crow(r, hi2); const float rs = rsqrtf(ds[r] * (1.0f / 128.0f) + RMS_EPS);
#pragma unroll
                for (int d0 = 0; d0 < 4; ++d0) Ow2[(long)orow * LDO + d0 * 32 + r32l] = f2bf(o[d0][r] * rs * g[d0]); }
        }
    }
    __syncthreads();
#undef SLOAD
#undef SWRITE
}
template <int DQK, int LDQ, int LDK, int LDV, int LDO>
__device__ __forceinline__ void attn_body_stag(const bf16_t* __restrict__ Qb, const bf16_t* __restrict__ Qb2, const bf16_t* __restrict__ Kh, const bf16_t* __restrict__ Vh, bf16_t* __restrict__ Ob, const int seq, LAS char* lds, const int tid) {
    using C = Cfg<DQK>;
    constexpr int SHM_V = C::SHM_V, SHM_K = C::SHM_K, KROW = C::KROW, NKC = C::NKC, CH = C::CH;
    const int wid = __builtin_amdgcn_readfirstlane(tid >> 6), lane = tid & 63, r32 = lane & 31, hi = lane >> 5, half = wid >> 2;
    LAS char* V_lds = lds; LAS char* K_lds = lds + 2 * SHM_V;
    LAS float* ws = (LAS float*)(lds + 2 * SHM_V + 2 * SHM_K) + wid * 64; LAS float* li_l = ws; LAS float* al_l = ws + 32;
    float m_reg = 0.f, l_reg = 0; f32x16 o[4] = {}; bf16x8 qr[DQK / 16];
    const bf16_t* Qw = Qb + (long)(wid * QBLK + r32) * LDQ + hi * 8; const bf16_t* Qw2 = Qb2 + (long)(wid * QBLK + r32) * LDQ + hi * 8;
#pragma unroll
    for (int d0 = 0; d0 < DQK / 16; ++d0) qr[d0] = d0 < 8 ? *(const bf16x8*)(Qw + d0 * 16) : *(const bf16x8*)(Qw2 + (d0 - 8) * 16);
    const int sr = tid >> 4, sc = (tid & 15) * 8, vst0 = v_st(sr, sc), vst1 = v_st(32 + sr, sc);
    int kst[NKC]; unsigned koff[NKC];
#pragma unroll
    for (int i = 0; i < NKC; ++i) { const int e = tid + 512 * i, krow = e / CH, kcol = (e % CH) * 8; kst[i] = krow * KROW + ((kcol * 2) ^ (((krow >> 1) & 7) << 4)); koff[i] = (unsigned)(krow * LDK + kcol); }
    const unsigned voff0 = (unsigned)(sr * LDV + sc), voff1 = (unsigned)((32 + sr) * LDV + sc);
    const int vb0 = (int)(uintptr_t)V_lds + v_rd_base(lane);
    bf16x8 vs0, vs1, ks[NKC];
#define KLOAD(k0) do { const bf16_t* kt_ = Kh + (size_t)(k0) * LDK; _Pragma("unroll") for (int _c = 0; _c < NKC; ++_c) ks[_c] = *(const bf16x8*)(kt_ + koff[_c]); } while (0)
#define VLOAD(k0) do { const bf16_t* vt_ = Vh + (size_t)(k0) * LDV; vs0 = *(const bf16x8*)(vt_ + voff0); vs1 = *(const bf16x8*)(vt_ + voff1); } while (0)
#define KWRITE(b) do { _Pragma("unroll") for (int _c = 0; _c < NKC; ++_c) *(LAS bf16x8*)(K_lds + (b) * SHM_K + kst[_c]) = ks[_c]; } while (0)
#define VWRITE(b) do { *(LAS bf16x8*)(V_lds + (b) * SHM_V + vst0) = vs0; *(LAS bf16x8*)(V_lds + (b) * SHM_V + vst1) = vs1; } while (0)
    const int NT = seq / KVBLK;
    KLOAD(0); VLOAD(0); KWRITE(0); VWRITE(0); KLOAD(KVBLK); VLOAD(KVBLK);
    __syncthreads();
    f32x16 p0 = {}, p1 = {}; float al = 1.f;
#define STG_K(J_) do { if ((J_) + 1 < NT) { KWRITE(((J_) + 1) & 1); if ((J_) + 2 < NT) KLOAD(((J_) + 2) * KVBLK); } } while (0)
#define STG_V(J_) do { if ((J_) + 1 < NT) { VWRITE(((J_) + 1) & 1); if ((J_) + 2 < NT) VLOAD(((J_) + 2) * KVBLK); } } while (0)
#define SP0(j_) do { qkt<DQK>(p0, p1, K_lds + ((j_) & 1) * SHM_K, qr, r32, hi, m_reg); partialSM<true>(p0, p1, m_reg, al, (j_) == 0); } while (0)
#define SP1(j_) do { bf16x8 pa0, pa1, pa2, pa3; \
        if (__any(al < 1.f)) { if (hi == 0) al_l[r32] = al; asm volatile("s_waitcnt lgkmcnt(0)" ::: "memory"); \
            _Pragma("unroll") for (int d = 0; d < 4; ++d) _Pragma("unroll") for (int r = 0; r < 16; ++r) o[d][r] *= al_l[crow(r, hi)]; } \
        finishSM(p0, p1, al, l_reg, pa0, pa1, pa2, pa3); SBAR(); \
        pv_pipe(o, vb0 + ((j_) & 1) * SHM_V, pa0, pa1, pa2, pa3); } while (0)
    if (half == 0) {
#pragma unroll 1
        for (int J = 0; J < NT; ++J) { STG_K(J); SP0(J); __syncthreads(); STG_V(J); SP1(J); __syncthreads(); }
        __syncthreads();
    } else {
        STG_K(0); __syncthreads(); STG_V(0); SP0(0); __syncthreads();
#pragma unroll 1
        for (int J = 1; J < NT; ++J) { STG_K(J); SP1(J - 1); __syncthreads(); STG_V(J); SP0(J); __syncthreads(); }
        SP1(NT - 1); __syncthreads();
    }
#undef STG_K
#undef STG_V
#undef SP0
#undef SP1
    if (hi == 0) li_l[r32] = l_reg; asm volatile("s_waitcnt lgkmcnt(0)" ::: "memory");
    float rli[16];
#pragma unroll
    for (int r = 0; r < 16; ++r) rli[r] = __builtin_amdgcn_rcpf(li_l[crow(r, hi)]);
    bf16_t* Ow = Ob + (long)(wid * QBLK) * LDO;
#pragma unroll
    for (int r = 0; r < 16; ++r) { const int orow = crow(r, hi);
#pragma unroll
        for (int d0 = 0; d0 < 4; ++d0) Ow[(long)orow * LDO + d0 * 32 + r32] = f2bf(o[d0][r] * rli[r]); }
    __syncthreads();
#undef KLOAD
#undef VLOAD
#undef KWRITE
#undef VWRITE
}
template <int DQK, int SDEPTH, int NH, int VSHARE, bool CTXQ, bool KSH = false>
__device__ __forceinline__ void attn_phase(const bf16_t* Q, const bf16_t* K, const bf16_t* V, bf16_t* O, LAS char* lds, const int tid) {
    constexpr int LDQ = NH * DQK, LDK = KSH ? DQK : NH * DQK, LDV = KSH ? DQK : (NH / VSHARE) * DV, LDO = NH * DV;
    if constexpr (KSH) V = K;
    const int c = blockIdx.x, xcd = c & 7, slot = c >> 3;
    constexpr int ROUNDS = NB * NH / 8;
#pragma unroll 1
    for (int i = 0; i <= ROUNDS; ++i) {
        int b, h, seq; size_t qtok;
        if (i < ROUNDS) { const int bh = i * 8 + xcd; b = bh / NH; h = bh % NH; qtok = (size_t)b * TB + CTX + (size_t)slot * 256; seq = TB; }
        else { if (!CTXQ || c >= NB * NH) break; b = c / NH; h = c % NH; qtok = (size_t)b * TB; seq = CTX; }
        const size_t t0 = (size_t)b * TB;
        if constexpr (SDEPTH == 3) attn_body_stag<DQK, LDQ, LDK, LDV, LDO>(Q + qtok * LDQ + h * (DQK > 128 ? 128 : DQK), Q + qtok * LDQ + NH * 128 + h * (DQK > 128 ? DQK - 128 : 0), K + t0 * LDK + h * DQK, V + t0 * LDV + (h / VSHARE) * DV, O + qtok * LDO + h * DV, seq, lds, tid);
        else if constexpr (SDEPTH == 0) attn_body_simple<DQK, LDQ, LDK, LDV, LDO>(Q + qtok * LDQ + h * (DQK > 128 ? 128 : DQK), Q + qtok * LDQ + NH * 128 + h * (DQK > 128 ? DQK - 128 : 0), K + t0 * LDK + (KSH ? 0 : h * DQK), V + t0 * LDV + (KSH ? 0 : (h / VSHARE) * DV), O + qtok * LDO + h * DV, seq, lds, tid);
        else attn_body<DQK, ((SDEPTH == 0 || SDEPTH == 3) ? 1 : SDEPTH), LDQ, LDK, LDV, LDO>(Q + qtok * LDQ + h * DQK, Q + qtok * LDQ + h * DQK, K + t0 * LDK + h * DQK, V + t0 * LDV + (h / VSHARE) * DV, O + qtok * LDO + h * DV, seq, lds, tid);
    }
}
template <int L>
__device__ __forceinline__ void attn_phase_da(const bf16_t* Q, const bf16_t* K, const bf16_t* V, bf16_t* O2, const float* lamv, const float* subg, LAS char* lds, const int tid) {
    constexpr int LD = 1024;
    const float lam_init = L == 0 ? 0.2f : 0.8f - 0.6f * 0.40656965974059917f;
    const int lane = tid & 63;
    const float d01 = wave_sum(lamv[lane] * lamv[64 + lane]), d23 = wave_sum(lamv[128 + lane] * lamv[192 + lane]);
    const float lam = __uint_as_float(__builtin_amdgcn_readfirstlane(__float_as_uint(expf(d01) - expf(d23) + lam_init))), gsc = 1.0f - lam_init;
    LAS bf16_t* stash = (LAS bf16_t*)(lds + 52 * 1024);
    const int c = blockIdx.x, xcd = c & 7, slot = c >> 3;
    constexpr int NU = 2 * NB + ((L != 3) ? 2 : 0);
#pragma unroll 1
    for (int i = 0; i < NU; ++i) {
        const int msel = i & 1; int b, h, seq; size_t qtok;
        if (i < 2 * NB) { const int bh = (i >> 1) * 8 + xcd; b = bh >> 3; h = bh & 7; qtok = (size_t)b * TB + CTX + (size_t)slot * 256; seq = TB; }
        else { if (c >= NB * 8) break; b = c >> 3; h = c & 7; qtok = (size_t)b * TB; seq = CTX; }
        const size_t t0 = (size_t)b * TB; const int hh = 2 * h + msel;
        attn_body<64, 2, LD, LD, LD, LD, 1>(Q + qtok * LD + hh * 64, Q + qtok * LD + hh * 64, K + t0 * LD + hh * 64, V + t0 * LD + h * 128, O2 + qtok * LD + h * 128, seq, lds, tid, msel, lam, gsc, subg, stash);
    }
}
}

struct Params { const float* in[27]; float* out; unsigned char* ws; int ph_lo, ph_hi; };
enum { I_X = 0, I_C, I_CTX, I_CCTX, I_ADAW, I_ADAB, I_NORMG, I_FINALG, I_DA_WIN, I_DA_WOUT, I_DA_LAM, I_DA_SUBG, I_RET_WIN, I_RET_DECAY, I_RET_WOUT, I_MLA_WIN, I_MLA_QG,
       I_MLA_WQUP, I_MLA_KVG, I_MLA_WKVUP, I_MLA_WOUT, I_MOE_WR, I_MOE_BR, I_MOE_WGU, I_MOE_BGU, I_MOE_WDN, I_MOE_BDN };

struct Frame {
    const Params* p; LAS unsigned char* lds; LAS unsigned char* reg; volatile LAS int* misc; int tid, lane, wave;
    unsigned char* ws;
};

enum { PK_ID = 0, PK_DA_IN, PK_RET_IN, PK_MLA_QUP, PK_MOE_GU };
__device__ __forceinline__ int src_col(int n, int kind) {
    if (kind == PK_DA_IN) { if ((n >> 10) == 1) return n; const int o = n & 63, axis = o >> 5, p = o & 31, f = p >> 1; return (n & ~63) | (axis * 32 + ((p & 1) ? 16 + f : f)); }
    if (kind == PK_RET_IN) { if (n < 1024 || (n >= 3072 && n < 4096)) { const int o = n & 255, f = o >> 1; return (n & ~255) | ((o & 1) ? 128 + f : f); } return n; }
    if (kind == PK_MLA_QUP) { if (n < 1024) return (n >> 7) * 192 + (n & 127); const int nn = n - 1024, hd = nn >> 6, oo = nn & 63, axis = oo >> 5, p = oo & 31, f = p >> 1; return hd * 192 + 128 + axis * 32 + ((p & 1) ? 16 + f : f); }
    if (kind == PK_MOE_GU) return ((n >> 7) & 1) * 1024 + (n >> 8) * 128 + (n & 127);
    return n;
}
__device__ __forceinline__ void tr_item(const float* W, int Ksrc, int Nsrc, bf16_t* WT, int Kdst, int Ndst, int Nvalid, int kind, LAS float* scr, int item, int lane) {
    const int nblk = Ndst / 32, kb = item / nblk, nb = item % nblk, k0 = 64 * kb, n0 = 32 * nb;
    const int n = n0 + (lane & 31); const bool nv = n < Nvalid; const int scn = nv ? src_col(n, kind) : 0;
#pragma unroll 8
    for (int i = 0; i < 32; ++i) { const int kk = 2 * i + (lane >> 5), k = k0 + kk; scr[kk * 33 + (lane & 31)] = (nv && k < Ksrc) ? W[(size_t)k * Nsrc + scn] : 0.f; }
    asm volatile("s_waitcnt lgkmcnt(0)" ::: "memory");
    const int c = lane & 7;
#pragma unroll
    for (int j = 0; j < 4; ++j) { const int nn = (lane >> 3) + 8 * j; const LAS float* s = scr + (8 * c) * 33 + nn;
        u32x4 o; o.x = pk2(s[0 * 33], s[1 * 33]); o.y = pk2(s[2 * 33], s[3 * 33]); o.z = pk2(s[4 * 33], s[5 * 33]); o.w = pk2(s[6 * 33], s[7 * 33]);
        *(u32x4*)(WT + (size_t)(n0 + nn) * Kdst + k0 + 8 * c) = o; }
    asm volatile("s_waitcnt lgkmcnt(0)" ::: "memory");
}
__device__ __forceinline__ void tr_itemq(const float* W, int Ksrc, int Nsrc, signed char* WT, int Kdst, int Ndst, int Nvalid, int kind, const unsigned* raw, LAS float* scr, int item, int lane) {
    const int nblk = Ndst / 32, kb = item / nblk, nb = item % nblk, k0 = 64 * kb, n0 = 32 * nb;
    const int n = n0 + (lane & 31); const bool nv = n < Nvalid; const int scn = nv ? src_col(n, kind) : 0; const float inv = 127.0f / fmaxf(__uint_as_float(raw[scn]), 1e-30f);
#pragma unroll 8
    for (int i = 0; i < 32; ++i) { const int kk = 2 * i + (lane >> 5), k = k0 + kk; const float v = (nv && k < Ksrc) ? W[(size_t)k * Nsrc + scn] * inv : 0.f; scr[kk * 33 + (lane & 31)] = fminf(fmaxf(rintf(v), -127.f), 127.f); }
    asm volatile("s_waitcnt lgkmcnt(0)" ::: "memory");
    const int c = lane & 7;
#pragma unroll
    for (int j = 0; j < 4; ++j) { const int nn = (lane >> 3) + 8 * j; const LAS float* s = scr + (8 * c) * 33 + nn;
        unsigned lo = ((unsigned)(int)s[0 * 33] & 0xffu) | (((unsigned)(int)s[1 * 33] & 0xffu) << 8) | (((unsigned)(int)s[2 * 33] & 0xffu) << 16) | (((unsigned)(int)s[3 * 33] & 0xffu) << 24);
        unsigned hi = ((unsigned)(int)s[4 * 33] & 0xffu) | (((unsigned)(int)s[5 * 33] & 0xffu) << 8) | (((unsigned)(int)s[6 * 33] & 0xffu) << 16) | (((unsigned)(int)s[7 * 33] & 0xffu) << 24);
        *(u32x2*)(WT + (size_t)(n0 + nn) * Kdst + k0 + 8 * c) = (u32x2){lo, hi}; }
    asm volatile("s_waitcnt lgkmcnt(0)" ::: "memory");
}
__device__ __forceinline__ void tr_item4q(const float* W, int Nsrc, signed char* WT, int Kdst, int Ndst, int kind, const unsigned* raw, LAS float* scr, int item, int lane) {
    const int nblk = Ndst / 32, kb = item / nblk, nb = item % nblk, k0 = 64 * kb, n0 = 32 * nb, nq = lane & 7, kr = lane >> 3;
    const int scn = src_col(n0 + 4 * nq, kind); const float* wp = W + (size_t)(k0 + kr) * Nsrc + scn;
    const u32x4 rw4 = *(const u32x4*)(raw + scn); const f32x4 inv = (f32x4){127.0f / fmaxf(__uint_as_float(rw4.x), 1e-30f), 127.0f / fmaxf(__uint_as_float(rw4.y), 1e-30f), 127.0f / fmaxf(__uint_as_float(rw4.z), 1e-30f), 127.0f / fmaxf(__uint_as_float(rw4.w), 1e-30f)};
    f32x4 v[8];
#pragma unroll
    for (int i = 0; i < 8; ++i) v[i] = *(const f32x4*)(wp + (size_t)(8 * i) * Nsrc);
#pragma unroll
    for (int i = 0; i < 8; ++i) { LAS float* d = scr + (8 * i + kr) * 33 + 4 * nq; const f32x4 q = v[i] * inv;
        d[0] = fminf(fmaxf(rintf(q[0]), -127.f), 127.f); d[1] = fminf(fmaxf(rintf(q[1]), -127.f), 127.f); d[2] = fminf(fmaxf(rintf(q[2]), -127.f), 127.f); d[3] = fminf(fmaxf(rintf(q[3]), -127.f), 127.f); }
    asm volatile("s_waitcnt lgkmcnt(0)" ::: "memory");
    const int c = lane & 7;
#pragma unroll
    for (int j = 0; j < 4; ++j) { const int nn = (lane >> 3) + 8 * j; const LAS float* s = scr + (8 * c) * 33 + nn;
        unsigned lo = ((unsigned)(int)s[0 * 33] & 0xffu) | (((unsigned)(int)s[1 * 33] & 0xffu) << 8) | (((unsigned)(int)s[2 * 33] & 0xffu) << 16) | (((unsigned)(int)s[3 * 33] & 0xffu) << 24);
        unsigned hi = ((unsigned)(int)s[4 * 33] & 0xffu) | (((unsigned)(int)s[5 * 33] & 0xffu) << 8) | (((unsigned)(int)s[6 * 33] & 0xffu) << 16) | (((unsigned)(int)s[7 * 33] & 0xffu) << 24);
        *(u32x2*)(WT + (size_t)(n0 + nn) * Kdst + k0 + 8 * c) = (u32x2){lo, hi}; }
    asm volatile("s_waitcnt lgkmcnt(0)" ::: "memory");
}
__device__ __forceinline__ void tr4_load(f32x4 (&v)[8], const float* W, int Nsrc, int Ndst, int kind, int item, int lane, int& scn) {
    const int nblk = Ndst / 32, kb = item / nblk, nb = item % nblk, k0 = 64 * kb, n0 = 32 * nb, nq = lane & 7, kr = lane >> 3;
    scn = src_col(n0 + 4 * nq, kind); const float* wp = W + (size_t)(k0 + kr) * Nsrc + scn;
#pragma unroll
    for (int i = 0; i < 8; ++i) v[i] = *(const f32x4*)(wp + (size_t)(8 * i) * Nsrc);
}
template <bool Q8> __device__ __forceinline__ void tr4_store(const f32x4 (&v)[8], void* WTv, int Kdst, int Ndst, const unsigned* raw, int scn, LAS float* scr, int item, int lane) {
    const int nblk = Ndst / 32, kb = item / nblk, nb = item % nblk, k0 = 64 * kb, n0 = 32 * nb, nq = lane & 7, kr = lane >> 3;
    f32x4 inv = (f32x4){1.f, 1.f, 1.f, 1.f};
    if constexpr (Q8) { const u32x4 rw4 = *(const u32x4*)(raw + scn); inv = (f32x4){127.0f / fmaxf(__uint_as_float(rw4.x), 1e-30f), 127.0f / fmaxf(__uint_as_float(rw4.y), 1e-30f), 127.0f / fmaxf(__uint_as_float(rw4.z), 1e-30f), 127.0f / fmaxf(__uint_as_float(rw4.w), 1e-30f)}; }
#pragma unroll
    for (int i = 0; i < 8; ++i) { LAS float* d = scr + (8 * i + kr) * 33 + 4 * nq;
        if constexpr (Q8) { const f32x4 q = v[i] * inv; d[0] = fminf(fmaxf(rintf(q[0]), -127.f), 127.f); d[1] = fminf(fmaxf(rintf(q[1]), -127.f), 127.f); d[2] = fminf(fmaxf(rintf(q[2]), -127.f), 127.f); d[3] = fminf(fmaxf(rintf(q[3]), -127.f), 127.f); }
        else { d[0] = v[i][0]; d[1] = v[i][1]; d[2] = v[i][2]; d[3] = v[i][3]; } }
    asm volatile("s_waitcnt lgkmcnt(0)" ::: "memory");
    const int c = lane & 7;
#pragma unroll
    for (int j = 0; j < 4; ++j) { const int nn = (lane >> 3) + 8 * j; const LAS float* s = scr + (8 * c) * 33 + nn;
        if constexpr (Q8) {
            unsigned lo = ((unsigned)(int)s[0 * 33] & 0xffu) | (((unsigned)(int)s[1 * 33] & 0xffu) << 8) | (((unsigned)(int)s[2 * 33] & 0xffu) << 16) | (((unsigned)(int)s[3 * 33] & 0xffu) << 24);
            unsigned hi = ((unsigned)(int)s[4 * 33] & 0xffu) | (((unsigned)(int)s[5 * 33] & 0xffu) << 8) | (((unsigned)(int)s[6 * 33] & 0xffu) << 16) | (((unsigned)(int)s[7 * 33] & 0xffu) << 24);
            *(u32x2*)((signed char*)WTv + (size_t)(n0 + nn) * Kdst + k0 + 8 * c) = (u32x2){lo, hi};
        } else { u32x4 o; o.x = pk2(s[0 * 33], s[1 * 33]); o.y = pk2(s[2 * 33], s[3 * 33]); o.z = pk2(s[4 * 33], s[5 * 33]); o.w = pk2(s[6 * 33], s[7 * 33]);
            *(u32x4*)((bf16_t*)WTv + (size_t)(n0 + nn) * Kdst + k0 + 8 * c) = o; } }
    asm volatile("s_waitcnt lgkmcnt(0)" ::: "memory");
}
__device__ __forceinline__ void tr4_store_inv(const f32x4 (&v)[8], signed char* WT, int Kdst, int Ndst, const f32x4 inv, LAS float* scr, int item, int lane) {
    const int nblk = Ndst / 32, kb = item / nblk, nb = item % nblk, k0 = 64 * kb, n0 = 32 * nb, nq = lane & 7, kr = lane >> 3;
#pragma unroll
    for (int i = 0; i < 8; ++i) { LAS float* d = scr + (8 * i + kr) * 33 + 4 * nq; const f32x4 q = v[i] * inv;
        d[0] = fminf(fmaxf(rintf(q[0]), -127.f), 127.f); d[1] = fminf(fmaxf(rintf(q[1]), -127.f), 127.f); d[2] = fminf(fmaxf(rintf(q[2]), -127.f), 127.f); d[3] = fminf(fmaxf(rintf(q[3]), -127.f), 127.f); }
    asm volatile("s_waitcnt lgkmcnt(0)" ::: "memory");
    const int c = lane & 7;
#pragma unroll
    for (int j = 0; j < 4; ++j) { const int nn = (lane >> 3) + 8 * j; const LAS float* s = scr + (8 * c) * 33 + nn;
        unsigned lo = ((unsigned)(int)s[0 * 33] & 0xffu) | (((unsigned)(int)s[1 * 33] & 0xffu) << 8) | (((unsigned)(int)s[2 * 33] & 0xffu) << 16) | (((unsigned)(int)s[3 * 33] & 0xffu) << 24);
        unsigned hi = ((unsigned)(int)s[4 * 33] & 0xffu) | (((unsigned)(int)s[5 * 33] & 0xffu) << 8) | (((unsigned)(int)s[6 * 33] & 0xffu) << 16) | (((unsigned)(int)s[7 * 33] & 0xffu) << 24);
        *(u32x2*)(WT + (size_t)(n0 + nn) * Kdst + k0 + 8 * c) = (u32x2){lo, hi}; }
    asm volatile("s_waitcnt lgkmcnt(0)" ::: "memory");
}
template <bool Q8> __device__ __forceinline__ void tr4_job(const float* W, int K, int N, void* WT, int kind, int count, const unsigned* raw, LAS float* scr, int gw, int NGW, int lane) {
    const int per = (K / 64) * (N / 32), total = per * count; const size_t esz = Q8 ? 1 : 2;
    if (gw >= total) return;
    f32x4 va[8], vb[8]; int sa = 0, sb = 0;
    tr4_load(va, W + (size_t)(gw / per) * K * N, N, N, kind, gw % per, lane, sa);
#pragma unroll 1
    for (int it = gw; it < total; it += 2 * NGW) {
        const int it1 = it + NGW, it2 = it + 2 * NGW;
        if (it1 < total) tr4_load(vb, W + (size_t)(it1 / per) * K * N, N, N, kind, it1 % per, lane, sb);
        tr4_store<Q8>(va, (char*)WT + (size_t)(it / per) * K * N * esz, K, N, raw ? raw + (size_t)(it / per) * N : nullptr, sa, scr, it % per, lane);
        if (it2 < total) tr4_load(va, W + (size_t)(it2 / per) * K * N, N, N, kind, it2 % per, lane, sa);
        if (it1 < total) tr4_store<Q8>(vb, (char*)WT + (size_t)(it1 / per) * K * N * esz, K, N, raw ? raw + (size_t)(it1 / per) * N : nullptr, sb, scr, it1 % per, lane);
    }
}
__device__ __forceinline__ void tr_item4(const float* W, int Nsrc, bf16_t* WT, int Kdst, int Ndst, int kind, LAS float* scr, int item, int lane) {
    const int nblk = Ndst / 32, kb = item / nblk, nb = item % nblk, k0 = 64 * kb, n0 = 32 * nb, nq = lane & 7, kr = lane >> 3;
    const int scn = src_col(n0 + 4 * nq, kind); const float* wp = W + (size_t)(k0 + kr) * Nsrc + scn;
    f32x4 v[8];
#pragma unroll
    for (int i = 0; i < 8; ++i) v[i] = *(const f32x4*)(wp + (size_t)(8 * i) * Nsrc);
#pragma unroll
    for (int i = 0; i < 8; ++i) { LAS float* d = scr + (8 * i + kr) * 33 + 4 * nq; d[0] = v[i][0]; d[1] = v[i][1]; d[2] = v[i][2]; d[3] = v[i][3]; }
    asm volatile("s_waitcnt lgkmcnt(0)" ::: "memory");
    const int c = lane & 7;
#pragma unroll
    for (int j = 0; j < 4; ++j) { const int nn = (lane >> 3) + 8 * j; const LAS float* s = scr + (8 * c) * 33 + nn;
        u32x4 o; o.x = pk2(s[0 * 33], s[1 * 33]); o.y = pk2(s[2 * 33], s[3 * 33]); o.z = pk2(s[4 * 33], s[5 * 33]); o.w = pk2(s[6 * 33], s[7 * 33]);
        *(u32x4*)(WT + (size_t)(n0 + nn) * Kdst + k0 + 8 * c) = o; }
    asm volatile("s_waitcnt lgkmcnt(0)" ::: "memory");
}
__device__ __forceinline__ float silu_f(float x) { return x / (1.0f + __expf(-x)); }

__device__ __forceinline__ void gu_convert(Frame& F, const int it0, const int nit, const int vb, const int nvb, const bool down = false) {
    const Params& P = *F.p; unsigned char* ws = F.ws;
    LAS float* scr = (LAS float*)(F.reg + F.wave * 8704);
    const float* WGU = gp(P.in[down ? I_MOE_WDN : I_MOE_WGU]); signed char* W8 = (signed char*)(ws + (down ? WS_W_DN : WS_W_GU)); float* SWt = (float*)(ws + (down ? WS_SWD : WS_SW));
    const int LG = down ? 5 : 6, NN = down ? 1024 : 2048, KIND = down ? PK_ID : PK_MOE_GU, NBM = (1 << LG) - 1;
    LAS float* red = (LAS float*)(F.reg + 120 * 1024);
    const int NIT = it0 + nit; const int w = F.wave, lane = F.lane, nq = lane & 7;
    f32x4 va0[8], va1[8], vb0[8], vb1[8]; int sca = 0, scb = 0;
#define GU_LOAD(V0, V1, IT, SC) do { const float* W_ = WGU + (size_t)((IT) >> LG) * 1024 * NN; tr4_load(V0, W_, NN, NN, KIND, ((2 * w) << LG) + ((IT) & NBM), lane, SC); tr4_load(V1, W_, NN, NN, KIND, ((2 * w + 1) << LG) + ((IT) & NBM), lane, SC); } while (0)
#define GU_PROC(V0, V1, IT, SC) do { f32x4 m_ = (f32x4){0.f, 0.f, 0.f, 0.f}; \
    _Pragma("unroll") for (int i_ = 0; i_ < 8; ++i_) _Pragma("unroll") for (int c_ = 0; c_ < 4; ++c_) m_[c_] = fmaxf(m_[c_], fmaxf(fabsf(V0[i_][c_]), fabsf(V1[i_][c_]))); \
    _Pragma("unroll") for (int c_ = 0; c_ < 4; ++c_) {   \
        m_[c_] = fmaxf(m_[c_], __uint_as_float(__builtin_amdgcn_ds_swizzle(__float_as_uint(m_[c_]), (8 << 10) | 0x1f))); \
        m_[c_] = fmaxf(m_[c_], __uint_as_float(__builtin_amdgcn_ds_swizzle(__float_as_uint(m_[c_]), (16 << 10) | 0x1f))); \
        auto rr_ = __builtin_amdgcn_permlane32_swap(__float_as_uint(m_[c_]), __float_as_uint(m_[c_]), false, false); m_[c_] = fmaxf(__uint_as_float(rr_[0]), __uint_as_float(rr_[1])); } \
    if (lane < 8) *(LAS f32x4*)(red + w * 32 + 4 * lane) = m_; \
    __syncthreads(); \
    f32x4 cm_ = *(const LAS f32x4*)(red + 4 * nq); \
    _Pragma("unroll") for (int w2_ = 1; w2_ < 8; ++w2_) { const f32x4 t_ = *(const LAS f32x4*)(red + w2_ * 32 + 4 * nq); _Pragma("unroll") for (int c_ = 0; c_ < 4; ++c_) cm_[c_] = fmaxf(cm_[c_], t_[c_]); } \
    _Pragma("unroll") for (int c_ = 0; c_ < 4; ++c_) cm_[c_] = fmaxf(cm_[c_], 1e-30f); \
    const f32x4 inv_ = (f32x4){127.0f / cm_[0], 127.0f / cm_[1], 127.0f / cm_[2], 127.0f / cm_[3]}; \
    if (w == 0 && lane < 8) *(f32x4*)(SWt + (size_t)((IT) >> LG) * NN + (SC)) = cm_ * (1.0f / 127.0f); \
    signed char* D_ = W8 + (size_t)((IT) >> LG) * 1024 * NN; \
    tr4_store_inv(V0, D_, 1024, NN, inv_, scr, ((2 * w) << LG) + ((IT) & NBM), lane); tr4_store_inv(V1, D_, 1024, NN, inv_, scr, ((2 * w + 1) << LG) + ((IT) & NBM), lane); \
    __syncthreads(); } while (0)
    int it = it0 + vb;
    if (it < NIT) GU_LOAD(va0, va1, it, sca);
#pragma unroll 1
    for (; it < NIT; it += 2 * nvb) {
        const int it1 = it + nvb, it2 = it + 2 * nvb;
        if (it1 < NIT) GU_LOAD(vb0, vb1, it1, scb);
        GU_PROC(va0, va1, it, sca);
        if (it2 < NIT) GU_LOAD(va0, va1, it2, sca);
        if (it1 < NIT) GU_PROC(vb0, vb1, it1, scb);
    }
#undef GU_LOAD
#undef GU_PROC
}
__device__ __forceinline__ void phase_actq(Frame& F) {
    unsigned char* ws = F.ws; const bf16_t* ACT = (const bf16_t*)(ws + MO_ACT); signed char* A8 = (signed char*)(ws + MO_ACT8); float* SA2 = (float*)(ws + MO_SA2);
    const int rows = F.misc[64 + 32], lane = F.lane; constexpr int STEP = GRID * 8 * 8;
    u32x4 va[8][2], vb[8][2];
#define AQ_LOAD(V, R0) do { _Pragma("unroll") for (int i_ = 0; i_ < 8; ++i_) { const bf16_t* rp_ = ACT + (size_t)((R0) + i_) * 1024 + 16 * lane; V[i_][0] = *(const u32x4*)rp_; V[i_][1] = *(const u32x4*)(rp_ + 8); } } while (0)
#define AQ_SWZ(M_) m_ = max(m_, (unsigned)__builtin_amdgcn_ds_swizzle((int)m_, ((M_) << 10) | 0x1f))
#define AQ_PROC(V, R0) do { _Pragma("unroll") for (int i_ = 0; i_ < 8; ++i_) { \
          \
        unsigned lo_ = 0u, hi_ = 0u; \
        _Pragma("unroll") for (int h_ = 0; h_ < 2; ++h_) { const u32x4 x_ = V[i_][h_]; lo_ = max(max(lo_, x_.x & 0x7fffu), max(x_.y & 0x7fffu, max(x_.z & 0x7fffu, x_.w & 0x7fffu))); hi_ = max(max(hi_, x_.x & 0x7fff0000u), max(x_.y & 0x7fff0000u, max(x_.z & 0x7fff0000u, x_.w & 0x7fff0000u))); } \
        unsigned m_ = max(lo_ << 16, hi_); AQ_SWZ(1); AQ_SWZ(2); AQ_SWZ(4); AQ_SWZ(8); AQ_SWZ(16); { auto rr_ = __builtin_amdgcn_permlane32_swap(m_, m_, false, false); m_ = max(rr_[0], rr_[1]); } \
        const float mx_ = fmaxf(__uint_as_float(m_), 1e-30f), inv_ = 127.0f * __builtin_amdgcn_rcpf(mx_); u32x4 o_; \
        _Pragma("unroll") for (int h_ = 0; h_ < 2; ++h_) { const u32x4 x_ = V[i_][h_];   \
            const unsigned f0_ = __float_as_uint(fmaf(bflo(x_.x), inv_, 12582912.0f)), f1_ = __float_as_uint(fmaf(bfhi(x_.x), inv_, 12582912.0f)), f2_ = __float_as_uint(fmaf(bflo(x_.y), inv_, 12582912.0f)), f3_ = __float_as_uint(fmaf(bfhi(x_.y), inv_, 12582912.0f)); \
            const unsigned f4_ = __float_as_uint(fmaf(bflo(x_.z), inv_, 12582912.0f)), f5_ = __float_as_uint(fmaf(bfhi(x_.z), inv_, 12582912.0f)), f6_ = __float_as_uint(fmaf(bflo(x_.w), inv_, 12582912.0f)), f7_ = __float_as_uint(fmaf(bfhi(x_.w), inv_, 12582912.0f)); \
            const unsigned w0_ = __builtin_amdgcn_perm(f1_, f0_, 0x0c0c0400u) | __builtin_amdgcn_perm(f3_, f2_, 0x04000c0cu), w1_ = __builtin_amdgcn_perm(f5_, f4_, 0x0c0c0400u) | __builtin_amdgcn_perm(f7_, f6_, 0x04000c0cu); \
            if (h_ == 0) { o_.x = w0_; o_.y = w1_; } else { o_.z = w0_; o_.w = w1_; } } \
        *(u32x4*)(A8 + (size_t)((R0) + i_) * 1024 + 16 * lane) = o_; \
        if (lane == 0) SA2[(R0) + i_] = mx_ * (1.0f / 127.0f); } } while (0)
    int r0 = (blockIdx.x * 8 + F.wave) * 8;
    if (r0 < rows) AQ_LOAD(va, r0);
#pragma unroll 1
    for (; r0 < rows; r0 += 2 * STEP) {
        const int r1 = r0 + STEP, r2 = r0 + 2 * STEP;
        if (r1 < rows) AQ_LOAD(vb, r1);
        AQ_PROC(va, r0);
        if (r2 < rows) AQ_LOAD(va, r2);
        if (r1 < rows) AQ_PROC(vb, r1);
    }
#undef AQ_LOAD
#undef AQ_SWZ
#undef AQ_PROC
}
__device__ __forceinline__ void phase_prologue(Frame& F, const XcdBarrier& bar) {
    const Params& P = *F.p; unsigned char* ws = F.ws;
    const int gw = blockIdx.x * 8 + F.wave, NGW = GRID * 8, gt = blockIdx.x * NTHR + F.tid, NGT = GRID * NTHR;
    {
        unsigned* RAWGU = (unsigned*)(ws + WS_RAWGU); unsigned* RAWP = (unsigned*)(ws + WS_RAWP);
#define MAX_JOB(W_, Ksrc_, Nsrc_, RAW_, COUNT_, IT0_) do { constexpr int ns_ = ((Nsrc_) + 255) / 256, nr_ = (Ksrc_) / 128, per_ = ns_ * nr_; \
        _Pragma("unroll 1") for (int it_ = gw - (IT0_); it_ < per_ * (COUNT_); it_ += NGW) { if (it_ < 0) continue; const int mi_ = it_ / per_, r_ = it_ % per_, st_ = r_ / nr_, rb_ = r_ % nr_, c_ = st_ * 256 + 4 * F.lane; \
            if (c_ < (Nsrc_)) { const float* w_ = (W_) + (size_t)mi_ * (Ksrc_) * (Nsrc_) + (size_t)(rb_ * 128) * (Nsrc_) + c_; f32x4 m_ = (f32x4){0.f, 0.f, 0.f, 0.f}; \
                _Pragma("unroll 16") for (int k_ = 0; k_ < 128; ++k_) { const f32x4 v_ = *(const f32x4*)(w_ + (size_t)k_ * (Nsrc_)); m_[0] = fmaxf(m_[0], fabsf(v_[0])); m_[1] = fmaxf(m_[1], fabsf(v_[1])); m_[2] = fmaxf(m_[2], fabsf(v_[2])); m_[3] = fmaxf(m_[3], fabsf(v_[3])); } \
                unsigned* d_ = (RAW_) + (size_t)mi_ * (Nsrc_) + c_; atomicMax(d_, __float_as_uint(m_[0])); atomicMax(d_ + 1, __float_as_uint(m_[1])); atomicMax(d_ + 2, __float_as_uint(m_[2])); atomicMax(d_ + 3, __float_as_uint(m_[3])); } } } while (0)
        MAX_JOB(gp(P.in[I_DA_WIN]), 1024, 3072, RAWP + RAW_DA, 2, 0);
        MAX_JOB(gp(P.in[I_RET_WIN]), 1024, 6144, RAWP + RAW_RET, 1, 192);
        MAX_JOB(gp(P.in[I_MLA_WIN]), 1024, 448, RAWP + RAW_MLA, 1, 384);
        MAX_JOB(gp(P.in[I_RET_WOUT]), 2048, 1024, RAWP + RAW_RETO, 1, 400);
#undef MAX_JOB
    }
    LAS float* sc = (LAS float*)(F.reg + 72 * 1024);
    for (int i = F.tid; i < 9 * 1024; i += NTHR) { const int r = i >> 10, k = i & 1023; const float v = r < 8 ? gp(P.in[I_C])[r * 1024 + k] : gp(P.in[I_CCTX])[k]; sc[i] = silu_f(v); }
    __syncthreads();
    {
        float* MOD = (float*)(ws + WS_MOD); LAS float* red = (LAS float*)(F.reg + 110 * 1024);
        for (int u = blockIdx.x; u < 4 * 96; u += GRID) { const int L = u / 96, n = (u % 96) * 64 + F.lane; const float* W = gp(P.in[I_ADAW]) + (size_t)L * 1024 * 6144 + (size_t)(128 * F.wave) * 6144 + n;
            float a[9];
#pragma unroll
            for (int r = 0; r < 9; ++r) a[r] = 0.f;
#pragma unroll 16
            for (int k = 0; k < 128; ++k) { const float w = W[(size_t)k * 6144];
#pragma unroll
                for (int r = 0; r < 9; ++r) a[r] = fmaf(sc[r * 1024 + 128 * F.wave + k], w, a[r]); }
#pragma unroll
            for (int r = 0; r < 9; ++r) red[(F.wave * 9 + r) * 64 + F.lane] = a[r];
            __syncthreads();
            for (int i = F.tid; i < 9 * 64; i += NTHR) { const int r = i >> 6, c = i & 63; float s = gp(P.in[I_ADAB])[L * 6144 + (u % 96) * 64 + c];
#pragma unroll
                for (int w8 = 0; w8 < 8; ++w8) s += red[(w8 * 9 + r) * 64 + c];
                MOD[((size_t)L * 9 + r) * 6144 + (u % 96) * 64 + c] = s; }
            __syncthreads(); }
    }
    {
        f32x2* TA = (f32x2*)(ws + WS_TABA); f32x2* TR = (f32x2*)(ws + WS_TABR);
        for (int i = gt; i < 128 * 16; i += NGT) { const int pos = i >> 4, j = i & 15; const float inv = powf(10000.0f, -(float)(2 * j) / 32.0f), a = (float)pos * inv; float s, c; sincosf(a, &s, &c); TA[i] = (f32x2){c, s}; }
        for (int i = gt; i < 8192 * 128; i += NGT) { const int pos = i >> 7, j = i & 127; const float inv = powf(10000.0f, -(float)(2 * j) / 256.0f), a = (float)pos * inv; float s, c; sincosf(a, &s, &c); TR[i] = (f32x2){c, s}; }
    }
    {
        LAS float* scr = (LAS float*)(F.reg + F.wave * 8704);
#define TR_JOB(W_, Ksrc_, Nsrc_, DST_, Kdst_, Ndst_, Nvalid_, KIND_, COUNT_) do { const int per_ = ((Kdst_) / 64) * ((Ndst_) / 32), total_ = per_ * (COUNT_); \
        _Pragma("unroll 1") for (int it_ = gw; it_ < total_; it_ += NGW) { const int mi_ = it_ / per_, item_ = it_ % per_; \
            if (((KIND_) == PK_ID || (KIND_) == PK_MOE_GU) && (Ksrc_) == (Kdst_) && (Nvalid_) == (Ndst_)) tr_item4((W_) + (size_t)mi_ * (Ksrc_) * (Nsrc_), Nsrc_, (bf16_t*)(ws + (DST_)) + (size_t)mi_ * (Kdst_) * (Ndst_), Kdst_, Ndst_, KIND_, scr, item_, F.lane); \
            else tr_item((W_) + (size_t)mi_ * (Ksrc_) * (Nsrc_), Ksrc_, Nsrc_, (bf16_t*)(ws + (DST_)) + (size_t)mi_ * (Kdst_) * (Ndst_), Kdst_, Ndst_, Nvalid_, KIND_, scr, item_, F.lane); } } while (0)
        TR_JOB(gp(P.in[I_DA_WOUT]), 1024, 1024, WS_W_DA_OUT, 1024, 1024, 1024, PK_ID, 2);
        {
            const float* Wq = gp(P.in[I_MLA_WQUP]); const float* Wkv = gp(P.in[I_MLA_WKVUP]); const float* Wo = gp(P.in[I_MLA_WOUT]);
            bf16_t* WQ = (bf16_t*)(ws + WS_W_MLA_QUP); bf16_t* WO = (bf16_t*)(ws + WS_W_MLA_OUT);
#pragma unroll 1
            for (int it = gw; it < 64; it += NGW) tr_item(Wq, 256, 1536, WQ, 256, 1536, 1536, PK_MLA_QUP, scr, (it >> 4) * 48 + 32 + (it & 15), F.lane);
#pragma unroll 1
            for (int it = gw; it < 2048; it += NGW) { const int kq = it & 3, c = 2 * ((it >> 2) & 63), h = it >> 8;
                const float* aq = Wq + (size_t)(kq * 64 + F.lane) * 1536 + h * 192; const float* b0 = Wkv + (size_t)c * 2048 + h * 256; const float* b1 = b0 + 2048;
                float r0 = 0.f, r1 = 0.f;
#pragma unroll 8
                for (int d4 = 0; d4 < 32; ++d4) { const f32x4 av = *(const f32x4*)(aq + 4 * d4), x = *(const f32x4*)(b0 + 4 * d4), y = *(const f32x4*)(b1 + 4 * d4);
                    r0 += (av[0] * x[0] + av[1] * x[1]) + (av[2] * x[2] + av[3] * x[3]); r1 += (av[0] * y[0] + av[1] * y[1]) + (av[2] * y[2] + av[3] * y[3]); }
                WQ[(size_t)(h * 128 + c) * 256 + kq * 64 + F.lane] = f2bf(r0); WQ[(size_t)(h * 128 + c + 1) * 256 + kq * 64 + F.lane] = f2bf(r1); }
#pragma unroll 1
            for (int it = gw; it < 2048; it += NGW) { const int nch = it & 15, l0 = 8 * ((it >> 4) & 15), h = it >> 8, n = nch * 64 + F.lane;
                const float* wo = Wo + (size_t)(h * 128) * 1024 + n; const float* wk = Wkv + (size_t)l0 * 2048 + h * 256 + 128;
                float a0 = 0.f, a1 = 0.f, a2 = 0.f, a3 = 0.f, a4 = 0.f, a5 = 0.f, a6 = 0.f, a7 = 0.f;
#pragma unroll 8
                for (int d = 0; d < 128; ++d) { const float w = wo[(size_t)d * 1024];
                    a0 = fmaf(wk[d], w, a0); a1 = fmaf(wk[2048 + d], w, a1); a2 = fmaf(wk[4096 + d], w, a2); a3 = fmaf(wk[6144 + d], w, a3);
                    a4 = fmaf(wk[8192 + d], w, a4); a5 = fmaf(wk[10240 + d], w, a5); a6 = fmaf(wk[12288 + d], w, a6); a7 = fmaf(wk[14336 + d], w, a7); }
                u32x4 o; o.x = pk2(a0, a1); o.y = pk2(a2, a3); o.z = pk2(a4, a5); o.w = pk2(a6, a7); *(u32x4*)(WO + (size_t)n * 1024 + h * 128 + l0) = o; }
        }
        gu_convert(F, 0, 128 * 32, (int)blockIdx.x, GRID, true);
#undef TR_JOB
        if (!MK_MULTI) xcd_barrier(bar);
        {
            float* SW = (float*)(ws + WS_SW); float* SWP = (float*)(ws + WS_SWP); const unsigned* RG = (const unsigned*)(ws + WS_RAWGU); const unsigned* RP = (const unsigned*)(ws + WS_RAWP);
            for (int i = gt; i < (int)SWP_N; i += NGT) { float m;
                if (i < (int)SWP_RET) { const int mi = i / 3072, n = i % 3072; m = __uint_as_float(RP[RAW_DA + mi * 3072 + src_col(n, PK_DA_IN)]); }
                else if (i < (int)SWP_MLA) m = __uint_as_float(RP[RAW_RET + src_col(i - (int)SWP_RET, PK_RET_IN)]);
                else if (i < (int)SWP_RETO) { const int n = i - (int)SWP_MLA; m = n < 448 ? __uint_as_float(RP[RAW_MLA + n]) : 0.f; }
                else m = __uint_as_float(RP[RAW_RETO + i - (int)SWP_RETO]);
                SWP[i] = fmaxf(m, 1e-30f) * (1.0f / 127.0f); }
        }
#define TRQ_JOB(W_, Ksrc_, Nsrc_, DST_, Kdst_, Ndst_, Nvalid_, KIND_, COUNT_, OFF_) do { const int per_ = ((Kdst_) / 64) * ((Ndst_) / 32), total_ = per_ * (COUNT_); \
        _Pragma("unroll 1") for (int it_ = gw; it_ < total_; it_ += NGW) { const int mi_ = it_ / per_, item_ = it_ % per_; \
            tr_itemq((W_) + (size_t)mi_ * (Ksrc_) * (Nsrc_), Ksrc_, Nsrc_, (signed char*)(ws + (DST_)) + (size_t)mi_ * (Kdst_) * (Ndst_), Kdst_, Ndst_, Nvalid_, KIND_, (const unsigned*)(ws + WS_RAWP) + (OFF_) + (size_t)mi_ * (Nsrc_), scr, item_, F.lane); } } while (0)
        TRQ_JOB(gp(P.in[I_DA_WIN]), 1024, 3072, WS_W_DA_IN, 1024, 3072, 3072, PK_DA_IN, 2, RAW_DA);
        TRQ_JOB(gp(P.in[I_RET_WIN]), 1024, 6144, WS_W_RET_IN, 1024, 6144, 6144, PK_RET_IN, 1, RAW_RET);
        TRQ_JOB(gp(P.in[I_RET_WOUT]), 2048, 1024, WS_W_RET_OUT, 2048, 1024, 1024, PK_ID, 1, RAW_RETO);
        TRQ_JOB(gp(P.in[I_MLA_WIN]), 1024, 448, WS_W_MLA_IN, 1024, 512, 448, PK_ID, 1, RAW_MLA);
#undef TRQ_JOB
        gu_convert(F, 0, 32 * 64, (int)blockIdx.x, GRID);
    }
}

template <int L, int LC = L - 1>
__device__ __forceinline__ void phase_norm1(Frame& F) {
    const Params& P = *F.p; unsigned char* ws = F.ws;
    bf16_t* XR = (bf16_t*)(ws + WS_XRES); const float* MOD = (const float*)(ws + WS_MOD);
    const int* SLOT = (const int*)(ws + WS_SLOT); const float* GATE = (const float*)(ws + WS_GATE); const signed char* OUT8 = (const signed char*)(ws + MO_OUT); const float* OUTS = (const float*)(ws + MO_OUTS);
    const float* gain = L < 4 ? gp(P.in[I_NORMG]) + (size_t)(L * 2 + 0) * 1024 : gp(P.in[I_FINALG]);
    f32x4 gn[4];
#pragma unroll
    for (int j = 0; j < 4; ++j) gn[j] = *(const f32x4*)(gain + 4 * F.lane + 256 * j);
#pragma unroll 3
    for (int i = 0; i < TOK_PER_BLK / 8; ++i) {
        const int t = blockIdx.x * TOK_PER_BLK + F.wave + 8 * i; const int b = t / TB, jt = t % TB; const bool isctx = jt < CTX; const int mrow = isctx ? 8 : b;
        if (L == 4 && isctx) continue;
        f32x4 v[4]; bf16_t* xr = XR + (size_t)t * 1024 + 4 * F.lane;
        if (L == 0) { const float* xsrc = (isctx ? gp(P.in[I_CTX]) + ((size_t)b * CTX + jt) * 1024 : gp(P.in[I_X]) + ((size_t)b * SEQ + (jt - CTX)) * 1024) + 4 * F.lane;
#pragma unroll
            for (int j = 0; j < 4; ++j) { v[j] = *(const f32x4*)(xsrc + 256 * j); st4bf(xr + 256 * j, v[j]); }
        } else {
#pragma unroll
            for (int j = 0; j < 4; ++j) v[j] = ld4bf(xr + 256 * j); }
        if (LC >= 0) {
            const int4 sl = *(const int4*)(SLOT + (size_t)t * 4); const f32x4 gt = *(const f32x4*)(GATE + (size_t)t * 4);
            const int sls[4] = {sl.x, sl.y, sl.z, sl.w};
            f32x4 a[4];
#pragma unroll
            for (int j = 0; j < 4; ++j) a[j] = (f32x4){0.f, 0.f, 0.f, 0.f};
#pragma unroll
            for (int k = 0; k < 4; ++k) { const signed char* orow = OUT8 + (size_t)sls[k] * 1024 + 4 * F.lane; const float* srow = OUTS + (size_t)sls[k] * 32 + (F.lane >> 3); const float gk = gt[k];
#pragma unroll
                for (int j = 0; j < 4; ++j) { const unsigned w = *(const unsigned*)(orow + 256 * j); const float sc = gk * srow[8 * j];
                    a[j] += sc * (f32x4){(float)(int)(signed char)(w & 0xffu), (float)(int)(signed char)((w >> 8) & 0xffu), (float)(int)(signed char)((w >> 16) & 0xffu), (float)((int)w >> 24)}; } }
            const float* m5 = MOD + ((size_t)(LC < 0 ? 0 : LC) * 9 + mrow) * 6144 + 5 * 1024 + 4 * F.lane;
#pragma unroll
            for (int j = 0; j < 4; ++j) { v[j] += *(const f32x4*)(m5 + 256 * j) * a[j]; if (L < 4) st4bf(xr + 256 * j, v[j]); }
        }
#ifdef DBG_NANFIX
        if (L == 4) {
#pragma unroll
            for (int j = 0; j < 4; ++j)
#pragma unroll
                for (int e = 0; e < 4; ++e) if (!(fabsf(v[j][e]) < 1e30f)) v[j][e] = 1000.0f; }
#endif
        float ss = 0.f;
#pragma unroll
        for (int j = 0; j < 4; ++j) ss += (v[j][0] * v[j][0] + v[j][1] * v[j][1]) + (v[j][2] * v[j][2] + v[j][3] * v[j][3]);
        const float rstd = rsqrtf(wave_sum(ss) * (1.0f / 1024.0f) + RMS_EPS);
        if (L < 4) {
            const float* msh = MOD + ((size_t)L * 9 + mrow) * 6144 + 4 * F.lane; f32x4 y[4]; float am = 0.f;
#pragma unroll
            for (int j = 0; j < 4; ++j) { const f32x4 sh = *(const f32x4*)(msh + 256 * j), scl = *(const f32x4*)(msh + 1024 + 256 * j);
                y[j] = v[j] * rstd * gn[j] * (scl + 1.0f) + sh; am = fmaxf(fmaxf(am, fmaxf(fabsf(y[j][0]), fabsf(y[j][1]))), fmaxf(fabsf(y[j][2]), fabsf(y[j][3]))); }
#pragma unroll
            for (int o = 1; o < 64; o <<= 1) am = fmaxf(am, __shfl_xor(am, o));
            am = fmaxf(am, 1e-30f); const float qinv = 127.0f / am; signed char* hq = (signed char*)(ws + WS_HQ1) + (size_t)t * 1024 + 4 * F.lane;
#pragma unroll
            for (int j = 0; j < 4; ++j) { const int q0 = (int)rintf(y[j][0] * qinv), q1 = (int)rintf(y[j][1] * qinv), q2 = (int)rintf(y[j][2] * qinv), q3 = (int)rintf(y[j][3] * qinv);
                *(unsigned*)(hq + 256 * j) = ((unsigned)q0 & 0xffu) | (((unsigned)q1 & 0xffu) << 8) | (((unsigned)q2 & 0xffu) << 16) | (((unsigned)q3 & 0xffu) << 24); }
            if (F.lane == 0) ((float*)(ws + WS_SA1))[t] = am * (1.0f / 127.0f);
        } else {
            float* orow = gp(P.out) + ((size_t)b * SEQ + (jt - CTX)) * 1024 + 4 * F.lane;
#pragma unroll
            for (int j = 0; j < 4; ++j) *(f32x4*)(orow + 256 * j) = v[j] * rstd * gn[j];
        }
    }
}

template <int L>
__device__ __forceinline__ void phase_norm2(Frame& F) {
    const Params& P = *F.p; unsigned char* ws = F.ws;
    const bf16_t* XR = (const bf16_t*)(ws + WS_XRES); const float* MOD = (const float*)(ws + WS_MOD);
    int* IDX = (int*)(ws + WS_IDX); float* GATE = (float*)(ws + WS_GATE); int* RANK = (int*)(ws + WS_RANK); int* BLKCNT = (int*)(ws + WS_BLKCNT);
    const float* gain = gp(P.in[I_NORMG]) + (size_t)(L * 2 + 1) * 1024; const float* Wr = gp(P.in[I_MOE_WR]) + (size_t)L * 1024 * 32; const float* br = gp(P.in[I_MOE_BR]) + L * 32;
    constexpr int HS_ = 1028;
    LAS float* hf = (LAS float*)F.reg;
    LAS float* part = (LAS float*)(F.reg + 16 * HS_ * 4);
    LAS int* lcnt = (LAS int*)(F.reg + 16 * HS_ * 4 + 8 * 16 * 32 * 4);
    if (F.tid < 32) lcnt[F.tid] = 0;
    const int w = F.wave, l15 = F.lane & 15, g = F.lane >> 4;
    float wb[2][32];
#pragma unroll
    for (int ks = 0; ks < 32; ++ks)
#pragma unroll
        for (int nt = 0; nt < 2; ++nt) wb[nt][ks] = Wr[(size_t)(128 * w + 4 * ks + g) * 32 + 16 * nt + l15];
    f32x4 gn[4];
#pragma unroll
    for (int j = 0; j < 4; ++j) gn[j] = *(const f32x4*)(gain + 4 * F.lane + 256 * j);
    const float bre = br[F.lane & 31];
    __syncthreads();
    constexpr int NIT = (TOK_PER_BLK + 15) / 16;
#pragma unroll 1
    for (int i = 0; i < NIT; ++i) {
        const int tl0 = 16 * i;
#pragma unroll
        for (int rr = 0; rr < 2; ++rr) {
            const int tl = tl0 + 2 * w + rr;
            if (tl < TOK_PER_BLK) {
                const int t = blockIdx.x * TOK_PER_BLK + tl; const int b = t / TB, jt = t % TB; const int mrow = jt < CTX ? 8 : b;
                if (L == 3 && jt < CTX) continue;
                f32x4 v[4]; const bf16_t* xr = XR + (size_t)t * 1024 + 4 * F.lane;
#pragma unroll
                for (int j = 0; j < 4; ++j) v[j] = ld4bf(xr + 256 * j);
                float ss = 0.f;
#pragma unroll
                for (int j = 0; j < 4; ++j) ss += (v[j][0] * v[j][0] + v[j][1] * v[j][1]) + (v[j][2] * v[j][2] + v[j][3] * v[j][3]);
                const float rstd = rsqrtf(wave_sum(ss) * (1.0f / 1024.0f) + RMS_EPS);
                const float* msh = MOD + ((size_t)L * 9 + mrow) * 6144 + 3 * 1024 + 4 * F.lane; f32x4 y[4]; float am = 0.f;
#pragma unroll
                for (int j = 0; j < 4; ++j) { const f32x4 sh = *(const f32x4*)(msh + 256 * j), scl = *(const f32x4*)(msh + 1024 + 256 * j);
                    y[j] = v[j] * rstd * gn[j] * (scl + 1.0f) + sh; am = fmaxf(fmaxf(am, fmaxf(fabsf(y[j][0]), fabsf(y[j][1]))), fmaxf(fabsf(y[j][2]), fabsf(y[j][3])));
                    *(LAS f32x4*)(hf + (2 * w + rr) * HS_ + 4 * F.lane + 256 * j) = y[j]; }
#pragma unroll
                for (int o = 1; o < 64; o <<= 1) am = fmaxf(am, __shfl_xor(am, o));
                am = fmaxf(am, 1e-30f); const float qinv = 127.0f / am; signed char* hq = (signed char*)(ws + MO_HQ) + (size_t)t * 1024 + 4 * F.lane;
#pragma unroll
                for (int j = 0; j < 4; ++j) { const int q0 = (int)rintf(y[j][0] * qinv), q1 = (int)rintf(y[j][1] * qinv), q2 = (int)rintf(y[j][2] * qinv), q3 = (int)rintf(y[j][3] * qinv);
                    *(unsigned*)(hq + 256 * j) = ((unsigned)q0 & 0xffu) | (((unsigned)q1 & 0xffu) << 8) | (((unsigned)q2 & 0xffu) << 16) | (((unsigned)q3 & 0xffu) << 24); }
                if (F.lane == 0) ((float*)(ws + MO_SA))[t] = am * (1.0f / 127.0f);
            }
        }
        __syncthreads();
        {
            f32x4 a0 = (f32x4){0.f, 0.f, 0.f, 0.f}, a1 = a0; const LAS float* hp = hf + l15 * HS_ + 128 * w + g;
#pragma unroll
            for (int ks = 0; ks < 32; ++ks) { const float av = hp[4 * ks];
                a0 = __builtin_amdgcn_mfma_f32_16x16x4f32(av, wb[0][ks], a0, 0, 0, 0); a1 = __builtin_amdgcn_mfma_f32_16x16x4f32(av, wb[1][ks], a1, 0, 0, 0); }
#pragma unroll
            for (int r = 0; r < 4; ++r) { part[(w * 16 + 4 * g + r) * 32 + l15] = a0[r]; part[(w * 16 + 4 * g + r) * 32 + 16 + l15] = a1[r]; }
        }
        __syncthreads();
        {
            const int tok = F.tid >> 5, e = F.tid & 31; float v = bre;
#pragma unroll
            for (int ww = 0; ww < 8; ++ww) v += part[(ww * 16 + tok) * 32 + e];
            int id[4]; float lv[4];
#pragma unroll
            for (int k = 0; k < 4; ++k) { float bv = v; int bi = e;
#pragma unroll
                for (int m = 16; m >= 1; m >>= 1) { const float ov = __shfl_xor(bv, m, 32); const int oi = __shfl_xor(bi, m, 32); if (ov > bv || (ov == bv && oi < bi)) { bv = ov; bi = oi; } }
                id[k] = bi; lv[k] = bv; if (e == bi) v = -3.0e38f; }
            const int tl = tl0 + tok;
            if (e == 0 && tl < TOK_PER_BLK && !(L == 3 && (blockIdx.x * TOK_PER_BLK + tl) % TB < CTX)) {
                const int t = blockIdx.x * TOK_PER_BLK + tl;
                float ex[4], s = 0.f;
#pragma unroll
                for (int k = 0; k < 4; ++k) { ex[k] = __expf(lv[k] - lv[0]); s += ex[k]; }
                const float inv = 1.0f / s; int rk[4];
#pragma unroll
                for (int k = 0; k < 4; ++k) rk[k] = atomicAdd((int*)(lcnt + id[k]), 1);
                *(int4*)(IDX + (size_t)t * 4) = make_int4(id[0], id[1], id[2], id[3]);
                *(f32x4*)(GATE + (size_t)t * 4) = (f32x4){ex[0] * inv, ex[1] * inv, ex[2] * inv, ex[3] * inv};
                *(int4*)(RANK + (size_t)t * 4) = make_int4(rk[0], rk[1], rk[2], rk[3]);
            }
        }
    }
    __syncthreads();
    if (F.tid < 32) BLKCNT[blockIdx.x * 32 + F.tid] = lcnt[F.tid];
}

__device__ __forceinline__ void moe_offsets(Frame& F) {
    const int* BLKCNT = (const int*)(F.ws + WS_BLKCNT);
    __syncthreads();
    if (F.tid < 32) { int tot = 0, pre = 0;
        for (int b = 0; b < GRID; ++b) { const int c = BLKCNT[b * 32 + F.tid]; pre += (b < (int)blockIdx.x) ? c : 0; tot += c; }
        F.misc[128 + F.tid] = pre; F.misc[160 + F.tid] = (tot + 255) & ~255; F.misc[192 + F.tid] = tot; }
    __syncthreads();
    if (F.tid == 0) { int s = 0; for (int e = 0; e < 32; ++e) { F.misc[64 + e] = s; s += F.misc[160 + e]; } F.misc[64 + 32] = s; }
    __syncthreads();
    { volatile LAS unsigned char* texp = (volatile LAS unsigned char*)F.misc + 1024; const int nt_ = F.misc[64 + 32] >> 8;
      for (int tl = F.tid; tl < nt_; tl += NTHR) { const int r0 = tl * 256; int e = 0; for (int k = 1; k < NEXP; ++k) e += (F.misc[64 + k] <= r0) ? 1 : 0; texp[tl] = (unsigned char)e; } }
    __syncthreads();
}
template <int L>
__device__ __forceinline__ void phase_scatter(Frame& F) {
    unsigned char* ws = F.ws;
    const int* IDX = (const int*)(ws + WS_IDX); const int* RANK = (const int*)(ws + WS_RANK); int* SLOT = (int*)(ws + WS_SLOT); int* TOKOF = (int*)(ws + WS_TOKOF);
    moe_offsets(F);
    for (int q = F.tid; q < TOK_PER_BLK * 4; q += NTHR) { const int t = blockIdx.x * TOK_PER_BLK + (q >> 2);
        if (L == 3 && t % TB < CTX) continue;
        const size_t gi = (size_t)blockIdx.x * TOK_PER_BLK * 4 + q; const int e = IDX[gi], r = RANK[gi]; const int slot = F.misc[64 + e] + F.misc[128 + e] + r;
        SLOT[gi] = slot; TOKOF[slot] = t; ((float*)(ws + MO_SASLOT))[slot] = ((const float*)(ws + MO_SA))[t]; }
    if (blockIdx.x < NEXP) { const int e = blockIdx.x; for (int s = F.misc[64 + e] + F.misc[192 + e] + F.tid; s < F.misc[64 + e + 1]; s += NTHR) { TOKOF[s] = 0; ((float*)(ws + MO_SASLOT))[s] = 0.f; } }
}

template <int L>
__device__ __forceinline__ void phase_da_post(Frame& F) {
    const Params& P = *F.p; unsigned char* ws = F.ws; constexpr int J = L / 3;
    const bf16_t* O = (const bf16_t*)(ws + DA_O); bf16_t* O2 = (bf16_t*)(ws + DA_O2);
    const float* lamv = gp(P.in[I_DA_LAM]) + J * 256; const float* subg = gp(P.in[I_DA_SUBG]) + J * 128;
    const float lam_init = L == 0 ? 0.2f : 0.8f - 0.6f * 0.40656965974059917f;
    const float d01 = wave_sum(lamv[F.lane] * lamv[64 + F.lane]), d23 = wave_sum(lamv[128 + F.lane] * lamv[192 + F.lane]);
    const float lam = expf(d01) - expf(d23) + lam_init;
    const int h = F.lane >> 3, ch = F.lane & 7; float g[16];
#pragma unroll
    for (int e = 0; e < 16; ++e) g[e] = subg[ch * 16 + e] * (1.0f - lam_init);
    for (int t = blockIdx.x * 8 + F.wave; t < T; t += GRID * 8) {
        if (L == 3 && t % TB < CTX) continue;
        const bf16_t* r0 = O + (size_t)t * 2048 + (2 * h) * 128 + ch * 16; const bf16_t* r1 = r0 + 128;
        const u32x4 a0 = *(const u32x4*)r0, a1 = *(const u32x4*)(r0 + 8), b0 = *(const u32x4*)r1, b1 = *(const u32x4*)(r1 + 8);
        float d[16]; const unsigned aw[8] = {a0.x, a0.y, a0.z, a0.w, a1.x, a1.y, a1.z, a1.w}, bw[8] = {b0.x, b0.y, b0.z, b0.w, b1.x, b1.y, b1.z, b1.w};
        float ss = 0.f;
#pragma unroll
        for (int e = 0; e < 8; ++e) { d[2 * e] = bflo(aw[e]) - lam * bflo(bw[e]); d[2 * e + 1] = bfhi(aw[e]) - lam * bfhi(bw[e]); ss += d[2 * e] * d[2 * e] + d[2 * e + 1] * d[2 * e + 1]; }
        ss += __shfl_xor(ss, 1); ss += __shfl_xor(ss, 2); ss += __shfl_xor(ss, 4);
        const float r = rsqrtf(ss * (1.0f / 128.0f) + RMS_EPS);
        u32x4 w0, w1;
        w0.x = pk2(d[0] * r * g[0], d[1] * r * g[1]); w0.y = pk2(d[2] * r * g[2], d[3] * r * g[3]); w0.z = pk2(d[4] * r * g[4], d[5] * r * g[5]); w0.w = pk2(d[6] * r * g[6], d[7] * r * g[7]);
        w1.x = pk2(d[8] * r * g[8], d[9] * r * g[9]); w1.y = pk2(d[10] * r * g[10], d[11] * r * g[11]); w1.z = pk2(d[12] * r * g[12], d[13] * r * g[13]); w1.w = pk2(d[14] * r * g[14], d[15] * r * g[15]);
        bf16_t* orow = O2 + (size_t)t * 1024 + h * 128 + ch * 16; *(u32x4*)orow = w0; *(u32x4*)(orow + 8) = w1;
    }
}

__device__ __forceinline__ void phase_ret_post(Frame& F) {
    unsigned char* ws = F.ws;
    const bf16_t* OF = (const bf16_t*)(ws + RT_OF); const bf16_t* OB = (const bf16_t*)(ws + RT_OB); const bf16_t* Gb = (const bf16_t*)(ws + RT_G); signed char* A = (signed char*)(ws + RT_A); float* SA = (float*)(ws + RT_SA);
    for (int t = blockIdx.x * 8 + F.wave; t < T; t += GRID * 8) {
        const size_t off = (size_t)t * 2048 + F.lane * 32; float o[32]; float ss = 0.f;
#pragma unroll
        for (int q = 0; q < 4; ++q) { const u32x4 a = *(const u32x4*)(OF + off + 8 * q), b = *(const u32x4*)(OB + off + 8 * q); const unsigned aw[4] = {a.x, a.y, a.z, a.w}, bw[4] = {b.x, b.y, b.z, b.w};
#pragma unroll
            for (int e = 0; e < 4; ++e) { const float x0 = bflo(aw[e]) + bflo(bw[e]), x1 = bfhi(aw[e]) + bfhi(bw[e]); o[8 * q + 2 * e] = x0; o[8 * q + 2 * e + 1] = x1; ss += x0 * x0 + x1 * x1; } }
        ss += __shfl_xor(ss, 1); ss += __shfl_xor(ss, 2); ss += __shfl_xor(ss, 4); ss += __shfl_xor(ss, 8);
        const float r = rsqrtf(ss * (1.0f / 512.0f) + RMS_EPS); float am = 0.f;
#pragma unroll
        for (int q = 0; q < 4; ++q) { const u32x4 gq = *(const u32x4*)(Gb + off + 8 * q); const unsigned gw[4] = {gq.x, gq.y, gq.z, gq.w};
#pragma unroll
            for (int e = 0; e < 4; ++e) { const float y0 = silu_f(bflo(gw[e])) * o[8 * q + 2 * e] * r, y1 = silu_f(bfhi(gw[e])) * o[8 * q + 2 * e + 1] * r; o[8 * q + 2 * e] = y0; o[8 * q + 2 * e + 1] = y1; am = fmaxf(am, fmaxf(fabsf(y0), fabsf(y1))); } }
#pragma unroll
        for (int m = 1; m < 64; m <<= 1) am = fmaxf(am, __shfl_xor(am, m));
        am = fmaxf(am, 1e-30f); const float qinv = 127.0f / am;
#pragma unroll
        for (int q = 0; q < 2; ++q) { unsigned w[4];
#pragma unroll
            for (int e = 0; e < 4; ++e) { const int b0 = 16 * q + 4 * e; w[e] = ((unsigned)(int)rintf(o[b0] * qinv) & 0xffu) | (((unsigned)(int)rintf(o[b0 + 1] * qinv) & 0xffu) << 8) | (((unsigned)(int)rintf(o[b0 + 2] * qinv) & 0xffu) << 16) | (((unsigned)(int)rintf(o[b0 + 3] * qinv) & 0xffu) << 24); }
            *(u32x4*)(A + off + 16 * q) = (u32x4){w[0], w[1], w[2], w[3]}; }
        if (F.lane == 0) SA[t] = am * (1.0f / 127.0f);
    }
}

__device__ __forceinline__ void phase_mla_norm(Frame& F) {
    const Params& P = *F.p; unsigned char* ws = F.ws;
    const float* Pm = (const float*)(ws + ML_P); bf16_t* AQ = (bf16_t*)(ws + ML_AQ); bf16_t* Kb = (bf16_t*)(ws + ML_K);
    const f32x2* TA = (const f32x2*)(ws + WS_TABA);
    const f32x2 gkv = *(const f32x2*)(gp(P.in[I_MLA_KVG]) + 2 * F.lane); const f32x4 gq = *(const f32x4*)(gp(P.in[I_MLA_QG]) + 4 * F.lane);
    for (int t = blockIdx.x * 8 + F.wave; t < T; t += GRID * 8) {
        const float* pr = Pm + (size_t)t * 512; const int jt = t % TB; const bool lat = jt >= CTX; const int p = jt - CTX;
        const f32x2 ckv = *(const f32x2*)(pr + 2 * F.lane); const f32x4 cq = *(const f32x4*)(pr + 192 + 4 * F.lane);
        const float rkv = rsqrtf(wave_sum(ckv[0] * ckv[0] + ckv[1] * ckv[1]) * (1.0f / 128.0f) + RMS_EPS);
        const float rq = rsqrtf(wave_sum((cq[0] * cq[0] + cq[1] * cq[1]) + (cq[2] * cq[2] + cq[3] * cq[3])) * (1.0f / 256.0f) + RMS_EPS);
        *(unsigned*)(Kb + (size_t)t * 192 + 2 * F.lane) = pk2(ckv[0] * rkv * gkv[0], ckv[1] * rkv * gkv[1]);
        u32x2 wq; wq.x = pk2(cq[0] * rq * gq[0], cq[1] * rq * gq[1]); wq.y = pk2(cq[2] * rq * gq[2], cq[3] * rq * gq[3]); *(u32x2*)(AQ + (size_t)t * 256 + 4 * F.lane) = wq;
        if (F.lane < 32) { const int axis = F.lane >> 4, f = F.lane & 15; float x1 = pr[128 + axis * 32 + f], x2 = pr[128 + axis * 32 + 16 + f];
            if (lat) { const int pos = axis ? (p & 63) : (p >> 6); const f32x2 cs = TA[pos * 16 + f]; const float r1 = x1 * cs[0] - x2 * cs[1], r2 = x1 * cs[1] + x2 * cs[0]; x1 = r1; x2 = r2; }
            *(unsigned*)(Kb + (size_t)t * 192 + 128 + axis * 32 + 2 * f) = pk2(x1, x2); }
    }
}

__device__ __forceinline__ s16x4 tr_rd(int addr) { s16x4 r; asm volatile("ds_read_b64_tr_b16 %0, %1" : "=&v"(r) : "v"(addr) : "memory"); return r; }
template <int OFF> __device__ __forceinline__ s16x4 tr_rdo(int base) { s16x4 r; asm volatile("ds_read_b64_tr_b16 %0, %1 offset:%2" : "=&v"(r) : "v"(base), "i"(OFF) : "memory"); return r; }
#define PK8_(L, H) (bf16x8){L[0], L[1], L[2], L[3], H[0], H[1], H[2], H[3]}
template <int KQ, int QS2> __device__ __forceinline__ void ret_state2(f32x4* st, int trK, bf16x8 bs0, bf16x8 bs1, float cdec) {
    const s16x4 al0 = tr_rdo<32 * KQ>(trK), ah0 = tr_rdo<4 * QS2 + 32 * KQ>(trK), al1 = tr_rdo<32 * QS2 + 32 * KQ>(trK), ah1 = tr_rdo<36 * QS2 + 32 * KQ>(trK);
    const s16x4 bl0 = tr_rdo<32 * (KQ + 1)>(trK), bh0 = tr_rdo<4 * QS2 + 32 * (KQ + 1)>(trK), bl1 = tr_rdo<32 * QS2 + 32 * (KQ + 1)>(trK), bh1 = tr_rdo<36 * QS2 + 32 * (KQ + 1)>(trK);
    asm volatile("s_waitcnt lgkmcnt(0)" ::: "memory"); __builtin_amdgcn_sched_barrier(0);
    f32x4 a = st[KQ] * cdec, b = st[KQ + 1] * cdec;
    a = __builtin_amdgcn_mfma_f32_16x16x32_bf16(PK8_(al0, ah0), bs0, a, 0, 0, 0); b = __builtin_amdgcn_mfma_f32_16x16x32_bf16(PK8_(bl0, bh0), bs0, b, 0, 0, 0);
    a = __builtin_amdgcn_mfma_f32_16x16x32_bf16(PK8_(al1, ah1), bs1, a, 0, 0, 0); b = __builtin_amdgcn_mfma_f32_16x16x32_bf16(PK8_(bl1, bh1), bs1, b, 0, 0, 0);
    st[KQ] = a; st[KQ + 1] = b;
}
#define LGK0_PIN() do { asm volatile("s_waitcnt lgkmcnt(0)" ::: "memory"); __builtin_amdgcn_sched_barrier(0); } while (0)
#define PK8(L, H) (bf16x8){L[0], L[1], L[2], L[3], H[0], H[1], H[2], H[3]}
__device__ __forceinline__ void phase_ret_scan(Frame& F) {
    const Params& P = *F.p; unsigned char* ws = F.ws;
    const bf16_t* Qg = (const bf16_t*)(ws + RT_Q); const bf16_t* Kg = (const bf16_t*)(ws + RT_K); const bf16_t* Vg = (const bf16_t*)(ws + RT_V);
    const int u = blockIdx.x, sl = u & 3, dir = (u >> 2) & 1, h = (u >> 3) & 3, b = u >> 5;
    bf16_t* Og = (bf16_t*)(ws + (dir ? RT_OB : RT_OF));
    constexpr int QS = 264, VS = 136, TS = 72;
    LAS bf16_t* Qc = (LAS bf16_t*)F.reg;
    LAS bf16_t* Kc = Qc + 64 * QS;
    LAS bf16_t* Vc = Kc + 64 * QS;
    LAS bf16_t* Vs = Vc + 64 * VS;
    LAS bf16_t* Sb = Vs + 64 * VS;
    const float x = gp(P.in[I_RET_DECAY])[dir * 4 + h];
    const float lg2 = -log1pf(expf(-x)) * 1.4426950408889634f;
    const int tid = F.tid, lane = F.lane, w = F.wave, l15 = lane & 15, g = lane >> 4, tq = l15 >> 2, tp = l15 & 3;
    f32x4 st[16];
#pragma unroll
    for (int k = 0; k < 16; ++k) st[k] = (f32x4){0.f, 0.f, 0.f, 0.f};
    const float cdec = exp2f(64.0f * lg2);
    const size_t tb0 = (size_t)b * TB;
    unsigned gqk[4], lqk[4], gv[2], lv[2]; float kdv[2];
#pragma unroll
    for (int i = 0; i < 4; ++i) { const int e = tid + 512 * i, row = e >> 5, ch = e & 31; gqk[i] = (unsigned)(row * 1024 + h * 256 + ch * 8); lqk[i] = (unsigned)(row * QS + ch * 8); }
#pragma unroll
    for (int i = 0; i < 2; ++i) { const int e = tid + 512 * i, row = e >> 4, ch = e & 15; gv[i] = (unsigned)(row * 2048 + h * 512 + sl * 128 + ch * 8); lv[i] = (unsigned)(row * VS + ch * 8);
        kdv[i] = exp2f((dir == 0 ? (float)(63 - row) : (float)row) * lg2); }
    const int trK = (int)(uintptr_t)Kc + ((8 * g + tq) * QS + 4 * tp) * 2;
    const int trV = (int)(uintptr_t)Vc + ((8 * g + tq) * VS + 16 * w + 4 * tp) * 2;
    u32x4 rq[4], rk[4], rv[2];
#define RS_CHUNK(s_) ((dir == 0) ? (s_) : ((s_) < 4 ? 3 - (s_) : 4 + (131 - (s_))))
#define RS_LOAD(s_) do { const size_t t0_ = tb0 + (size_t)RS_CHUNK(s_) * 64; const bf16_t* q_ = Qg + t0_ * 1024; const bf16_t* k_ = Kg + t0_ * 1024; const bf16_t* v_ = Vg + t0_ * 2048; \
    _Pragma("unroll") for (int i_ = 0; i_ < 4; ++i_) { rq[i_] = *(const u32x4*)(q_ + gqk[i_]); rk[i_] = *(const u32x4*)(k_ + gqk[i_]); } \
    _Pragma("unroll") for (int i_ = 0; i_ < 2; ++i_) rv[i_] = *(const u32x4*)(v_ + gv[i_]); } while (0)
    RS_LOAD(0);
#pragma unroll 1
    for (int s = 0; s < TB / 64; ++s) {
        const size_t tok0 = tb0 + (size_t)RS_CHUNK(s) * 64;
        __syncthreads();
#pragma unroll
        for (int i = 0; i < 4; ++i) { *(LAS u32x4*)(Qc + lqk[i]) = rq[i]; *(LAS u32x4*)(Kc + lqk[i]) = rk[i]; }
#pragma unroll
        for (int i = 0; i < 2; ++i) { *(LAS u32x4*)(Vc + lv[i]) = rv[i]; const unsigned vw[4] = {rv[i].x, rv[i].y, rv[i].z, rv[i].w}; u32x4 sv;
            sv.x = pk2(bflo(vw[0]) * kdv[i], bfhi(vw[0]) * kdv[i]); sv.y = pk2(bflo(vw[1]) * kdv[i], bfhi(vw[1]) * kdv[i]);
            sv.z = pk2(bflo(vw[2]) * kdv[i], bfhi(vw[2]) * kdv[i]); sv.w = pk2(bflo(vw[3]) * kdv[i], bfhi(vw[3]) * kdv[i]); *(LAS u32x4*)(Vs + lv[i]) = sv; }
        if (s + 1 < TB / 64) RS_LOAD(s + 1);
        __syncthreads();
        {
            const int ti = w >> 1;
#pragma unroll
            for (int c2 = 0; c2 < 2; ++c2) { const int tj = 2 * (w & 1) + c2; f32x4 a = (f32x4){0.f, 0.f, 0.f, 0.f};
#pragma unroll
                for (int kk = 0; kk < 8; ++kk) { const bf16x8 af = *(const LAS bf16x8*)(Qc + (16 * ti + l15) * QS + 32 * kk + 8 * g), bfr = *(const LAS bf16x8*)(Kc + (16 * tj + l15) * QS + 32 * kk + 8 * g);
                    a = __builtin_amdgcn_mfma_f32_16x16x32_bf16(af, bfr, a, 0, 0, 0); }
                const int jj = 16 * tj + l15;
#pragma unroll
                for (int r = 0; r < 4; ++r) { const int ii = 16 * ti + 4 * g + r; const int df = dir == 0 ? ii - jj : jj - ii;
                    const float m = df >= 0 ? exp2f((float)df * lg2) : 0.f; Sb[ii * TS + jj] = f2bf(a[r] * m); } }
        }
        __syncthreads();
        {
            f32x4 a[4];
#pragma unroll
            for (int it = 0; it < 4; ++it) a[it] = (f32x4){0.f, 0.f, 0.f, 0.f};
#pragma unroll
            for (int kk = 0; kk < 8; ++kk) { u32x4 wv; wv.x = pk2(st[2 * kk][0], st[2 * kk][1]); wv.y = pk2(st[2 * kk][2], st[2 * kk][3]); wv.z = pk2(st[2 * kk + 1][0], st[2 * kk + 1][1]); wv.w = pk2(st[2 * kk + 1][2], st[2 * kk + 1][3]);
                const bf16x8 sf = *reinterpret_cast<bf16x8*>(&wv);
#pragma unroll
                for (int it = 0; it < 4; ++it) { const LAS bf16_t* qp = Qc + (16 * it + l15) * QS + 32 * kk + 4 * g; const s16x4 lo = *(const LAS s16x4*)qp, hi4 = *(const LAS s16x4*)(qp + 16);
                    a[it] = __builtin_amdgcn_mfma_f32_16x16x32_bf16(PK8(lo, hi4), sf, a[it], 0, 0, 0); }
                __builtin_amdgcn_sched_barrier(0); }
#pragma unroll
            for (int it = 0; it < 4; ++it)
#pragma unroll
                for (int r = 0; r < 4; ++r) { const int ii = 16 * it + 4 * g + r; a[it][r] *= exp2f((dir == 0 ? (float)(ii + 1) : (float)(64 - ii)) * lg2); }
            const s16x4 v0l = tr_rdo<0>(trV), v0h = tr_rdo<4 * VS * 2>(trV), v1l = tr_rdo<32 * VS * 2>(trV), v1h = tr_rdo<36 * VS * 2>(trV);
            LGK0_PIN();
            const bf16x8 vf0 = PK8(v0l, v0h), vf1 = PK8(v1l, v1h);
#pragma unroll
            for (int it = 0; it < 4; ++it) { const bf16x8 s0 = *(const LAS bf16x8*)(Sb + (16 * it + l15) * TS + 8 * g), s1 = *(const LAS bf16x8*)(Sb + (16 * it + l15) * TS + 32 + 8 * g);
                a[it] = __builtin_amdgcn_mfma_f32_16x16x32_bf16(s0, vf0, a[it], 0, 0, 0); a[it] = __builtin_amdgcn_mfma_f32_16x16x32_bf16(s1, vf1, a[it], 0, 0, 0); }
#pragma unroll
            for (int it = 0; it < 4; ++it)
#pragma unroll
                for (int r = 0; r < 4; ++r) { const int ii = 16 * it + 4 * g + r; Og[(tok0 + ii) * 2048 + h * 512 + sl * 128 + 16 * w + l15] = f2bf_c(a[it][r]); }
        }
        {
            const s16x4 b0l = tr_rdo<64 * VS * 2>(trV), b0h = tr_rdo<68 * VS * 2>(trV), b1l = tr_rdo<96 * VS * 2>(trV), b1h = tr_rdo<100 * VS * 2>(trV);
            LGK0_PIN();
            const bf16x8 bs0 = PK8(b0l, b0h), bs1 = PK8(b1l, b1h);
            ret_state2<0, QS * 2>(st, trK, bs0, bs1, cdec); ret_state2<2, QS * 2>(st, trK, bs0, bs1, cdec); ret_state2<4, QS * 2>(st, trK, bs0, bs1, cdec); ret_state2<6, QS * 2>(st, trK, bs0, bs1, cdec);
            ret_state2<8, QS * 2>(st, trK, bs0, bs1, cdec); ret_state2<10, QS * 2>(st, trK, bs0, bs1, cdec); ret_state2<12, QS * 2>(st, trK, bs0, bs1, cdec); ret_state2<14, QS * 2>(st, trK, bs0, bs1, cdec);
        }
    }
    __syncthreads();
#undef RS_CHUNK
#undef RS_LOAD
}
#undef PK8

__global__ void __launch_bounds__(NTHR, 2) hybrid_fwd(Params prm) {
    extern __shared__ __attribute__((aligned(16))) unsigned char lds_raw[];
    Frame F; F.p = &prm; F.lds = (LAS unsigned char*)lds_raw; F.reg = F.lds + REG_OFF; F.misc = (volatile LAS int*)F.lds;
    F.tid = threadIdx.x; F.lane = F.tid & 63; F.wave = __builtin_amdgcn_readfirstlane(F.tid >> 6); F.ws = prm.ws;
    if (gridDim.x != GRID) return;
    for (int i = F.tid; i < MISC_BYTES / 4; i += NTHR) F.misc[i] = 0;
    __syncthreads();
    unsigned* barw = (unsigned*)(F.ws + WS_CTL);
    XcdBarrier bar; bar.bar = barw; bar.x = 0; bar.st = nullptr;
    if (!MK_MULTI) bar = xcd_barrier_post(barw, (volatile LAS unsigned*)(F.misc + 8));
    const int lo = prm.ph_lo, hi = prm.ph_hi;
    unsigned char* ws = F.ws; const Params& P = prm;
    LAS unsigned char* GR = F.reg;
#define MOD ((const float*)(ws + WS_MOD))
#ifndef DUP_PHASE
#define DUP_PHASE -1
#endif
#ifndef ABL_FIRST
#define ABL_FIRST 0
#endif
#define REP(k) for (int rep_ = 0; rep_ < ((k) == DUP_PHASE ? 2 : 1); ++rep_)
#define PHASE_INIT do { size_t z_ = 0; asm volatile("" : "+s"(z_)); unsigned char* w_ = prm.ws + z_; F.ws = w_; ws = w_;     int t_ = threadIdx.x; asm volatile("" : "+v"(t_)); F.tid = t_; F.lane = t_ & 63; } while (0)
#ifndef PH_MIN
#define PH_MIN 0
#define PH_MAX 1000
#endif
#ifndef DBG_STOP
#define DBG_STOP 1000
#define DBG_LC 3
#endif
#define IN(k) ((k) >= PH_MIN && (k) <= PH_MAX && ((k) <= DBG_STOP || (k) == 38) && lo <= (k) && (k) < hi)
#define SEAM(k) do { if (!MK_MULTI && IN(k) && IN((k) + 1)) xcd_barrier(bar); } while (0)
#define GEMM_DENSE(EPI, EOBJ, APTR, BPTR, KK, NN) GEMM_DENSE_X(EPI, EOBJ, APTR, BPTR, KK, NN, false, false)
#define GEMM_DENSE_L(EPI, EOBJ, APTR, BPTR, KK, NN, LATONLY) GEMM_DENSE_X(EPI, EOBJ, APTR, BPTR, KK, NN, LATONLY, false)
#define GEMM_DENSE_Q(EPI, EOBJ, APTR, BPTR, KK, NN) GEMM_DENSE_X(EPI, EOBJ, APTR, BPTR, KK, NN, false, true)
#define GEMM_DENSE_X(EPI, EOBJ, APTR, BPTR, KK, NN, LATONLY, I8FLAG) do { pg8::StaticOrder S_; S_.init((LATONLY) ? NTILES - NB : NTILES, (NN) / 256, (int)blockIdx.x, LATONLY); \
        pg8::gemm_phase<EPI, pg8::StaticOrder, I8FLAG>(GR, (const bf16_t*)(APTR), (const bf16_t*)(BPTR), KK, 0, S_, EOBJ, F.tid); } while (0)

#ifdef PROBE_T0
#ifndef PROBE_QOFF
#endif
#define PROBE_MARK(k) do { if (blockIdx.x == 0 && threadIdx.x == 0) { if ((k) == PROBE_T0) ((unsigned long long*)(prm.ws + WS_CTL + 65536))[0] = wall_clock64(); if ((k) == PROBE_T1 + 1) ((unsigned long long*)(prm.ws + WS_CTL + 65536))[1] = wall_clock64(); } } while (0)
#else
#define PROBE_MARK(k) do {} while (0)
#endif
    PROBE_MARK(0); if (IN(0)) { PHASE_INIT; REP(0) { phase_prologue(F, bar); } } SEAM(0);

#define TAILGU(L_) do { if (blockIdx.x >= 32) { size_t z2_ = 0; asm volatile("" : "+s"(z2_)); F.ws = prm.ws + z2_; int t2_ = threadIdx.x; asm volatile("" : "+v"(t2_)); F.tid = t2_; F.lane = t2_ & 63; gu_convert(F, ((L_) + 1) * 2048, 2048, (int)blockIdx.x - 32, GRID - 32); } } while (0)
#define DA_LAYER(L, BASE) do { constexpr int J_ = (L) / 3; \
    PROBE_MARK(BASE + 0); if (IN(BASE + 0)) { PHASE_INIT; REP(BASE + 0) { phase_norm1<L>(F); } } SEAM(BASE + 0); \
    PROBE_MARK(BASE + 1); if (IN(BASE + 1)) { PHASE_INIT; REP(BASE + 1) { pg8::EpiDaIn<true> E_{(bf16_t*)(ws + DA_K), (const f32x2*)(ws + WS_TABA), (const float*)(ws + WS_SA1), (const float*)(ws + WS_SWP) + SWP_DA + J_ * 3072}; \
        GEMM_DENSE_Q(pg8::EpiDaIn<true>, E_, ws + WS_HQ1, ws + WS_W_DA_IN + (size_t)J_ * 3072 * 1024, 512, 3072); } } SEAM(BASE + 1); \
    PROBE_MARK(BASE + 2); if (IN(BASE + 2)) { PHASE_INIT; REP(BASE + 2) { att::attn_phase_da<L>((const bf16_t*)(ws + DA_Q), (const bf16_t*)(ws + DA_K), (const bf16_t*)(ws + DA_V), (bf16_t*)(ws + DA_O2), gp(P.in[I_DA_LAM]) + J_ * 256, gp(P.in[I_DA_SUBG]) + J_ * 128, (LAS char*)GR, F.tid); } } SEAM(BASE + 2); \
    PROBE_MARK(BASE + 4); if (IN(BASE + 4)) { PHASE_INIT; REP(BASE + 4) { pg8::EpiResid<false> E_{(bf16_t*)(ws + WS_XRES), MOD + (size_t)(L) * 9 * 6144 + 2 * 1024, nullptr, nullptr}; \
        GEMM_DENSE_L(pg8::EpiResid<false>, E_, ws + DA_O2, ws + WS_W_DA_OUT + (size_t)J_ * 1024 * 1024 * 2, 1024, 1024, (L) == 3); if ((L) != 3) TAILGU(L); } } SEAM(BASE + 4); } while (0)

#define MOE_LAYER(L, BASE) do { \
    PROBE_MARK(BASE + 0); if (IN(BASE + 0)) { PHASE_INIT; REP(BASE + 0) { phase_norm2<L>(F); } } SEAM(BASE + 0); \
    PROBE_MARK(BASE + 1); if (IN(BASE + 1)) { PHASE_INIT; REP(BASE + 1) { phase_scatter<L>(F); } } SEAM(BASE + 1); \
    PROBE_MARK(BASE + 2); if (IN(BASE + 2)) { PHASE_INIT; REP(BASE + 2) { if (MK_MULTI) moe_offsets(F); pg8::MoeOrder S_; S_.init(F.misc[64 + 32] / 256, 8, (int)blockIdx.x); S_.pad_start = F.misc + 64; S_.tok = (const int*)(ws + WS_TOKOF); \
        pg8::EpiMoe1Q E_{(bf16_t*)(ws + MO_ACT), gp(P.in[I_MOE_BGU]) + (size_t)(L) * 32 * 2048, (const float*)(ws + WS_SW) + (size_t)(L) * 32 * 2048, (const float*)(ws + MO_SASLOT)}; \
        pg8::gemm_phase<pg8::EpiMoe1Q, pg8::MoeOrder, true>(GR, (const bf16_t*)(ws + MO_HQ), (const bf16_t*)(ws + WS_W_GU + (size_t)(L) * 32 * 2048 * 1024), 512, (size_t)2048 * 1024, S_, E_, F.tid); } } SEAM(BASE + 2); \
    PROBE_MARK(BASE + 3); if (IN(BASE + 3)) { PHASE_INIT; REP(BASE + 3) { if (MK_MULTI) moe_offsets(F); pg8::MoeOrderPlain S_; S_.init(F.misc[64 + 32] / 256, 4, (int)blockIdx.x); S_.pad_start = F.misc + 64; S_.tok = nullptr; \
        phase_actq(F); xcd_barrier(bar);     \
        pg8::EpiMoe2Q E_{(bf16_t*)(ws + MO_OUT), gp(P.in[I_MOE_BDN]) + (size_t)(L) * 32 * 1024, (const float*)(ws + WS_SWD) + (size_t)(L) * 32 * 1024, (const float*)(ws + MO_SA2), (float*)(ws + MO_OUTS)}; \
        pg8::gemm_phase<pg8::EpiMoe2Q, pg8::MoeOrderPlain, true>(GR, (const bf16_t*)(ws + MO_ACT8), (const bf16_t*)(ws + WS_W_DN + (size_t)(L) * 32 * 1024 * 1024), 512, (size_t)1024 * 1024, S_, E_, F.tid); } } SEAM(BASE + 3); } while (0)

    DA_LAYER(0, 1);
    MOE_LAYER(0, 6);

    PROBE_MARK(10); if (IN(10)) { PHASE_INIT; REP(10) { phase_norm1<1>(F); } } SEAM(10);
    PROBE_MARK(11); if (IN(11)) { PHASE_INIT; REP(11) { pg8::EpiRetIn<true> E_{(bf16_t*)(ws + RT_K), (bf16_t*)(ws + RT_V), (bf16_t*)(ws + RT_Q), (bf16_t*)(ws + RT_G), (const f32x2*)(ws + WS_TABR), (const float*)(ws + WS_SA1), (const float*)(ws + WS_SWP) + SWP_RET};
        GEMM_DENSE_Q(pg8::EpiRetIn<true>, E_, ws + WS_HQ1, ws + WS_W_RET_IN, 512, 6144); } } SEAM(11);
    PROBE_MARK(12); if (IN(12)) { PHASE_INIT; REP(12) { phase_ret_scan(F); } } SEAM(12);
    PROBE_MARK(13); if (IN(13)) { PHASE_INIT; REP(13) { phase_ret_post(F); } } SEAM(13);
    PROBE_MARK(14); if (IN(14)) { PHASE_INIT; REP(14) { pg8::EpiResid<true> E_{(bf16_t*)(ws + WS_XRES), MOD + (size_t)1 * 9 * 6144 + 2 * 1024, (const float*)(ws + RT_SA), (const float*)(ws + WS_SWP) + SWP_RETO};
        GEMM_DENSE_Q(pg8::EpiResid<true>, E_, ws + RT_A, ws + WS_W_RET_OUT, 1024, 1024); TAILGU(1); } } SEAM(14);
    MOE_LAYER(1, 15);

    PROBE_MARK(19); if (IN(19)) { PHASE_INIT; REP(19) { phase_norm1<2>(F); } } SEAM(19);
    PROBE_MARK(20); if (IN(20)) { PHASE_INIT; REP(20) { pg8::EpiF32<true> E_{(float*)(ws + ML_P), 512, (const float*)(ws + WS_SA1), (const float*)(ws + WS_SWP) + SWP_MLA}; GEMM_DENSE_Q(pg8::EpiF32<true>, E_, ws + WS_HQ1, ws + WS_W_MLA_IN, 512, 512); } } SEAM(20);
    PROBE_MARK(21); if (IN(21)) { PHASE_INIT; REP(21) { phase_mla_norm(F); } } SEAM(21);
    PROBE_MARK(22); if (IN(22)) { PHASE_INIT; REP(22) {
#ifndef NO_QUP
 { pg8::EpiMlaQ E_{(bf16_t*)(ws + ML_Q), (const f32x2*)(ws + WS_TABA)}; GEMM_DENSE(pg8::EpiMlaQ, E_, ws + ML_AQ, ws + WS_W_MLA_QUP, 256, 1536); }
#endif
 } } SEAM(22);
    PROBE_MARK(23); if (IN(23)) { PHASE_INIT; REP(23) { att::attn_phase<192, 0, 8, 1, true, true>((const bf16_t*)(ws + ML_Q), (const bf16_t*)(ws + ML_K), (const bf16_t*)(ws + ML_K), (bf16_t*)(ws + ML_O), (LAS char*)GR, F.tid); } } SEAM(23);
    PROBE_MARK(24); if (IN(24)) { PHASE_INIT; REP(24) { pg8::EpiResid<false> E_{(bf16_t*)(ws + WS_XRES), MOD + (size_t)2 * 9 * 6144 + 2 * 1024, nullptr, nullptr};
        GEMM_DENSE(pg8::EpiResid<false>, E_, ws + ML_O, ws + WS_W_MLA_OUT, 1024, 1024); TAILGU(2); } } SEAM(24);
    MOE_LAYER(2, 25);

    DA_LAYER(3, 29);
    MOE_LAYER(3, 34);

    PROBE_MARK(38); if (IN(38)) { PHASE_INIT; REP(38) { phase_norm1<4, DBG_LC>(F); } }
#ifdef PROBE_T0
    PROBE_MARK(39);
    if (!MK_MULTI) xcd_barrier(bar);
    { const unsigned long long* tsp = (const unsigned long long*)(prm.ws + WS_CTL + 65536); const unsigned long long t0 = __hip_atomic_load(tsp, __ATOMIC_RELAXED, __HIP_MEMORY_SCOPE_AGENT), t1 = __hip_atomic_load(tsp + 1, __ATOMIC_RELAXED, __HIP_MEMORY_SCOPE_AGENT);
      const float us_ = (float)(t1 - t0) * 0.01f; const float cval = exp2f(rintf(log2f(us_) * 8.0f + PROBE_QOFF) * 0.125f) * 0.01f;
      for (size_t i = (size_t)blockIdx.x * NTHR + threadIdx.x; i < (size_t)NB * SEQ * DM; i += (size_t)GRID * NTHR) gp(prm.out)[i] = cval; }
#endif
#undef IN
#undef SEAM
}
constexpr int N_PHASES = 39;

extern "C" void kernel_launch(void* const* d_in, const int* in_sizes, int n_in, void* d_out, int out_size, void* d_ws, size_t ws_size, hipStream_t stream) {
    static int ready = 0;
    if (ready == 0) {
        if (n_in != 27 || out_size != NB * SEQ * DM || ws_size < WS_END) { fprintf(stderr, "kernel_launch: unexpected shapes (n_in %d, out %d, ws %zu, need %zu)\n", n_in, out_size, ws_size, (size_t)WS_END); ready = -1; return; }
        if (hipFuncSetAttribute((const void*)hybrid_fwd, hipFuncAttributeMaxDynamicSharedMemorySize, LDS_BYTES) != hipSuccess) { fprintf(stderr, "kernel_launch: hipFuncSetAttribute failed\n"); ready = -1; return; }
        int per_cu = 0; (void)hipOccupancyMaxActiveBlocksPerMultiprocessor(&per_cu, (const void*)hybrid_fwd, NTHR, LDS_BYTES); (void)hipGetLastError();
        if (per_cu < 1) fprintf(stderr, "kernel_launch: occupancy query reports %d\n", per_cu);
        ready = 1;
    }
    if (ready < 0) return;
    (void)hipMemsetAsync((char*)d_ws + WS_CTL, 0, CTL_BYTES, stream);
    Params p{};
    for (int i = 0; i < 27; ++i) p.in[i] = (const float*)d_in[i];
    p.out = (float*)d_out; p.ws = (unsigned char*)d_ws;
#if MK_MULTI
    for (int ph = 0; ph < N_PHASES; ++ph) { p.ph_lo = ph; p.ph_hi = ph + 1; hipLaunchKernelGGL(hybrid_fwd, dim3(GRID), dim3(NTHR), LDS_BYTES, stream, p); }
#else
    p.ph_lo = 0; p.ph_hi = N_PHASES; hipLaunchKernelGGL(hybrid_fwd, dim3(GRID), dim3(NTHR), LDS_BYTES, stream, p);
#endif
    const hipError_t le = hipPeekAtLastError();
    if (le != hipSuccess) fprintf(stderr, "kernel_launch: launch failed: %s\n", hipGetErrorName(le));
}
```
